# Optimizing an MI355X kernel written in HIP

```python
import math
import jax, jax.numpy as jnp
from jax import lax
import numpy as np

D_MODEL = 1024
BATCH = 16
SEQ = 2048
DEPTH = 2

GRID_W = 64
CTX_LEN = 256

D_HY = D_MODEL // 4
D_HG = D_MODEL // 2
D_FN = D_MODEL // 4
D_MIX = D_HY + D_HG + D_FN

HY_ORDER = 2
HY_SHORT_CONV = 3
HY_BANDS = 16
HY_EMB_DIM = 1 + 2 * HY_BANDS
HY_FILTER_HIDDEN = 64
HY_DECAY_TARGET = 1e-2
HY_FAST_DECAY_PCT = 0.3
HY_SLOW_DECAY_PCT = 1.5
D_HY_PROJ = (HY_ORDER + 1) * D_HY

HG_HEAD_DIM = 128
HG_HEADS = D_HG // HG_HEAD_DIM
HG_CHUNK = 64
HG_PROJ = 5 * D_HG

FN_GROUPS = 4
FN_GROUP_DIM = D_FN // FN_GROUPS

D_PROJ = D_HY_PROJ + HG_PROJ + D_FN

N_EXPERTS = 16
N_GROUPS = 4
EXPERTS_PER_GROUP = N_EXPERTS // N_GROUPS
TOP_K = 2
D_EXPERT = 512

N_MOD = 6
RMS_EPS = 1e-6
POS_BASE = 10000.0

kernel_name = "hybrid_hyena_hgrn2_fnet_moe_dit"


def rmsnorm(x, g):
    xf = x.astype(jnp.float32)
    y = xf * lax.rsqrt(jnp.mean(xf * xf, axis=-1, keepdims=True) + RMS_EPS)
    return (y * g.astype(jnp.float32)).astype(x.dtype)


def modulate(h, shift, scale):
    return h * (1 + scale) + shift


def ada_modulation(cond, w, b):
    return jnp.split(jax.nn.silu(cond) @ w + b, N_MOD, axis=-1)


def grid_sincos(n_tok):
    rows = n_tok // GRID_W
    row = jnp.repeat(jnp.arange(rows, dtype=jnp.float32), GRID_W)
    col = jnp.tile(jnp.arange(GRID_W, dtype=jnp.float32), rows)
    quarter = D_MODEL // 4
    omega = 1.0 / (POS_BASE ** (jnp.arange(quarter, dtype=jnp.float32) / quarter))
    ar = row[:, None] * omega
    ac = col[:, None] * omega
    return jnp.concatenate([jnp.sin(ar), jnp.cos(ar), jnp.sin(ac), jnp.cos(ac)], axis=-1)


def short_conv3(u, w, b):
    up = jnp.pad(u, ((0, 0), (1, 1), (0, 0)))
    return up[:, :-2] * w[0] + up[:, 1:-1] * w[1] + up[:, 2:] * w[2] + b


def hyena_deltas():
    max_decay = math.log(HY_DECAY_TARGET) / HY_FAST_DECAY_PCT
    min_decay = math.log(HY_DECAY_TARGET) / HY_SLOW_DECAY_PCT
    return jnp.linspace(min_decay, max_decay, D_HY, dtype=jnp.float32)


def hyena_filters(L, w1, b1, w2, b2, w3, freq):
    f32 = jnp.float32
    t = jnp.linspace(0.0, 1.0, L, dtype=f32)[:, None]
    w = 2.0 * math.pi * jnp.arange(L, dtype=f32)[:, None] / L
    bands = jnp.linspace(1e-4, HY_BANDS - 1, HY_BANDS, dtype=f32)[None, :]
    z = jnp.concatenate([t, jnp.cos(bands * w), -jnp.sin(bands * w)], axis=-1)
    fr = freq.astype(f32)
    h = jnp.sin(fr * (z @ w1.astype(f32) + b1.astype(f32)))
    h = jnp.sin(fr * (h @ w2.astype(f32) + b2.astype(f32)))
    h = (h @ w3.astype(f32)).reshape(L, 2 * HY_ORDER, D_HY)
    decay = jnp.exp(-t[:, :, None] * jnp.abs(hyena_deltas()))
    return h * decay


def bidir_fftconv(u, h_fwd, h_bwd, skip):
    L, C = h_fwd.shape
    k = jnp.concatenate([h_fwd, jnp.zeros((1, C), jnp.float32), h_bwd[1:][::-1]], axis=0)
    uf = jnp.fft.rfft(u.astype(jnp.float32), n=2 * L, axis=1)
    kf = jnp.fft.rfft(k, n=2 * L, axis=0)
    y = jnp.fft.irfft(uf * kf[None], n=2 * L, axis=1)[:, :L]
    return (y + u.astype(jnp.float32) * skip.astype(jnp.float32)).astype(u.dtype)


def hyena_mixer(z, conv_w, conv_b, w1, b1, w2, b2, w3, freq, bias, norm_g):
    L = z.shape[1]
    u = short_conv3(z, conv_w, conv_b)
    v, x1, x2 = jnp.split(u, HY_ORDER + 1, axis=-1)
    h = hyena_filters(L, w1, b1, w2, b2, w3, freq)
    y = x1 * bidir_fftconv(v, h[:, 0], h[:, 1], bias[0])
    y = x2 * bidir_fftconv(y, h[:, 2], h[:, 3], bias[1])
    return rmsnorm(y, norm_g)


def fourier_mixer(z, w, b, norm_g):
    B, L, _ = z.shape
    zg = z.astype(jnp.float32).reshape(B, L, FN_GROUPS, FN_GROUP_DIM)
    y = jnp.fft.fftn(zg, axes=(1, 3), norm="ortho").real
    y = jnp.einsum("blgc,gcd->blgd", y, w.astype(jnp.float32)).reshape(B, L, D_FN) + b.astype(jnp.float32)
    return rmsnorm(y.astype(z.dtype), norm_g)


def hgrn_lower_bounds(raw):
    cs = jnp.cumsum(jax.nn.softmax(raw.astype(jnp.float32), axis=0), axis=0)
    return cs - cs[0:1]


def hgrn2_inputs(z, lb):
    B, L, _ = z.shape
    q, f_fwd, f_bwd, i, g = jnp.split(z.astype(jnp.float32), 5, axis=-1)
    heads = lambda t: t.reshape(B, L, HG_HEADS, HG_HEAD_DIM)
    q = heads(jax.nn.silu(q)) * (HG_HEAD_DIM ** -0.5)
    dirs = []
    for d, f_raw in enumerate((f_fwd, f_bwd)):
        lbd = lb[d]
        forget = lbd + (1.0 - lbd) * jax.nn.sigmoid(f_raw)
        dirs.append((heads(1.0 - forget), heads(jnp.log(forget))))
    return q, heads(i), g, dirs


def to_chunks(t):
    B, L, H, d = t.shape
    return t.reshape(B, L // HG_CHUNK, HG_CHUNK, H, d).transpose(1, 0, 3, 2, 4)


def from_chunks(t):
    n, B, H, C, d = t.shape
    return t.transpose(1, 0, 3, 2, 4).reshape(B, n * C, H, d)


def gla_chunk_scan(q, k, v, logf, s0):
    causal = jnp.tril(jnp.ones((HG_CHUNK, HG_CHUNK), dtype=bool))

    def step(s, inp):
        qc, kc, vc, gc = inp
        b = jnp.cumsum(gc, axis=2)
        o_inter = jnp.einsum("bhtd,bhdv->bhtv", qc * jnp.exp(b), s)
        diff = b[:, :, :, None, :] - b[:, :, None, :, :]
        decay = jnp.exp(jnp.where(causal[:, :, None], diff, -jnp.inf))
        scores = jnp.einsum("bhtd,bhsd,bhtsd->bhts", qc, kc, decay)
        o_intra = jnp.einsum("bhts,bhsv->bhtv", scores, vc)
        b_end = b[:, :, -1, :]
        s_new = jnp.exp(b_end)[..., None] * s + jnp.einsum(
            "bhsd,bhsv->bhdv", kc * jnp.exp(b_end[:, :, None, :] - b), vc)
        return s_new, o_inter + o_intra

    s_fin, o = lax.scan(step, s0, (to_chunks(q), to_chunks(k), to_chunks(v), to_chunks(logf)))
    return s_fin, from_chunks(o)


def hgrn2_bidir(q, v, dirs, s0_fwd, s0_bwd):
    (k_f, g_f), (k_b, g_b) = dirs
    s_f, o_f = gla_chunk_scan(q, k_f, v, g_f, s0_fwd)
    flip = lambda t: t[:, ::-1]
    s_b, o_b = gla_chunk_scan(flip(q), flip(k_b), flip(v), flip(g_b), s0_bwd)
    return s_f, s_b, o_f + flip(o_b)


def hgrn2_readout(o, g, norm_g):
    B, L, H, d = o.shape
    on = o * lax.rsqrt(jnp.mean(o * o, axis=-1, keepdims=True) + RMS_EPS)
    return on.reshape(B, L, D_HG) * norm_g.astype(jnp.float32) * jax.nn.silu(g)


def mixer_output(z, o_hg, g_hg, w_out, conv_w, conv_b, w1, b1, w2, b2, w3, freq,
                 hy_bias, hy_norm_g, hg_norm_g, fn_w, fn_b, fn_norm_g):
    y_hy = hyena_mixer(z[..., :D_HY_PROJ], conv_w, conv_b, w1, b1, w2, b2, w3, freq, hy_bias, hy_norm_g)
    y_hg = hgrn2_readout(o_hg, g_hg, hg_norm_g).astype(z.dtype)
    y_fn = fourier_mixer(z[..., D_HY_PROJ + HG_PROJ:], fn_w, fn_b, fn_norm_g)
    return jnp.concatenate([y_hy, y_hg, y_fn], axis=-1) @ w_out


def moe_ffn(h, router_w, router_b, w_gate, w_up, w_down):
    N = h.shape[0]
    probs = jax.nn.softmax(h.astype(jnp.float32) @ router_w.astype(jnp.float32), axis=-1)
    sel = probs + router_b.astype(jnp.float32)
    group_score = lax.top_k(sel.reshape(N, N_GROUPS, EXPERTS_PER_GROUP), TOP_K)[0].sum(-1)
    best_group = jnp.argmax(group_score, axis=-1)
    in_group = (jnp.arange(N_EXPERTS) // EXPERTS_PER_GROUP)[None, :] == best_group[:, None]
    _, idx = lax.top_k(jnp.where(in_group, sel, -jnp.inf), TOP_K)
    gp = jnp.take_along_axis(probs, idx, axis=-1)
    gp = gp / jnp.sum(gp, axis=-1, keepdims=True)
    combine = jnp.sum(jax.nn.one_hot(idx, N_EXPERTS, dtype=jnp.float32) * gp[..., None], axis=1)
    out = jnp.zeros(h.shape, jnp.float32)
    for e in range(N_EXPERTS):
        he = (jax.nn.silu(h @ w_gate[e]) * (h @ w_up[e])) @ w_down[e]
        out = out + combine[:, e:e + 1] * he.astype(jnp.float32)
    return out.astype(h.dtype)


def setup_inputs(seed: int = 0) -> dict:
    key = jax.random.key(seed)
    ks = jax.random.split(key, 32)
    f32 = jnp.float32
    nrm = lambda k, shape, s: s * jax.random.normal(k, shape, f32)
    D = D_MODEL
    return {
        "x": nrm(ks[0], (BATCH, SEQ, D), 1.0),
        "c": nrm(ks[1], (BATCH, D), 1.0),
        "ctx": nrm(ks[2], (BATCH, CTX_LEN, D), 1.0),
        "c_ctx": nrm(ks[3], (D,), 1.0),
        "ada_w": nrm(ks[4], (DEPTH, D, N_MOD * D), 0.5 * D ** -0.5),
        "ada_b": nrm(ks[5], (DEPTH, N_MOD * D), 0.02),
        "norm1_g": 1.0 + nrm(ks[6], (DEPTH, D), 0.1),
        "norm2_g": 1.0 + nrm(ks[7], (DEPTH, D), 0.1),
        "w_in": nrm(ks[8], (DEPTH, D, D_PROJ), D ** -0.5),
        "w_out": nrm(ks[9], (DEPTH, D_MIX, D), D_MIX ** -0.5),
        "hy_conv_w": nrm(ks[10], (DEPTH, HY_SHORT_CONV, D_HY_PROJ), 0.5),
        "hy_conv_b": nrm(ks[11], (DEPTH, D_HY_PROJ), 0.02),
        "hy_filt_w1": nrm(ks[12], (DEPTH, HY_EMB_DIM, HY_FILTER_HIDDEN), HY_EMB_DIM ** -0.5),
        "hy_filt_b1": nrm(ks[13], (DEPTH, HY_FILTER_HIDDEN), 0.02),
        "hy_filt_w2": nrm(ks[14], (DEPTH, HY_FILTER_HIDDEN, HY_FILTER_HIDDEN), HY_FILTER_HIDDEN ** -0.5),
        "hy_filt_b2": nrm(ks[15], (DEPTH, HY_FILTER_HIDDEN), 0.02),
        "hy_filt_w3": nrm(ks[16], (DEPTH, HY_FILTER_HIDDEN, 2 * HY_ORDER * D_HY), HY_FILTER_HIDDEN ** -0.5),
        "hy_filt_freq": 1.0 + nrm(ks[17], (DEPTH, HY_FILTER_HIDDEN), 0.1),
        "hy_bias": nrm(ks[18], (DEPTH, HY_ORDER, D_HY), 0.5),
        "hy_norm_g": 1.0 + nrm(ks[19], (DEPTH, D_HY), 0.1),
        "hg_lower_bounds": nrm(ks[20], (DEPTH, 2, D_HG), 1.0),
        "hg_norm_g": 1.0 + nrm(ks[21], (DEPTH, D_HG), 0.1),
        "fn_w": nrm(ks[22], (DEPTH, FN_GROUPS, FN_GROUP_DIM, FN_GROUP_DIM), FN_GROUP_DIM ** -0.5),
        "fn_b": nrm(ks[23], (DEPTH, D_FN), 0.02),
        "fn_norm_g": 1.0 + nrm(ks[24], (DEPTH, D_FN), 0.1),
        "router_w": nrm(ks[25], (D, N_EXPERTS), D ** -0.5),
        "router_b": nrm(ks[26], (N_EXPERTS,), 0.01),
        "moe_w_gate": nrm(ks[27], (DEPTH, N_EXPERTS, D, D_EXPERT), D ** -0.5),
        "moe_w_up": nrm(ks[28], (DEPTH, N_EXPERTS, D, D_EXPERT), D ** -0.5),
        "moe_w_down": nrm(ks[29], (DEPTH, N_EXPERTS, D_EXPERT, D), D_EXPERT ** -0.5),
        "final_norm_g": 1.0 + nrm(ks[30], (D,), 0.1),
    }


def reference(x, c, ctx, c_ctx, ada_w, ada_b, norm1_g, norm2_g, w_in, w_out, hy_conv_w, hy_conv_b,
              hy_filt_w1, hy_filt_b1, hy_filt_w2, hy_filt_b2, hy_filt_w3, hy_filt_freq, hy_bias, hy_norm_g,
              hg_lower_bounds, hg_norm_g, fn_w, fn_b, fn_norm_g, router_w, router_b,
              moe_w_gate, moe_w_up, moe_w_down, final_norm_g):
    B, L, D = x.shape
    n_ctx = ctx.shape[1]
    lower_bounds = hgrn_lower_bounds(hg_lower_bounds)
    x = x + grid_sincos(L).astype(x.dtype)[None]
    cond_x = c[:, None, :]
    cond_c = c_ctx[None, None, :]
    s_zero = jnp.zeros((B, HG_HEADS, HG_HEAD_DIM, HG_HEAD_DIM), jnp.float32)
    hg_lo, hg_hi = D_HY_PROJ, D_HY_PROJ + HG_PROJ
    for layer in range(DEPTH):
        last = layer == DEPTH - 1
        mod_x = ada_modulation(cond_x, ada_w[layer], ada_b[layer])
        mod_c = ada_modulation(cond_c, ada_w[layer], ada_b[layer])
        mix_params = (w_out[layer], hy_conv_w[layer], hy_conv_b[layer], hy_filt_w1[layer], hy_filt_b1[layer],
                      hy_filt_w2[layer], hy_filt_b2[layer], hy_filt_w3[layer], hy_filt_freq[layer],
                      hy_bias[layer], hy_norm_g[layer], hg_norm_g[layer], fn_w[layer], fn_b[layer], fn_norm_g[layer])
        hx = modulate(rmsnorm(x, norm1_g[layer]), mod_x[0], mod_x[1])
        hc = modulate(rmsnorm(ctx, norm1_g[layer]), mod_c[0], mod_c[1])
        zx = hx @ w_in[layer]
        zc = hc @ w_in[layer]
        q_c, v_c, g_c, dirs_c = hgrn2_inputs(zc[..., hg_lo:hg_hi], lower_bounds[layer])
        s_f, s_b, o_c = hgrn2_bidir(q_c, v_c, dirs_c, s_zero, s_zero)
        q_x, v_x, g_x, dirs_x = hgrn2_inputs(zx[..., hg_lo:hg_hi], lower_bounds[layer])
        _, _, o_x = hgrn2_bidir(q_x, v_x, dirs_x, s_f, s_b)
        x = x + mod_x[2] * mixer_output(zx, o_x, g_x, *mix_params)
        hx2 = modulate(rmsnorm(x, norm2_g[layer]), mod_x[3], mod_x[4])
        if last:
            ff_x = moe_ffn(hx2.reshape(B * L, D), router_w, router_b,
                           moe_w_gate[layer], moe_w_up[layer], moe_w_down[layer])
        else:
            ctx = ctx + mod_c[2] * mixer_output(zc, o_c, g_c, *mix_params)
            hc2 = modulate(rmsnorm(ctx, norm2_g[layer]), mod_c[3], mod_c[4])
            ff = moe_ffn(jnp.concatenate([hc2.reshape(B * n_ctx, D), hx2.reshape(B * L, D)], axis=0),
                         router_w, router_b, moe_w_gate[layer], moe_w_up[layer], moe_w_down[layer])
            ctx = ctx + mod_c[5] * ff[:B * n_ctx].reshape(B, n_ctx, D)
            ff_x = ff[B * n_ctx:]
        x = x + mod_x[5] * ff_x.reshape(B, L, D)
    return rmsnorm(x, final_norm_g)
```

```cpp
#include <hip/hip_runtime.h>
#include <cstdio>
#include <cstdint>
#include <stdint.h>
#include <math.h>

#ifndef HD
#ifdef CPU_SHIM
#define HD
#else
#define HD __host__ __device__ __forceinline__
#endif
#endif

typedef unsigned short bf16s;
HD float bf2f(bf16s v) { union { unsigned u; float f; } c; c.u = ((unsigned)v) << 16; return c.f; }
HD bf16s f2bf(float f) { union { unsigned u; float f; } c; c.f = f; unsigned u = c.u; u += 0x7FFFu + ((u >> 16) & 1u); return (bf16s)(u >> 16); }
HD float ldv(const float* p) { return *p; }
HD float ldv(const bf16s* p) { return bf2f(*p); }
HD void stv(float* p, float v) { *p = v; }
HD void stv(bf16s* p, float v) { *p = f2bf(v); }
HD float silu_f(float x) { return x / (1.f + expf(-x)); }
HD float sigm_f(float x) { return 1.f / (1.f + expf(-x)); }

#ifdef CPU_SHIM
static inline int atomic_add_i(int* p, int v) { int o = *p; *p = o + v; return o; }
static inline void atomic_add_f(float* p, float v) { *p += v; }
#else
__device__ __forceinline__ int atomic_add_i(int* p, int v) { return atomicAdd(p, v); }
__device__ __forceinline__ void atomic_add_f(float* p, float v) { unsafeAtomicAdd(p, v); }
#endif

struct DimsFull {
    static constexpr int D = 1024, B = 16, L = 2048, NC = 256, DEPTH = 2, GRID_W = 64;
    static constexpr int C = 256  , DHG = 512, CFN = 256, NB = 16, EMB = 33, FH = 64;
    static constexpr int HDIM = 128, H = 4, G = 4, GD = 64;
    static constexpr int DP = 3 * C + 5 * DHG + CFN;
    static constexpr int ZW = 3 * C + 5 * DHG + 2 * CFN;
    static constexpr int E = 16, NG = 4, EPG = 4, DE = 512;
    static constexpr int RB = 8, BB = 8, MPAD = 256;
    typedef bf16s st;
};
#ifdef CPU_SHIM
struct DimsTest {
    static constexpr int D = 64, B = 2, L = 64, NC = 16, DEPTH = 2, GRID_W = 8;
    static constexpr int C = 16, DHG = 32, CFN = 16, NB = 4, EMB = 9, FH = 8;
    static constexpr int HDIM = 8, H = 4, G = 2, GD = 8;
    static constexpr int DP = 3 * C + 5 * DHG + CFN;
    static constexpr int ZW = 3 * C + 5 * DHG + 2 * CFN;
    static constexpr int E = 16, NG = 4, EPG = 4, DE = 16;
    static constexpr int RB = 8, BB = 2, MPAD = 8;
#ifdef TEST_BF16
    typedef bf16s st;
#else
    typedef float st;
#endif
};
#endif

template <class Dm> struct Params {
    typedef typename Dm::st st;
    const float *x, *c, *ctx, *c_ctx, *ada_w, *ada_b, *norm1_g, *norm2_g, *w_in, *w_out, *hy_conv_w, *hy_conv_b, *hy_w1, *hy_b1, *hy_w2, *hy_b2, *hy_w3, *hy_freq,
        *hy_bias, *hy_norm_g, *hg_lb, *hg_norm_g, *fn_w, *fn_b, *fn_norm_g, *router_w, *router_b, *moe_wg, *moe_wu, *moe_wd, *final_g;
    float* out;
    float* cw;
    float* mod;
    float* lbv;
    float* wcs;
    float* wfn;
    float* hf1;
    float* hf2;
    float* hfil;
    float* rs;
    st* hx;
    st* z;
    st* zh_c; st* zh_x;
    st* pq_c; st* pq_x;
    st* krt_c; st* krt_x;
    st* y1t_c; st* y1t_x; st* y2t_c; st* y2t_x;
    st* dft_c; st* dft_x;
    st* uv;
    st* y1;
    st* y2;
    st* o;
    st* ob;
    st* vit;
    st* yfn;
    int* ridx;
    float* rgp;
    int* cnt;
    int* perm;
    int* rrank;
    int* rpos;
    int* wgbase;
    st* hmid;
};

template <class Dm> struct NV {
    typedef Params<Dm> P;
    typedef typename Dm::st st;
    static constexpr int D = Dm::D, B = Dm::B, L = Dm::L, NC = Dm::NC, C = Dm::C, DHG = Dm::DHG, CFN = Dm::CFN, ZW = Dm::ZW, DP = Dm::DP;
    static constexpr int RC = B * NC, RX = B * L, RALL = RC + RX;
    static constexpr int ZS = 4 * DHG, OFF_Q = 0, OFF_FF = DHG, OFF_FB = 2 * DHG, OFF_G = 3 * DHG;
    static constexpr float EPS = 1e-6f;
    static constexpr float TWO_PI = 6.283185307179586f;

    static HD float* xrow(const P& p, int R) { return R < RC ? p.cw + (size_t)R * D : p.out + (size_t)(R - RC) * D; }
    static HD int row_b(int R) { return R < RC ? R / NC : (R - RC) / L; }
    static HD int row_l(int R) { return R < RC ? R % NC : (R - RC) % L; }
    static HD int row_modr(int R) { return R < RC ? B : (R - RC) / L; }
    static HD int row_of(int isx, int b, int l) { return isx ? RC + b * L + l : b * NC + l; }
    static HD const float* modp(const P& p, int layer, int mr, int which) { return p.mod + ((size_t)(layer * (B + 1) + mr) * 6 + which) * D; }

    static HD void p_pro_a(const P& p, long tid, long nth) {
        for (long i = tid; i < 2 * DHG; i += nth) {
            float mx = -1e30f;
            for (int l = 0; l < Dm::DEPTH; ++l) mx = fmaxf(mx, p.hg_lb[l * 2 * DHG + i]);
            float den = 0.f;
            for (int l = 0; l < Dm::DEPTH; ++l) den += expf(p.hg_lb[l * 2 * DHG + i] - mx);
            float cs = 0.f;
            for (int l = 0; l < Dm::DEPTH; ++l) { if (l > 0) cs += expf(p.hg_lb[l * 2 * DHG + i] - mx) / den; p.lbv[l * 2 * DHG + i] = cs; }
        }
        for (long i = tid; i < (long)Dm::DEPTH * Dm::G * Dm::GD * 2 * Dm::GD; i += nth) {
            const int GD = Dm::GD; const int d2 = (int)(i % (2 * GD)), c = (int)((i / (2 * GD)) % GD), g = (int)((i / (2 * GD * GD)) % Dm::G), layer = (int)(i / ((long)2 * GD * GD * Dm::G));
            const int d = d2 % GD, sn = d2 / GD;
            const float* w = p.fn_w + ((size_t)(layer * Dm::G + g) * GD) * GD + d;
            float acc = 0.f;
            for (int m = 0; m < GD; ++m) { const int cm = (c * m) % GD;
                const float ang = TWO_PI * (float)cm / (float)GD; acc += (sn ? __sinf(ang) : __cosf(ang)) * w[(size_t)m * GD]; }
            p.wcs[i] = acc;
        }
        for (long i = tid; i < (long)Dm::DEPTH * (NC + L) * Dm::FH; i += nth) {
            const int j = (int)(i % Dm::FH), ll = (int)((i / Dm::FH) % (NC + L)), layer = (int)(i / ((long)Dm::FH * (NC + L)));
            const int Lw = ll < NC ? NC : L, l = ll < NC ? ll : ll - NC;
            const float t = (float)l / (float)(Lw - 1), wv = TWO_PI * (float)l / (float)Lw;
            const float* w1 = p.hy_w1 + (size_t)layer * Dm::EMB * Dm::FH + j;
            float acc = t * w1[0];
            for (int bi = 0; bi < Dm::NB; ++bi) {
                const float band = 1e-4f + (float)bi * ((float)(Dm::NB - 1) - 1e-4f) / (float)(Dm::NB - 1);
                acc += cosf(band * wv) * w1[(size_t)(1 + bi) * Dm::FH] - sinf(band * wv) * w1[(size_t)(1 + Dm::NB + bi) * Dm::FH];
            }
            acc += p.hy_b1[layer * Dm::FH + j];
            p.hf1[i] = sinf(p.hy_freq[layer * Dm::FH + j] * acc);
        }
    }
    static HD void p_pro_b(const P& p, long tid, long nth) {
        for (long i = tid; i < (long)Dm::DEPTH * (NC + L) * Dm::FH; i += nth) {
            const int j = (int)(i % Dm::FH), layer = (int)(i / ((long)Dm::FH * (NC + L)));
            const float* h1 = p.hf1 + (i / Dm::FH) * Dm::FH;
            const float* w2 = p.hy_w2 + (size_t)layer * Dm::FH * Dm::FH + j;
            float acc = 0.f;
            for (int k = 0; k < Dm::FH; ++k) acc += h1[k] * w2[(size_t)k * Dm::FH];
            acc += p.hy_b2[layer * Dm::FH + j];
            p.hf2[i] = sinf(p.hy_freq[layer * Dm::FH + j] * acc);
        }
        for (long i = tid; i < (long)Dm::DEPTH * D * 2 * CFN; i += nth) {
            const int GD = Dm::GD; const int j = (int)(i % (2 * CFN)), k = (int)((i / (2 * CFN)) % D), layer = (int)(i / ((long)2 * CFN * D));
            const int sn = j / CFN, g = (j % CFN) / GD, d = j % GD;
            const float* wi = p.w_in + ((size_t)layer * D + k) * DP + 3 * C + 5 * DHG + g * GD;
            const float* wc = p.wcs + ((size_t)(layer * Dm::G + g) * GD) * 2 * GD + sn * GD + d;
            float acc = 0.f;
            for (int c = 0; c < GD; ++c) acc += wi[c] * wc[(size_t)c * 2 * GD];
            p.wfn[i] = acc;
        }
    }
    static HD void p_pro_c(const P& p, long tid, long nth) {
        const float max_decay = logf(1e-2f) / 0.3f, min_decay = logf(1e-2f) / 1.5f;
        for (long i = tid; i < (long)Dm::DEPTH * (NC + L) * 4 * C; i += nth) {
            const int oc = (int)(i % (4 * C)), ll = (int)((i / (4 * C)) % (NC + L)), layer = (int)(i / ((long)4 * C * (NC + L)));
            const int Lw = ll < NC ? NC : L, l = ll < NC ? ll : ll - NC, c = oc % C;
            const float t = (float)l / (float)(Lw - 1);
            const float* h2 = p.hf2 + (i / (4 * C)) * Dm::FH;
            const float* w3 = p.hy_w3 + (size_t)layer * Dm::FH * 4 * C + oc;
            float acc = 0.f;
            for (int k = 0; k < Dm::FH; ++k) acc += h2[k] * w3[(size_t)k * 4 * C];
            const float delta = min_decay + (max_decay - min_decay) * (float)c / (float)(C - 1);
            p.hfil[i] = acc * expf(-t * fabsf(delta));
        }
    }
    static HD float shortconv(const P& p, int layer, int R, int pc) {
        const int l = row_l(R), Lw = R < RC ? NC : L;
        const float* cwt = p.hy_conv_w + (size_t)layer * 3 * 3 * C + pc;
        const st* zr = R < RC ? p.zh_c + (size_t)pc * RC + R : p.zh_x + (size_t)pc * RX + (R - RC);
        float v = ldv(zr) * cwt[3 * C] + p.hy_conv_b[layer * 3 * C + pc];
        if (l > 0) v += ldv(zr - 1) * cwt[0];
        if (l < Lw - 1) v += ldv(zr + 1) * cwt[2 * 3 * C];
        return v;
    }
    static HD void p_uv(const P& p, int layer, int r0, long tid, long nth) {
        for (long i = (long)r0 * C + tid; i < (long)RALL * C; i += nth) { const int R = (int)(i / C), c = (int)(i % C); stv(p.uv + i, shortconv(p, layer, R, c)); }
    }
    static HD float hy_k(const P& p, int layer, int isx, int order, int d, int c) {
        const float* hf = p.hfil + ((size_t)layer * (NC + L) + (isx ? NC : 0)) * 4 * C;
        float v = d >= 0 ? hf[(size_t)d * 4 * C + (2 * order) * C + c] : hf[(size_t)(-d) * 4 * C + (2 * order + 1) * C + c];
        if (d == 0) v += p.hy_bias[(layer * 2 + order) * C + c];
        return v;
    }
    static HD void p_hyconv(const P& p, int layer, int order, int r0, long tid, long nth) {
        constexpr int BB = Dm::BB;
        const st* in = p.y1; st* outp = order == 0 ? p.y1 : p.y2;
        const long nc_items = (long)(B / BB) * NC * C, nx_items = (long)(B / BB) * L * C;
        for (long i = (r0 >= RC ? nc_items : 0) + tid; i < nc_items + nx_items; i += nth) {
            const int isx = i >= nc_items; const long ii = isx ? i - nc_items : i; const int Lw = isx ? L : NC;
            const int c = (int)(ii % C), t = (int)((ii / C) % Lw), b0 = (int)(ii / ((long)C * Lw)) * BB;
            float acc[BB];
#pragma unroll
            for (int r = 0; r < BB; ++r) acc[r] = 0.f;
            for (int s = 0; s < Lw; ++s) { const float kv = hy_k(p, layer, isx, order, t - s, c);
#pragma unroll
                for (int r = 0; r < BB; ++r) acc[r] += kv * (order == 0 ? shortconv(p, layer, row_of(isx, b0 + r, s), c) : ldv(in + (size_t)row_of(isx, b0 + r, s) * C + c)); }
#pragma unroll
            for (int r = 0; r < BB; ++r) { const int R = row_of(isx, b0 + r, t); stv(outp + (size_t)R * C + c, acc[r] * shortconv(p, layer, R, (order + 1) * C + c)); }
        }
    }
    static HD void p_hgscan(const P& p, long tid, long nth) {
        constexpr int HDM = Dm::HDIM;
        for (long i = tid; i < (long)B * Dm::H * HDM; i += nth) {
            const int v = (int)(i % HDM), h = (int)((i / HDM) % Dm::H), b = (int)(i / ((long)HDM * Dm::H));
            for (int dir = 0; dir < 2; ++dir) {
                float S[HDM];
#pragma unroll
                for (int d = 0; d < HDM; ++d) S[d] = 0.f;
                for (int seg = 0; seg < 2; ++seg) {
                    const int Lw = seg ? L : NC;
                    for (int tt = 0; tt < Lw; ++tt) {
                        const int t = dir ? Lw - 1 - tt : tt; const int R = row_of(seg, b, t);
                        const st* zr = p.z + (size_t)R * ZS;
                        const float vv = ldv(p.vit + (size_t)(h * HDM + v) * RALL + R);
                        const st* lf = zr + (dir ? OFF_FB : OFF_FF) + h * HDM; const st* q = zr + OFF_Q + h * HDM;
                        float o = 0.f;
#pragma unroll
                        for (int d = 0; d < HDM; ++d) { const float f = expf(ldv(lf + d)); S[d] = f * S[d] + (1.f - f) * vv; o += S[d] * ldv(q + d); }
                        stv((dir ? p.ob : p.o) + (size_t)R * DHG + h * HDM + v, o);
                    }
                }
            }
        }
    }
    static HD void p_moe_reset(const P& p, long tid, long nth) {
        for (long i = tid; i < 32; i += nth) p.cnt[i] = 0;
        for (long i = tid; i < (long)2 * RALL + Dm::E * Dm::MPAD; i += nth) p.perm[i] = -1;
    }
    static HD int moe_off(const P& p, int e) {
        int o = 0;
        for (int j = 0; j < e; ++j) o += (p.cnt[j] + Dm::MPAD - 1) / Dm::MPAD * Dm::MPAD;
        return o;
    }
    static HD void p_place(const P& p, int r0, long tid, long nth) {
        for (long ts = (long)r0 * 2 + tid; ts < (long)RALL * 2; ts += nth) {
            const int e = p.ridx[ts];
            const int pos = moe_off(p, e) + atomic_add_i(p.cnt + 16 + e, 1);
            p.perm[pos] = (int)ts;
        }
    }
    static HD void p_gather_dummy(const P&) {}
    static HD int moe_expert_of_unused(const P& p, int pos) { int e = 0; while (e + 1 < Dm::E && pos >= moe_off(p, e + 1)) ++e; return e; }
};
#define LAS __attribute__((address_space(3)))
typedef short bf16x8 __attribute__((ext_vector_type(8)));
typedef float f32x4 __attribute__((ext_vector_type(4)));
typedef float f32x2 __attribute__((ext_vector_type(2)));
typedef unsigned u32x4 __attribute__((ext_vector_type(4)));
typedef unsigned u32x2 __attribute__((ext_vector_type(2)));
typedef DimsFull DmF; typedef NV<DmF> NVF; typedef Params<DmF> PF;
constexpr int NTHREADS = 512;
constexpr int STAGE_BYTES = 131072;
constexpr int LDS_MISC_OFF = 143360;
constexpr int LDS_BYTES = LDS_MISC_OFF + 1024;

__device__ __forceinline__ unsigned cvt_pk_bf16(float lo, float hi) { unsigned r; asm volatile("v_cvt_pk_bf16_f32 %0, %1, %2" : "=v"(r) : "v"(lo), "v"(hi)); return r; }
__device__ __forceinline__ int tidx() { int t = threadIdx.x; asm volatile("" : "+v"(t)); return t; }
__device__ __forceinline__ void lds_barrier() { asm volatile("s_waitcnt lgkmcnt(0)" ::: "memory"); __builtin_amdgcn_s_barrier(); asm volatile("" ::: "memory"); }
__device__ __forceinline__ float fast_silu(float x) { return x * __builtin_amdgcn_rcpf(1.f + __expf(-x)); }

#ifndef REP_EPI
#define REP_EPI 1
#endif
#ifndef RELAX_WAITS
#define RELAX_WAITS 0
#endif
namespace pg8 {
constexpr int BM = 256, BK = 64, HALF = 128, HTB = HALF * BK * 2;
__host__ __device__ __forceinline__ int lds_byte(int r, int c) { const int st = (r >> 4) * 2 + (c >> 5), rr = r & 15, cc = c & 31, ob = rr * 64 + cc * 2; return st * 1024 + (ob ^ (((ob >> 9) & 1) << 5)); }
__host__ __device__ __forceinline__ void stage_rc(int b, int& R, int& C) { const int st = b / 1024, sb = b % 1024, swz = sb ^ (((sb >> 9) & 1) << 5); R = (st >> 1) * 16 + swz / 64; C = (st & 1) * 32 + (swz % 64) / 2; }
__host__ __device__ __forceinline__ int perm32(int rho) { const int n = rho >> 4, i = rho & 15; return 8 * (i >> 2) + 4 * n + (i & 3); }
struct Unit { const char* a; const char* b; int i0, i1, i2, i3; const int* rows; };
struct Gemm { int K, lda, ldb; int* diag = nullptr; };
template <class Epi, class Sched, bool ALIGN_EPI = true, bool GATHER = false>
__device__ __forceinline__ void gemm_phase(LAS unsigned char* lds, const Gemm g, const Sched& S, const Epi& E) {
    const int tid = tidx(), wid = __builtin_amdgcn_readfirstlane(tid >> 6), lane = tid & 63, wr = wid >> 2, wc = wid & 3, fr = lane & 15, fq = lane >> 4;
    const int K = g.K, nt = K / BK;
    unsigned voffA[2], voffB[2];
#pragma unroll
    for (int i = 0; i < 2; ++i) { int R, C; stage_rc(tid * 16 + i * 8192, R, C); const int Rb = Epi::PERM ? ((R & ~31) + perm32(R & 31)) : R;
        voffA[i] = (unsigned)(R * g.lda + C) * 2u; voffB[i] = (unsigned)(Rb * g.ldb + C) * 2u; }
    const size_t kstep = (size_t)(BK * 2);
    const size_t hstepA = (size_t)HALF * g.lda * 2, hstepB = (size_t)HALF * g.ldb * 2;
    const unsigned ldsw = (unsigned)wid * 1024u;
    const int aoff = lds_byte(wr * 64 + fr, fq * 8), boff = lds_byte(wc * 32 + fr, fq * 8);
#define PG8_SA(b, h) (((b) * 2 + (h)) * HTB)
#define PG8_SB(b, h) ((4 + (b) * 2 + (h)) * HTB)
#define PG8_STAGE(bufoff, gbase, voff) do { _Pragma("unroll") for (int _i = 0; _i < 2; ++_i) \
        __builtin_amdgcn_global_load_lds((const unsigned*)((const char*)(gbase) + (voff)[_i]), (LAS unsigned*)(lds + (bufoff) + ldsw + _i * 8192), 16, 0, 0); } while (0)
#define PG8_TAB(k) (STAGE_BYTES + ((k) & 1) * 1024)
#define PG8_TABLOAD(k, u) do { if (wid == 0) __builtin_amdgcn_global_load_lds((const unsigned*)((u).rows + lane * 4), (LAS unsigned*)(lds + PG8_TAB(k)), 16, 0, 0); } while (0)
#define PG8_STAGEA(bufoff, gbase, h, k) do { if constexpr (GATHER) { _Pragma("unroll") for (int _i = 0; _i < 2; ++_i) { \
            const int ts_ = *(const LAS int*)(lds + PG8_TAB(k) + ((h) * 128 + (int)(voffA[_i] >> 11)) * 4); \
            __builtin_amdgcn_global_load_lds((const unsigned*)((const char*)(gbase) + ((unsigned)(ts_ < 0 ? 0 : ts_ >> 1) << 11) + (voffA[_i] & 2047u)), (LAS unsigned*)(lds + (bufoff) + ldsw + _i * 8192), 16, 0, 0); } } \
        else { PG8_STAGE(bufoff, (gbase) + (h) * hstepA, voffA); } } while (0)
#define PG8_LDA(dst, b, h) do { _Pragma("unroll") for (int m = 0; m < 4; ++m) _Pragma("unroll") for (int k = 0; k < 2; ++k) dst[m][k] = *(const LAS bf16x8*)(lds + PG8_SA(b, h) + aoff + m * 2048 + k * 1024); } while (0)
#define PG8_LDB(dst, b, h) do { _Pragma("unroll") for (int n = 0; n < 2; ++n) _Pragma("unroll") for (int k = 0; k < 2; ++k) dst[n][k] = *(const LAS bf16x8*)(lds + PG8_SB(b, h) + boff + n * 2048 + k * 1024); } while (0)
#define PG8_MMA(ai, bj, At, Bt) do { __builtin_amdgcn_s_setprio(1); _Pragma("unroll") for (int m = 0; m < 4; ++m) _Pragma("unroll") for (int n = 0; n < 2; ++n) _Pragma("unroll") for (int k = 0; k < 2; ++k) \
        acc[ai][bj][m][n] = __builtin_amdgcn_mfma_f32_16x16x32_bf16(Bt[n][k], At[m][k], acc[ai][bj][m][n], 0, 0, 0); __builtin_amdgcn_s_setprio(0); } while (0)
#define PG8_WAIT_V(n) asm volatile("s_waitcnt vmcnt(" #n ")" ::: "memory")
#define PG8_WAIT_V8R_(N) asm volatile("s_cmp_lg_u32 %0, 0\n\ts_cbranch_scc1 .Lrn%=\n\ts_cmp_eq_u32 %1, 0\n\ts_cbranch_scc1 .Lrn%=\n\ts_waitcnt vmcnt(" #N ")\n\ts_branch .Lrd%=\n.Lrn%=:\n\ts_waitcnt vmcnt(8)\n.Lrd%=:" :: "s"(t), "s"(ui) : "memory", "scc")
#define PG8_WAIT_V8R() do { if constexpr (!RELAX_WAITS) asm volatile("s_waitcnt vmcnt(8)" ::: "memory"); else if constexpr (Epi::NST == 16) PG8_WAIT_V8R_(24); else PG8_WAIT_V8R_(16); } while (0)
#define PG8_WAIT_L(n) asm volatile("s_waitcnt lgkmcnt(" #n ")" ::: "memory")
#define PG8_BAR __builtin_amdgcn_s_barrier()
#define PG8_SCHED __builtin_amdgcn_sched_barrier(0)
    Unit cur, nxt; int ui = 0;
    if (!S.next(0, cur)) return;
    f32x4 acc[2][2][4][2];
#pragma unroll
    for (int a = 0; a < 2; ++a)
#pragma unroll
        for (int b = 0; b < 2; ++b)
#pragma unroll
            for (int m = 0; m < 4; ++m)
#pragma unroll
                for (int n = 0; n < 2; ++n) acc[a][b][m][n] = (f32x4){0.f, 0.f, 0.f, 0.f};
    bf16x8 At[4][2], B0[2][2], B1[2][2];
    const char* cA = cur.a; const char* cB = cur.b;
    if constexpr (GATHER) { PG8_TABLOAD(0, cur); PG8_WAIT_V(0); __syncthreads(); }
    PG8_STAGE(PG8_SB(0, 0), cB, voffB); PG8_STAGE(PG8_SB(0, 1), cB + hstepB, voffB); PG8_STAGEA(PG8_SA(0, 0), cA, 0, 0); PG8_STAGEA(PG8_SA(0, 1), cA, 1, 0);
    if (wr == 1) PG8_BAR;
    PG8_WAIT_V(2); PG8_BAR;
    PG8_STAGE(PG8_SB(1, 0), cB + kstep, voffB); PG8_STAGEA(PG8_SA(1, 0), cA + kstep, 0, 0); PG8_STAGE(PG8_SB(1, 1), cB + hstepB + kstep, voffB);
    PG8_WAIT_V(6); PG8_BAR;
#ifdef DIAG_GEMMTIME
    unsigned long long tk_ = 0, te_ = 0, t0_ = 0, t1_ = 0;
#endif
    for (;;) {
        const bool has_next = S.next(ui + 1, nxt);
        const char* nA = has_next ? nxt.a : cA; const char* nB = has_next ? nxt.b : cB;
        const int kn = has_next ? ui + 1 : ui;
        if constexpr (GATHER) { if (has_next) PG8_TABLOAD(ui + 1, nxt); }
#ifdef DIAG_GEMMTIME
        t0_ = wall_clock64();
#endif
        for (int t = 0; t < nt; t += 2) {
            const bool last = (t == nt - 2);
            const char* a1 = cA + (size_t)(t + 1) * kstep;
            const char* a2 = last ? nA : cA + (size_t)(t + 2) * kstep; const char* b2 = last ? nB : cB + (size_t)(t + 2) * kstep;
            const char* a3 = a2 + kstep; const char* b3 = b2 + kstep;
            const int kl = last ? kn : ui;
            PG8_LDB(B0, 0, 0); PG8_LDB(B1, 0, 1); PG8_SCHED; PG8_LDA(At, 0, 0); PG8_STAGEA(PG8_SA(1, 1), a1, 1, ui);
            PG8_WAIT_V8R(); PG8_WAIT_L(0); PG8_BAR; PG8_MMA(0, 0, At, B0); PG8_MMA(0, 1, At, B1); PG8_BAR; PG8_SCHED;
            PG8_LDA(At, 0, 1); PG8_STAGE(PG8_SB(0, 0), b2, voffB); PG8_STAGE(PG8_SB(0, 1), b2 + hstepB, voffB); PG8_STAGEA(PG8_SA(0, 0), a2, 0, kl);
            PG8_WAIT_V8R(); PG8_WAIT_L(0); PG8_BAR; PG8_MMA(1, 0, At, B0); PG8_MMA(1, 1, At, B1); PG8_BAR; PG8_SCHED;
            PG8_LDB(B0, 1, 0); PG8_LDB(B1, 1, 1); PG8_SCHED; PG8_LDA(At, 1, 0); PG8_STAGEA(PG8_SA(0, 1), a2, 1, kl);
            PG8_WAIT_V8R(); PG8_WAIT_L(0); PG8_BAR; PG8_MMA(0, 0, At, B0); PG8_MMA(0, 1, At, B1); PG8_BAR; PG8_SCHED;
            PG8_LDA(At, 1, 1); PG8_STAGE(PG8_SB(1, 0), b3, voffB); PG8_STAGE(PG8_SB(1, 1), b3 + hstepB, voffB); PG8_STAGEA(PG8_SA(1, 0), a3, 0, kl);
            PG8_WAIT_V(8); PG8_WAIT_L(0); PG8_BAR; PG8_MMA(1, 0, At, B0); PG8_MMA(1, 1, At, B1); PG8_BAR; PG8_SCHED;
        }
#ifdef DIAG_GEMMTIME
        t1_ = wall_clock64(); tk_ += t1_ - t0_;
#endif
        if constexpr (ALIGN_EPI) { if (wr == 0) PG8_BAR; }
        for (int re_ = 0; re_ < (Epi::PERM ? REP_EPI : 1); ++re_) E(acc, cur, wr, wc, fr, fq);
#ifdef DIAG_GEMMTIME
        te_ += wall_clock64() - t1_;
        if (!has_next && g.diag && blockIdx.x == DIAG_BLOCK && tid == 0) { g.diag[0] = (int)tk_; g.diag[1] = (int)te_; g.diag[2] = ui + 1; }
#endif
        if (!has_next) break;
#pragma unroll
        for (int a = 0; a < 2; ++a)
#pragma unroll
            for (int b = 0; b < 2; ++b)
#pragma unroll
                for (int m = 0; m < 4; ++m)
#pragma unroll
                    for (int n = 0; n < 2; ++n) acc[a][b][m][n] = (f32x4){0.f, 0.f, 0.f, 0.f};
        cur = nxt; cA = nA; cB = nB; ++ui;
        if constexpr (ALIGN_EPI) { if (wr == 1) PG8_BAR; }
    }
    PG8_WAIT_V(0);
    if constexpr (!ALIGN_EPI) { if (wr == 0) PG8_BAR; }
    PG8_BAR;
#undef PG8_SA
#undef PG8_SB
#undef PG8_STAGE
#undef PG8_LDA
#undef PG8_STAGEA
#undef PG8_TAB
#undef PG8_TABLOAD
#undef PG8_LDB
#undef PG8_MMA
#undef PG8_WAIT_V
#undef PG8_WAIT_L
#undef PG8_WAIT_V8R
#undef PG8_WAIT_V8R_
#undef PG8_BAR
#undef PG8_SCHED
}
}

struct FastWs {
    bf16s* wt_in;
    bf16s* wt_out;
    bf16s* wt_gu;
    bf16s* wt_d;
    bf16s* hxs;
};

struct Deal { int x, j, W; __device__ __forceinline__ void init() { const int G = gridDim.x, c = blockIdx.x; x = c & 7; j = c >> 3; W = (G + 7) >> 3; } };

struct XpJob { const float* src; int sld, k0, n0; bf16s* dst; int dld, drow0; };
__device__ __forceinline__ void xpose_load(const XpJob& j, int t, f32x4 (&v)[2]) {
#pragma unroll
    for (int ps = 0; ps < 2; ++ps) { const int k = (t >> 4) + 32 * ps, n4 = (t & 15) * 4; v[ps] = *(const f32x4*)(j.src + (size_t)(j.k0 + k) * j.sld + j.n0 + n4); }
}
__device__ __forceinline__ void xpose_store(LAS float* tile, const XpJob& j, int t, const f32x4 (&v)[2]) {
#pragma unroll
    for (int ps = 0; ps < 2; ++ps) { const int k = (t >> 4) + 32 * ps, n4 = (t & 15) * 4;
        tile[k * 65 + n4 + 0] = v[ps][0]; tile[k * 65 + n4 + 1] = v[ps][1]; tile[k * 65 + n4 + 2] = v[ps][2]; tile[k * 65 + n4 + 3] = v[ps][3]; }
    lds_barrier();
    { const int n = t >> 3, k8 = (t & 7) * 8; u32x4 w;
      w.x = cvt_pk_bf16(tile[(k8 + 0) * 65 + n], tile[(k8 + 1) * 65 + n]); w.y = cvt_pk_bf16(tile[(k8 + 2) * 65 + n], tile[(k8 + 3) * 65 + n]);
      w.z = cvt_pk_bf16(tile[(k8 + 4) * 65 + n], tile[(k8 + 5) * 65 + n]); w.w = cvt_pk_bf16(tile[(k8 + 6) * 65 + n], tile[(k8 + 7) * 65 + n]);
      *(u32x4*)(j.dst + (size_t)(j.drow0 + n) * j.dld + j.k0 + k8) = w; }
    lds_barrier();
}
__device__ __forceinline__ XpJob job_inout(const PF& p, const FastWs& f, int layer, int it) {
    constexpr int D = DmF::D, T_IN = (3328 / 64) * (D / 64), T_FN = (512 / 64) * (D / 64);
    int r = it;
    if (r < T_IN) { const int nt = r / (D / 64), kt = r % (D / 64); return XpJob{p.w_in + (size_t)layer * D * DmF::DP, DmF::DP, kt * 64, nt * 64, f.wt_in, D, nt * 64}; } r -= T_IN;
    if (r < T_FN) { const int nt = r / (D / 64), kt = r % (D / 64); return XpJob{p.wfn + (size_t)layer * D * 512, 512, kt * 64, nt * 64, f.wt_in, D, 3328 + nt * 64}; } r -= T_FN;
    { const int nt = r / (D / 64), kt = r % (D / 64); return XpJob{p.w_out + (size_t)layer * D * D, D, kt * 64, nt * 64, f.wt_out, D, nt * 64}; }
}
__device__ __forceinline__ void f_cvt_inout(const PF& p, const FastWs& f, int layer, LAS unsigned char* lds) {
    LAS float* tile = (LAS float*)lds; const int t = tidx();
    constexpr int D = DmF::D, NT = (3328 / 64) * (D / 64) + (512 / 64) * (D / 64) + (D / 64) * (D / 64);
    int it = blockIdx.x; if (it >= NT) return;
    XpJob cur = job_inout(p, f, layer, it); f32x4 v[2]; xpose_load(cur, t, v);
    for (;;) { const int nx = it + (int)gridDim.x; const bool more = nx < NT; XpJob nj = cur; f32x4 nvv[2];
        if (more) { nj = job_inout(p, f, layer, nx); xpose_load(nj, t, nvv); }
        xpose_store(tile, cur, t, v);
        if (!more) break;
        cur = nj; v[0] = nvv[0]; v[1] = nvv[1]; it = nx; }
}
__device__ __forceinline__ XpJob job_moe(const PF& p, const FastWs& f, int layer, int it) {
    constexpr int D = DmF::D, DE = DmF::DE, TG = (DE / 64) * (D / 64)  , TD = (D / 64) * (DE / 64)  , PER_E = 2 * TG + TD;
    const int e = it / PER_E; int r = it % PER_E;
    if (r < 2 * TG) { const int up = r / TG; r %= TG; const int nt = r / (D / 64), kt = r % (D / 64); const int n0 = nt * 64;
        const float* src = (up ? p.moe_wu : p.moe_wg) + ((size_t)(layer * DmF::E + e) * D) * DE;
        return XpJob{src, DE, kt * 64, n0, f.wt_gu + (size_t)e * 1024 * D, D, (n0 / 128) * 256 + up * 128 + (n0 % 128)}; }
    r -= 2 * TG;
    { const int nt = r / (DE / 64), kt = r % (DE / 64);
      return XpJob{p.moe_wd + ((size_t)(layer * DmF::E + e) * DE) * D, D, kt * 64, nt * 64, f.wt_d + (size_t)e * D * DE, DE, nt * 64}; }
}
__device__ __forceinline__ void f_cvt_moe(const PF& p, const FastWs& f, int layer, LAS unsigned char* lds, int rank, int nwork) {
    LAS float* tile = (LAS float*)lds; const int t = tidx();
    constexpr int NT = DmF::E * (2 * 128 + 128);
    int it = rank; if (it < 0 || it >= NT) return;
    XpJob cur = job_moe(p, f, layer, it); f32x4 v[2]; xpose_load(cur, t, v);
    for (;;) { const int nx = it + nwork; const bool more = nx < NT; XpJob nj = cur; f32x4 nvv[2];
        if (more) { nj = job_moe(p, f, layer, nx); xpose_load(nj, t, nvv); }
        xpose_store(tile, cur, t, v);
        if (!more) break;
        cur = nj; v[0] = nvv[0]; v[1] = nvv[1]; it = nx; }
}

struct EpiInproj {
    static constexpr bool PERM = true; static constexpr int NST = 16;
    bf16s* z; bf16s* zh_c; bf16s* zh_x; bf16s* pq_c; bf16s* pq_x; bf16s* vit; const float* lbv;
    __device__ __forceinline__ void operator()(const f32x4 (&acc)[2][2][4][2], const pg8::Unit& u, int wr, int wc, int fr, int fq) const {
        const int tile = u.i1, pm = u.i0;
        if (u.i2) {
            const int tk = wc * 32 + 8 * fq;
            bf16s* base; size_t cstride;
            if (tile == 9 || tile == 10) { base = vit + (size_t)(tile - 9) * 256 * NVF::RALL + pm * 256; cstride = NVF::RALL; }
            else if (tile < 3) { if (pm < 16) { base = zh_c + (size_t)tile * 256 * NVF::RC + pm * 256; cstride = NVF::RC; } else { base = zh_x + (size_t)tile * 256 * NVF::RX + (pm - 16) * 256; cstride = NVF::RX; } }
            else { const int sn = tile - 13;
                if (pm < 16) { base = pq_c + ((size_t)pm * 256 * 2 + sn) * 256; cstride = 2 * 256; }
                else { const int b = (pm - 16) >> 3, l0 = ((pm - 16) & 7) * 256; base = pq_x + ((size_t)b * 256 * 2 + sn) * 2048 + l0; cstride = 2 * 2048; } }
#pragma unroll
            for (int ai = 0; ai < 2; ++ai)
#pragma unroll
                for (int m = 0; m < 4; ++m) { bf16s* rowp = base + (size_t)(ai * 128 + wr * 64 + m * 16 + fr) * cstride + tk;
#pragma unroll
                    for (int bj = 0; bj < 2; ++bj) { const f32x4 v0 = acc[ai][bj][m][0], v1 = acc[ai][bj][m][1];
                        u32x4 w; w.x = cvt_pk_bf16(v0[0], v0[1]); w.y = cvt_pk_bf16(v0[2], v0[3]); w.z = cvt_pk_bf16(v1[0], v1[1]); w.w = cvt_pk_bf16(v1[2], v1[3]);
                        *(u32x4*)(rowp + bj * 128) = w; } }
            return;
        }
        const int row0 = pm * 256 + wr * 64 + fr; const int colt = (tile < 9 ? tile - 3 : tile - 5) * 256 + wc * 32 + 8 * fq;
        const int kind = tile < 5 ? 1 : tile < 9 ? 2 : 3;
        const float qs = 0.08838834764831845f;
#pragma unroll
        for (int bj = 0; bj < 2; ++bj) {
            const int col = colt + bj * 128;
            float lb[8];
            if (kind == 2) { const float* lp = lbv + (col - NVF::OFF_FF);
#pragma unroll
                for (int j = 0; j < 8; ++j) lb[j] = 1.f - lp[j]; }
#pragma unroll
            for (int ai = 0; ai < 2; ++ai)
#pragma unroll
                for (int m = 0; m < 4; ++m) {
                    float v[8];
#pragma unroll
                    for (int j = 0; j < 4; ++j) { v[j] = acc[ai][bj][m][0][j]; v[4 + j] = acc[ai][bj][m][1][j]; }
                    if (kind == 1) {
#pragma unroll
                        for (int j = 0; j < 8; ++j) v[j] = fast_silu(v[j]) * qs;
                    } else if (kind == 2) {
#pragma unroll
                        for (int j = 0; j < 8; ++j) { const float k = lb[j] * __builtin_amdgcn_rcpf(1.f + __expf(v[j])); v[j] = fmaxf(__logf(1.f - k), -30.f); }
                    } else if (kind == 3) {
#pragma unroll
                        for (int j = 0; j < 8; ++j) v[j] = fast_silu(v[j]);
                    }
                    u32x4 w; w.x = cvt_pk_bf16(v[0], v[1]); w.y = cvt_pk_bf16(v[2], v[3]); w.z = cvt_pk_bf16(v[4], v[5]); w.w = cvt_pk_bf16(v[6], v[7]);
                    *(u32x4*)(z + (size_t)(row0 + ai * 128 + m * 16) * NVF::ZS + col) = w;
                }
        }
    }
};
struct SchedInproj {
    const bf16s* hx; const bf16s* wt; int last; Deal d;
    __device__ __forceinline__ bool next(int i, pg8::Unit& u) const {
        if (d.W != 32) return next_generic(i, u);
        int r = i; const int s = d.j;
        int seen = -1;
        for (r = 0; r <= 8; ++r) { if (valid(r, s)) { if (++seen == i) break; } }
        if (r > 8) return false;
        fill(r, s, u); return true;
    }
#ifndef INPROJ_PB
#define INPROJ_PB 2
#endif
    static constexpr int PB = INPROJ_PB, TBITS = 5 - PB, TPR = 1 << TBITS, RPG = 16 >> TBITS  ;
    __device__ __forceinline__ bool valid(int r, int s) const { if (r < 8) return ((r & (RPG - 1)) * TPR + (s & (TPR - 1))) < 15; const int tile = s & 15; return last ? (tile >= 3 && tile <= 12) : (tile < 15); }
    __device__ __forceinline__ void fill(int r, int s, pg8::Unit& u) const {
        int pm, tile;
        if (r < 8) { tile = (r & (RPG - 1)) * TPR + (s & (TPR - 1)); pm = 16 + d.x * 16 + (1 << PB) * (r / RPG) + (s >> TBITS); } else { tile = s & 15; pm = d.x * 2 + (s >> 4); }
        const char* pa = (const char*)(hx + (size_t)pm * 256 * DmF::D); const char* pb = (const char*)(wt + (size_t)tile * 256 * DmF::D); const bool sw = tile < 3 || tile >= 13 || tile == 9 || tile == 10;
        u.a = sw ? pb : pa; u.b = sw ? pa : pb; u.i0 = pm; u.i1 = tile; u.i2 = sw ? 1 : 0; u.i3 = 0; u.rows = nullptr;
    }
    __device__ __forceinline__ bool next_generic(int i, pg8::Unit& u) const {
        const int nx = 128 * 15, nc = last ? 160 : 240; const int li = i * (int)gridDim.x + (int)blockIdx.x; if (li >= nx + nc) return false;
        int pm, tile; if (li < nx) { pm = 16 + li / 15; tile = li % 15; } else { const int q = li - nx; if (last) { pm = q / 10; tile = 3 + q % 10; } else { pm = q / 15; tile = q % 15; } }
        const char* pa = (const char*)(hx + (size_t)pm * 256 * DmF::D); const char* pb = (const char*)(wt + (size_t)tile * 256 * DmF::D); const bool sw = tile < 3 || tile >= 13 || tile == 9 || tile == 10;
        u.a = sw ? pb : pa; u.b = sw ? pa : pb; u.i0 = pm; u.i1 = tile; u.i2 = sw ? 1 : 0; u.i3 = 0; u.rows = nullptr; return true;
    }
};
__device__ __forceinline__ void f_inproj(const PF& p, const FastWs& f, int layer, int last, LAS unsigned char* lds) {
    SchedInproj S; S.hx = p.hx; S.wt = f.wt_in; S.last = last; S.d.init();
    EpiInproj E{p.z, p.zh_c, p.zh_x, p.pq_c, p.pq_x, p.vit, p.lbv + layer * 2 * DmF::DHG};
#ifndef INPROJ_ALIGN
#define INPROJ_ALIGN true
#endif
#ifdef DIAG_GEMMTIME
    pg8::gemm_phase<EpiInproj, SchedInproj, INPROJ_ALIGN>(lds, pg8::Gemm{DmF::D, DmF::D, DmF::D, layer == 0 ? p.cnt + 48 : nullptr}, S, E);
#else
    pg8::gemm_phase<EpiInproj, SchedInproj, INPROJ_ALIGN>(lds, pg8::Gemm{DmF::D, DmF::D, DmF::D}, S, E);
#endif
}

struct EpiWout {
    static constexpr bool PERM = false; static constexpr int NST = 8;
    float* cw; float* out; const float* mod; float scale;
    __device__ __forceinline__ void operator()(const f32x4 (&acc)[2][2][4][2], const pg8::Unit& u, int wr, int wc, int fr, int fq) const {
        const int pm = u.i0; const int col0 = u.i1 * 256 + wc * 32 + 4 * fq;
        const int mr = pm < 16 ? DmF::B : (pm - 16) / 8;
        float* base = pm < 16 ? cw + (size_t)pm * 256 * DmF::D : out + (size_t)(pm - 16) * 256 * DmF::D;
        const float* gate = mod + ((size_t)mr * 6 + 2) * DmF::D;
        f32x4 gv[2][2];
#pragma unroll
        for (int bj = 0; bj < 2; ++bj)
#pragma unroll
            for (int n = 0; n < 2; ++n) gv[bj][n] = *(const f32x4*)(gate + col0 + bj * 128 + n * 16) * scale;
#pragma unroll
        for (int ai = 0; ai < 2; ++ai)
#pragma unroll
            for (int m0 = 0; m0 < 4; m0 += 2) { f32x4 old[2][2][2];
#pragma unroll
                for (int mm = 0; mm < 2; ++mm) { const float* rowp = base + (size_t)(ai * 128 + wr * 64 + (m0 + mm) * 16 + fr) * DmF::D + col0;
#pragma unroll
                    for (int bj = 0; bj < 2; ++bj)
#pragma unroll
                        for (int n = 0; n < 2; ++n) old[mm][bj][n] = *(const f32x4*)(rowp + bj * 128 + n * 16); }
#pragma unroll
                for (int mm = 0; mm < 2; ++mm) { float* rowp = base + (size_t)(ai * 128 + wr * 64 + (m0 + mm) * 16 + fr) * DmF::D + col0;
#pragma unroll
                    for (int bj = 0; bj < 2; ++bj)
#pragma unroll
                        for (int n = 0; n < 2; ++n) *(f32x4*)(rowp + bj * 128 + n * 16) = old[mm][bj][n] + gv[bj][n] * acc[ai][bj][m0 + mm][n]; } }
    }
};
struct SchedWout {
    const bf16s* mix; const bf16s* wt; int p0; Deal d;
    __device__ __forceinline__ bool next(int i, pg8::Unit& u) const {
        const int ppx = (144 - p0) >> 3; const int li = i * d.W + d.j; if (li >= ppx * 4) return false;
        const int pm = p0 + d.x * ppx + (li >> 2), tile = li & 3;
        u.a = (const char*)(mix + (size_t)pm * 256 * DmF::D); u.b = (const char*)(wt + (size_t)tile * 256 * DmF::D); u.i0 = pm; u.i1 = tile; u.i2 = 0; u.i3 = 0; u.rows = nullptr;
        return true;
    }
};
__device__ __forceinline__ void f_wout(const PF& p, const FastWs& f, int layer, int r0, LAS unsigned char* lds, float scale = 1.f) {
    SchedWout S; S.mix = p.hx; S.wt = f.wt_out; S.p0 = r0 / 256; S.d.init();
    EpiWout E{p.cw, p.out, p.mod + (size_t)layer * (DmF::B + 1) * 6 * DmF::D, scale};
#ifndef WOUT_ALIGN
#define WOUT_ALIGN true
#endif
    pg8::gemm_phase<EpiWout, SchedWout, WOUT_ALIGN>(lds, pg8::Gemm{DmF::D, DmF::D, DmF::D}, S, E);
}

__device__ __forceinline__ void f_gather(const PF& p, const FastWs& f) {
    const int total = NVF::moe_off(p, DmF::E);
    const long items = (long)total * 128;
    for (long i = (long)blockIdx.x * NTHREADS + tidx(); i < items; i += (long)gridDim.x * NTHREADS) {
        const int pos = (int)(i >> 7), ch = (int)(i & 127); const int ts = p.perm[pos];
        u32x4 v = (u32x4){0u, 0u, 0u, 0u};
        if (ts >= 0) v = *(const u32x4*)(p.hx + (size_t)(ts >> 1) * DmF::D + ch * 8);
        *(u32x4*)(f.hxs + (size_t)pos * DmF::D + ch * 8) = v;
    }
}
struct SchedMoe {
    const char* abase; size_t apanel; const char* bbase; size_t bexp, btile; const int* cnt; int npanels; Deal d; const int* perm;
    int segend[16];
    __device__ __forceinline__ void init_segments() { int o = 0;
#pragma unroll
        for (int j = 0; j < DmF::E; ++j) { o += (cnt[j] + 255) / 256 * 256; segend[j] = o; } }
    __device__ __forceinline__ int expert_of(int pos) const { int e = 0;
#pragma unroll
        for (int j = 0; j < DmF::E - 1; ++j) e += (pos >= segend[j]) ? 1 : 0;
        return e; }
    __device__ __forceinline__ bool next(int i, pg8::Unit& u) const {
        const int li = i * d.W + d.j; const int mine = (npanels - d.x + 7) >> 3; if (li >= mine * 4) return false;
        const int pm = d.x + 8 * (li >> 2), tile = li & 3;
        const int e = expert_of(pm * 256);
        u.a = perm ? abase : abase + (size_t)pm * apanel; u.b = bbase + (size_t)e * bexp + (size_t)tile * btile; u.i0 = pm; u.i1 = tile; u.i2 = e; u.i3 = 0; u.rows = perm ? perm + pm * 256 : nullptr;
        return true;
    }
};
struct EpiGateUp {
    static constexpr bool PERM = true; static constexpr int NST = 8;
    bf16s* hmid;
    __device__ __forceinline__ void operator()(const f32x4 (&acc)[2][2][4][2], const pg8::Unit& u, int wr, int wc, int fr, int fq) const {
        const int row0 = u.i0 * 256 + wr * 64 + fr; const int col = u.i1 * 128 + wc * 32 + 8 * fq;
#pragma unroll
        for (int ai = 0; ai < 2; ++ai)
#pragma unroll
            for (int m = 0; m < 4; ++m) {
                float v[8];
#pragma unroll
                for (int j = 0; j < 4; ++j) { v[j] = fast_silu(acc[ai][0][m][0][j]) * acc[ai][1][m][0][j]; v[4 + j] = fast_silu(acc[ai][0][m][1][j]) * acc[ai][1][m][1][j]; }
                u32x4 w; w.x = cvt_pk_bf16(v[0], v[1]); w.y = cvt_pk_bf16(v[2], v[3]); w.z = cvt_pk_bf16(v[4], v[5]); w.w = cvt_pk_bf16(v[6], v[7]);
                *(u32x4*)(hmid + (size_t)(row0 + ai * 128 + m * 16) * DmF::DE + col) = w;
            }
    }
};
struct EpiDown {
    static constexpr bool PERM = true; static constexpr int NST = 16;
    bf16s* ymoe;
    __device__ __forceinline__ void operator()(const f32x4 (&acc)[2][2][4][2], const pg8::Unit& u, int wr, int wc, int fr, int fq) const {
        const int row0 = u.i0 * 256 + wr * 64 + fr; const int col = u.i1 * 256 + wc * 32 + 8 * fq;
#pragma unroll
        for (int ai = 0; ai < 2; ++ai)
#pragma unroll
            for (int m = 0; m < 4; ++m)
#pragma unroll
                for (int bj = 0; bj < 2; ++bj) { const f32x4 v0 = acc[ai][bj][m][0], v1 = acc[ai][bj][m][1];
                    u32x4 w; w.x = cvt_pk_bf16(v0[0], v0[1]); w.y = cvt_pk_bf16(v0[2], v0[3]); w.z = cvt_pk_bf16(v1[0], v1[1]); w.w = cvt_pk_bf16(v1[2], v1[3]);
                    *(u32x4*)(ymoe + (size_t)(row0 + ai * 128 + m * 16) * DmF::D + col + bj * 128) = w; }
    }
};
__device__ __forceinline__ void f_gateup(const PF& p, const FastWs& f, LAS unsigned char* lds) {
    SchedMoe S; S.abase = (const char*)p.hx; S.perm = p.perm; S.apanel = 0; S.bbase = (const char*)f.wt_gu; S.bexp = (size_t)1024 * DmF::D * 2; S.btile = (size_t)256 * DmF::D * 2;
    S.cnt = p.cnt; S.init_segments(); S.npanels = S.segend[DmF::E - 1] / 256; S.d.init();
    EpiGateUp E{p.hmid};
#ifndef GATEUP_ALIGN
#define GATEUP_ALIGN true
#endif
    pg8::gemm_phase<EpiGateUp, SchedMoe, GATEUP_ALIGN, true>(lds, pg8::Gemm{DmF::D, DmF::D, DmF::D}, S, E);
}
__device__ __forceinline__ void f_down(const PF& p, const FastWs& f, int layer, LAS unsigned char* lds) {
    SchedMoe S; S.perm = nullptr; S.abase = (const char*)p.hmid; S.apanel = (size_t)256 * DmF::DE * 2; S.bbase = (const char*)f.wt_d; S.bexp = (size_t)DmF::D * DmF::DE * 2; S.btile = (size_t)256 * DmF::DE * 2;
    S.cnt = p.cnt; S.init_segments(); S.npanels = S.segend[DmF::E - 1] / 256; S.d.init();
    EpiDown E{f.hxs};
#ifndef DOWN_ALIGN
#define DOWN_ALIGN true
#endif
    pg8::gemm_phase<EpiDown, SchedMoe, DOWN_ALIGN>(lds, pg8::Gemm{DmF::DE, DmF::DE, DmF::DE}, S, E);
}

__device__ __forceinline__ void f_gen_dft(const PF& p, LAS unsigned char* lds) {
    LAS float* CT = (LAS float*)lds; LAS float* ST = CT + 2048;
    for (int m = tidx(); m < 2048; m += NTHREADS) { const float ang = 6.283185307179586f * (float)m / 2048.f; CT[m] = cosf(ang); ST[m] = sinf(ang); }
    __syncthreads();
    const long tid = (long)blockIdx.x * NTHREADS + tidx(), nth = (long)gridDim.x * NTHREADS;
    const float sx = 1.0f / sqrtf(64.f * 2048.f), sc = 1.0f / sqrtf(64.f * 256.f);
    for (long i = tid; i < ((long)2048 * 4096 + 256 * 512) / 2; i += nth) {
        const long e = i * 2; const bool isx = e < (long)2048 * 4096; const long ii = isx ? e : e - (long)2048 * 4096; const int Lw = isx ? 2048 : 256, sh = isx ? 0 : 3;
        const int k = (int)(ii / (2 * Lw)), lp = (int)(ii % (2 * Lw)), sn = lp >= Lw, l = sn ? lp - Lw : lp; const float s = isx ? sx : sc;
        const int m0 = ((k * l) & (Lw - 1)) << sh, m1 = ((k * (l + 1)) & (Lw - 1)) << sh;
        const float v0 = (sn ? -ST[m0] : CT[m0]) * s, v1 = (sn ? -ST[m1] : CT[m1]) * s;
        *(unsigned*)((isx ? p.dft_x : p.dft_c) + ii) = cvt_pk_bf16(v0, v1);
    }
    __syncthreads();
}
struct EpiFnet {
    static constexpr bool PERM = true; static constexpr int NST = 16;
    bf16s* yfn; const float* fn_b;
    __device__ __forceinline__ void operator()(const f32x4 (&acc)[2][2][4][2], const pg8::Unit& u, int wr, int wc, int fr, int fq) const {
        const int row0 = u.i0 + wr * 64 + fr; const int col0 = wc * 32 + 8 * fq;
#pragma unroll
        for (int bj = 0; bj < 2; ++bj) { const f32x4 b0 = *(const f32x4*)(fn_b + col0 + bj * 128), b1 = *(const f32x4*)(fn_b + col0 + bj * 128 + 4);
#pragma unroll
            for (int ai = 0; ai < 2; ++ai)
#pragma unroll
                for (int m = 0; m < 4; ++m) { const f32x4 v0 = acc[ai][bj][m][0] + b0, v1 = acc[ai][bj][m][1] + b1;
                    u32x4 w; w.x = cvt_pk_bf16(v0[0], v0[1]); w.y = cvt_pk_bf16(v0[2], v0[3]); w.z = cvt_pk_bf16(v1[0], v1[1]); w.w = cvt_pk_bf16(v1[2], v1[3]);
                    *(u32x4*)(yfn + (size_t)(row0 + ai * 128 + m * 16) * 256 + col0 + bj * 128) = w; } }
    }
};
struct SchedFnet {
    const bf16s* dft; const bf16s* pq; int first, n, npk_shift, rowbase, Lw;
    __device__ __forceinline__ bool next(int i, pg8::Unit& u) const {
        const int li = i * (int)gridDim.x + (int)blockIdx.x - first; if (li < 0 || li >= n) return false;
        const int b = li >> npk_shift, kp = li & ((1 << npk_shift) - 1);
        u.a = (const char*)(dft + (size_t)kp * 256 * 2 * Lw); u.b = (const char*)(pq + (size_t)b * 256 * 2 * Lw); u.i0 = rowbase + b * Lw + kp * 256; u.i1 = 0; u.i2 = 0; u.i3 = 0; u.rows = nullptr;
        return true;
    }
};
__device__ __forceinline__ void f_fnet(const PF& p, int layer, int with_ctx, LAS unsigned char* lds) {
    EpiFnet E{p.yfn, p.fn_b + layer * 256};
    { SchedFnet S{p.dft_x, p.pq_x, 0, 128, 3, NVF::RC, 2048}; pg8::gemm_phase<EpiFnet, SchedFnet>(lds, pg8::Gemm{4096, 4096, 4096}, S, E); }
    if (with_ctx) { SchedFnet S{p.dft_c, p.pq_c, 0, 16, 0, 0, 256}; pg8::gemm_phase<EpiFnet, SchedFnet>(lds, pg8::Gemm{512, 512, 512}, S, E); }
}
__device__ __forceinline__ float wave_sum(float v) {
#pragma unroll
    for (int o = 32; o >= 1; o >>= 1) v += __shfl_xor(v, o);
    return v;
}
__device__ __forceinline__ u32x2 pack4(f32x4 v) { u32x2 w; w.x = cvt_pk_bf16(v[0], v[1]); w.y = cvt_pk_bf16(v[2], v[3]); return w; }
__device__ __forceinline__ f32x4 unpack4(u32x2 w) { f32x4 v; v[0] = __uint_as_float(w.x << 16); v[1] = __uint_as_float(w.x & 0xffff0000u); v[2] = __uint_as_float(w.y << 16); v[3] = __uint_as_float(w.y & 0xffff0000u); return v; }

struct MoePos { int p0, p1; float g0, g1; };
struct MoeRows { u32x2 a[4], b[4]; float g0, g1; };
__device__ __forceinline__ MoePos moe_pos_load(const PF& p, int R) { MoePos m; m.p0 = p.rpos[R * 2]; m.p1 = p.rpos[R * 2 + 1]; m.g0 = p.rgp[R * 2]; m.g1 = p.rgp[R * 2 + 1]; return m; }
__device__ __forceinline__ MoeRows moe_rows_load(const bf16s* ymoe, const MoePos& m, int lane) { MoeRows y; y.g0 = m.g0; y.g1 = m.g1;
#pragma unroll
    for (int i = 0; i < 4; ++i) { const int c = i * 256 + lane * 4; y.a[i] = *(const u32x2*)(ymoe + (size_t)m.p0 * DmF::D + c); y.b[i] = *(const u32x2*)(ymoe + (size_t)m.p1 * DmF::D + c); }
    return y; }
__device__ __forceinline__ void moe_combine_apply(const PF& p, const MoeRows& y, int player, int R, int lane, f32x4 (&v)[4]) {
    const float* m5 = NVF::modp(p, player, NVF::row_modr(R), 5);
#pragma unroll
    for (int i = 0; i < 4; ++i) { const int c = i * 256 + lane * 4; v[i] = v[i] + *(const f32x4*)(m5 + c) * (unpack4(y.a[i]) * y.g0 + unpack4(y.b[i]) * y.g1); }
}
template <bool ROUTER, bool COMBINE, bool INIT = false>
__device__ __forceinline__ void f_normmod(const PF& p, const bf16s* ymoe, int layer, int which, int r0, LAS unsigned char* lds, const float* postab = nullptr) {
    const int t = tidx(), lane = t & 63, gw = blockIdx.x * (NTHREADS / 64) + (t >> 6), NGW = gridDim.x * (NTHREADS / 64);
    const float* g = (which ? p.norm2_g : p.norm1_g) + layer * DmF::D;
    LAS int* hist = (LAS int*)lds;
    LAS float* RW = (LAS float*)(lds + 256);
    if constexpr (ROUTER) { if (t < 16) hist[t] = 0;
        for (int i = t; i < DmF::D * 16; i += NTHREADS) { const int k = i >> 4, e = i & 15; RW[e * DmF::D + k] = p.router_w[i]; }
        __syncthreads(); }
    const int rpw = (NVF::RALL - r0 + NGW - 1) / NGW, Rb = r0 + gw * rpw, Re = (Rb + rpw < NVF::RALL) ? Rb + rpw : NVF::RALL;
    f32x4 nv[4];
#define NM_LOAD(RR, dst) do { _Pragma("unroll") for (int i_ = 0; i_ < 4; ++i_) { if constexpr (INIT) { if ((RR) < NVF::RC) dst[i_] = *(const f32x4*)(p.ctx + (size_t)(RR) * DmF::D + i_ * 256 + lane * 4); \
            else dst[i_] = *(const f32x4*)(p.x + (size_t)((RR) - NVF::RC) * DmF::D + i_ * 256 + lane * 4) + *(const f32x4*)(postab + (size_t)(((RR) - NVF::RC) % DmF::L) * DmF::D + i_ * 256 + lane * 4); } \
            else dst[i_] = *(const f32x4*)(NVF::xrow(p, (RR)) + i_ * 256 + lane * 4); } } while (0)
    MoePos npos; MoeRows nrows; int cur_mr = -1; f32x4 scg[4], shv[4];
    float rb[16];
    if constexpr (ROUTER) {
#pragma unroll
        for (int e = 0; e < 16; ++e) rb[e] = p.router_b[e]; }
    if (Rb < Re) { NM_LOAD(Rb, nv); if constexpr (COMBINE) { npos = moe_pos_load(p, Rb); nrows = moe_rows_load(ymoe, npos, lane); if (Rb + 1 < Re) npos = moe_pos_load(p, Rb + 1); } }
    for (int R = Rb; R < Re; ++R) {
        float* xr = NVF::xrow(p, R);
        f32x4 v[4]; float ss = 0.f; MoeRows crows;
#pragma unroll
        for (int i = 0; i < 4; ++i) v[i] = nv[i];
        if constexpr (COMBINE) crows = nrows;
        if (R + 1 < Re) { NM_LOAD(R + 1, nv); if constexpr (COMBINE) { nrows = moe_rows_load(ymoe, npos, lane); if (R + 2 < Re) npos = moe_pos_load(p, R + 2); } }
        if constexpr (COMBINE) moe_combine_apply(p, crows, layer - 1, R, lane, v);
        if constexpr (COMBINE || INIT) {
#pragma unroll
            for (int i = 0; i < 4; ++i) *(f32x4*)(xr + i * 256 + lane * 4) = v[i]; }
#pragma unroll
        for (int i = 0; i < 4; ++i) ss += v[i][0] * v[i][0] + v[i][1] * v[i][1] + v[i][2] * v[i][2] + v[i][3] * v[i][3];
        ss = wave_sum(ss);
        const float rstd = 1.0f / sqrtf(ss * (1.0f / DmF::D) + 1e-6f);
        const int mr = NVF::row_modr(R);
        if (mr != cur_mr) { cur_mr = mr; const float* sh = NVF::modp(p, layer, mr, which ? 3 : 0); const float* sc = NVF::modp(p, layer, mr, which ? 4 : 1);
#pragma unroll
            for (int i = 0; i < 4; ++i) { const int c = i * 256 + lane * 4; scg[i] = (*(const f32x4*)(sc + c) + 1.0f) * *(const f32x4*)(g + c); shv[i] = *(const f32x4*)(sh + c); } }
        bf16s* h = p.hx + (size_t)R * DmF::D;
#pragma unroll
        for (int i = 0; i < 4; ++i) { const int c = i * 256 + lane * 4; v[i] = v[i] * rstd * scg[i] + shv[i]; *(u32x2*)(h + c) = pack4(v[i]); }
        if constexpr (ROUTER) {
            float lg[16];
#pragma unroll
            for (int e = 0; e < 16; ++e) { float a = 0.f;
#pragma unroll
                for (int i = 0; i < 4; ++i) { const f32x4 wv4 = *(const LAS f32x4*)(RW + e * DmF::D + i * 256 + lane * 4); a += v[i][0] * wv4[0] + v[i][1] * wv4[1] + v[i][2] * wv4[2] + v[i][3] * wv4[3]; }
                lg[e] = a; }
#pragma unroll
            for (int e = 0; e < 16; ++e) lg[e] = wave_sum(lg[e]);
            if (lane == 0) {
                float mx = lg[0];
#pragma unroll
                for (int e = 1; e < 16; ++e) mx = fmaxf(mx, lg[e]);
                float den = 0.f;
#pragma unroll
                for (int e = 0; e < 16; ++e) { lg[e] = __expf(lg[e] - mx); den += lg[e]; }
                const float rden = 1.0f / den;
                float bestg = -1e30f; int bi0 = 0, bi1 = 0; float bp0 = 0.f, bp1 = 0.f;
#pragma unroll
                for (int gI = 0; gI < 4; ++gI) {
                    float s0 = -1e30f, s1 = -1e30f, p0 = 0.f, p1 = 0.f; int i0 = 0, i1 = 0;
#pragma unroll
                    for (int j = 0; j < 4; ++j) { const int e = gI * 4 + j; const float pr = lg[e] * rden; const float s = pr + rb[e];
                        if (s > s0) { s1 = s0; i1 = i0; p1 = p0; s0 = s; i0 = e; p0 = pr; } else if (s > s1) { s1 = s; i1 = e; p1 = pr; } }
                    const float gs = s0 + s1;
                    if (gs > bestg) { bestg = gs; bi0 = i0; bi1 = i1; bp0 = p0; bp1 = p1; }
                }
                const float sum = bp0 + bp1;
                p.ridx[R * 2] = bi0; p.ridx[R * 2 + 1] = bi1; p.rgp[R * 2] = bp0 / sum; p.rgp[R * 2 + 1] = bp1 / sum;
                p.rrank[R * 2] = __hip_atomic_fetch_add(hist + bi0, 1, __ATOMIC_RELAXED, __HIP_MEMORY_SCOPE_WORKGROUP);
                p.rrank[R * 2 + 1] = __hip_atomic_fetch_add(hist + bi1, 1, __ATOMIC_RELAXED, __HIP_MEMORY_SCOPE_WORKGROUP);
            }
        }
    }
#undef NM_LOAD
    if constexpr (ROUTER) { __syncthreads(); if (t < 16) p.wgbase[blockIdx.x * 16 + t] = atomicAdd(p.cnt + t, hist[t]); __syncthreads(); }
}
__device__ __forceinline__ void f_place_gather(const PF& p, const FastWs& f, int r0) {
    const int t = tidx(), lane = t & 63, gw = blockIdx.x * (NTHREADS / 64) + (t >> 6), NGW = gridDim.x * (NTHREADS / 64);
    const int rpw = (NVF::RALL - r0 + NGW - 1) / NGW, Rb = r0 + gw * rpw, Re = (Rb + rpw < NVF::RALL) ? Rb + rpw : NVF::RALL;
    for (int it = lane; it < (Re - Rb) * 2; it += 64) { const int ts = Rb * 2 + it, e = p.ridx[ts];
        const int pos = NVF::moe_off(p, e) + p.wgbase[blockIdx.x * 16 + e] + p.rrank[ts]; p.perm[pos] = ts; p.rpos[ts] = pos; }
}
__device__ __forceinline__ void f_mix(const PF& p, int layer, int r0) {
    const int t = tidx(), lane = t & 63, gw = blockIdx.x * (NTHREADS / 64) + (t >> 6), NGW = gridDim.x * (NTHREADS / 64);
    for (int R = r0 + gw; R < NVF::RALL; R += NGW) {
        bf16s* m = p.hx + (size_t)R * DmF::D;
        { f32x4 v = unpack4(*(const u32x2*)(p.y2 + (size_t)R * 256 + lane * 4)); float ss = wave_sum(v[0] * v[0] + v[1] * v[1] + v[2] * v[2] + v[3] * v[3]);
          const float rstd = 1.0f / sqrtf(ss * (1.0f / 256.f) + 1e-6f); const f32x4 gv = *(const f32x4*)(p.hy_norm_g + layer * 256 + lane * 4);
          *(u32x2*)(m + lane * 4) = pack4(v * rstd * gv); }
        {
          const u32x4 w = *(const u32x4*)(p.o + (size_t)R * 512 + lane * 8); f32x4 a = unpack4((u32x2){w.x, w.y}), b = unpack4((u32x2){w.z, w.w});
          float ss = a[0] * a[0] + a[1] * a[1] + a[2] * a[2] + a[3] * a[3] + b[0] * b[0] + b[1] * b[1] + b[2] * b[2] + b[3] * b[3];
#pragma unroll
          for (int o = 8; o >= 1; o >>= 1) ss += __shfl_xor(ss, o);
          const float rstd = 1.0f / sqrtf(ss * (1.0f / 128.f) + 1e-6f);
          const u32x4 gw4 = *(const u32x4*)(p.z + (size_t)R * NVF::ZS + NVF::OFF_G + lane * 8); const f32x4 ga = unpack4((u32x2){gw4.x, gw4.y}), gb = unpack4((u32x2){gw4.z, gw4.w});
          const f32x4 na = *(const f32x4*)(p.hg_norm_g + layer * 512 + lane * 8), nb = *(const f32x4*)(p.hg_norm_g + layer * 512 + lane * 8 + 4);
          const u32x2 o0 = pack4(a * rstd * na * ga), o1 = pack4(b * rstd * nb * gb);
          *(u32x4*)(m + 256 + lane * 8) = (u32x4){o0.x, o0.y, o1.x, o1.y}; }
        { f32x4 v = unpack4(*(const u32x2*)(p.yfn + (size_t)R * 256 + lane * 4)); float ss = wave_sum(v[0] * v[0] + v[1] * v[1] + v[2] * v[2] + v[3] * v[3]);
          const float rstd = 1.0f / sqrtf(ss * (1.0f / 256.f) + 1e-6f); const f32x4 gv = *(const f32x4*)(p.fn_norm_g + layer * 256 + lane * 4);
          *(u32x2*)(m + 768 + lane * 4) = pack4(v * rstd * gv); }
    }
}
__device__ __forceinline__ void f_final(const PF& p, const bf16s* ymoe) {
    const int t = tidx(), lane = t & 63, gw = blockIdx.x * (NTHREADS / 64) + (t >> 6), NGW = gridDim.x * (NTHREADS / 64);
    const int rpw = (NVF::RX + NGW - 1) / NGW, Rb = gw * rpw, Re = (Rb + rpw < NVF::RX) ? Rb + rpw : NVF::RX;
    f32x4 gfin[4];
#pragma unroll
    for (int i = 0; i < 4; ++i) gfin[i] = *(const f32x4*)(p.final_g + i * 256 + lane * 4);
    f32x4 nv[4]; MoePos npos; MoeRows nrows;
#define FN_LOAD(RR) do { _Pragma("unroll") for (int i_ = 0; i_ < 4; ++i_) nv[i_] = *(const f32x4*)(p.out + (size_t)(RR) * DmF::D + i_ * 256 + lane * 4); } while (0)
    if (Rb < Re) { FN_LOAD(Rb); npos = moe_pos_load(p, NVF::RC + Rb); nrows = moe_rows_load(ymoe, npos, lane); if (Rb + 1 < Re) npos = moe_pos_load(p, NVF::RC + Rb + 1); }
    for (int R = Rb; R < Re; ++R) {
        float* xr = p.out + (size_t)R * DmF::D;
        f32x4 v[4]; float ss = 0.f; const MoeRows crows = nrows;
#pragma unroll
        for (int i = 0; i < 4; ++i) v[i] = nv[i];
        if (R + 1 < Re) { FN_LOAD(R + 1); nrows = moe_rows_load(ymoe, npos, lane); if (R + 2 < Re) npos = moe_pos_load(p, NVF::RC + R + 2); }
        moe_combine_apply(p, crows, DmF::DEPTH - 1, NVF::RC + R, lane, v);
#pragma unroll
        for (int i = 0; i < 4; ++i) ss += v[i][0] * v[i][0] + v[i][1] * v[i][1] + v[i][2] * v[i][2] + v[i][3] * v[i][3];
        ss = wave_sum(ss);
        const float rstd = 1.0f / sqrtf(ss * (1.0f / DmF::D) + 1e-6f);
#pragma unroll
        for (int i = 0; i < 4; ++i) *(f32x4*)(xr + i * 256 + lane * 4) = v[i] * rstd * gfin[i];
    }
#undef FN_LOAD
#ifdef DIAG_OUT
    __syncthreads();
    if (blockIdx.x == 0 && t == 0) { asm volatile("s_waitcnt vmcnt(0)" ::: "memory"); p.out[0] = 1.0e4f * (1.0f + (float)__hip_atomic_load(p.cnt + DIAG_OUT, __ATOMIC_RELAXED, __HIP_MEMORY_SCOPE_AGENT)); }
#endif
#ifdef DIAG_SANITIZE
    __syncthreads();
    if (blockIdx.x == 0 && t == 0) { asm volatile("s_waitcnt vmcnt(0)" ::: "memory"); p.out[0] = 1.0e4f * (1.0f + (float)__hip_atomic_load(p.cnt + 40, __ATOMIC_RELAXED, __HIP_MEMORY_SCOPE_AGENT)); }
#endif
}
#ifndef REP_HYCONV
#define REP_HYCONV 1
#endif
template <int L> struct HyG {
    static_assert(8 * (2 * L * 2 + 32) + 16 * (L * 2 + 16) <= LDS_MISC_OFF, "Hyena LDS image does not fit");
    static constexpr int TB = L / 128;
    static constexpr int CS = 2 * L * 2 + 32;
    static constexpr int RSB = L * 2 + 16;
    static constexpr int U_OFF = 8 * CS;
    static constexpr int BYTES = U_OFF + 16 * RSB;
};
__device__ __forceinline__ float bflo(unsigned w) { return __uint_as_float(w << 16); }
__device__ __forceinline__ float bfhi(unsigned w) { return __uint_as_float(w & 0xffff0000u); }

template <int L> __device__ __forceinline__ void hy_build_copies(LAS unsigned char* lds, const bf16s* kr, int t) {
    constexpr int NCH = 2 * L / 8;
    for (int w = t; w < NCH; w += NTHREADS) {
        unsigned S[8];
        const u32x4 c0 = *(const u32x4*)(kr + w * 8); u32x4 c1 = (u32x4){0u, 0u, 0u, 0u};
        if (w + 1 < NCH) c1 = *(const u32x4*)(kr + w * 8 + 8);
        S[0] = c0.x; S[1] = c0.y; S[2] = c0.z; S[3] = c0.w; S[4] = c1.x; S[5] = c1.y; S[6] = c1.z; S[7] = c1.w;
#pragma unroll
        for (int a = 0; a < 8; ++a) { u32x4 o;
            if ((a & 1) == 0) { o.x = S[a / 2]; o.y = S[a / 2 + 1]; o.z = S[a / 2 + 2]; o.w = S[a / 2 + 3]; }
            else { const int h = (a - 1) / 2; o.x = (S[h] >> 16) | (S[h + 1] << 16); o.y = (S[h + 1] >> 16) | (S[h + 2] << 16); o.z = (S[h + 2] >> 16) | (S[h + 3] << 16); o.w = (S[h + 3] >> 16) | (S[h + 4] << 16); }
            *(LAS u32x4*)(lds + a * HyG<L>::CS + w * 16) = o; }
    }
}
template <int L, bool RAW> __device__ __forceinline__ void hy_stage_u(LAS unsigned char* lds, const bf16s* zrow, float w0, float w1, float w2, float bias, int t) {
    constexpr int NCH = 16 * L / 8, CPR = L / 8, PT = (NCH + NTHREADS - 1) / NTHREADS, G = PT < 4 ? PT : 4;
    static_assert(PT % G == 0, "chunk batching");
    for (int q0 = t; q0 < NCH; q0 += G * NTHREADS) {
        u32x4 v[G]; bf16s pv[G], nx[G];
#pragma unroll
        for (int u = 0; u < G; ++u) { const int q = q0 + u * NTHREADS; const bool ok = q < NCH; const int qq = ok ? q : 0; const int b = qq / CPR, s0 = (qq % CPR) * 8; const bf16s* src = zrow + (size_t)b * L + s0;
            v[u] = *(const u32x4*)src;
            if (!RAW) { pv[u] = src[s0 > 0 ? -1 : 0]; nx[u] = src[s0 + 8 < L ? 8 : 7]; } }
#pragma unroll
        for (int u = 0; u < G; ++u) { const int q = q0 + u * NTHREADS; if (q >= NCH) continue; const int b = q / CPR, s0 = (q % CPR) * 8;
            u32x4 o = v[u];
            if (!RAW) {
                const float prev = s0 > 0 ? bf2f(pv[u]) : 0.f, nxt = s0 + 8 < L ? bf2f(nx[u]) : 0.f;
                float z[10]; z[0] = prev; z[1] = bflo(o.x); z[2] = bfhi(o.x); z[3] = bflo(o.y); z[4] = bfhi(o.y); z[5] = bflo(o.z); z[6] = bfhi(o.z); z[7] = bflo(o.w); z[8] = bfhi(o.w); z[9] = nxt;
                float uu[8];
#pragma unroll
                for (int e = 0; e < 8; ++e) uu[e] = w0 * z[e] + w1 * z[e + 1] + w2 * z[e + 2] + bias;
                o.x = cvt_pk_bf16(uu[0], uu[1]); o.y = cvt_pk_bf16(uu[2], uu[3]); o.z = cvt_pk_bf16(uu[4], uu[5]); o.w = cvt_pk_bf16(uu[6], uu[7]);
            }
            *(LAS u32x4*)(lds + HyG<L>::U_OFF + b * HyG<L>::RSB + s0 * 2) = o; }
    }
}
template <int L, bool TO_LDS> __device__ __forceinline__ void hy_conv(LAS unsigned char* lds, const bf16s* zg, float g0, float g1, float g2, float gb, bf16s* outp, int t) {
    constexpr int TB = HyG<L>::TB, CS = HyG<L>::CS, RSB = HyG<L>::RSB, U_OFF = HyG<L>::U_OFF, NJ = L / 32;
    const int lane = t & 63, w = __builtin_amdgcn_readfirstlane(t >> 6), r = lane & 15, q = lane >> 4;
    const int a = 7 - (r & 7);
    const int baseA = a * CS + 2 * (L - 8 - 8 * (r >> 3) + 8 * q) - 32 * TB * w;
    const int baseB = U_OFF + r * RSB + 16 * q;
    f32x4 acc[TB]; bf16x8 F[TB];
#pragma unroll
    for (int ii = 0; ii < TB; ++ii) acc[ii] = (f32x4){0.f, 0.f, 0.f, 0.f};
#pragma unroll
    for (int ii = 2; ii < TB; ++ii) F[ii] = *(const LAS bf16x8*)(lds + baseA - 32 * ii);
    constexpr int PER = TB / 2;
    for (int j0 = 0; j0 < NJ; j0 += PER) {
        const int pA = baseA + 64 * j0, pB = baseB + 64 * j0;
#pragma unroll
        for (int jj = 0; jj < PER; ++jj) {
            F[(0 - 2 * jj) & (TB - 1)] = *(const LAS bf16x8*)(lds + pA + 64 * jj);
            F[(1 - 2 * jj) & (TB - 1)] = *(const LAS bf16x8*)(lds + pA + 64 * jj - 32);
            const bf16x8 Bf = *(const LAS bf16x8*)(lds + pB + 64 * jj);
#pragma unroll
            for (int ii = 0; ii < TB; ++ii) acc[ii] = __builtin_amdgcn_mfma_f32_16x16x32_bf16(F[(ii - 2 * jj) & (TB - 1)], Bf, acc[ii], 0, 0, 0);
        }
    }
    if constexpr (TO_LDS) lds_barrier();
    constexpr int EG = TB < 4 ? TB : 4;
#pragma unroll
    for (int i0 = 0; i0 < TB; i0 += EG) {
        u32x2 gv[EG]; bf16s pv[EG], nx[EG];
#pragma unroll
        for (int u = 0; u < EG; ++u) { const int t0 = 16 * (TB * w + i0 + u) + 4 * q; const bf16s* gp = zg + (size_t)r * L + t0;
            gv[u] = *(const u32x2*)gp; pv[u] = gp[t0 > 0 ? -1 : 0]; nx[u] = gp[t0 + 4 < L ? 4 : 3]; }
#pragma unroll
        for (int u = 0; u < EG; ++u) { const int ii = i0 + u; const int t0 = 16 * (TB * w + ii) + 4 * q;
            const float prev = t0 > 0 ? bf2f(pv[u]) : 0.f, nxt = t0 + 4 < L ? bf2f(nx[u]) : 0.f;
            float z[6]; z[0] = prev; z[1] = bflo(gv[u].x); z[2] = bfhi(gv[u].x); z[3] = bflo(gv[u].y); z[4] = bfhi(gv[u].y); z[5] = nxt;
            float o[4];
#pragma unroll
            for (int e = 0; e < 4; ++e) o[e] = acc[ii][e] * (g0 * z[e] + g1 * z[e + 1] + g2 * z[e + 2] + gb);
            u32x2 wv; wv.x = cvt_pk_bf16(o[0], o[1]); wv.y = cvt_pk_bf16(o[2], o[3]);
            if constexpr (TO_LDS) *(LAS u32x2*)(lds + U_OFF + r * RSB + t0 * 2) = wv; else *(u32x2*)(outp + (size_t)r * L + t0) = wv; }
    }
}
template <int L> __device__ __forceinline__ void hy_unit(const PF& p, int layer, int c, LAS unsigned char* lds, const bf16s* zh, size_t zstride, const bf16s* krt, bf16s* y1t, bf16s* y2t) {
    const int t = tidx();
    const float* cw = p.hy_conv_w + (size_t)layer * 9 * 256; const float* cb = p.hy_conv_b + (size_t)layer * 3 * 256;
    const bf16s* zv = zh + (size_t)c * zstride; const bf16s* z1 = zh + (size_t)(256 + c) * zstride; const bf16s* z2 = zh + (size_t)(512 + c) * zstride;
    hy_build_copies<L>(lds, krt + (size_t)c * 2 * L, t);
    hy_stage_u<L, false>(lds, zv, cw[c], cw[768 + c], cw[1536 + c], cb[c], t);
    lds_barrier();
    for (int q_ = 0; q_ < REP_HYCONV; ++q_) hy_conv<L, true>(lds, z1, cw[256 + c], cw[768 + 256 + c], cw[1536 + 256 + c], cb[256 + c], nullptr, t);
    hy_build_copies<L>(lds, krt + (size_t)(256 + c) * 2 * L, t);
    lds_barrier();
    for (int q_ = 0; q_ < REP_HYCONV; ++q_) hy_conv<L, false>(lds, z2, cw[512 + c], cw[768 + 512 + c], cw[1536 + 512 + c], cb[512 + c], y2t + (size_t)c * zstride, t);
    lds_barrier();
}
__device__ __forceinline__ void f_hyena(const PF& p, int layer, int with_ctx, LAS unsigned char* lds, int wg0, int nwg) {
    const int me = (int)blockIdx.x - wg0; if (me < 0 || me >= nwg) return;
    for (int c = me; c < 256; c += nwg)
        hy_unit<2048>(p, layer, c, lds, p.zh_x, NVF::RX, p.krt_x + (size_t)layer * 2 * 256 * 4096, p.y1t_x, p.y2t_x);
    if (with_ctx)
        for (int c = me; c < 256; c += nwg)
            hy_unit<256>(p, layer, c, lds, p.zh_c, NVF::RC, p.krt_c + (size_t)layer * 2 * 256 * 512, p.y1t_c, p.y2t_c);
}
__device__ __forceinline__ void f_gen_krt(const PF& p) {
    const long tid = (long)blockIdx.x * NTHREADS + tidx(), nth = (long)gridDim.x * NTHREADS;
    constexpr int NC = DmF::NC, L = DmF::L, C = DmF::C, FH = DmF::FH;
    const float max_decay = logf(1e-2f) / 0.3f, min_decay = logf(1e-2f) / 1.5f;
    for (long i = tid; i < (long)DmF::DEPTH * (NC + L) * 4 * C; i += nth) {
        const int oc = (int)(i % (4 * C)), ll = (int)((i / (4 * C)) % (NC + L)), layer = (int)(i / ((long)4 * C * (NC + L)));
        const int isx = ll >= NC, Lw = isx ? L : NC, l = isx ? ll - NC : ll, c = oc % C, fdir = oc / C, order = fdir >> 1, bwd = fdir & 1;
        const float tt = (float)l / (float)(Lw - 1);
        const float* h2 = p.hf2 + (i / (4 * C)) * FH;
        const float* w3 = p.hy_w3 + (size_t)layer * FH * 4 * C + oc;
        float acc = 0.f;
        for (int k = 0; k < FH; ++k) acc += h2[k] * w3[(size_t)k * 4 * C];
        const float delta = min_decay + (max_decay - min_decay) * (float)c / (float)(C - 1);
        float v = acc * expf(-tt * fabsf(delta));
        bf16s* kr = (isx ? p.krt_x : p.krt_c) + ((size_t)(layer * 2 + order) * 256 + c) * 2 * Lw;
        if (!bwd) { if (l == 0) v += p.hy_bias[(layer * 2 + order) * C + c]; kr[(Lw - 1) - l] = f2bf(v); }
        else { if (l > 0) kr[(Lw - 1) + l] = f2bf(v); else kr[2 * Lw - 1] = 0; }
    }
}
__device__ __forceinline__ void f_mix2(const PF& p, int layer, int r0, LAS unsigned char* lds) {
    const int t = tidx(), lane = t & 63, wv = t >> 6;
    constexpr int TS = 132;
    LAS float* ssb = (LAS float*)(lds + 256 * TS);
    float gq[32];
#pragma unroll
    for (int k = 0; k < 32; ++k) gq[k] = p.hy_norm_g[layer * 256 + wv * 32 + k];
    for (int tile = r0 / 64 + blockIdx.x; tile < NVF::RALL / 64; tile += gridDim.x) {
        const int R0 = tile * 64; const bool isc = R0 < NVF::RC;
        const bf16s* src = isc ? p.y2t_c + R0 : p.y2t_x + (R0 - NVF::RC); const size_t stride = isc ? NVF::RC : NVF::RX;
        for (int q = t; q < 2048; q += NTHREADS) { const int ch = q >> 3, k = q & 7; const u32x4 v = *(const u32x4*)(src + (size_t)ch * stride + k * 8);
            LAS unsigned* d = (LAS unsigned*)(lds + ch * TS + k * 16); d[0] = v.x; d[1] = v.y; d[2] = v.z; d[3] = v.w; }
        lds_barrier();
        float hv[32]; float ss = 0.f;
#pragma unroll
        for (int k = 0; k < 32; ++k) { hv[k] = bf2f(*(const LAS bf16s*)(lds + (wv * 32 + k) * TS + lane * 2)); ss += hv[k] * hv[k]; }
        ssb[wv * 64 + lane] = ss;
        lds_barrier();
        float tot = 0.f;
#pragma unroll
        for (int k = 0; k < 8; ++k) tot += ssb[k * 64 + lane];
        { const float rstd = 1.0f / sqrtf(tot * (1.0f / 256.f) + 1e-6f); bf16s* m = p.hx + (size_t)(R0 + lane) * DmF::D + wv * 32;
#pragma unroll
          for (int k = 0; k < 32; k += 8) { u32x4 w; w.x = cvt_pk_bf16(hv[k] * rstd * gq[k], hv[k + 1] * rstd * gq[k + 1]); w.y = cvt_pk_bf16(hv[k + 2] * rstd * gq[k + 2], hv[k + 3] * rstd * gq[k + 3]);
              w.z = cvt_pk_bf16(hv[k + 4] * rstd * gq[k + 4], hv[k + 5] * rstd * gq[k + 5]); w.w = cvt_pk_bf16(hv[k + 6] * rstd * gq[k + 6], hv[k + 7] * rstd * gq[k + 7]); *(u32x4*)(m + k) = w; } }
        { const f32x4 na = *(const f32x4*)(p.hg_norm_g + layer * 512 + lane * 8), nb = *(const f32x4*)(p.hg_norm_g + layer * 512 + lane * 8 + 4), gf = *(const f32x4*)(p.fn_norm_g + layer * 256 + lane * 4);
#pragma unroll
          for (int r4 = 0; r4 < 8; r4 += 4) {
            u32x4 wo[4], wb[4], wg[4]; u32x2 wf[4];
#pragma unroll
            for (int u = 0; u < 4; ++u) { const size_t R = (size_t)(R0 + wv * 8 + r4 + u);
                wo[u] = *(const u32x4*)(p.o + R * 512 + lane * 8); wb[u] = *(const u32x4*)(p.ob + R * 512 + lane * 8);
                wg[u] = *(const u32x4*)(p.z + R * NVF::ZS + NVF::OFF_G + lane * 8); wf[u] = *(const u32x2*)(p.yfn + R * 256 + lane * 4); }
#pragma unroll
            for (int u = 0; u < 4; ++u) { const int R = R0 + wv * 8 + r4 + u; bf16s* m = p.hx + (size_t)R * DmF::D;
                f32x4 a = unpack4((u32x2){wo[u].x, wo[u].y}) + unpack4((u32x2){wb[u].x, wb[u].y}), b = unpack4((u32x2){wo[u].z, wo[u].w}) + unpack4((u32x2){wb[u].z, wb[u].w});
                float s2 = a[0] * a[0] + a[1] * a[1] + a[2] * a[2] + a[3] * a[3] + b[0] * b[0] + b[1] * b[1] + b[2] * b[2] + b[3] * b[3];
#pragma unroll
                for (int o = 8; o >= 1; o >>= 1) s2 += __shfl_xor(s2, o);
                const float rstd = 1.0f / sqrtf(s2 * (1.0f / 128.f) + 1e-6f);
                const f32x4 ga = unpack4((u32x2){wg[u].x, wg[u].y}), gb = unpack4((u32x2){wg[u].z, wg[u].w});
                const u32x2 o0 = pack4(a * rstd * na * ga), o1 = pack4(b * rstd * nb * gb);
                *(u32x4*)(m + 256 + lane * 8) = (u32x4){o0.x, o0.y, o1.x, o1.y};
                f32x4 v = unpack4(wf[u]); float s3 = wave_sum(v[0] * v[0] + v[1] * v[1] + v[2] * v[2] + v[3] * v[3]);
                const float rstd3 = 1.0f / sqrtf(s3 * (1.0f / 256.f) + 1e-6f);
                *(u32x2*)(m + 768 + lane * 4) = pack4(v * rstd3 * gf); }
          } }
        lds_barrier();
    }
}
#ifndef REP_HG3
#define REP_HG3 1
#endif
namespace hg {
constexpr int RS = 272, QE_OFF = 0, QM_OFF = QE_OFF + 64 * RS, KM_OFF = QM_OFF + 64 * RS  ,
              KET_OFF = KM_OFF + 160 * RS, PT_OFF = KET_OFF + 128 * 144, TOT_OFF = PT_OFF + 64 * 144  , G_OFF = TOT_OFF + 4096, END = G_OFF + 512;
static_assert(END <= LDS_MISC_OFF, "HGRN LDS image does not fit");
typedef __bf16 bf16x2n __attribute__((ext_vector_type(2)));
__device__ __forceinline__ unsigned pk(float a, float b) { f32x2 v = {a, b}; bf16x2n r = __builtin_convertvector(v, bf16x2n); return __builtin_bit_cast(unsigned, r); }
__device__ __forceinline__ unsigned swp(unsigned x) { return (x >> 16) | (x << 16); }
__device__ __forceinline__ int chunk_rlo(int cc, int b, int dir) {
    const int seg = cc >= 4, ck = seg ? cc - 4 : cc, nck = seg ? 32 : 4, r0 = seg ? NVF::RC + b * 2048 : b * 256;
    return dir ? r0 + 64 * (nck - 1 - ck) : r0 + 64 * ck;
}
}
__device__ __forceinline__ void f_hgrn(const PF& p, LAS unsigned char* lds) {
    using namespace hg;
    const int t = tidx(), lane = t & 63, w = __builtin_amdgcn_readfirstlane(t >> 6), lr = lane & 15, qd = lane >> 4;
    const int sg = w >> 1, hh = w & 1, tau0 = 16 * sg + 8 * hh, d0 = 2 * lane;
    constexpr int ZS = NVF::ZS; constexpr size_t RALL = NVF::RALL;
    for (int ci = (int)gridDim.x - 1 - (int)blockIdx.x; ci < 128; ci += gridDim.x) {
        const int dir = ci & 1, h = (ci >> 1) & 3, b = ci >> 3;
        const bf16s* zq = p.z + NVF::OFF_Q + h * 128 + d0; const bf16s* zl = p.z + (dir ? NVF::OFF_FB : NVF::OFF_FF) + h * 128 + d0;
        const bf16s* vrow = p.vit + (size_t)(h * 128 + 16 * w + lr) * RALL;
        bf16s* outp = (dir ? p.ob : p.o) + h * 128 + 16 * w + 4 * qd;
        f32x4 S[8];
#pragma unroll
        for (int i = 0; i < 8; ++i) S[i] = (f32x4){0.f, 0.f, 0.f, 0.f};
        for (int i = t; i < 64 * 144 / 16; i += NTHREADS) *(LAS u32x4*)(lds + PT_OFF + i * 16) = (u32x4){0u, 0u, 0u, 0u};
#define HG_BAR() do { asm volatile("s_waitcnt lgkmcnt(0)" ::: "memory"); __builtin_amdgcn_s_barrier(); asm volatile("" ::: "memory"); } while (0)
        unsigned nq[8], nl[8]; u32x4 nv[2];
#define HG_LOAD(cc) do { const int rlo_ = chunk_rlo((cc), b, dir); _Pragma("unroll") for (int i_ = 0; i_ < 8; ++i_) { const size_t R_ = dir ? rlo_ + 63 - (tau0 + i_) : rlo_ + tau0 + i_; \
            nq[i_] = *(const unsigned*)(zq + R_ * ZS); nl[i_] = *(const unsigned*)(zl + R_ * ZS); } \
            _Pragma("unroll") for (int kb_ = 0; kb_ < 2; ++kb_) nv[kb_] = *(const u32x4*)(vrow + (dir ? rlo_ + 56 - 32 * kb_ - 8 * qd : rlo_ + 32 * kb_ + 8 * qd)); } while (0)
        unsigned cq[8], cl[8]; bf16x8 Vf[2];
#define HG_TAKE() do { _Pragma("unroll") for (int i_ = 0; i_ < 8; ++i_) { cq[i_] = nq[i_]; cl[i_] = nl[i_]; } \
            _Pragma("unroll") for (int kb_ = 0; kb_ < 2; ++kb_) { u32x4 x_ = nv[kb_]; if (dir) x_ = (u32x4){swp(x_.w), swp(x_.z), swp(x_.y), swp(x_.x)}; Vf[kb_] = __builtin_bit_cast(bf16x8, x_); } } while (0)
        HG_LOAD(0);
        HG_TAKE();
        HG_BAR();
        for (int cc = 0; cc < 36; ++cc) {
            const int Rlo = chunk_rlo(cc, b, dir);
            if (cc + 1 < 36) HG_LOAD(cc + 1);
            float c0[8], c1[8];
            { float a0 = 0.f, a1 = 0.f;
#pragma unroll
              for (int i = 0; i < 8; ++i) { a0 += bflo(cl[i]); a1 += bfhi(cl[i]); c0[i] = a0; c1[i] = a1; }
              *(LAS f32x2*)(lds + TOT_OFF + (w * 128 + d0) * 4) = (f32x2){a0, a1}; }
            HG_BAR();
            for (int rq_ = 0; rq_ < REP_HG3; ++rq_) { asm volatile("" ::: "memory");
            { f32x2 T[8];
#pragma unroll
              for (int j = 0; j < 8; ++j) T[j] = *(const LAS f32x2*)(lds + TOT_OFF + (j * 128 + d0) * 4);
              f32x2 pre[9]; pre[0] = (f32x2){0.f, 0.f};
#pragma unroll
              for (int j = 0; j < 8; ++j) pre[j + 1] = pre[j] + T[j];
              const f32x2 rt = sg == 0 ? pre[0] : sg == 1 ? pre[2] : sg == 2 ? pre[4] : pre[6];
              const f32x2 hoff = hh ? (sg == 0 ? T[0] : sg == 1 ? T[2] : sg == 2 ? T[4] : T[6]) : (f32x2){0.f, 0.f};
              const f32x2 bend = pre[8];
              const f32x2 Eoff = {__expf(rt[0]), __expf(rt[1])}, Fend = {__expf(bend[0] - rt[0]), __expf(bend[1] - rt[1])};
              const f32x2 F1 = {__expf(pre[2][0] - rt[0]), __expf(pre[2][1] - rt[1])}, F2 = {__expf(pre[4][0] - rt[0]), __expf(pre[4][1] - rt[1])}, F3 = {__expf(pre[6][0] - rt[0]), __expf(pre[6][1] - rt[1])};
              const int tl0 = sg == 0 ? 0 : sg == 1 ? 4 : sg == 2 ? 7 : 9;
              float ke0[8], ke1[8], kv0[8], kv1[8];
#pragma unroll
              for (int i = 0; i < 8; ++i) { const int tau = tau0 + i, trow = 8 * hh + i;
                  const float q0 = bflo(cq[i]), q1 = bfhi(cq[i]);
                  const float k0 = 1.f - __expf(bflo(cl[i])), k1 = 1.f - __expf(bfhi(cl[i]));
                  const float A0 = __expf(hoff[0] + c0[i]), A1 = __expf(hoff[1] + c1[i]);
                  const float ki0 = k0 * __builtin_amdgcn_rcpf(fmaxf(A0, 1.8e-35f)), ki1 = k1 * __builtin_amdgcn_rcpf(fmaxf(A1, 1.8e-35f));
                  const float qa0 = q0 * A0, qa1 = q1 * A1;
                  *(LAS unsigned*)(lds + QM_OFF + tau * RS + d0 * 2) = pk(qa0, qa1);
                  *(LAS unsigned*)(lds + QE_OFF + tau * RS + d0 * 2) = pk(qa0 * Eoff[0], qa1 * Eoff[1]);
                  *(LAS unsigned*)(lds + KM_OFF + (tl0 * 16 + trow) * RS + d0 * 2) = pk(ki0, ki1);
                  kv0[i] = ki0; kv1[i] = ki1; ke0[i] = ki0 * Fend[0]; ke1[i] = ki1 * Fend[1]; }
              if (sg < 1) {
#pragma unroll
                  for (int i = 0; i < 8; ++i) *(LAS unsigned*)(lds + KM_OFF + ((tl0 + 1 - sg) * 16 + 8 * hh + i) * RS + d0 * 2) = pk(kv0[i] * F1[0], kv1[i] * F1[1]); }
              if (sg < 2) {
#pragma unroll
                  for (int i = 0; i < 8; ++i) *(LAS unsigned*)(lds + KM_OFF + ((tl0 + 2 - sg) * 16 + 8 * hh + i) * RS + d0 * 2) = pk(kv0[i] * F2[0], kv1[i] * F2[1]); }
              if (sg < 3) {
#pragma unroll
                  for (int i = 0; i < 8; ++i) *(LAS unsigned*)(lds + KM_OFF + ((tl0 + 3 - sg) * 16 + 8 * hh + i) * RS + d0 * 2) = pk(kv0[i] * F3[0], kv1[i] * F3[1]); }
              u32x4 x0, x1; x0.x = pk(ke0[0], ke0[1]); x0.y = pk(ke0[2], ke0[3]); x0.z = pk(ke0[4], ke0[5]); x0.w = pk(ke0[6], ke0[7]); x1.x = pk(ke1[0], ke1[1]); x1.y = pk(ke1[2], ke1[3]); x1.z = pk(ke1[4], ke1[5]); x1.w = pk(ke1[6], ke1[7]);
              *(LAS u32x4*)(lds + KET_OFF + d0 * 144 + tau0 * 2) = x0; *(LAS u32x4*)(lds + KET_OFF + (d0 + 1) * 144 + tau0 * 2) = x1;
              if (w == 0) *(LAS f32x2*)(lds + G_OFF + d0 * 4) = (f32x2){__expf(bend[0]), __expf(bend[1])}; }
            }
            HG_BAR();
            for (int tl = w; tl < 10; tl += 8) {
                const int si = (int)((0x3221110000ull >> (4 * tl)) & 0xF), ti = (int)((0x3323213210ull >> (4 * tl)) & 0xF);
                f32x4 acc = (f32x4){0.f, 0.f, 0.f, 0.f};
#pragma unroll
                for (int kb = 0; kb < 4; ++kb) { const bf16x8 A = *(const LAS bf16x8*)(lds + KM_OFF + (16 * tl + lr) * RS + (32 * kb + 8 * qd) * 2); const bf16x8 B = *(const LAS bf16x8*)(lds + QM_OFF + (16 * ti + lr) * RS + (32 * kb + 8 * qd) * 2);
                    acc = __builtin_amdgcn_mfma_f32_16x16x32_bf16(A, B, acc, 0, 0, 0); }
                if (si == ti) {
#pragma unroll
                    for (int e = 0; e < 4; ++e) if (4 * qd + e > lr) acc[e] = 0.f; }
                u32x2 wv; wv.x = pk(acc[0], acc[1]); wv.y = pk(acc[2], acc[3]);
                *(LAS u32x2*)(lds + PT_OFF + (16 * ti + lr) * 144 + (16 * si + 4 * qd) * 2) = wv;
            }
            bf16x8 As[4];
#pragma unroll
            for (int kb = 0; kb < 4; ++kb) { u32x4 x; x.x = pk(S[2 * kb][0], S[2 * kb][1]); x.y = pk(S[2 * kb][2], S[2 * kb][3]); x.z = pk(S[2 * kb + 1][0], S[2 * kb + 1][1]); x.w = pk(S[2 * kb + 1][2], S[2 * kb + 1][3]); As[kb] = __builtin_bit_cast(bf16x8, x); }
            HG_BAR();
#pragma unroll
            for (int ti = 0; ti < 4; ++ti) {
                f32x4 acc = (f32x4){0.f, 0.f, 0.f, 0.f};
#pragma unroll
                for (int kb = 0; kb < 4; ++kb) { const u32x2 lo = *(const LAS u32x2*)(lds + QE_OFF + (16 * ti + lr) * RS + (32 * kb + 4 * qd) * 2), hi = *(const LAS u32x2*)(lds + QE_OFF + (16 * ti + lr) * RS + (32 * kb + 16 + 4 * qd) * 2);
                    const bf16x8 B = __builtin_bit_cast(bf16x8, (u32x4){lo.x, lo.y, hi.x, hi.y}); acc = __builtin_amdgcn_mfma_f32_16x16x32_bf16(As[kb], B, acc, 0, 0, 0); }
#pragma unroll
                for (int kb = 0; kb < 2; ++kb) if (kb == 0 || ti >= 2) { const bf16x8 B = *(const LAS bf16x8*)(lds + PT_OFF + (16 * ti + lr) * 144 + (32 * kb + 8 * qd) * 2); acc = __builtin_amdgcn_mfma_f32_16x16x32_bf16(Vf[kb], B, acc, 0, 0, 0); }
                const int tt = 16 * ti + lr; const size_t R = dir ? Rlo + 63 - tt : Rlo + tt;
                u32x2 wv; wv.x = pk(acc[0], acc[1]); wv.y = pk(acc[2], acc[3]);
                *(u32x2*)(outp + R * 512) = wv;
            }
#pragma unroll
            for (int i = 0; i < 8; ++i) { const f32x4 g4 = *(const LAS f32x4*)(lds + G_OFF + (16 * i + 4 * qd) * 4); f32x4 acc = S[i] * g4;
#pragma unroll
                for (int kb = 0; kb < 2; ++kb) { const bf16x8 A = *(const LAS bf16x8*)(lds + KET_OFF + (16 * i + lr) * 144 + (32 * kb + 8 * qd) * 2); acc = __builtin_amdgcn_mfma_f32_16x16x32_bf16(A, Vf[kb], acc, 0, 0, 0); }
                S[i] = acc; }
            if (cc + 1 < 36) HG_TAKE();
        }
#undef HG_TAKE
#undef HG_LOAD
#undef HG_BAR
        __syncthreads();
    }
}
__device__ __forceinline__ void f_ada(const PF& p, LAS unsigned char* lds) {
    const int t = tidx(), lane = t & 63, wv = t >> 6;
    constexpr int D = DmF::D, NR = DmF::B + 1, NITEM = DmF::DEPTH * 6 * D / 64;
    if ((int)blockIdx.x >= NITEM) return;
    LAS float* S = (LAS float*)lds;
    LAS float* PR = S + NR * D;
    for (int i = t; i < NR * D; i += NTHREADS) { const int r = i / D, k = i % D; const float c = r < DmF::B ? p.c[r * D + k] : p.c_ctx[k]; S[i] = c / (1.f + __expf(-c)); }
    __syncthreads();
    for (int q = blockIdx.x; q < NITEM; q += gridDim.x) {
        const int layer = q / (6 * D / 64), j = (q % (6 * D / 64)) * 64 + lane;
        const float* w = p.ada_w + (size_t)layer * D * 6 * D + j;
        float acc[NR];
#pragma unroll
        for (int r = 0; r < NR; ++r) acc[r] = 0.f;
#pragma unroll 2
        for (int k = wv * 128; k < wv * 128 + 128; k += 8) {
            float wq[8];
#pragma unroll
            for (int u = 0; u < 8; ++u) wq[u] = w[(size_t)(k + u) * 6 * D];
#pragma unroll
            for (int u = 0; u < 8; u += 4)
#pragma unroll
                for (int r = 0; r < NR; ++r) { const f32x4 s4 = *(const LAS f32x4*)(S + r * D + k + u); acc[r] += s4[0] * wq[u] + s4[1] * wq[u + 1] + s4[2] * wq[u + 2] + s4[3] * wq[u + 3]; }
        }
#pragma unroll
        for (int r = 0; r < NR; ++r) PR[(wv * NR + r) * 64 + lane] = acc[r];
        __syncthreads();
        for (int i = t; i < NR * 64; i += NTHREADS) { const int r = i >> 6, l2 = i & 63; float sum = 0.f;
#pragma unroll
            for (int w8 = 0; w8 < 8; ++w8) sum += PR[(w8 * NR + r) * 64 + l2];
            const int jj = (q % (6 * D / 64)) * 64 + l2; p.mod[((size_t)layer * NR + r) * 6 * D + jj] = sum + p.ada_b[layer * 6 * D + jj]; }
        __syncthreads();
    }
}
__device__ __forceinline__ void f_gen_postab(const PF& p, float* postab) {
    const long tid = (long)blockIdx.x * NTHREADS + tidx(), nth = (long)gridDim.x * NTHREADS;
    constexpr int D = DmF::D, L = DmF::L, Q4 = D / 4;
    for (long i = tid; i < (long)L * (D / 4); i += nth) {
        const int l = (int)(i / (D / 4)), k = (int)(i % (D / 4)) * 4, wq = k / Q4;
        const float pos = (float)(wq < 2 ? l / DmF::GRID_W : l % DmF::GRID_W);
        f32x4 pe;
#pragma unroll
        for (int e = 0; e < 4; ++e) { const int ix = (k + e) % Q4; const float omega = 1.0f / powf(10000.0f, (float)ix / (float)Q4); const float a = pos * omega; pe[e] = (wq & 1) ? cosf(a) : sinf(a); }
        *(f32x4*)(postab + (size_t)l * D + k) = pe;
    }
}
__device__ __forceinline__ void f_gen_krt3(const PF& p, LAS unsigned char* lds) {
    const int t = tidx(), cl = t & 63, lg = t >> 6;
    constexpr int NC = DmF::NC, L = DmF::L, C = DmF::C, FH = DmF::FH, NLB = (NC + L) / 64, NOB = 4 * C / 64;
    const float max_decay = logf(1e-2f) / 0.3f, min_decay = logf(1e-2f) / 1.5f;
    LAS float* T = (LAS float*)lds;
    constexpr int NCOMBO = DmF::DEPTH * NOB;
    const int combo = (int)blockIdx.x % NCOMBO, grp = (int)blockIdx.x / NCOMBO, ngrp = ((int)gridDim.x - combo + NCOMBO - 1) / NCOMBO;
    const int layer = combo / NOB, ob = combo % NOB, oc = ob * 64 + cl, c = oc % C;
    float wr[FH];
    { const float* w3 = p.hy_w3 + (size_t)layer * FH * 4 * C + oc;
#pragma unroll
      for (int k = 0; k < FH; ++k) wr[k] = w3[(size_t)k * 4 * C]; }
    for (int lb = grp; lb < NLB; lb += ngrp) {
        const int isx = lb >= NC / 64, Lw = isx ? L : NC, l0 = (isx ? lb - NC / 64 : lb) * 64;
        const float delta = fabsf(min_decay + (max_decay - min_decay) * (float)c / (float)(C - 1));
#pragma unroll
        for (int i = 0; i < 8; ++i) { const int l = l0 + lg * 8 + i; const float* h2 = p.hf2 + ((size_t)layer * (NC + L) + lb * 64 + lg * 8 + i) * FH;
            float acc = 0.f;
#pragma unroll
            for (int k = 0; k < FH; k += 4) { const f32x4 h = *(const f32x4*)(h2 + k); acc += h[0] * wr[k] + h[1] * wr[k + 1] + h[2] * wr[k + 2] + h[3] * wr[k + 3]; }
            T[cl * 65 + lg * 8 + i] = acc * expf(-((float)l / (float)(Lw - 1)) * delta); }
        lds_barrier();
        { const int c2 = t >> 3, sg = t & 7, oc2 = ob * 64 + c2, cc = oc2 % C, fdir = oc2 / C, order = fdir >> 1, bwd = fdir & 1;
          bf16s* kr = (isx ? p.krt_x : p.krt_c) + ((size_t)(layer * 2 + order) * 256 + cc) * 2 * Lw;
#pragma unroll
          for (int i = 0; i < 8; ++i) { const int l = l0 + sg * 8 + i; float v = T[c2 * 65 + sg * 8 + i];
              if (!bwd) { if (l == 0) v += p.hy_bias[(layer * 2 + order) * C + cc]; kr[(Lw - 1) - l] = f2bf(v); }
              else { if (l > 0) kr[(Lw - 1) + l] = f2bf(v); else kr[2 * Lw - 1] = 0; } } }
        lds_barrier();
    }
}

#define XB_TMO      128
#define XB_XCNT(j)  (256  + 64 * (j))
#define XB_XSUB(j)  (1280 + 64 * (j))
#define XB_XGEN(j)  (2304 + 64 * (j))
#define XB_TOP      3328
#define XB_TOPGEN   3392
#define XCD_BAR_WORDS 3456
#define XB_SPIN_CAP (1u << 21)

__device__ __forceinline__ unsigned xb_ld(unsigned* p)              { return __hip_atomic_load(p, __ATOMIC_RELAXED, __HIP_MEMORY_SCOPE_AGENT); }
__device__ __forceinline__ unsigned xb_add(unsigned* p, unsigned v) { return __hip_atomic_fetch_add(p, v, __ATOMIC_RELAXED, __HIP_MEMORY_SCOPE_AGENT); }
__device__ __forceinline__ unsigned xb_xcc_id() { return (unsigned)__builtin_amdgcn_s_getreg((3 << 11) | 20) & 0xFu; }
#define XB_SPIN(cond, bar) do { unsigned _sp = 0; while (cond) { __builtin_amdgcn_s_sleep(1); \
    if ((++_sp & 255u) == 0u) { if (xb_ld(&(bar)[XB_TMO])) break; if (_sp > XB_SPIN_CAP) { atomicAdd(&(bar)[XB_TMO], 1u); break; } } } } while (0)

struct XcdBarrier { unsigned* bar; unsigned x; volatile LAS unsigned* st; };

__device__ __forceinline__ XcdBarrier xcd_barrier_post(unsigned* bar, volatile LAS unsigned* st) {
    XcdBarrier b; b.bar = bar; b.x = xb_xcc_id(); b.st = st;
    if (threadIdx.x == 0) (void)xb_add(&bar[XB_XCNT(b.x)], 1u);
    return b;
}
__device__ __forceinline__ void xcd_barrier_complete(unsigned* bar, unsigned x, unsigned& nloc, unsigned& nx) {
    const unsigned G = gridDim.x * gridDim.y * gridDim.z;
    unsigned sum, cnt, mine, sp = 0u;
    for (;;) {
        sum = 0u; cnt = 0u; mine = 0u;
#pragma unroll
        for (unsigned j = 0; j < 16; ++j) { const unsigned c = xb_ld(&bar[XB_XCNT(j)]); sum += c; cnt += (c > 0u) ? 1u : 0u; mine = (j == x) ? c : mine; }
        if (sum == G) break;
        __builtin_amdgcn_s_sleep(1);
        if ((++sp & 255u) == 0u) { if (xb_ld(&bar[XB_TMO])) break; if (sp > XB_SPIN_CAP) { atomicAdd(&bar[XB_TMO], 1u); break; } }
    }
    nloc = mine > 0u ? mine : 1u; nx = cnt > 0u ? cnt : 1u;
}
__device__ __forceinline__ void xcd_barrier(const XcdBarrier& b) {
    asm volatile("s_waitcnt vmcnt(0)" ::: "memory");
    __syncthreads();
    if (threadIdx.x == 0) {
        unsigned* bar = b.bar;
        __builtin_amdgcn_s_waitcnt(0);
        unsigned nloc = b.st[0], nx = b.st[1];
        if (nloc == 0u) { xcd_barrier_complete(bar, b.x, nloc, nx); b.st[0] = nloc; b.st[1] = nx; }
        const unsigned old = xb_add(&bar[XB_XSUB(b.x)], 1u);
        const unsigned gen = old / nloc;
        if (old + 1u == (gen + 1u) * nloc) {
            __builtin_amdgcn_fence(__ATOMIC_RELEASE, "agent");
            asm volatile("s_waitcnt vmcnt(0)" ::: "memory");
            const unsigned og = xb_add(&bar[XB_TOP], 1u);
            const unsigned tg = og / nx;
            if (og + 1u == (tg + 1u) * nx) xb_add(&bar[XB_TOPGEN], 1u);
            else XB_SPIN(xb_ld(&bar[XB_TOPGEN]) == tg, bar);
            __builtin_amdgcn_fence(__ATOMIC_ACQUIRE, "agent");
            xb_add(&bar[XB_XGEN(b.x)], 1u);
            asm volatile("s_waitcnt vmcnt(0)" ::: "memory");
        } else {
            XB_SPIN(xb_ld(&bar[XB_XGEN(b.x)]) == gen, bar);
            __builtin_amdgcn_fence(__ATOMIC_ACQUIRE, "agent");
            asm volatile("s_waitcnt vmcnt(0)" ::: "memory");
        }
    }
    __syncthreads();
}

constexpr int NPH = 3 + 9 * DmF::DEPTH + 1;
#ifndef ONE_LAUNCH
#define ONE_LAUNCH 1
#endif

#ifndef REP_ADA
#define REP_ADA 1
#endif
#ifndef REP_PA
#define REP_PA 1
#endif
#ifndef REP_INIT
#define REP_INIT 1
#endif
#ifndef REP_DFT
#define REP_DFT 1
#endif
#ifndef REP_PB
#define REP_PB 1
#endif
#ifndef REP_KRT
#define REP_KRT 1
#endif
#ifndef REP_DOWN
#define REP_DOWN 1
#endif
#ifndef REP_WOUT
#define REP_WOUT 1
#endif
#ifndef REP_NM2N
#define REP_NM2N 1
#endif
#ifndef REP_BAR
#define REP_BAR 0
#endif
#ifndef REP_PRO
#define REP_PRO 1
#endif
#ifndef REP_NM1
#define REP_NM1 1
#endif
#ifndef REP_INPROJ
#define REP_INPROJ 1
#endif
#ifndef REP_FNET
#define REP_FNET 1
#endif
#ifndef REP_HGRN
#define REP_HGRN 1
#endif
#ifndef REP_HYENA
#define REP_HYENA 1
#endif
#ifndef REP_MIX
#define REP_MIX 1
#endif
#ifndef REP_CVTMOE
#define REP_CVTMOE 1
#endif
#ifndef REP_GATHER
#define REP_GATHER 1
#endif
#ifndef REP_GATEUP
#define REP_GATEUP 1
#endif
#ifndef FAST_HGRN
#define FAST_HGRN 1
#endif
#ifndef FAST_GEMM
#define FAST_GEMM 1
#endif
struct KArgs { PF p; FastWs f; unsigned* bar; int lo, hi; };
typedef const __attribute__((address_space(4))) KArgs* KP;

__global__ void __launch_bounds__(NTHREADS, 2) mega(KArgs a) {
    extern __shared__ __attribute__((aligned(16))) unsigned char lds_raw[];
    LAS unsigned char* lds = (LAS unsigned char*)lds_raw;
    volatile LAS unsigned* xbw = (volatile LAS unsigned*)(lds + LDS_MISC_OFF);
    if (threadIdx.x < 4) xbw[threadIdx.x] = 0u;
    __syncthreads();
    const int lo = a.lo, hi = a.hi;
    XcdBarrier bar; bar.bar = a.bar; bar.x = 0; bar.st = xbw;
    if (hi - lo > 1) bar = xcd_barrier_post(a.bar, xbw);
    int ph = 0;
#define PHASE(...) do { int lo_ = lo, hi_ = hi; asm volatile("" : "+s"(lo_), "+s"(hi_)); if (ph >= lo_ && ph < hi_) { { KP kp_ = (KP)__builtin_amdgcn_kernarg_segment_ptr(); asm volatile("" : "+s"(kp_)); PF p; FastWs f; __builtin_memcpy(&p, &kp_->p, sizeof(PF)); __builtin_memcpy(&f, &kp_->f, sizeof(FastWs)); (void)f; \
        const long tid = (long)blockIdx.x * NTHREADS + tidx(), nth = (long)gridDim.x * NTHREADS; (void)tid; (void)nth; __VA_ARGS__; } if (ph + 1 < hi_) xcd_barrier(bar); } ++ph; } while (0)
    for (int rep_ = 0; rep_ < REP_PRO; ++rep_) { if (rep_) ph -= 3;
    PHASE({ for (int q_ = 0; q_ < REP_ADA; ++q_) f_ada(p, lds); for (int q_ = 0; q_ < REP_PA; ++q_) NVF::p_pro_a(p, tid, nth); for (int q_ = 0; q_ < REP_INIT; ++q_) f_gen_postab(p, (float*)p.z); for (int q_ = 0; q_ < REP_DFT; ++q_) f_gen_dft(p, lds); });
    PHASE({ for (int q_ = 0; q_ < REP_PB; ++q_) NVF::p_pro_b(p, tid, nth); });
    PHASE({ for (int q_ = 0; q_ < REP_KRT; ++q_) f_gen_krt3(p, lds); }); }
    for (int q_ = 0; q_ < REP_BAR; ++q_) { PHASE({}); --ph; }
    for (int layer = 0; layer < DmF::DEPTH; ++layer) {
        const int last = layer == DmF::DEPTH - 1, r0 = last ? NVF::RC : 0;
        PHASE({ for (int rep_ = 0; rep_ < REP_NM1; ++rep_) { if (layer == 0) f_normmod<false, false, true>(p, f.hxs, layer, 0, 0, lds, (const float*)p.z); else f_normmod<false, true>(p, f.hxs, layer, 0, 0, lds); f_cvt_inout(p, f, layer, lds); } });
        PHASE({ for (int rep_ = 0; rep_ < REP_INPROJ; ++rep_) f_inproj(p, f, layer, last, lds); });
        PHASE({ const bool g256 = gridDim.x == 256;
                for (int rep_ = 0; rep_ < REP_FNET; ++rep_) f_fnet(p, layer, !last, lds);
                for (int rep_ = 0; rep_ < REP_HGRN; ++rep_) f_hgrn(p, lds);
                for (int rep_ = 0; rep_ < REP_HYENA; ++rep_) f_hyena(p, layer, !last, lds, 0, g256 ? 128 : (int)gridDim.x); });
        PHASE({ for (int rep_ = 0; rep_ < REP_MIX; ++rep_) f_mix2(p, layer, r0, lds); });
        PHASE({ for (int q_ = 1; q_ < REP_WOUT; ++q_) f_wout(p, f, layer, r0, lds, 0.f); f_wout(p, f, layer, r0, lds);
                { const int G_ = (int)gridDim.x, j_ = (int)blockIdx.x >> 3, x_ = (int)blockIdx.x & 7; int rank_ = (int)blockIdx.x, nw_ = G_;
                  if (!last && G_ == 256) { rank_ = j_ < 8 ? -1 : (j_ - 8) * 8 + x_; nw_ = 192; }
                  for (int rep_ = 0; rep_ < REP_CVTMOE; ++rep_) { NVF::p_moe_reset(p, tid, nth); f_cvt_moe(p, f, layer, lds, rank_, nw_); } } });
        PHASE({ for (int q_ = 1; q_ < REP_NM2N; ++q_) f_normmod<false, false>(p, f.hxs, layer, 1, r0, lds); f_normmod<true, false>(p, f.hxs, layer, 1, r0, lds); });
        PHASE({ for (int rep_ = 0; rep_ < REP_GATHER; ++rep_) f_place_gather(p, f, r0); });
        PHASE({ for (int rep_ = 0; rep_ < REP_GATEUP; ++rep_) f_gateup(p, f, lds); });
        PHASE({ for (int q_ = 0; q_ < REP_DOWN; ++q_) f_down(p, f, layer, lds); });
    }
    PHASE(f_final(p, f.hxs));
#undef PHASE
}

static inline size_t al256(size_t x) { return (x + 255) & ~(size_t)255; }
extern "C" void kernel_launch(void* const* d_in, const int* in_sizes, int n_in, void* d_out, int out_size, void* d_ws, size_t ws_size, hipStream_t stream) {
    typedef DmF Dm; constexpr size_t RALL = NVF::RALL, D = Dm::D;
    KArgs a{};
    PF& p = a.p;
    const float** ip = (const float**)&p.x;
    for (int i = 0; i < 31; ++i) ip[i] = (const float*)d_in[i];
    p.out = (float*)d_out;
    size_t off = 0; char* ws = (char*)d_ws;
    auto carve = [&](size_t bytes) { char* r = ws + off; off += al256(bytes); return r; };
    unsigned* ctl = (unsigned*)carve(65536);
    a.bar = ctl; p.cnt = (int*)(ctl + 8192);
    p.mod = (float*)carve((size_t)Dm::DEPTH * (Dm::B + 1) * 6 * D * 4);
    p.lbv = (float*)carve((size_t)Dm::DEPTH * 2 * Dm::DHG * 4);
    p.wcs = (float*)carve((size_t)Dm::DEPTH * Dm::G * Dm::GD * 2 * Dm::GD * 4);
    p.wfn = (float*)carve((size_t)Dm::DEPTH * D * 2 * Dm::CFN * 4);
    p.hf1 = (float*)carve((size_t)Dm::DEPTH * (Dm::NC + Dm::L) * Dm::FH * 4);
    p.hf2 = (float*)carve((size_t)Dm::DEPTH * (Dm::NC + Dm::L) * Dm::FH * 4);
    p.hfil = nullptr;
    p.krt_x = (bf16s*)carve((size_t)Dm::DEPTH * 2 * Dm::C * 2 * Dm::L * 2); p.krt_c = (bf16s*)carve((size_t)Dm::DEPTH * 2 * Dm::C * 2 * Dm::NC * 2);
    p.cw = (float*)carve((size_t)NVF::RC * D * 4);
    p.rs = (float*)carve(RALL * 4);
    p.hx = (bf16s*)carve(RALL * D * 2);
    p.dft_x = (bf16s*)carve((size_t)2048 * 4096 * 2); p.dft_c = (bf16s*)carve((size_t)256 * 512 * 2);
    p.z = (bf16s*)carve(RALL * NVF::ZS * 2);
    p.zh_c = (bf16s*)carve((size_t)3 * Dm::C * NVF::RC * 2); p.zh_x = (bf16s*)carve((size_t)3 * Dm::C * NVF::RX * 2);
    p.pq_c = (bf16s*)carve((size_t)NVF::RC * Dm::CFN * 2 * 2); p.pq_x = (bf16s*)carve((size_t)NVF::RX * Dm::CFN * 2 * 2);
    p.uv = nullptr;
    p.y1 = nullptr; p.y2 = nullptr;
    p.y1t_c = p.hx; p.y1t_x = p.hx + (size_t)Dm::C * NVF::RC;
    p.y2t_c = (bf16s*)carve((size_t)Dm::C * NVF::RC * 2); p.y2t_x = (bf16s*)carve((size_t)Dm::C * NVF::RX * 2);
    p.o = (bf16s*)carve(RALL * Dm::DHG * 2); p.ob = (bf16s*)carve(RALL * Dm::DHG * 2); p.vit = (bf16s*)carve(RALL * Dm::DHG * 2);
    p.yfn = (bf16s*)carve(RALL * Dm::CFN * 2);
    p.ridx = (int*)carve(RALL * 2 * 4);
    p.rgp = (float*)carve(RALL * 2 * 4);
    p.perm = (int*)carve((2 * RALL + Dm::E * Dm::MPAD) * 4);
    p.rrank = (int*)carve(RALL * 2 * 4); p.rpos = (int*)carve(RALL * 2 * 4); p.wgbase = (int*)carve(4096 * 16 * 4);
    { char* big = (char*)p.z; const size_t npos = 2 * RALL + Dm::E * Dm::MPAD;
      a.f.hxs = (bf16s*)big; p.hmid = (bf16s*)(big + al256(npos * D * 2));
      a.f.wt_gu = (bf16s*)((char*)p.hmid + al256(npos * Dm::DE * 2)); a.f.wt_d = a.f.wt_gu + (size_t)Dm::E * 1024 * D;
      if ((char*)(a.f.wt_d + (size_t)Dm::E * D * Dm::DE) > (char*)(p.yfn + RALL * Dm::CFN)) { fprintf(stderr, "kernel_launch: MoE overlay does not fit\n"); return; } }
    a.f.wt_in = (bf16s*)carve((size_t)Dm::ZW * D * 2);
    a.f.wt_out = (bf16s*)carve((size_t)D * D * 2);
    if (off > ws_size || n_in != 31) { fprintf(stderr, "kernel_launch: workspace too small (%zu needed, %zu given) or n_in %d != 31; nothing launched\n", off, ws_size, n_in); return; }
    static int grid = 0;
    if (grid == 0) {
        int dev = 0, cus = 0, per_cu = 0;
        hipGetDevice(&dev); hipDeviceGetAttribute(&cus, hipDeviceAttributeMultiprocessorCount, dev);
        if (hipFuncSetAttribute((const void*)mega, hipFuncAttributeMaxDynamicSharedMemorySize, LDS_BYTES) != hipSuccess) { fprintf(stderr, "kernel_launch: hipFuncSetAttribute failed\n"); grid = -1; return; }
        hipOccupancyMaxActiveBlocksPerMultiprocessor(&per_cu, (const void*)mega, NTHREADS, LDS_BYTES);
        (void)hipGetLastError();
        if (per_cu < 1) fprintf(stderr, "kernel_launch: occupancy query says %d blocks per CU\n", per_cu);
        grid = cus > 0 ? cus : 256;
    }
    if (grid < 0) return;
    hipMemsetAsync(ctl, 0, 65536, stream);
#if ONE_LAUNCH
    a.lo = 0; a.hi = NPH;
    hipLaunchKernelGGL(mega, dim3(grid), dim3(NTHREADS), LDS_BYTES, stream, a);
#else
    for (int k = 0; k < NPH; ++k) { a.lo = k; a.hi = k + 1; hipLaunchKernelGGL(mega, dim3(grid), dim3(NTHREADS), LDS_BYTES, stream, a); }
#endif
}
```

```cpp
#include <hip/hip_runtime.h>
#include <cstdio>
#include <cstdint>
#include <stdint.h>
#include <math.h>

#ifndef HD
#ifdef CPU_SHIM
#define HD
#else
#define HD __host__ __device__ __forceinline__
#endif
#endif

typedef unsigned short bf16s;
HD float bf2f(bf16s v) { union { unsigned u; float f; } c; c.u = ((unsigned)v) << 16; return c.f; }
HD bf16s f2bf(float f) { union { unsigned u; float f; } c; c.f = f; unsigned u = c.u; u += 0x7FFFu + ((u >> 16) & 1u); return (bf16s)(u >> 16); }
HD float ldv(const float* p) { return *p; }
HD float ldv(const bf16s* p) { return bf2f(*p); }
HD void stv(float* p, float v) { *p = v; }
HD void stv(bf16s* p, float v) { *p = f2bf(v); }
HD float silu_f(float x) { return x / (1.f + expf(-x)); }
HD float sigm_f(float x) { return 1.f / (1.f + expf(-x)); }

#ifdef CPU_SHIM
static inline int atomic_add_i(int* p, int v) { int o = *p; *p = o + v; return o; }
static inline void atomic_add_f(float* p, float v) { *p += v; }
#else
__device__ __forceinline__ int atomic_add_i(int* p, int v) { return atomicAdd(p, v); }
__device__ __forceinline__ void atomic_add_f(float* p, float v) { unsafeAtomicAdd(p, v); }
#endif

struct DimsFull {
    static constexpr int D = 1024, B = 16, L = 2048, NC = 256, DEPTH = 2, GRID_W = 64;
    static constexpr int C = 256  , DHG = 512, CFN = 256, NB = 16, EMB = 33, FH = 64;
    static constexpr int HDIM = 128, H = 4, G = 4, GD = 64;
    static constexpr int DP = 3 * C + 5 * DHG + CFN;
    static constexpr int ZW = 3 * C + 5 * DHG + 2 * CFN;
    static constexpr int E = 16, NG = 4, EPG = 4, DE = 512;
    static constexpr int RB = 8, BB = 8, MPAD = 256;
    typedef bf16s st;
};
#ifdef CPU_SHIM
struct DimsTest {
    static constexpr int D = 64, B = 2, L = 64, NC = 16, DEPTH = 2, GRID_W = 8;
    static constexpr int C = 16, DHG = 32, CFN = 16, NB = 4, EMB = 9, FH = 8;
    static constexpr int HDIM = 8, H = 4, G = 2, GD = 8;
    static constexpr int DP = 3 * C + 5 * DHG + CFN;
    static constexpr int ZW = 3 * C + 5 * DHG + 2 * CFN;
    static constexpr int E = 16, NG = 4, EPG = 4, DE = 16;
    static constexpr int RB = 8, BB = 2, MPAD = 8;
#ifdef TEST_BF16
    typedef bf16s st;
#else
    typedef float st;
#endif
};
#endif

template <class Dm> struct Params {
    typedef typename Dm::st st;
    const float *x, *c, *ctx, *c_ctx, *ada_w, *ada_b, *norm1_g, *norm2_g, *w_in, *w_out, *hy_conv_w, *hy_conv_b, *hy_w1, *hy_b1, *hy_w2, *hy_b2, *hy_w3, *hy_freq,
        *hy_bias, *hy_norm_g, *hg_lb, *hg_norm_g, *fn_w, *fn_b, *fn_norm_g, *router_w, *router_b, *moe_wg, *moe_wu, *moe_wd, *final_g;
    float* out;
    float* cw;
    st* xb;
    float* mod;
    float* lbv;
    float* wcs;
    float* wfn;
    float* hf1;
    float* hf2;
    float* hfil;
    float* rs;
    st* hx;
    st* z;
    st* zh_c; st* zh_x;
    st* pq_c; st* pq_x;
    st* krt_c; st* krt_x;
    st* y1t_c; st* y1t_x; st* y2t_c; st* y2t_x;
    st* dft_c; st* dft_x;
    st* uv;
    st* y1;
    st* y2;
    st* o;
    st* ob;
    st* vit;
    st* yfn;
    int* ridx;
    float* rgp;
    int* cnt;
    int* perm;
    int* rrank;
    int* rpos;
    int* wgbase;
    st* hmid;
};

template <class Dm> struct NV {
    typedef Params<Dm> P;
    typedef typename Dm::st st;
    static constexpr int D = Dm::D, B = Dm::B, L = Dm::L, NC = Dm::NC, C = Dm::C, DHG = Dm::DHG, CFN = Dm::CFN, ZW = Dm::ZW, DP = Dm::DP;
    static constexpr int RC = B * NC, RX = B * L, RALL = RC + RX;
    static constexpr int ZS = 4 * DHG, OFF_Q = 0, OFF_FF = DHG, OFF_FB = 2 * DHG, OFF_G = 3 * DHG;
    static constexpr float EPS = 1e-6f;
    static constexpr float TWO_PI = 6.283185307179586f;

    static HD float* xrow(const P& p, int R) { return R < RC ? p.cw + (size_t)R * D : p.out + (size_t)(R - RC) * D; }
    static HD int row_b(int R) { return R < RC ? R / NC : (R - RC) / L; }
    static HD int row_l(int R) { return R < RC ? R % NC : (R - RC) % L; }
    static HD int row_modr(int R) { return R < RC ? B : (R - RC) / L; }
    static HD int row_of(int isx, int b, int l) { return isx ? RC + b * L + l : b * NC + l; }
    static HD const float* modp(const P& p, int layer, int mr, int which) { return p.mod + ((size_t)(layer * (B + 1) + mr) * 6 + which) * D; }

    static HD void p_pro_a(const P& p, long tid, long nth) {
        for (long i = tid; i < 2 * DHG; i += nth) {
            float mx = -1e30f;
            for (int l = 0; l < Dm::DEPTH; ++l) mx = fmaxf(mx, p.hg_lb[l * 2 * DHG + i]);
            float den = 0.f;
            for (int l = 0; l < Dm::DEPTH; ++l) den += expf(p.hg_lb[l * 2 * DHG + i] - mx);
            float cs = 0.f;
            for (int l = 0; l < Dm::DEPTH; ++l) { if (l > 0) cs += expf(p.hg_lb[l * 2 * DHG + i] - mx) / den; p.lbv[l * 2 * DHG + i] = cs; }
        }
        for (long i = tid; i < (long)Dm::DEPTH * Dm::G * Dm::GD * 2 * Dm::GD; i += nth) {
            const int GD = Dm::GD; const int d2 = (int)(i % (2 * GD)), c = (int)((i / (2 * GD)) % GD), g = (int)((i / (2 * GD * GD)) % Dm::G), layer = (int)(i / ((long)2 * GD * GD * Dm::G));
            const int d = d2 % GD, sn = d2 / GD;
            const float* w = p.fn_w + ((size_t)(layer * Dm::G + g) * GD) * GD + d;
            float acc = 0.f;
            for (int m = 0; m < GD; ++m) { const int cm = (c * m) % GD;
                const float ang = TWO_PI * (float)cm / (float)GD; acc += (sn ? __sinf(ang) : __cosf(ang)) * w[(size_t)m * GD]; }
            p.wcs[i] = acc;
        }
        for (long i = tid; i < (long)Dm::DEPTH * (NC + L) * Dm::FH; i += nth) {
            const int j = (int)(i % Dm::FH), ll = (int)((i / Dm::FH) % (NC + L)), layer = (int)(i / ((long)Dm::FH * (NC + L)));
            const int Lw = ll < NC ? NC : L, l = ll < NC ? ll : ll - NC;
            const float t = (float)l / (float)(Lw - 1), wv = TWO_PI * (float)l / (float)Lw;
            const float* w1 = p.hy_w1 + (size_t)layer * Dm::EMB * Dm::FH + j;
            float acc = t * w1[0];
            for (int bi = 0; bi < Dm::NB; ++bi) {
                const float band = 1e-4f + (float)bi * ((float)(Dm::NB - 1) - 1e-4f) / (float)(Dm::NB - 1);
                acc += cosf(band * wv) * w1[(size_t)(1 + bi) * Dm::FH] - sinf(band * wv) * w1[(size_t)(1 + Dm::NB + bi) * Dm::FH];
            }
            acc += p.hy_b1[layer * Dm::FH + j];
            p.hf1[i] = sinf(p.hy_freq[layer * Dm::FH + j] * acc);
        }
    }
    static HD void p_pro_b(const P& p, long tid, long nth) {
        for (long i = tid; i < (long)Dm::DEPTH * (NC + L) * Dm::FH; i += nth) {
            const int j = (int)(i % Dm::FH), layer = (int)(i / ((long)Dm::FH * (NC + L)));
            const float* h1 = p.hf1 + (i / Dm::FH) * Dm::FH;
            const float* w2 = p.hy_w2 + (size_t)layer * Dm::FH * Dm::FH + j;
            float acc = 0.f;
            for (int k = 0; k < Dm::FH; ++k) acc += h1[k] * w2[(size_t)k * Dm::FH];
            acc += p.hy_b2[layer * Dm::FH + j];
            p.hf2[i] = sinf(p.hy_freq[layer * Dm::FH + j] * acc);
        }
        for (long i = tid; i < (long)Dm::DEPTH * D * 2 * CFN; i += nth) {
            const int GD = Dm::GD; const int j = (int)(i % (2 * CFN)), k = (int)((i / (2 * CFN)) % D), layer = (int)(i / ((long)2 * CFN * D));
            const int sn = j / CFN, g = (j % CFN) / GD, d = j % GD;
            const float* wi = p.w_in + ((size_t)layer * D + k) * DP + 3 * C + 5 * DHG + g * GD;
            const float* wc = p.wcs + ((size_t)(layer * Dm::G + g) * GD) * 2 * GD + sn * GD + d;
            float acc = 0.f;
            for (int c = 0; c < GD; ++c) acc += wi[c] * wc[(size_t)c * 2 * GD];
            p.wfn[i] = acc;
        }
    }
    static HD void p_pro_c(const P& p, long tid, long nth) {
        const float max_decay = logf(1e-2f) / 0.3f, min_decay = logf(1e-2f) / 1.5f;
        for (long i = tid; i < (long)Dm::DEPTH * (NC + L) * 4 * C; i += nth) {
            const int oc = (int)(i % (4 * C)), ll = (int)((i / (4 * C)) % (NC + L)), layer = (int)(i / ((long)4 * C * (NC + L)));
            const int Lw = ll < NC ? NC : L, l = ll < NC ? ll : ll - NC, c = oc % C;
            const float t = (float)l / (float)(Lw - 1);
            const float* h2 = p.hf2 + (i / (4 * C)) * Dm::FH;
            const float* w3 = p.hy_w3 + (size_t)layer * Dm::FH * 4 * C + oc;
            float acc = 0.f;
            for (int k = 0; k < Dm::FH; ++k) acc += h2[k] * w3[(size_t)k * 4 * C];
            const float delta = min_decay + (max_decay - min_decay) * (float)c / (float)(C - 1);
            p.hfil[i] = acc * expf(-t * fabsf(delta));
        }
    }
    static HD float shortconv(const P& p, int layer, int R, int pc) {
        const int l = row_l(R), Lw = R < RC ? NC : L;
        const float* cwt = p.hy_conv_w + (size_t)layer * 3 * 3 * C + pc;
        const st* zr = R < RC ? p.zh_c + (size_t)pc * RC + R : p.zh_x + (size_t)pc * RX + (R - RC);
        float v = ldv(zr) * cwt[3 * C] + p.hy_conv_b[layer * 3 * C + pc];
        if (l > 0) v += ldv(zr - 1) * cwt[0];
        if (l < Lw - 1) v += ldv(zr + 1) * cwt[2 * 3 * C];
        return v;
    }
    static HD void p_uv(const P& p, int layer, int r0, long tid, long nth) {
        for (long i = (long)r0 * C + tid; i < (long)RALL * C; i += nth) { const int R = (int)(i / C), c = (int)(i % C); stv(p.uv + i, shortconv(p, layer, R, c)); }
    }
    static HD float hy_k(const P& p, int layer, int isx, int order, int d, int c) {
        const float* hf = p.hfil + ((size_t)layer * (NC + L) + (isx ? NC : 0)) * 4 * C;
        float v = d >= 0 ? hf[(size_t)d * 4 * C + (2 * order) * C + c] : hf[(size_t)(-d) * 4 * C + (2 * order + 1) * C + c];
        if (d == 0) v += p.hy_bias[(layer * 2 + order) * C + c];
        return v;
    }
    static HD void p_hyconv(const P& p, int layer, int order, int r0, long tid, long nth) {
        constexpr int BB = Dm::BB;
        const st* in = p.y1; st* outp = order == 0 ? p.y1 : p.y2;
        const long nc_items = (long)(B / BB) * NC * C, nx_items = (long)(B / BB) * L * C;
        for (long i = (r0 >= RC ? nc_items : 0) + tid; i < nc_items + nx_items; i += nth) {
            const int isx = i >= nc_items; const long ii = isx ? i - nc_items : i; const int Lw = isx ? L : NC;
            const int c = (int)(ii % C), t = (int)((ii / C) % Lw), b0 = (int)(ii / ((long)C * Lw)) * BB;
            float acc[BB];
#pragma unroll
            for (int r = 0; r < BB; ++r) acc[r] = 0.f;
            for (int s = 0; s < Lw; ++s) { const float kv = hy_k(p, layer, isx, order, t - s, c);
#pragma unroll
                for (int r = 0; r < BB; ++r) acc[r] += kv * (order == 0 ? shortconv(p, layer, row_of(isx, b0 + r, s), c) : ldv(in + (size_t)row_of(isx, b0 + r, s) * C + c)); }
#pragma unroll
            for (int r = 0; r < BB; ++r) { const int R = row_of(isx, b0 + r, t); stv(outp + (size_t)R * C + c, acc[r] * shortconv(p, layer, R, (order + 1) * C + c)); }
        }
    }
    static HD void p_hgscan(const P& p, long tid, long nth) {
        constexpr int HDM = Dm::HDIM;
        for (long i = tid; i < (long)B * Dm::H * HDM; i += nth) {
            const int v = (int)(i % HDM), h = (int)((i / HDM) % Dm::H), b = (int)(i / ((long)HDM * Dm::H));
            for (int dir = 0; dir < 2; ++dir) {
                float S[HDM];
#pragma unroll
                for (int d = 0; d < HDM; ++d) S[d] = 0.f;
                for (int seg = 0; seg < 2; ++seg) {
                    const int Lw = seg ? L : NC;
                    for (int tt = 0; tt < Lw; ++tt) {
                        const int t = dir ? Lw - 1 - tt : tt; const int R = row_of(seg, b, t);
                        const st* zr = p.z + (size_t)R * ZS;
                        const float vv = ldv(p.vit + (size_t)(h * HDM + v) * RALL + R);
                        const st* lf = zr + (dir ? OFF_FB : OFF_FF) + h * HDM; const st* q = zr + OFF_Q + h * HDM;
                        float o = 0.f;
#pragma unroll
                        for (int d = 0; d < HDM; ++d) { const float f = expf(ldv(lf + d)); S[d] = f * S[d] + (1.f - f) * vv; o += S[d] * ldv(q + d); }
                        stv((dir ? p.ob : p.o) + (size_t)R * DHG + h * HDM + v, o);
                    }
                }
            }
        }
    }
    static HD void p_moe_reset(const P& p, long tid, long nth) {
        for (long i = tid; i < 32; i += nth) p.cnt[i] = 0;
        for (long i = tid; i < (long)2 * RALL + Dm::E * Dm::MPAD; i += nth) p.perm[i] = -1;
    }
    static HD int moe_off(const P& p, int e) {
        int o = 0;
        for (int j = 0; j < e; ++j) o += (p.cnt[j] + Dm::MPAD - 1) / Dm::MPAD * Dm::MPAD;
        return o;
    }
    static HD void p_place(const P& p, int r0, long tid, long nth) {
        for (long ts = (long)r0 * 2 + tid; ts < (long)RALL * 2; ts += nth) {
            const int e = p.ridx[ts];
            const int pos = moe_off(p, e) + atomic_add_i(p.cnt + 16 + e, 1);
            p.perm[pos] = (int)ts;
        }
    }
    static HD void p_gather_dummy(const P&) {}
    static HD int moe_expert_of_unused(const P& p, int pos) { int e = 0; while (e + 1 < Dm::E && pos >= moe_off(p, e + 1)) ++e; return e; }
};
#define LAS __attribute__((address_space(3)))
typedef short bf16x8 __attribute__((ext_vector_type(8)));
typedef float f32x4 __attribute__((ext_vector_type(4)));
typedef float f32x2 __attribute__((ext_vector_type(2)));
typedef unsigned u32x4 __attribute__((ext_vector_type(4)));
typedef unsigned u32x2 __attribute__((ext_vector_type(2)));
typedef DimsFull DmF; typedef NV<DmF> NVF; typedef Params<DmF> PF;
constexpr int NTHREADS = 512;
constexpr int STAGE_BYTES = 131072;
constexpr int LDS_MISC_OFF = 143360;
constexpr int LDS_BYTES = LDS_MISC_OFF + 1024;

__device__ __forceinline__ unsigned cvt_pk_bf16(float lo, float hi) { unsigned r; asm volatile("v_cvt_pk_bf16_f32 %0, %1, %2" : "=v"(r) : "v"(lo), "v"(hi)); return r; }
__device__ __forceinline__ int tidx() { int t = threadIdx.x; asm volatile("" : "+v"(t)); return t; }
__device__ __forceinline__ void lds_barrier() { asm volatile("s_waitcnt lgkmcnt(0)" ::: "memory"); __builtin_amdgcn_s_barrier(); asm volatile("" ::: "memory"); }
__device__ __forceinline__ u32x2 pack4(f32x4 v) { u32x2 w; w.x = cvt_pk_bf16(v[0], v[1]); w.y = cvt_pk_bf16(v[2], v[3]); return w; }
__device__ __forceinline__ f32x4 unpack4(u32x2 w) { f32x4 v; v[0] = __uint_as_float(w.x << 16); v[1] = __uint_as_float(w.x & 0xffff0000u); v[2] = __uint_as_float(w.y << 16); v[3] = __uint_as_float(w.y & 0xffff0000u); return v; }
__device__ __forceinline__ float fast_silu(float x) { return x * __builtin_amdgcn_rcpf(1.f + __expf(-x)); }

#ifndef REP_EPI
#define REP_EPI 1
#endif
#ifndef RELAX_WAITS
#define RELAX_WAITS 0
#endif
namespace pg8 {
constexpr int BM = 256, BK = 64, HALF = 128, HTB = HALF * BK * 2;
__host__ __device__ __forceinline__ int lds_byte(int r, int c) { const int st = (r >> 4) * 2 + (c >> 5), rr = r & 15, cc = c & 31, ob = rr * 64 + cc * 2; return st * 1024 + (ob ^ (((ob >> 9) & 1) << 5)); }
__host__ __device__ __forceinline__ void stage_rc(int b, int& R, int& C) { const int st = b / 1024, sb = b % 1024, swz = sb ^ (((sb >> 9) & 1) << 5); R = (st >> 1) * 16 + swz / 64; C = (st & 1) * 32 + (swz % 64) / 2; }
__host__ __device__ __forceinline__ int perm32(int rho) { const int n = rho >> 4, i = rho & 15; return 8 * (i >> 2) + 4 * n + (i & 3); }
struct Unit { const char* a; const char* b; int i0, i1, i2, i3; const int* rows; };
struct Gemm { int K, lda, ldb; int* diag = nullptr; };
template <class Epi, class Sched, bool ALIGN_EPI = true, bool GATHER = false>
__device__ __forceinline__ void gemm_phase(LAS unsigned char* lds, const Gemm g, const Sched& S, const Epi& E) {
    const int tid = tidx(), wid = __builtin_amdgcn_readfirstlane(tid >> 6), lane = tid & 63, wr = wid >> 2, wc = wid & 3, fr = lane & 15, fq = lane >> 4;
    const int K = g.K, nt = K / BK;
    unsigned voffA[2], voffB[2];
#pragma unroll
    for (int i = 0; i < 2; ++i) { int R, C; stage_rc(tid * 16 + i * 8192, R, C); const int Rb = Epi::PERM ? ((R & ~31) + perm32(R & 31)) : R;
        voffA[i] = (unsigned)(R * g.lda + C) * 2u; voffB[i] = (unsigned)(Rb * g.ldb + C) * 2u; }
    const size_t kstep = (size_t)(BK * 2);
    const size_t hstepA = (size_t)HALF * g.lda * 2, hstepB = (size_t)HALF * g.ldb * 2;
    const unsigned ldsw = (unsigned)wid * 1024u;
    const int aoff = lds_byte(wr * 64 + fr, fq * 8), boff = lds_byte(wc * 32 + fr, fq * 8);
#define PG8_SA(b, h) (((b) * 2 + (h)) * HTB)
#define PG8_SB(b, h) ((4 + (b) * 2 + (h)) * HTB)
#define PG8_STAGE(bufoff, gbase, voff) do { _Pragma("unroll") for (int _i = 0; _i < 2; ++_i) \
        __builtin_amdgcn_global_load_lds((const unsigned*)((const char*)(gbase) + (voff)[_i]), (LAS unsigned*)(lds + (bufoff) + ldsw + _i * 8192), 16, 0, 0); } while (0)
#define PG8_TAB(k) (STAGE_BYTES + ((k) & 1) * 1024)
#define PG8_TABLOAD(k, u) do { if (wid == 0) __builtin_amdgcn_global_load_lds((const unsigned*)((u).rows + lane * 4), (LAS unsigned*)(lds + PG8_TAB(k)), 16, 0, 0); } while (0)
#define PG8_STAGEA(bufoff, gbase, h, k) do { if constexpr (GATHER) { _Pragma("unroll") for (int _i = 0; _i < 2; ++_i) { \
            const int ts_ = *(const LAS int*)(lds + PG8_TAB(k) + ((h) * 128 + (int)(voffA[_i] >> 11)) * 4); \
            __builtin_amdgcn_global_load_lds((const unsigned*)((const char*)(gbase) + ((unsigned)(ts_ < 0 ? 0 : ts_ >> 1) << 11) + (voffA[_i] & 2047u)), (LAS unsigned*)(lds + (bufoff) + ldsw + _i * 8192), 16, 0, 0); } } \
        else { PG8_STAGE(bufoff, (gbase) + (h) * hstepA, voffA); } } while (0)
#define PG8_LDA(dst, b, h) do { _Pragma("unroll") for (int m = 0; m < 4; ++m) _Pragma("unroll") for (int k = 0; k < 2; ++k) dst[m][k] = *(const LAS bf16x8*)(lds + PG8_SA(b, h) + aoff + m * 2048 + k * 1024); } while (0)
#define PG8_LDB(dst, b, h) do { _Pragma("unroll") for (int n = 0; n < 2; ++n) _Pragma("unroll") for (int k = 0; k < 2; ++k) dst[n][k] = *(const LAS bf16x8*)(lds + PG8_SB(b, h) + boff + n * 2048 + k * 1024); } while (0)
#define PG8_MMA(ai, bj, At, Bt) do { __builtin_amdgcn_s_setprio(1); _Pragma("unroll") for (int m = 0; m < 4; ++m) _Pragma("unroll") for (int n = 0; n < 2; ++n) _Pragma("unroll") for (int k = 0; k < 2; ++k) \
        acc[ai][bj][m][n] = __builtin_amdgcn_mfma_f32_16x16x32_bf16(Bt[n][k], At[m][k], acc[ai][bj][m][n], 0, 0, 0); __builtin_amdgcn_s_setprio(0); } while (0)
#define PG8_WAIT_V(n) asm volatile("s_waitcnt vmcnt(" #n ")" ::: "memory")
#define PG8_WAIT_V8R_(N) asm volatile("s_cmp_lg_u32 %0, 0\n\ts_cbranch_scc1 .Lrn%=\n\ts_cmp_eq_u32 %1, 0\n\ts_cbranch_scc1 .Lrn%=\n\ts_waitcnt vmcnt(" #N ")\n\ts_branch .Lrd%=\n.Lrn%=:\n\ts_waitcnt vmcnt(8)\n.Lrd%=:" :: "s"(t), "s"(ui) : "memory", "scc")
#define PG8_WAIT_V8R() do { if constexpr (!RELAX_WAITS) asm volatile("s_waitcnt vmcnt(8)" ::: "memory"); else if constexpr (Epi::NST == 16) PG8_WAIT_V8R_(24); else PG8_WAIT_V8R_(16); } while (0)
#define PG8_WAIT_L(n) asm volatile("s_waitcnt lgkmcnt(" #n ")" ::: "memory")
#define PG8_BAR __builtin_amdgcn_s_barrier()
#define PG8_SCHED __builtin_amdgcn_sched_barrier(0)
    Unit cur, nxt; int ui = 0;
    if (!S.next(0, cur)) return;
    f32x4 acc[2][2][4][2];
#pragma unroll
    for (int a = 0; a < 2; ++a)
#pragma unroll
        for (int b = 0; b < 2; ++b)
#pragma unroll
            for (int m = 0; m < 4; ++m)
#pragma unroll
                for (int n = 0; n < 2; ++n) acc[a][b][m][n] = (f32x4){0.f, 0.f, 0.f, 0.f};
    bf16x8 At[4][2], B0[2][2], B1[2][2];
    const char* cA = cur.a; const char* cB = cur.b;
    if constexpr (GATHER) { PG8_TABLOAD(0, cur); PG8_WAIT_V(0); __syncthreads(); }
    PG8_STAGE(PG8_SB(0, 0), cB, voffB); PG8_STAGE(PG8_SB(0, 1), cB + hstepB, voffB); PG8_STAGEA(PG8_SA(0, 0), cA, 0, 0); PG8_STAGEA(PG8_SA(0, 1), cA, 1, 0);
    if (wr == 1) PG8_BAR;
    PG8_WAIT_V(2); PG8_BAR;
    PG8_STAGE(PG8_SB(1, 0), cB + kstep, voffB); PG8_STAGEA(PG8_SA(1, 0), cA + kstep, 0, 0); PG8_STAGE(PG8_SB(1, 1), cB + hstepB + kstep, voffB);
    PG8_WAIT_V(6); PG8_BAR;
#ifdef DIAG_GEMMTIME
    unsigned long long tk_ = 0, te_ = 0, t0_ = 0, t1_ = 0;
#endif
    for (;;) {
        const bool has_next = S.next(ui + 1, nxt);
        const char* nA = has_next ? nxt.a : cA; const char* nB = has_next ? nxt.b : cB;
        const int kn = has_next ? ui + 1 : ui;
        if constexpr (GATHER) { if (has_next) PG8_TABLOAD(ui + 1, nxt); }
#ifdef DIAG_GEMMTIME
        t0_ = wall_clock64();
#endif
        for (int t = 0; t < nt; t += 2) {
            const bool last = (t == nt - 2);
            const char* a1 = cA + (size_t)(t + 1) * kstep;
            const char* a2 = last ? nA : cA + (size_t)(t + 2) * kstep; const char* b2 = last ? nB : cB + (size_t)(t + 2) * kstep;
            const char* a3 = a2 + kstep; const char* b3 = b2 + kstep;
            const int kl = last ? kn : ui;
            PG8_LDB(B0, 0, 0); PG8_LDB(B1, 0, 1); PG8_SCHED; PG8_LDA(At, 0, 0); PG8_STAGEA(PG8_SA(1, 1), a1, 1, ui);
            PG8_WAIT_V8R(); PG8_WAIT_L(0); PG8_BAR; PG8_MMA(0, 0, At, B0); PG8_MMA(0, 1, At, B1); PG8_BAR; PG8_SCHED;
            PG8_LDA(At, 0, 1); PG8_STAGE(PG8_SB(0, 0), b2, voffB); PG8_STAGE(PG8_SB(0, 1), b2 + hstepB, voffB); PG8_STAGEA(PG8_SA(0, 0), a2, 0, kl);
            PG8_WAIT_V8R(); PG8_WAIT_L(0); PG8_BAR; PG8_MMA(1, 0, At, B0); PG8_MMA(1, 1, At, B1); PG8_BAR; PG8_SCHED;
            PG8_LDB(B0, 1, 0); PG8_LDB(B1, 1, 1); PG8_SCHED; PG8_LDA(At, 1, 0); PG8_STAGEA(PG8_SA(0, 1), a2, 1, kl);
            PG8_WAIT_V8R(); PG8_WAIT_L(0); PG8_BAR; PG8_MMA(0, 0, At, B0); PG8_MMA(0, 1, At, B1); PG8_BAR; PG8_SCHED;
            PG8_LDA(At, 1, 1); PG8_STAGE(PG8_SB(1, 0), b3, voffB); PG8_STAGE(PG8_SB(1, 1), b3 + hstepB, voffB); PG8_STAGEA(PG8_SA(1, 0), a3, 0, kl);
            PG8_WAIT_V(8); PG8_WAIT_L(0); PG8_BAR; PG8_MMA(1, 0, At, B0); PG8_MMA(1, 1, At, B1); PG8_BAR; PG8_SCHED;
        }
#ifdef DIAG_GEMMTIME
        t1_ = wall_clock64(); tk_ += t1_ - t0_;
#endif
        if constexpr (ALIGN_EPI) { if (wr == 0) PG8_BAR; }
        for (int re_ = 0; re_ < (Epi::PERM ? REP_EPI : 1); ++re_) E(acc, cur, wr, wc, fr, fq);
#ifdef DIAG_GEMMTIME
        te_ += wall_clock64() - t1_;
        if (!has_next && g.diag && blockIdx.x == DIAG_BLOCK && tid == 0) { g.diag[0] = (int)tk_; g.diag[1] = (int)te_; g.diag[2] = ui + 1; }
#endif
        if (!has_next) break;
#pragma unroll
        for (int a = 0; a < 2; ++a)
#pragma unroll
            for (int b = 0; b < 2; ++b)
#pragma unroll
                for (int m = 0; m < 4; ++m)
#pragma unroll
                    for (int n = 0; n < 2; ++n) acc[a][b][m][n] = (f32x4){0.f, 0.f, 0.f, 0.f};
        cur = nxt; cA = nA; cB = nB; ++ui;
        if constexpr (ALIGN_EPI) { if (wr == 1) PG8_BAR; }
    }
    PG8_WAIT_V(0);
    if constexpr (!ALIGN_EPI) { if (wr == 0) PG8_BAR; }
    PG8_BAR;
#undef PG8_SA
#undef PG8_SB
#undef PG8_STAGE
#undef PG8_LDA
#undef PG8_STAGEA
#undef PG8_TAB
#undef PG8_TABLOAD
#undef PG8_LDB
#undef PG8_MMA
#undef PG8_WAIT_V
#undef PG8_WAIT_L
#undef PG8_WAIT_V8R
#undef PG8_WAIT_V8R_
#undef PG8_BAR
#undef PG8_SCHED
}
}

struct FastWs {
    bf16s* wt_in;
    bf16s* wt_out;
    bf16s* wt_gu;
    bf16s* wt_d;
    bf16s* hxs;
};

struct Deal { int x, j, W; __device__ __forceinline__ void init() { const int G = gridDim.x, c = blockIdx.x; x = c & 7; j = c >> 3; W = (G + 7) >> 3; } };

struct XpJob { const float* src; int sld, k0, n0; bf16s* dst; int dld, drow0; };
__device__ __forceinline__ void xpose_load(const XpJob& j, int t, f32x4 (&v)[2]) {
#pragma unroll
    for (int ps = 0; ps < 2; ++ps) { const int k = (t >> 4) + 32 * ps, n4 = (t & 15) * 4; v[ps] = *(const f32x4*)(j.src + (size_t)(j.k0 + k) * j.sld + j.n0 + n4); }
}
__device__ __forceinline__ void xpose_store(LAS float* tile, const XpJob& j, int t, const f32x4 (&v)[2]) {
#pragma unroll
    for (int ps = 0; ps < 2; ++ps) { const int k = (t >> 4) + 32 * ps, n4 = (t & 15) * 4;
        tile[k * 65 + n4 + 0] = v[ps][0]; tile[k * 65 + n4 + 1] = v[ps][1]; tile[k * 65 + n4 + 2] = v[ps][2]; tile[k * 65 + n4 + 3] = v[ps][3]; }
    lds_barrier();
    { const int n = t >> 3, k8 = (t & 7) * 8; u32x4 w;
      w.x = cvt_pk_bf16(tile[(k8 + 0) * 65 + n], tile[(k8 + 1) * 65 + n]); w.y = cvt_pk_bf16(tile[(k8 + 2) * 65 + n], tile[(k8 + 3) * 65 + n]);
      w.z = cvt_pk_bf16(tile[(k8 + 4) * 65 + n], tile[(k8 + 5) * 65 + n]); w.w = cvt_pk_bf16(tile[(k8 + 6) * 65 + n], tile[(k8 + 7) * 65 + n]);
      *(u32x4*)(j.dst + (size_t)(j.drow0 + n) * j.dld + j.k0 + k8) = w; }
    lds_barrier();
}
__device__ __forceinline__ XpJob job_inout(const PF& p, const FastWs& f, int layer, int it) {
    constexpr int D = DmF::D, T_IN = (3328 / 64) * (D / 64), T_FN = (512 / 64) * (D / 64);
    int r = it;
    if (r < T_IN) { const int nt = r / (D / 64), kt = r % (D / 64); return XpJob{p.w_in + (size_t)layer * D * DmF::DP, DmF::DP, kt * 64, nt * 64, f.wt_in, D, nt * 64}; } r -= T_IN;
    if (r < T_FN) { const int nt = r / (D / 64), kt = r % (D / 64); return XpJob{p.wfn + (size_t)layer * D * 512, 512, kt * 64, nt * 64, f.wt_in, D, 3328 + nt * 64}; } r -= T_FN;
    { const int nt = r / (D / 64), kt = r % (D / 64); return XpJob{p.w_out + (size_t)layer * D * D, D, kt * 64, nt * 64, f.wt_out, D, nt * 64}; }
}
__device__ __forceinline__ void f_cvt_inout(const PF& p, const FastWs& f, int layer, LAS unsigned char* lds) {
    LAS float* tile = (LAS float*)lds; const int t = tidx();
    constexpr int D = DmF::D, NT = (3328 / 64) * (D / 64) + (512 / 64) * (D / 64) + (D / 64) * (D / 64);
    int it = blockIdx.x; if (it >= NT) return;
    XpJob cur = job_inout(p, f, layer, it); f32x4 v[2]; xpose_load(cur, t, v);
    for (;;) { const int nx = it + (int)gridDim.x; const bool more = nx < NT; XpJob nj = cur; f32x4 nvv[2];
        if (more) { nj = job_inout(p, f, layer, nx); xpose_load(nj, t, nvv); }
        xpose_store(tile, cur, t, v);
        if (!more) break;
        cur = nj; v[0] = nvv[0]; v[1] = nvv[1]; it = nx; }
}
__device__ __forceinline__ XpJob job_moe(const PF& p, const FastWs& f, int layer, int it) {
    constexpr int D = DmF::D, DE = DmF::DE, TG = (DE / 64) * (D / 64)  , TD = (D / 64) * (DE / 64)  , PER_E = 2 * TG + TD;
    const int e = it / PER_E; int r = it % PER_E;
    if (r < 2 * TG) { const int up = r / TG; r %= TG; const int nt = r / (D / 64), kt = r % (D / 64); const int n0 = nt * 64;
        const float* src = (up ? p.moe_wu : p.moe_wg) + ((size_t)(layer * DmF::E + e) * D) * DE;
        return XpJob{src, DE, kt * 64, n0, f.wt_gu + (size_t)e * 1024 * D, D, (n0 / 128) * 256 + up * 128 + (n0 % 128)}; }
    r -= 2 * TG;
    { const int nt = r / (DE / 64), kt = r % (DE / 64);
      return XpJob{p.moe_wd + ((size_t)(layer * DmF::E + e) * DE) * D, D, kt * 64, nt * 64, f.wt_d + (size_t)e * D * DE, DE, nt * 64}; }
}
__device__ __forceinline__ void f_cvt_moe(const PF& p, const FastWs& f, int layer, LAS unsigned char* lds, int rank, int nwork) {
    LAS float* tile = (LAS float*)lds; const int t = tidx();
    constexpr int NT = DmF::E * (2 * 128 + 128);
    int it = rank; if (it < 0 || it >= NT) return;
    XpJob cur = job_moe(p, f, layer, it); f32x4 v[2]; xpose_load(cur, t, v);
    for (;;) { const int nx = it + nwork; const bool more = nx < NT; XpJob nj = cur; f32x4 nvv[2];
        if (more) { nj = job_moe(p, f, layer, nx); xpose_load(nj, t, nvv); }
        xpose_store(tile, cur, t, v);
        if (!more) break;
        cur = nj; v[0] = nvv[0]; v[1] = nvv[1]; it = nx; }
}

struct EpiInproj {
    static constexpr bool PERM = true; static constexpr int NST = 16;
    bf16s* z; bf16s* zh_c; bf16s* zh_x; bf16s* pq_c; bf16s* pq_x; bf16s* vit; const float* lbv;
    __device__ __forceinline__ void operator()(const f32x4 (&acc)[2][2][4][2], const pg8::Unit& u, int wr, int wc, int fr, int fq) const {
        const int tile = u.i1, pm = u.i0;
        if (u.i2) {
            const int tk = wc * 32 + 8 * fq;
            bf16s* base; size_t cstride;
            if (tile == 9 || tile == 10) { base = vit + (size_t)(tile - 9) * 256 * NVF::RALL + pm * 256; cstride = NVF::RALL; }
            else if (tile < 3) { if (pm < 16) { base = zh_c + (size_t)tile * 256 * NVF::RC + pm * 256; cstride = NVF::RC; } else { base = zh_x + (size_t)tile * 256 * NVF::RX + (pm - 16) * 256; cstride = NVF::RX; } }
            else { const int sn = tile - 13;
                if (pm < 16) { base = pq_c + ((size_t)pm * 256 * 2 + sn) * 256; cstride = 2 * 256; }
                else { const int b = (pm - 16) >> 3, l0 = ((pm - 16) & 7) * 256; base = pq_x + ((size_t)b * 256 * 2 + sn) * 2048 + l0; cstride = 2 * 2048; } }
#pragma unroll
            for (int ai = 0; ai < 2; ++ai)
#pragma unroll
                for (int m = 0; m < 4; ++m) { bf16s* rowp = base + (size_t)(ai * 128 + wr * 64 + m * 16 + fr) * cstride + tk;
#pragma unroll
                    for (int bj = 0; bj < 2; ++bj) { const f32x4 v0 = acc[ai][bj][m][0], v1 = acc[ai][bj][m][1];
                        u32x4 w; w.x = cvt_pk_bf16(v0[0], v0[1]); w.y = cvt_pk_bf16(v0[2], v0[3]); w.z = cvt_pk_bf16(v1[0], v1[1]); w.w = cvt_pk_bf16(v1[2], v1[3]);
                        *(u32x4*)(rowp + bj * 128) = w; } }
            return;
        }
        const int row0 = pm * 256 + wr * 64 + fr; const int colt = (tile < 9 ? tile - 3 : tile - 5) * 256 + wc * 32 + 8 * fq;
        const int kind = tile < 5 ? 1 : tile < 9 ? 2 : 3;
        const float qs = 0.08838834764831845f;
#pragma unroll
        for (int bj = 0; bj < 2; ++bj) {
            const int col = colt + bj * 128;
            float lb[8];
            if (kind == 2) { const float* lp = lbv + (col - NVF::OFF_FF);
#pragma unroll
                for (int j = 0; j < 8; ++j) lb[j] = 1.f - lp[j]; }
#pragma unroll
            for (int ai = 0; ai < 2; ++ai)
#pragma unroll
                for (int m = 0; m < 4; ++m) {
                    float v[8];
#pragma unroll
                    for (int j = 0; j < 4; ++j) { v[j] = acc[ai][bj][m][0][j]; v[4 + j] = acc[ai][bj][m][1][j]; }
                    if (kind == 1) {
#pragma unroll
                        for (int j = 0; j < 8; ++j) v[j] = fast_silu(v[j]) * qs;
                    } else if (kind == 2) {
#pragma unroll
                        for (int j = 0; j < 8; ++j) { const float k = lb[j] * __builtin_amdgcn_rcpf(1.f + __expf(v[j])); v[j] = fmaxf(__logf(1.f - k), -30.f); }
                    } else if (kind == 3) {
#pragma unroll
                        for (int j = 0; j < 8; ++j) v[j] = fast_silu(v[j]);
                    }
                    u32x4 w; w.x = cvt_pk_bf16(v[0], v[1]); w.y = cvt_pk_bf16(v[2], v[3]); w.z = cvt_pk_bf16(v[4], v[5]); w.w = cvt_pk_bf16(v[6], v[7]);
                    *(u32x4*)(z + (size_t)(row0 + ai * 128 + m * 16) * NVF::ZS + col) = w;
                }
        }
    }
};
struct SchedInproj {
    const bf16s* hx; const bf16s* wt; int last; Deal d;
    __device__ __forceinline__ bool next(int i, pg8::Unit& u) const {
        if (d.W != 32) return next_generic(i, u);
        int r = i; const int s = d.j;
        int seen = -1;
        for (r = 0; r <= 8; ++r) { if (valid(r, s)) { if (++seen == i) break; } }
        if (r > 8) return false;
        fill(r, s, u); return true;
    }
#ifndef INPROJ_PB
#define INPROJ_PB 2
#endif
    static constexpr int PB = INPROJ_PB, TBITS = 5 - PB, TPR = 1 << TBITS, RPG = 16 >> TBITS  ;
    __device__ __forceinline__ bool valid(int r, int s) const { if (r < 8) return ((r & (RPG - 1)) * TPR + (s & (TPR - 1))) < 15; const int tile = s & 15; return last ? (tile >= 3 && tile <= 12) : (tile < 15); }
    __device__ __forceinline__ void fill(int r, int s, pg8::Unit& u) const {
        int pm, tile;
        if (r < 8) { tile = (r & (RPG - 1)) * TPR + (s & (TPR - 1)); pm = 16 + d.x * 16 + (1 << PB) * (r / RPG) + (s >> TBITS); } else { tile = s & 15; pm = d.x * 2 + (s >> 4); }
        const char* pa = (const char*)(hx + (size_t)pm * 256 * DmF::D); const char* pb = (const char*)(wt + (size_t)tile * 256 * DmF::D); const bool sw = tile < 3 || tile >= 13 || tile == 9 || tile == 10;
        u.a = sw ? pb : pa; u.b = sw ? pa : pb; u.i0 = pm; u.i1 = tile; u.i2 = sw ? 1 : 0; u.i3 = 0; u.rows = nullptr;
    }
    __device__ __forceinline__ bool next_generic(int i, pg8::Unit& u) const {
        const int nx = 128 * 15, nc = last ? 160 : 240; const int li = i * (int)gridDim.x + (int)blockIdx.x; if (li >= nx + nc) return false;
        int pm, tile; if (li < nx) { pm = 16 + li / 15; tile = li % 15; } else { const int q = li - nx; if (last) { pm = q / 10; tile = 3 + q % 10; } else { pm = q / 15; tile = q % 15; } }
        const char* pa = (const char*)(hx + (size_t)pm * 256 * DmF::D); const char* pb = (const char*)(wt + (size_t)tile * 256 * DmF::D); const bool sw = tile < 3 || tile >= 13 || tile == 9 || tile == 10;
        u.a = sw ? pb : pa; u.b = sw ? pa : pb; u.i0 = pm; u.i1 = tile; u.i2 = sw ? 1 : 0; u.i3 = 0; u.rows = nullptr; return true;
    }
};
__device__ __forceinline__ void f_inproj(const PF& p, const FastWs& f, int layer, int last, LAS unsigned char* lds) {
    SchedInproj S; S.hx = p.hx; S.wt = f.wt_in; S.last = last; S.d.init();
    EpiInproj E{p.z, p.zh_c, p.zh_x, p.pq_c, p.pq_x, p.vit, p.lbv + layer * 2 * DmF::DHG};
#ifndef INPROJ_ALIGN
#define INPROJ_ALIGN true
#endif
#ifdef DIAG_GEMMTIME
    pg8::gemm_phase<EpiInproj, SchedInproj, INPROJ_ALIGN>(lds, pg8::Gemm{DmF::D, DmF::D, DmF::D, layer == 0 ? p.cnt + 48 : nullptr}, S, E);
#else
    pg8::gemm_phase<EpiInproj, SchedInproj, INPROJ_ALIGN>(lds, pg8::Gemm{DmF::D, DmF::D, DmF::D}, S, E);
#endif
}

#ifndef XBF16
#define XBF16 1
#endif
#if XBF16
struct EpiWout {
    static constexpr bool PERM = true; static constexpr int NST = 8;
    bf16s* xb; const float* mod; float scale;
    __device__ __forceinline__ void operator()(const f32x4 (&acc)[2][2][4][2], const pg8::Unit& u, int wr, int wc, int fr, int fq) const {
        const int pm = u.i0; const int col0 = u.i1 * 256 + wc * 32 + 8 * fq;
        const int mr = pm < 16 ? DmF::B : (pm - 16) / 8;
        bf16s* base = xb + (size_t)pm * 256 * DmF::D;
        const float* gate = mod + ((size_t)mr * 6 + 2) * DmF::D;
        f32x4 gv[2][2];
#pragma unroll
        for (int bj = 0; bj < 2; ++bj)
#pragma unroll
            for (int n = 0; n < 2; ++n) gv[bj][n] = *(const f32x4*)(gate + col0 + bj * 128 + n * 4) * scale;
#pragma unroll
        for (int ai = 0; ai < 2; ++ai) { u32x4 old[4][2];
#pragma unroll
            for (int m = 0; m < 4; ++m)
#pragma unroll
                for (int bj = 0; bj < 2; ++bj) old[m][bj] = *(const u32x4*)(base + (size_t)(ai * 128 + wr * 64 + m * 16 + fr) * DmF::D + col0 + bj * 128);
#pragma unroll
            for (int m = 0; m < 4; ++m)
#pragma unroll
                for (int bj = 0; bj < 2; ++bj) { const f32x4 v0 = unpack4((u32x2){old[m][bj].x, old[m][bj].y}) + gv[bj][0] * acc[ai][bj][m][0], v1 = unpack4((u32x2){old[m][bj].z, old[m][bj].w}) + gv[bj][1] * acc[ai][bj][m][1];
                    u32x4 w; w.x = cvt_pk_bf16(v0[0], v0[1]); w.y = cvt_pk_bf16(v0[2], v0[3]); w.z = cvt_pk_bf16(v1[0], v1[1]); w.w = cvt_pk_bf16(v1[2], v1[3]);
                    *(u32x4*)(base + (size_t)(ai * 128 + wr * 64 + m * 16 + fr) * DmF::D + col0 + bj * 128) = w; } }
    }
};
#else
struct EpiWout {
    static constexpr bool PERM = false; static constexpr int NST = 8;
    float* cw; float* out; const float* mod; float scale;
    __device__ __forceinline__ void operator()(const f32x4 (&acc)[2][2][4][2], const pg8::Unit& u, int wr, int wc, int fr, int fq) const {
        const int pm = u.i0; const int col0 = u.i1 * 256 + wc * 32 + 4 * fq;
        const int mr = pm < 16 ? DmF::B : (pm - 16) / 8;
        float* base = pm < 16 ? cw + (size_t)pm * 256 * DmF::D : out + (size_t)(pm - 16) * 256 * DmF::D;
        const float* gate = mod + ((size_t)mr * 6 + 2) * DmF::D;
        f32x4 gv[2][2];
#pragma unroll
        for (int bj = 0; bj < 2; ++bj)
#pragma unroll
            for (int n = 0; n < 2; ++n) gv[bj][n] = *(const f32x4*)(gate + col0 + bj * 128 + n * 16) * scale;
#pragma unroll
        for (int ai = 0; ai < 2; ++ai)
#pragma unroll
            for (int m0 = 0; m0 < 4; m0 += 2) { f32x4 old[2][2][2];
#pragma unroll
                for (int mm = 0; mm < 2; ++mm) { const float* rowp = base + (size_t)(ai * 128 + wr * 64 + (m0 + mm) * 16 + fr) * DmF::D + col0;
#pragma unroll
                    for (int bj = 0; bj < 2; ++bj)
#pragma unroll
                        for (int n = 0; n < 2; ++n) old[mm][bj][n] = *(const f32x4*)(rowp + bj * 128 + n * 16); }
#pragma unroll
                for (int mm = 0; mm < 2; ++mm) { float* rowp = base + (size_t)(ai * 128 + wr * 64 + (m0 + mm) * 16 + fr) * DmF::D + col0;
#pragma unroll
                    for (int bj = 0; bj < 2; ++bj)
#pragma unroll
                        for (int n = 0; n < 2; ++n) *(f32x4*)(rowp + bj * 128 + n * 16) = old[mm][bj][n] + gv[bj][n] * acc[ai][bj][m0 + mm][n]; } }
    }
};
#endif
struct SchedWout {
    const bf16s* mix; const bf16s* wt; int p0; Deal d;
    __device__ __forceinline__ bool next(int i, pg8::Unit& u) const {
        const int ppx = (144 - p0) >> 3; const int li = i * d.W + d.j; if (li >= ppx * 4) return false;
        const int pm = p0 + d.x * ppx + (li >> 2), tile = li & 3;
        u.a = (const char*)(mix + (size_t)pm * 256 * DmF::D); u.b = (const char*)(wt + (size_t)tile * 256 * DmF::D); u.i0 = pm; u.i1 = tile; u.i2 = 0; u.i3 = 0; u.rows = nullptr;
        return true;
    }
};
__device__ __forceinline__ void f_wout(const PF& p, const FastWs& f, int layer, int r0, LAS unsigned char* lds, float scale = 1.f) {
    SchedWout S; S.mix = p.hx; S.wt = f.wt_out; S.p0 = r0 / 256; S.d.init();
#if XBF16
    EpiWout E{p.xb, p.mod + (size_t)layer * (DmF::B + 1) * 6 * DmF::D, scale};
#else
    EpiWout E{p.cw, p.out, p.mod + (size_t)layer * (DmF::B + 1) * 6 * DmF::D, scale};
#endif
#ifndef WOUT_ALIGN
#define WOUT_ALIGN true
#endif
    pg8::gemm_phase<EpiWout, SchedWout, WOUT_ALIGN>(lds, pg8::Gemm{DmF::D, DmF::D, DmF::D}, S, E);
}

__device__ __forceinline__ void f_gather(const PF& p, const FastWs& f) {
    const int total = NVF::moe_off(p, DmF::E);
    const long items = (long)total * 128;
    for (long i = (long)blockIdx.x * NTHREADS + tidx(); i < items; i += (long)gridDim.x * NTHREADS) {
        const int pos = (int)(i >> 7), ch = (int)(i & 127); const int ts = p.perm[pos];
        u32x4 v = (u32x4){0u, 0u, 0u, 0u};
        if (ts >= 0) v = *(const u32x4*)(p.hx + (size_t)(ts >> 1) * DmF::D + ch * 8);
        *(u32x4*)(f.hxs + (size_t)pos * DmF::D + ch * 8) = v;
    }
}
struct SchedMoe {
    const char* abase; size_t apanel; const char* bbase; size_t bexp, btile; const int* cnt; int npanels; Deal d; const int* perm;
    int segend[16];
    __device__ __forceinline__ void init_segments() { int o = 0;
#pragma unroll
        for (int j = 0; j < DmF::E; ++j) { o += (cnt[j] + 255) / 256 * 256; segend[j] = o; } }
    __device__ __forceinline__ int expert_of(int pos) const { int e = 0;
#pragma unroll
        for (int j = 0; j < DmF::E - 1; ++j) e += (pos >= segend[j]) ? 1 : 0;
        return e; }
    __device__ __forceinline__ bool next(int i, pg8::Unit& u) const {
        const int li = i * d.W + d.j; const int mine = (npanels - d.x + 7) >> 3; if (li >= mine * 4) return false;
        const int pm = d.x + 8 * (li >> 2), tile = li & 3;
        const int e = expert_of(pm * 256);
        u.a = perm ? abase : abase + (size_t)pm * apanel; u.b = bbase + (size_t)e * bexp + (size_t)tile * btile; u.i0 = pm; u.i1 = tile; u.i2 = e; u.i3 = 0; u.rows = perm ? perm + pm * 256 : nullptr;
        return true;
    }
};
struct EpiGateUp {
    static constexpr bool PERM = true; static constexpr int NST = 8;
    bf16s* hmid;
    __device__ __forceinline__ void operator()(const f32x4 (&acc)[2][2][4][2], const pg8::Unit& u, int wr, int wc, int fr, int fq) const {
        const int row0 = u.i0 * 256 + wr * 64 + fr; const int col = u.i1 * 128 + wc * 32 + 8 * fq;
#pragma unroll
        for (int ai = 0; ai < 2; ++ai)
#pragma unroll
            for (int m = 0; m < 4; ++m) {
                float v[8];
#pragma unroll
                for (int j = 0; j < 4; ++j) { v[j] = fast_silu(acc[ai][0][m][0][j]) * acc[ai][1][m][0][j]; v[4 + j] = fast_silu(acc[ai][0][m][1][j]) * acc[ai][1][m][1][j]; }
                u32x4 w; w.x = cvt_pk_bf16(v[0], v[1]); w.y = cvt_pk_bf16(v[2], v[3]); w.z = cvt_pk_bf16(v[4], v[5]); w.w = cvt_pk_bf16(v[6], v[7]);
                *(u32x4*)(hmid + (size_t)(row0 + ai * 128 + m * 16) * DmF::DE + col) = w;
            }
    }
};
struct EpiDown {
    static constexpr bool PERM = true; static constexpr int NST = 16;
    bf16s* ymoe;
    __device__ __forceinline__ void operator()(const f32x4 (&acc)[2][2][4][2], const pg8::Unit& u, int wr, int wc, int fr, int fq) const {
        const int row0 = u.i0 * 256 + wr * 64 + fr; const int col = u.i1 * 256 + wc * 32 + 8 * fq;
#pragma unroll
        for (int ai = 0; ai < 2; ++ai)
#pragma unroll
            for (int m = 0; m < 4; ++m)
#pragma unroll
                for (int bj = 0; bj < 2; ++bj) { const f32x4 v0 = acc[ai][bj][m][0], v1 = acc[ai][bj][m][1];
                    u32x4 w; w.x = cvt_pk_bf16(v0[0], v0[1]); w.y = cvt_pk_bf16(v0[2], v0[3]); w.z = cvt_pk_bf16(v1[0], v1[1]); w.w = cvt_pk_bf16(v1[2], v1[3]);
                    *(u32x4*)(ymoe + (size_t)(row0 + ai * 128 + m * 16) * DmF::D + col + bj * 128) = w; }
    }
};
__device__ __forceinline__ void f_gateup(const PF& p, const FastWs& f, LAS unsigned char* lds) {
    SchedMoe S; S.abase = (const char*)p.hx; S.perm = p.perm; S.apanel = 0; S.bbase = (const char*)f.wt_gu; S.bexp = (size_t)1024 * DmF::D * 2; S.btile = (size_t)256 * DmF::D * 2;
    S.cnt = p.cnt; S.init_segments(); S.npanels = S.segend[DmF::E - 1] / 256; S.d.init();
    EpiGateUp E{p.hmid};
#ifndef GATEUP_ALIGN
#define GATEUP_ALIGN true
#endif
    pg8::gemm_phase<EpiGateUp, SchedMoe, GATEUP_ALIGN, true>(lds, pg8::Gemm{DmF::D, DmF::D, DmF::D}, S, E);
}
__device__ __forceinline__ void f_down(const PF& p, const FastWs& f, int layer, LAS unsigned char* lds) {
    SchedMoe S; S.perm = nullptr; S.abase = (const char*)p.hmid; S.apanel = (size_t)256 * DmF::DE * 2; S.bbase = (const char*)f.wt_d; S.bexp = (size_t)DmF::D * DmF::DE * 2; S.btile = (size_t)256 * DmF::DE * 2;
    S.cnt = p.cnt; S.init_segments(); S.npanels = S.segend[DmF::E - 1] / 256; S.d.init();
    EpiDown E{f.hxs};
#ifndef DOWN_ALIGN
#define DOWN_ALIGN true
#endif
    pg8::gemm_phase<EpiDown, SchedMoe, DOWN_ALIGN>(lds, pg8::Gemm{DmF::DE, DmF::DE, DmF::DE}, S, E);
}

__device__ __forceinline__ void f_gen_dft(const PF& p, LAS unsigned char* lds) {
    LAS float* CT = (LAS float*)lds; LAS float* ST = CT + 2048;
    for (int m = tidx(); m < 2048; m += NTHREADS) { const float ang = 6.283185307179586f * (float)m / 2048.f; CT[m] = cosf(ang); ST[m] = sinf(ang); }
    __syncthreads();
    const long tid = (long)blockIdx.x * NTHREADS + tidx(), nth = (long)gridDim.x * NTHREADS;
    const float sx = 1.0f / sqrtf(64.f * 2048.f), sc = 1.0f / sqrtf(64.f * 256.f);
    for (long i = tid; i < ((long)2048 * 4096 + 256 * 512) / 2; i += nth) {
        const long e = i * 2; const bool isx = e < (long)2048 * 4096; const long ii = isx ? e : e - (long)2048 * 4096; const int Lw = isx ? 2048 : 256, sh = isx ? 0 : 3;
        const int k = (int)(ii / (2 * Lw)), lp = (int)(ii % (2 * Lw)), sn = lp >= Lw, l = sn ? lp - Lw : lp; const float s = isx ? sx : sc;
        const int m0 = ((k * l) & (Lw - 1)) << sh, m1 = ((k * (l + 1)) & (Lw - 1)) << sh;
        const float v0 = (sn ? -ST[m0] : CT[m0]) * s, v1 = (sn ? -ST[m1] : CT[m1]) * s;
        *(unsigned*)((isx ? p.dft_x : p.dft_c) + ii) = cvt_pk_bf16(v0, v1);
    }
    __syncthreads();
}
struct EpiFnet {
    static constexpr bool PERM = true; static constexpr int NST = 16;
    bf16s* yfn; const float* fn_b;
    __device__ __forceinline__ void operator()(const f32x4 (&acc)[2][2][4][2], const pg8::Unit& u, int wr, int wc, int fr, int fq) const {
        const int row0 = u.i0 + wr * 64 + fr; const int col0 = wc * 32 + 8 * fq;
#pragma unroll
        for (int bj = 0; bj < 2; ++bj) { const f32x4 b0 = *(const f32x4*)(fn_b + col0 + bj * 128), b1 = *(const f32x4*)(fn_b + col0 + bj * 128 + 4);
#pragma unroll
            for (int ai = 0; ai < 2; ++ai)
#pragma unroll
                for (int m = 0; m < 4; ++m) { const f32x4 v0 = acc[ai][bj][m][0] + b0, v1 = acc[ai][bj][m][1] + b1;
                    u32x4 w; w.x = cvt_pk_bf16(v0[0], v0[1]); w.y = cvt_pk_bf16(v0[2], v0[3]); w.z = cvt_pk_bf16(v1[0], v1[1]); w.w = cvt_pk_bf16(v1[2], v1[3]);
                    *(u32x4*)(yfn + (size_t)(row0 + ai * 128 + m * 16) * 256 + col0 + bj * 128) = w; } }
    }
};
struct SchedFnet {
    const bf16s* dft; const bf16s* pq; int first, n, npk_shift, rowbase, Lw;
    __device__ __forceinline__ bool next(int i, pg8::Unit& u) const {
        const int li = i * (int)gridDim.x + (int)blockIdx.x - first; if (li < 0 || li >= n) return false;
        const int b = li >> npk_shift, kp = li & ((1 << npk_shift) - 1);
        u.a = (const char*)(dft + (size_t)kp * 256 * 2 * Lw); u.b = (const char*)(pq + (size_t)b * 256 * 2 * Lw); u.i0 = rowbase + b * Lw + kp * 256; u.i1 = 0; u.i2 = 0; u.i3 = 0; u.rows = nullptr;
        return true;
    }
};
__device__ __forceinline__ void f_fnet(const PF& p, int layer, int with_ctx, LAS unsigned char* lds) {
    EpiFnet E{p.yfn, p.fn_b + layer * 256};
    { SchedFnet S{p.dft_x, p.pq_x, 0, 128, 3, NVF::RC, 2048}; pg8::gemm_phase<EpiFnet, SchedFnet>(lds, pg8::Gemm{4096, 4096, 4096}, S, E); }
    if (with_ctx) { SchedFnet S{p.dft_c, p.pq_c, 0, 16, 0, 0, 256}; pg8::gemm_phase<EpiFnet, SchedFnet>(lds, pg8::Gemm{512, 512, 512}, S, E); }
}
__device__ __forceinline__ float wave_sum(float v) {
#pragma unroll
    for (int o = 32; o >= 1; o >>= 1) v += __shfl_xor(v, o);
    return v;
}

#ifndef XBF16
#define XBF16 1
#endif
#if XBF16
#define XS_LOAD4(p, R, c) unpack4(*(const u32x2*)((p).xb + (size_t)(R) * DmF::D + (c)))
#define XS_STORE4(p, R, c, v) (*(u32x2*)((p).xb + (size_t)(R) * DmF::D + (c)) = pack4(v))
#else
#define XS_LOAD4(p, R, c) (*(const f32x4*)(NVF::xrow((p), (R)) + (c)))
#define XS_STORE4(p, R, c, v) (*(f32x4*)(NVF::xrow((p), (R)) + (c)) = (v))
#endif
struct MoePos { int p0, p1; float g0, g1; };
struct MoeRows { u32x2 a[4], b[4]; float g0, g1; };
__device__ __forceinline__ MoePos moe_pos_load(const PF& p, int R) { MoePos m; m.p0 = p.rpos[R * 2]; m.p1 = p.rpos[R * 2 + 1]; m.g0 = p.rgp[R * 2]; m.g1 = p.rgp[R * 2 + 1]; return m; }
__device__ __forceinline__ MoeRows moe_rows_load(const bf16s* ymoe, const MoePos& m, int lane) { MoeRows y; y.g0 = m.g0; y.g1 = m.g1;
#pragma unroll
    for (int i = 0; i < 4; ++i) { const int c = i * 256 + lane * 4; y.a[i] = *(const u32x2*)(ymoe + (size_t)m.p0 * DmF::D + c); y.b[i] = *(const u32x2*)(ymoe + (size_t)m.p1 * DmF::D + c); }
    return y; }
__device__ __forceinline__ void moe_combine_apply(const PF& p, const MoeRows& y, int player, int R, int lane, f32x4 (&v)[4]) {
    const float* m5 = NVF::modp(p, player, NVF::row_modr(R), 5);
#pragma unroll
    for (int i = 0; i < 4; ++i) { const int c = i * 256 + lane * 4; v[i] = v[i] + *(const f32x4*)(m5 + c) * (unpack4(y.a[i]) * y.g0 + unpack4(y.b[i]) * y.g1); }
}
template <bool ROUTER, bool COMBINE, bool INIT = false>
__device__ __forceinline__ void f_normmod(const PF& p, const bf16s* ymoe, int layer, int which, int r0, LAS unsigned char* lds, const float* postab = nullptr) {
    const int t = tidx(), lane = t & 63, gw = blockIdx.x * (NTHREADS / 64) + (t >> 6), NGW = gridDim.x * (NTHREADS / 64);
    const float* g = (which ? p.norm2_g : p.norm1_g) + layer * DmF::D;
    LAS int* hist = (LAS int*)lds;
    LAS float* RW = (LAS float*)(lds + 256);
    if constexpr (ROUTER) { if (t < 16) hist[t] = 0;
        for (int i = t; i < DmF::D * 16; i += NTHREADS) { const int k = i >> 4, e = i & 15; RW[e * DmF::D + k] = p.router_w[i]; }
        __syncthreads(); }
    const int rpw = (NVF::RALL - r0 + NGW - 1) / NGW, Rb = r0 + gw * rpw, Re = (Rb + rpw < NVF::RALL) ? Rb + rpw : NVF::RALL;
    f32x4 nv[4];
#define NM_LOAD(RR, dst) do { _Pragma("unroll") for (int i_ = 0; i_ < 4; ++i_) { if constexpr (INIT) { if ((RR) < NVF::RC) dst[i_] = *(const f32x4*)(p.ctx + (size_t)(RR) * DmF::D + i_ * 256 + lane * 4); \
            else dst[i_] = *(const f32x4*)(p.x + (size_t)((RR) - NVF::RC) * DmF::D + i_ * 256 + lane * 4) + *(const f32x4*)(postab + (size_t)(((RR) - NVF::RC) % DmF::L) * DmF::D + i_ * 256 + lane * 4); } \
            else dst[i_] = XS_LOAD4(p, (RR), i_ * 256 + lane * 4); } } while (0)
    MoePos npos; MoeRows nrows; int cur_mr = -1; f32x4 scg[4], shv[4];
    float rb[16];
    if constexpr (ROUTER) {
#pragma unroll
        for (int e = 0; e < 16; ++e) rb[e] = p.router_b[e]; }
    if (Rb < Re) { NM_LOAD(Rb, nv); if constexpr (COMBINE) { npos = moe_pos_load(p, Rb); nrows = moe_rows_load(ymoe, npos, lane); if (Rb + 1 < Re) npos = moe_pos_load(p, Rb + 1); } }
    for (int R = Rb; R < Re; ++R) {
        f32x4 v[4]; float ss = 0.f; MoeRows crows;
#pragma unroll
        for (int i = 0; i < 4; ++i) v[i] = nv[i];
        if constexpr (COMBINE) crows = nrows;
        if (R + 1 < Re) { NM_LOAD(R + 1, nv); if constexpr (COMBINE) { nrows = moe_rows_load(ymoe, npos, lane); if (R + 2 < Re) npos = moe_pos_load(p, R + 2); } }
        if constexpr (COMBINE) moe_combine_apply(p, crows, layer - 1, R, lane, v);
        if constexpr (COMBINE || INIT) {
#pragma unroll
            for (int i = 0; i < 4; ++i) XS_STORE4(p, R, i * 256 + lane * 4, v[i]); }
#pragma unroll
        for (int i = 0; i < 4; ++i) ss += v[i][0] * v[i][0] + v[i][1] * v[i][1] + v[i][2] * v[i][2] + v[i][3] * v[i][3];
        ss = wave_sum(ss);
        const float rstd = 1.0f / sqrtf(ss * (1.0f / DmF::D) + 1e-6f);
        const int mr = NVF::row_modr(R);
        if (mr != cur_mr) { cur_mr = mr; const float* sh = NVF::modp(p, layer, mr, which ? 3 : 0); const float* sc = NVF::modp(p, layer, mr, which ? 4 : 1);
#pragma unroll
            for (int i = 0; i < 4; ++i) { const int c = i * 256 + lane * 4; scg[i] = (*(const f32x4*)(sc + c) + 1.0f) * *(const f32x4*)(g + c); shv[i] = *(const f32x4*)(sh + c); } }
        bf16s* h = p.hx + (size_t)R * DmF::D;
#pragma unroll
        for (int i = 0; i < 4; ++i) { const int c = i * 256 + lane * 4; v[i] = v[i] * rstd * scg[i] + shv[i]; *(u32x2*)(h + c) = pack4(v[i]); }
        if constexpr (ROUTER) {
            float lg[16];
#pragma unroll
            for (int e = 0; e < 16; ++e) { float a = 0.f;
#pragma unroll
                for (int i = 0; i < 4; ++i) { const f32x4 wv4 = *(const LAS f32x4*)(RW + e * DmF::D + i * 256 + lane * 4); a += v[i][0] * wv4[0] + v[i][1] * wv4[1] + v[i][2] * wv4[2] + v[i][3] * wv4[3]; }
                lg[e] = a; }
#pragma unroll
            for (int e = 0; e < 16; ++e) lg[e] = wave_sum(lg[e]);
            if (lane == 0) {
                float mx = lg[0];
#pragma unroll
                for (int e = 1; e < 16; ++e) mx = fmaxf(mx, lg[e]);
                float den = 0.f;
#pragma unroll
                for (int e = 0; e < 16; ++e) { lg[e] = __expf(lg[e] - mx); den += lg[e]; }
                const float rden = 1.0f / den;
                float bestg = -1e30f; int bi0 = 0, bi1 = 0; float bp0 = 0.f, bp1 = 0.f;
#pragma unroll
                for (int gI = 0; gI < 4; ++gI) {
                    float s0 = -1e30f, s1 = -1e30f, p0 = 0.f, p1 = 0.f; int i0 = 0, i1 = 0;
#pragma unroll
                    for (int j = 0; j < 4; ++j) { const int e = gI * 4 + j; const float pr = lg[e] * rden; const float s = pr + rb[e];
                        if (s > s0) { s1 = s0; i1 = i0; p1 = p0; s0 = s; i0 = e; p0 = pr; } else if (s > s1) { s1 = s; i1 = e; p1 = pr; } }
                    const float gs = s0 + s1;
                    if (gs > bestg) { bestg = gs; bi0 = i0; bi1 = i1; bp0 = p0; bp1 = p1; }
                }
                const float sum = bp0 + bp1;
                p.ridx[R * 2] = bi0; p.ridx[R * 2 + 1] = bi1; p.rgp[R * 2] = bp0 / sum; p.rgp[R * 2 + 1] = bp1 / sum;
                p.rrank[R * 2] = __hip_atomic_fetch_add(hist + bi0, 1, __ATOMIC_RELAXED, __HIP_MEMORY_SCOPE_WORKGROUP);
                p.rrank[R * 2 + 1] = __hip_atomic_fetch_add(hist + bi1, 1, __ATOMIC_RELAXED, __HIP_MEMORY_SCOPE_WORKGROUP);
            }
        }
    }
#undef NM_LOAD
    if constexpr (ROUTER) { __syncthreads(); if (t < 16) p.wgbase[blockIdx.x * 16 + t] = atomicAdd(p.cnt + t, hist[t]); __syncthreads(); }
}
__device__ __forceinline__ void f_place_gather(const PF& p, const FastWs& f, int r0) {
    const int t = tidx(), lane = t & 63, gw = blockIdx.x * (NTHREADS / 64) + (t >> 6), NGW = gridDim.x * (NTHREADS / 64);
    const int rpw = (NVF::RALL - r0 + NGW - 1) / NGW, Rb = r0 + gw * rpw, Re = (Rb + rpw < NVF::RALL) ? Rb + rpw : NVF::RALL;
    for (int it = lane; it < (Re - Rb) * 2; it += 64) { const int ts = Rb * 2 + it, e = p.ridx[ts];
        const int pos = NVF::moe_off(p, e) + p.wgbase[blockIdx.x * 16 + e] + p.rrank[ts]; p.perm[pos] = ts; p.rpos[ts] = pos; }
}
__device__ __forceinline__ void f_mix(const PF& p, int layer, int r0) {
    const int t = tidx(), lane = t & 63, gw = blockIdx.x * (NTHREADS / 64) + (t >> 6), NGW = gridDim.x * (NTHREADS / 64);
    for (int R = r0 + gw; R < NVF::RALL; R += NGW) {
        bf16s* m = p.hx + (size_t)R * DmF::D;
        { f32x4 v = unpack4(*(const u32x2*)(p.y2 + (size_t)R * 256 + lane * 4)); float ss = wave_sum(v[0] * v[0] + v[1] * v[1] + v[2] * v[2] + v[3] * v[3]);
          const float rstd = 1.0f / sqrtf(ss * (1.0f / 256.f) + 1e-6f); const f32x4 gv = *(const f32x4*)(p.hy_norm_g + layer * 256 + lane * 4);
          *(u32x2*)(m + lane * 4) = pack4(v * rstd * gv); }
        {
          const u32x4 w = *(const u32x4*)(p.o + (size_t)R * 512 + lane * 8); f32x4 a = unpack4((u32x2){w.x, w.y}), b = unpack4((u32x2){w.z, w.w});
          float ss = a[0] * a[0] + a[1] * a[1] + a[2] * a[2] + a[3] * a[3] + b[0] * b[0] + b[1] * b[1] + b[2] * b[2] + b[3] * b[3];
#pragma unroll
          for (int o = 8; o >= 1; o >>= 1) ss += __shfl_xor(ss, o);
          const float rstd = 1.0f / sqrtf(ss * (1.0f / 128.f) + 1e-6f);
          const u32x4 gw4 = *(const u32x4*)(p.z + (size_t)R * NVF::ZS + NVF::OFF_G + lane * 8); const f32x4 ga = unpack4((u32x2){gw4.x, gw4.y}), gb = unpack4((u32x2){gw4.z, gw4.w});
          const f32x4 na = *(const f32x4*)(p.hg_norm_g + layer * 512 + lane * 8), nb = *(const f32x4*)(p.hg_norm_g + layer * 512 + lane * 8 + 4);
          const u32x2 o0 = pack4(a * rstd * na * ga), o1 = pack4(b * rstd * nb * gb);
          *(u32x4*)(m + 256 + lane * 8) = (u32x4){o0.x, o0.y, o1.x, o1.y}; }
        { f32x4 v = unpack4(*(const u32x2*)(p.yfn + (size_t)R * 256 + lane * 4)); float ss = wave_sum(v[0] * v[0] + v[1] * v[1] + v[2] * v[2] + v[3] * v[3]);
          const float rstd = 1.0f / sqrtf(ss * (1.0f / 256.f) + 1e-6f); const f32x4 gv = *(const f32x4*)(p.fn_norm_g + layer * 256 + lane * 4);
          *(u32x2*)(m + 768 + lane * 4) = pack4(v * rstd * gv); }
    }
}
__device__ __forceinline__ void f_final(const PF& p, const bf16s* ymoe) {
    const int t = tidx(), lane = t & 63, gw = blockIdx.x * (NTHREADS / 64) + (t >> 6), NGW = gridDim.x * (NTHREADS / 64);
    const int rpw = (NVF::RX + NGW - 1) / NGW, Rb = gw * rpw, Re = (Rb + rpw < NVF::RX) ? Rb + rpw : NVF::RX;
    f32x4 gfin[4];
#pragma unroll
    for (int i = 0; i < 4; ++i) gfin[i] = *(const f32x4*)(p.final_g + i * 256 + lane * 4);
    f32x4 nv[4]; MoePos npos; MoeRows nrows;
#define FN_LOAD(RR) do { _Pragma("unroll") for (int i_ = 0; i_ < 4; ++i_) nv[i_] = XS_LOAD4(p, NVF::RC + (RR), i_ * 256 + lane * 4); } while (0)
    if (Rb < Re) { FN_LOAD(Rb); npos = moe_pos_load(p, NVF::RC + Rb); nrows = moe_rows_load(ymoe, npos, lane); if (Rb + 1 < Re) npos = moe_pos_load(p, NVF::RC + Rb + 1); }
    for (int R = Rb; R < Re; ++R) {
        float* xr = p.out + (size_t)R * DmF::D;
        f32x4 v[4]; float ss = 0.f; const MoeRows crows = nrows;
#pragma unroll
        for (int i = 0; i < 4; ++i) v[i] = nv[i];
        if (R + 1 < Re) { FN_LOAD(R + 1); nrows = moe_rows_load(ymoe, npos, lane); if (R + 2 < Re) npos = moe_pos_load(p, NVF::RC + R + 2); }
        moe_combine_apply(p, crows, DmF::DEPTH - 1, NVF::RC + R, lane, v);
#pragma unroll
        for (int i = 0; i < 4; ++i) ss += v[i][0] * v[i][0] + v[i][1] * v[i][1] + v[i][2] * v[i][2] + v[i][3] * v[i][3];
        ss = wave_sum(ss);
        const float rstd = 1.0f / sqrtf(ss * (1.0f / DmF::D) + 1e-6f);
#pragma unroll
        for (int i = 0; i < 4; ++i) *(f32x4*)(xr + i * 256 + lane * 4) = v[i] * rstd * gfin[i];
    }
#undef FN_LOAD
#ifdef DIAG_OUT
    __syncthreads();
    if (blockIdx.x == 0 && t == 0) { asm volatile("s_waitcnt vmcnt(0)" ::: "memory"); p.out[0] = 1.0e4f * (1.0f + (float)__hip_atomic_load(p.cnt + DIAG_OUT, __ATOMIC_RELAXED, __HIP_MEMORY_SCOPE_AGENT)); }
#endif
#ifdef DIAG_SANITIZE
    __syncthreads();
    if (blockIdx.x == 0 && t == 0) { asm volatile("s_waitcnt vmcnt(0)" ::: "memory"); p.out[0] = 1.0e4f * (1.0f + (float)__hip_atomic_load(p.cnt + 40, __ATOMIC_RELAXED, __HIP_MEMORY_SCOPE_AGENT)); }
#endif
}
#ifndef REP_HYCONV
#define REP_HYCONV 1
#endif
template <int L> struct HyG {
    static_assert(8 * (2 * L * 2 + 32) + 16 * (L * 2 + 16) <= LDS_MISC_OFF, "Hyena LDS image does not fit");
    static constexpr int TB = L / 128;
    static constexpr int CS = 2 * L * 2 + 32;
    static constexpr int RSB = L * 2 + 16;
    static constexpr int U_OFF = 8 * CS;
    static constexpr int BYTES = U_OFF + 16 * RSB;
};
__device__ __forceinline__ float bflo(unsigned w) { return __uint_as_float(w << 16); }
__device__ __forceinline__ float bfhi(unsigned w) { return __uint_as_float(w & 0xffff0000u); }

template <int L> __device__ __forceinline__ void hy_build_copies(LAS unsigned char* lds, const bf16s* kr, int t) {
    constexpr int NCH = 2 * L / 8;
    for (int w = t; w < NCH; w += NTHREADS) {
        unsigned S[8];
        const u32x4 c0 = *(const u32x4*)(kr + w * 8); u32x4 c1 = (u32x4){0u, 0u, 0u, 0u};
        if (w + 1 < NCH) c1 = *(const u32x4*)(kr + w * 8 + 8);
        S[0] = c0.x; S[1] = c0.y; S[2] = c0.z; S[3] = c0.w; S[4] = c1.x; S[5] = c1.y; S[6] = c1.z; S[7] = c1.w;
#pragma unroll
        for (int a = 0; a < 8; ++a) { u32x4 o;
            if ((a & 1) == 0) { o.x = S[a / 2]; o.y = S[a / 2 + 1]; o.z = S[a / 2 + 2]; o.w = S[a / 2 + 3]; }
            else { const int h = (a - 1) / 2; o.x = (S[h] >> 16) | (S[h + 1] << 16); o.y = (S[h + 1] >> 16) | (S[h + 2] << 16); o.z = (S[h + 2] >> 16) | (S[h + 3] << 16); o.w = (S[h + 3] >> 16) | (S[h + 4] << 16); }
            *(LAS u32x4*)(lds + a * HyG<L>::CS + w * 16) = o; }
    }
}
template <int L, bool RAW> __device__ __forceinline__ void hy_stage_u(LAS unsigned char* lds, const bf16s* zrow, float w0, float w1, float w2, float bias, int t) {
    constexpr int NCH = 16 * L / 8, CPR = L / 8, PT = (NCH + NTHREADS - 1) / NTHREADS, G = PT < 4 ? PT : 4;
    static_assert(PT % G == 0, "chunk batching");
    for (int q0 = t; q0 < NCH; q0 += G * NTHREADS) {
        u32x4 v[G]; bf16s pv[G], nx[G];
#pragma unroll
        for (int u = 0; u < G; ++u) { const int q = q0 + u * NTHREADS; const bool ok = q < NCH; const int qq = ok ? q : 0; const int b = qq / CPR, s0 = (qq % CPR) * 8; const bf16s* src = zrow + (size_t)b * L + s0;
            v[u] = *(const u32x4*)src;
            if (!RAW) { pv[u] = src[s0 > 0 ? -1 : 0]; nx[u] = src[s0 + 8 < L ? 8 : 7]; } }
#pragma unroll
        for (int u = 0; u < G; ++u) { const int q = q0 + u * NTHREADS; if (q >= NCH) continue; const int b = q / CPR, s0 = (q % CPR) * 8;
            u32x4 o = v[u];
            if (!RAW) {
                const float prev = s0 > 0 ? bf2f(pv[u]) : 0.f, nxt = s0 + 8 < L ? bf2f(nx[u]) : 0.f;
                float z[10]; z[0] = prev; z[1] = bflo(o.x); z[2] = bfhi(o.x); z[3] = bflo(o.y); z[4] = bfhi(o.y); z[5] = bflo(o.z); z[6] = bfhi(o.z); z[7] = bflo(o.w); z[8] = bfhi(o.w); z[9] = nxt;
                float uu[8];
#pragma unroll
                for (int e = 0; e < 8; ++e) uu[e] = w0 * z[e] + w1 * z[e + 1] + w2 * z[e + 2] + bias;
                o.x = cvt_pk_bf16(uu[0], uu[1]); o.y = cvt_pk_bf16(uu[2], uu[3]); o.z = cvt_pk_bf16(uu[4], uu[5]); o.w = cvt_pk_bf16(uu[6], uu[7]);
            }
            *(LAS u32x4*)(lds + HyG<L>::U_OFF + b * HyG<L>::RSB + s0 * 2) = o; }
    }
}
template <int L, bool TO_LDS> __device__ __forceinline__ void hy_conv(LAS unsigned char* lds, const bf16s* zg, float g0, float g1, float g2, float gb, bf16s* outp, int t) {
    constexpr int TB = HyG<L>::TB, CS = HyG<L>::CS, RSB = HyG<L>::RSB, U_OFF = HyG<L>::U_OFF, NJ = L / 32;
    const int lane = t & 63, w = __builtin_amdgcn_readfirstlane(t >> 6), r = lane & 15, q = lane >> 4;
    const int a = 7 - (r & 7);
    const int baseA = a * CS + 2 * (L - 8 - 8 * (r >> 3) + 8 * q) - 32 * TB * w;
    const int baseB = U_OFF + r * RSB + 16 * q;
    f32x4 acc[TB]; bf16x8 F[TB];
#pragma unroll
    for (int ii = 0; ii < TB; ++ii) acc[ii] = (f32x4){0.f, 0.f, 0.f, 0.f};
#pragma unroll
    for (int ii = 2; ii < TB; ++ii) F[ii] = *(const LAS bf16x8*)(lds + baseA - 32 * ii);
    constexpr int PER = TB / 2;
    for (int j0 = 0; j0 < NJ; j0 += PER) {
        const int pA = baseA + 64 * j0, pB = baseB + 64 * j0;
#pragma unroll
        for (int jj = 0; jj < PER; ++jj) {
            F[(0 - 2 * jj) & (TB - 1)] = *(const LAS bf16x8*)(lds + pA + 64 * jj);
            F[(1 - 2 * jj) & (TB - 1)] = *(const LAS bf16x8*)(lds + pA + 64 * jj - 32);
            const bf16x8 Bf = *(const LAS bf16x8*)(lds + pB + 64 * jj);
#pragma unroll
            for (int ii = 0; ii < TB; ++ii) acc[ii] = __builtin_amdgcn_mfma_f32_16x16x32_bf16(F[(ii - 2 * jj) & (TB - 1)], Bf, acc[ii], 0, 0, 0);
        }
    }
    if constexpr (TO_LDS) lds_barrier();
    constexpr int EG = TB < 4 ? TB : 4;
#pragma unroll
    for (int i0 = 0; i0 < TB; i0 += EG) {
        u32x2 gv[EG]; bf16s pv[EG], nx[EG];
#pragma unroll
        for (int u = 0; u < EG; ++u) { const int t0 = 16 * (TB * w + i0 + u) + 4 * q; const bf16s* gp = zg + (size_t)r * L + t0;
            gv[u] = *(const u32x2*)gp; pv[u] = gp[t0 > 0 ? -1 : 0]; nx[u] = gp[t0 + 4 < L ? 4 : 3]; }
#pragma unroll
        for (int u = 0; u < EG; ++u) { const int ii = i0 + u; const int t0 = 16 * (TB * w + ii) + 4 * q;
            const float prev = t0 > 0 ? bf2f(pv[u]) : 0.f, nxt = t0 + 4 < L ? bf2f(nx[u]) : 0.f;
            float z[6]; z[0] = prev; z[1] = bflo(gv[u].x); z[2] = bfhi(gv[u].x); z[3] = bflo(gv[u].y); z[4] = bfhi(gv[u].y); z[5] = nxt;
            float o[4];
#pragma unroll
            for (int e = 0; e < 4; ++e) o[e] = acc[ii][e] * (g0 * z[e] + g1 * z[e + 1] + g2 * z[e + 2] + gb);
            u32x2 wv; wv.x = cvt_pk_bf16(o[0], o[1]); wv.y = cvt_pk_bf16(o[2], o[3]);
            if constexpr (TO_LDS) *(LAS u32x2*)(lds + U_OFF + r * RSB + t0 * 2) = wv; else *(u32x2*)(outp + (size_t)r * L + t0) = wv; }
    }
}
template <int L> __device__ __forceinline__ void hy_unit(const PF& p, int layer, int c, LAS unsigned char* lds, const bf16s* zh, size_t zstride, const bf16s* krt, bf16s* y1t, bf16s* y2t) {
    const int t = tidx();
    const float* cw = p.hy_conv_w + (size_t)layer * 9 * 256; const float* cb = p.hy_conv_b + (size_t)layer * 3 * 256;
    const bf16s* zv = zh + (size_t)c * zstride; const bf16s* z1 = zh + (size_t)(256 + c) * zstride; const bf16s* z2 = zh + (size_t)(512 + c) * zstride;
    hy_build_copies<L>(lds, krt + (size_t)c * 2 * L, t);
    hy_stage_u<L, false>(lds, zv, cw[c], cw[768 + c], cw[1536 + c], cb[c], t);
    lds_barrier();
    for (int q_ = 0; q_ < REP_HYCONV; ++q_) hy_conv<L, true>(lds, z1, cw[256 + c], cw[768 + 256 + c], cw[1536 + 256 + c], cb[256 + c], nullptr, t);
    hy_build_copies<L>(lds, krt + (size_t)(256 + c) * 2 * L, t);
    lds_barrier();
    for (int q_ = 0; q_ < REP_HYCONV; ++q_) hy_conv<L, false>(lds, z2, cw[512 + c], cw[768 + 512 + c], cw[1536 + 512 + c], cb[512 + c], y2t + (size_t)c * zstride, t);
    lds_barrier();
}
__device__ __forceinline__ void f_hyena(const PF& p, int layer, int with_ctx, LAS unsigned char* lds, int wg0, int nwg) {
    const int me = (int)blockIdx.x - wg0; if (me < 0 || me >= nwg) return;
    for (int c = me; c < 256; c += nwg)
        hy_unit<2048>(p, layer, c, lds, p.zh_x, NVF::RX, p.krt_x + (size_t)layer * 2 * 256 * 4096, p.y1t_x, p.y2t_x);
    if (with_ctx)
        for (int c = me; c < 256; c += nwg)
            hy_unit<256>(p, layer, c, lds, p.zh_c, NVF::RC, p.krt_c + (size_t)layer * 2 * 256 * 512, p.y1t_c, p.y2t_c);
}
__device__ __forceinline__ void f_gen_krt(const PF& p) {
    const long tid = (long)blockIdx.x * NTHREADS + tidx(), nth = (long)gridDim.x * NTHREADS;
    constexpr int NC = DmF::NC, L = DmF::L, C = DmF::C, FH = DmF::FH;
    const float max_decay = logf(1e-2f) / 0.3f, min_decay = logf(1e-2f) / 1.5f;
    for (long i = tid; i < (long)DmF::DEPTH * (NC + L) * 4 * C; i += nth) {
        const int oc = (int)(i % (4 * C)), ll = (int)((i / (4 * C)) % (NC + L)), layer = (int)(i / ((long)4 * C * (NC + L)));
        const int isx = ll >= NC, Lw = isx ? L : NC, l = isx ? ll - NC : ll, c = oc % C, fdir = oc / C, order = fdir >> 1, bwd = fdir & 1;
        const float tt = (float)l / (float)(Lw - 1);
        const float* h2 = p.hf2 + (i / (4 * C)) * FH;
        const float* w3 = p.hy_w3 + (size_t)layer * FH * 4 * C + oc;
        float acc = 0.f;
        for (int k = 0; k < FH; ++k) acc += h2[k] * w3[(size_t)k * 4 * C];
        const float delta = min_decay + (max_decay - min_decay) * (float)c / (float)(C - 1);
        float v = acc * expf(-tt * fabsf(delta));
        bf16s* kr = (isx ? p.krt_x : p.krt_c) + ((size_t)(layer * 2 + order) * 256 + c) * 2 * Lw;
        if (!bwd) { if (l == 0) v += p.hy_bias[(layer * 2 + order) * C + c]; kr[(Lw - 1) - l] = f2bf(v); }
        else { if (l > 0) kr[(Lw - 1) + l] = f2bf(v); else kr[2 * Lw - 1] = 0; }
    }
}
__device__ __forceinline__ void f_mix2(const PF& p, int layer, int r0, LAS unsigned char* lds) {
    const int t = tidx(), lane = t & 63, wv = t >> 6;
    constexpr int TS = 132;
    LAS float* ssb = (LAS float*)(lds + 256 * TS);
    float gq[32];
#pragma unroll
    for (int k = 0; k < 32; ++k) gq[k] = p.hy_norm_g[layer * 256 + wv * 32 + k];
    for (int tile = r0 / 64 + blockIdx.x; tile < NVF::RALL / 64; tile += gridDim.x) {
        const int R0 = tile * 64; const bool isc = R0 < NVF::RC;
        const bf16s* src = isc ? p.y2t_c + R0 : p.y2t_x + (R0 - NVF::RC); const size_t stride = isc ? NVF::RC : NVF::RX;
        for (int q = t; q < 2048; q += NTHREADS) { const int ch = q >> 3, k = q & 7; const u32x4 v = *(const u32x4*)(src + (size_t)ch * stride + k * 8);
            LAS unsigned* d = (LAS unsigned*)(lds + ch * TS + k * 16); d[0] = v.x; d[1] = v.y; d[2] = v.z; d[3] = v.w; }
        lds_barrier();
        float hv[32]; float ss = 0.f;
#pragma unroll
        for (int k = 0; k < 32; ++k) { hv[k] = bf2f(*(const LAS bf16s*)(lds + (wv * 32 + k) * TS + lane * 2)); ss += hv[k] * hv[k]; }
        ssb[wv * 64 + lane] = ss;
        lds_barrier();
        float tot = 0.f;
#pragma unroll
        for (int k = 0; k < 8; ++k) tot += ssb[k * 64 + lane];
        { const float rstd = 1.0f / sqrtf(tot * (1.0f / 256.f) + 1e-6f); bf16s* m = p.hx + (size_t)(R0 + lane) * DmF::D + wv * 32;
#pragma unroll
          for (int k = 0; k < 32; k += 8) { u32x4 w; w.x = cvt_pk_bf16(hv[k] * rstd * gq[k], hv[k + 1] * rstd * gq[k + 1]); w.y = cvt_pk_bf16(hv[k + 2] * rstd * gq[k + 2], hv[k + 3] * rstd * gq[k + 3]);
              w.z = cvt_pk_bf16(hv[k + 4] * rstd * gq[k + 4], hv[k + 5] * rstd * gq[k + 5]); w.w = cvt_pk_bf16(hv[k + 6] * rstd * gq[k + 6], hv[k + 7] * rstd * gq[k + 7]); *(u32x4*)(m + k) = w; } }
        { const f32x4 na = *(const f32x4*)(p.hg_norm_g + layer * 512 + lane * 8), nb = *(const f32x4*)(p.hg_norm_g + layer * 512 + lane * 8 + 4), gf = *(const f32x4*)(p.fn_norm_g + layer * 256 + lane * 4);
#pragma unroll
          for (int r4 = 0; r4 < 8; r4 += 4) {
            u32x4 wo[4], wb[4], wg[4]; u32x2 wf[4];
#pragma unroll
            for (int u = 0; u < 4; ++u) { const size_t R = (size_t)(R0 + wv * 8 + r4 + u);
                wo[u] = *(const u32x4*)(p.o + R * 512 + lane * 8); wb[u] = *(const u32x4*)(p.ob + R * 512 + lane * 8);
                wg[u] = *(const u32x4*)(p.z + R * NVF::ZS + NVF::OFF_G + lane * 8); wf[u] = *(const u32x2*)(p.yfn + R * 256 + lane * 4); }
#pragma unroll
            for (int u = 0; u < 4; ++u) { const int R = R0 + wv * 8 + r4 + u; bf16s* m = p.hx + (size_t)R * DmF::D;
                f32x4 a = unpack4((u32x2){wo[u].x, wo[u].y}) + unpack4((u32x2){wb[u].x, wb[u].y}), b = unpack4((u32x2){wo[u].z, wo[u].w}) + unpack4((u32x2){wb[u].z, wb[u].w});
                float s2 = a[0] * a[0] + a[1] * a[1] + a[2] * a[2] + a[3] * a[3] + b[0] * b[0] + b[1] * b[1] + b[2] * b[2] + b[3] * b[3];
#pragma unroll
                for (int o = 8; o >= 1; o >>= 1) s2 += __shfl_xor(s2, o);
                const float rstd = 1.0f / sqrtf(s2 * (1.0f / 128.f) + 1e-6f);
                const f32x4 ga = unpack4((u32x2){wg[u].x, wg[u].y}), gb = unpack4((u32x2){wg[u].z, wg[u].w});
                const u32x2 o0 = pack4(a * rstd * na * ga), o1 = pack4(b * rstd * nb * gb);
                *(u32x4*)(m + 256 + lane * 8) = (u32x4){o0.x, o0.y, o1.x, o1.y};
                f32x4 v = unpack4(wf[u]); float s3 = wave_sum(v[0] * v[0] + v[1] * v[1] + v[2] * v[2] + v[3] * v[3]);
                const float rstd3 = 1.0f / sqrtf(s3 * (1.0f / 256.f) + 1e-6f);
                *(u32x2*)(m + 768 + lane * 4) = pack4(v * rstd3 * gf); }
          } }
        lds_barrier();
    }
}
#ifndef REP_HG3
#define REP_HG3 1
#endif
namespace hg {
constexpr int RS = 272, QE_OFF = 0, QM_OFF = QE_OFF + 64 * RS, KM_OFF = QM_OFF + 64 * RS  ,
              KET_OFF = KM_OFF + 160 * RS, PT_OFF = KET_OFF + 128 * 144, TOT_OFF = PT_OFF + 64 * 144  , G_OFF = TOT_OFF + 4096, END = G_OFF + 512;
static_assert(END <= LDS_MISC_OFF, "HGRN LDS image does not fit");
typedef __bf16 bf16x2n __attribute__((ext_vector_type(2)));
__device__ __forceinline__ unsigned pk(float a, float b) { f32x2 v = {a, b}; bf16x2n r = __builtin_convertvector(v, bf16x2n); return __builtin_bit_cast(unsigned, r); }
__device__ __forceinline__ unsigned swp(unsigned x) { return (x >> 16) | (x << 16); }
__device__ __forceinline__ int chunk_rlo(int cc, int b, int dir) {
    const int seg = cc >= 4, ck = seg ? cc - 4 : cc, nck = seg ? 32 : 4, r0 = seg ? NVF::RC + b * 2048 : b * 256;
    return dir ? r0 + 64 * (nck - 1 - ck) : r0 + 64 * ck;
}
}
__device__ __forceinline__ void f_hgrn(const PF& p, LAS unsigned char* lds) {
    using namespace hg;
    const int t = tidx(), lane = t & 63, w = __builtin_amdgcn_readfirstlane(t >> 6), lr = lane & 15, qd = lane >> 4;
    const int sg = w >> 1, hh = w & 1, tau0 = 16 * sg + 8 * hh, d0 = 2 * lane;
    constexpr int ZS = NVF::ZS; constexpr size_t RALL = NVF::RALL;
    for (int ci = (int)gridDim.x - 1 - (int)blockIdx.x; ci < 128; ci += gridDim.x) {
        const int dir = ci & 1, h = (ci >> 1) & 3, b = ci >> 3;
        const bf16s* zq = p.z + NVF::OFF_Q + h * 128 + d0; const bf16s* zl = p.z + (dir ? NVF::OFF_FB : NVF::OFF_FF) + h * 128 + d0;
        const bf16s* vrow = p.vit + (size_t)(h * 128 + 16 * w + lr) * RALL;
        bf16s* outp = (dir ? p.ob : p.o) + h * 128 + 16 * w + 4 * qd;
        f32x4 S[8];
#pragma unroll
        for (int i = 0; i < 8; ++i) S[i] = (f32x4){0.f, 0.f, 0.f, 0.f};
        for (int i = t; i < 64 * 144 / 16; i += NTHREADS) *(LAS u32x4*)(lds + PT_OFF + i * 16) = (u32x4){0u, 0u, 0u, 0u};
#define HG_BAR() do { asm volatile("s_waitcnt lgkmcnt(0)" ::: "memory"); __builtin_amdgcn_s_barrier(); asm volatile("" ::: "memory"); } while (0)
        unsigned nq[8], nl[8]; u32x4 nv[2];
#define HG_LOAD(cc) do { const int rlo_ = chunk_rlo((cc), b, dir); _Pragma("unroll") for (int i_ = 0; i_ < 8; ++i_) { const size_t R_ = dir ? rlo_ + 63 - (tau0 + i_) : rlo_ + tau0 + i_; \
            nq[i_] = *(const unsigned*)(zq + R_ * ZS); nl[i_] = *(const unsigned*)(zl + R_ * ZS); } \
            _Pragma("unroll") for (int kb_ = 0; kb_ < 2; ++kb_) nv[kb_] = *(const u32x4*)(vrow + (dir ? rlo_ + 56 - 32 * kb_ - 8 * qd : rlo_ + 32 * kb_ + 8 * qd)); } while (0)
        unsigned cq[8], cl[8]; bf16x8 Vf[2];
#define HG_TAKE() do { _Pragma("unroll") for (int i_ = 0; i_ < 8; ++i_) { cq[i_] = nq[i_]; cl[i_] = nl[i_]; } \
            _Pragma("unroll") for (int kb_ = 0; kb_ < 2; ++kb_) { u32x4 x_ = nv[kb_]; if (dir) x_ = (u32x4){swp(x_.w), swp(x_.z), swp(x_.y), swp(x_.x)}; Vf[kb_] = __builtin_bit_cast(bf16x8, x_); } } while (0)
        HG_LOAD(0);
        HG_TAKE();
        HG_BAR();
        for (int cc = 0; cc < 36; ++cc) {
            const int Rlo = chunk_rlo(cc, b, dir);
            if (cc + 1 < 36) HG_LOAD(cc + 1);
            float c0[8], c1[8];
            { float a0 = 0.f, a1 = 0.f;
#pragma unroll
              for (int i = 0; i < 8; ++i) { a0 += bflo(cl[i]); a1 += bfhi(cl[i]); c0[i] = a0; c1[i] = a1; }
              *(LAS f32x2*)(lds + TOT_OFF + (w * 128 + d0) * 4) = (f32x2){a0, a1}; }
            HG_BAR();
            for (int rq_ = 0; rq_ < REP_HG3; ++rq_) { asm volatile("" ::: "memory");
            { f32x2 T[8];
#pragma unroll
              for (int j = 0; j < 8; ++j) T[j] = *(const LAS f32x2*)(lds + TOT_OFF + (j * 128 + d0) * 4);
              f32x2 pre[9]; pre[0] = (f32x2){0.f, 0.f};
#pragma unroll
              for (int j = 0; j < 8; ++j) pre[j + 1] = pre[j] + T[j];
              const f32x2 rt = sg == 0 ? pre[0] : sg == 1 ? pre[2] : sg == 2 ? pre[4] : pre[6];
              const f32x2 hoff = hh ? (sg == 0 ? T[0] : sg == 1 ? T[2] : sg == 2 ? T[4] : T[6]) : (f32x2){0.f, 0.f};
              const f32x2 bend = pre[8];
              const f32x2 Eoff = {__expf(rt[0]), __expf(rt[1])}, Fend = {__expf(bend[0] - rt[0]), __expf(bend[1] - rt[1])};
              const f32x2 F1 = {__expf(pre[2][0] - rt[0]), __expf(pre[2][1] - rt[1])}, F2 = {__expf(pre[4][0] - rt[0]), __expf(pre[4][1] - rt[1])}, F3 = {__expf(pre[6][0] - rt[0]), __expf(pre[6][1] - rt[1])};
              const int tl0 = sg == 0 ? 0 : sg == 1 ? 4 : sg == 2 ? 7 : 9;
              float ke0[8], ke1[8], kv0[8], kv1[8];
#pragma unroll
              for (int i = 0; i < 8; ++i) { const int tau = tau0 + i, trow = 8 * hh + i;
                  const float q0 = bflo(cq[i]), q1 = bfhi(cq[i]);
                  const float k0 = 1.f - __expf(bflo(cl[i])), k1 = 1.f - __expf(bfhi(cl[i]));
                  const float A0 = __expf(hoff[0] + c0[i]), A1 = __expf(hoff[1] + c1[i]);
                  const float ki0 = k0 * __builtin_amdgcn_rcpf(fmaxf(A0, 1.8e-35f)), ki1 = k1 * __builtin_amdgcn_rcpf(fmaxf(A1, 1.8e-35f));
                  const float qa0 = q0 * A0, qa1 = q1 * A1;
                  *(LAS unsigned*)(lds + QM_OFF + tau * RS + d0 * 2) = pk(qa0, qa1);
                  *(LAS unsigned*)(lds + QE_OFF + tau * RS + d0 * 2) = pk(qa0 * Eoff[0], qa1 * Eoff[1]);
                  *(LAS unsigned*)(lds + KM_OFF + (tl0 * 16 + trow) * RS + d0 * 2) = pk(ki0, ki1);
                  kv0[i] = ki0; kv1[i] = ki1; ke0[i] = ki0 * Fend[0]; ke1[i] = ki1 * Fend[1]; }
              if (sg < 1) {
#pragma unroll
                  for (int i = 0; i < 8; ++i) *(LAS unsigned*)(lds + KM_OFF + ((tl0 + 1 - sg) * 16 + 8 * hh + i) * RS + d0 * 2) = pk(kv0[i] * F1[0], kv1[i] * F1[1]); }
              if (sg < 2) {
#pragma unroll
                  for (int i = 0; i < 8; ++i) *(LAS unsigned*)(lds + KM_OFF + ((tl0 + 2 - sg) * 16 + 8 * hh + i) * RS + d0 * 2) = pk(kv0[i] * F2[0], kv1[i] * F2[1]); }
              if (sg < 3) {
#pragma unroll
                  for (int i = 0; i < 8; ++i) *(LAS unsigned*)(lds + KM_OFF + ((tl0 + 3 - sg) * 16 + 8 * hh + i) * RS + d0 * 2) = pk(kv0[i] * F3[0], kv1[i] * F3[1]); }
              u32x4 x0, x1; x0.x = pk(ke0[0], ke0[1]); x0.y = pk(ke0[2], ke0[3]); x0.z = pk(ke0[4], ke0[5]); x0.w = pk(ke0[6], ke0[7]); x1.x = pk(ke1[0], ke1[1]); x1.y = pk(ke1[2], ke1[3]); x1.z = pk(ke1[4], ke1[5]); x1.w = pk(ke1[6], ke1[7]);
              *(LAS u32x4*)(lds + KET_OFF + d0 * 144 + tau0 * 2) = x0; *(LAS u32x4*)(lds + KET_OFF + (d0 + 1) * 144 + tau0 * 2) = x1;
              if (w == 0) *(LAS f32x2*)(lds + G_OFF + d0 * 4) = (f32x2){__expf(bend[0]), __expf(bend[1])}; }
            }
            HG_BAR();
            for (int tl = w; tl < 10; tl += 8) {
                const int si = (int)((0x3221110000ull >> (4 * tl)) & 0xF), ti = (int)((0x3323213210ull >> (4 * tl)) & 0xF);
                f32x4 acc = (f32x4){0.f, 0.f, 0.f, 0.f};
#pragma unroll
                for (int kb = 0; kb < 4; ++kb) { const bf16x8 A = *(const LAS bf16x8*)(lds + KM_OFF + (16 * tl + lr) * RS + (32 * kb + 8 * qd) * 2); const bf16x8 B = *(const LAS bf16x8*)(lds + QM_OFF + (16 * ti + lr) * RS + (32 * kb + 8 * qd) * 2);
                    acc = __builtin_amdgcn_mfma_f32_16x16x32_bf16(A, B, acc, 0, 0, 0); }
                if (si == ti) {
#pragma unroll
                    for (int e = 0; e < 4; ++e) if (4 * qd + e > lr) acc[e] = 0.f; }
                u32x2 wv; wv.x = pk(acc[0], acc[1]); wv.y = pk(acc[2], acc[3]);
                *(LAS u32x2*)(lds + PT_OFF + (16 * ti + lr) * 144 + (16 * si + 4 * qd) * 2) = wv;
            }
            bf16x8 As[4];
#pragma unroll
            for (int kb = 0; kb < 4; ++kb) { u32x4 x; x.x = pk(S[2 * kb][0], S[2 * kb][1]); x.y = pk(S[2 * kb][2], S[2 * kb][3]); x.z = pk(S[2 * kb + 1][0], S[2 * kb + 1][1]); x.w = pk(S[2 * kb + 1][2], S[2 * kb + 1][3]); As[kb] = __builtin_bit_cast(bf16x8, x); }
            HG_BAR();
#pragma unroll
            for (int ti = 0; ti < 4; ++ti) {
                f32x4 acc = (f32x4){0.f, 0.f, 0.f, 0.f};
#pragma unroll
                for (int kb = 0; kb < 4; ++kb) { const u32x2 lo = *(const LAS u32x2*)(lds + QE_OFF + (16 * ti + lr) * RS + (32 * kb + 4 * qd) * 2), hi = *(const LAS u32x2*)(lds + QE_OFF + (16 * ti + lr) * RS + (32 * kb + 16 + 4 * qd) * 2);
                    const bf16x8 B = __builtin_bit_cast(bf16x8, (u32x4){lo.x, lo.y, hi.x, hi.y}); acc = __builtin_amdgcn_mfma_f32_16x16x32_bf16(As[kb], B, acc, 0, 0, 0); }
#pragma unroll
                for (int kb = 0; kb < 2; ++kb) if (kb == 0 || ti >= 2) { const bf16x8 B = *(const LAS bf16x8*)(lds + PT_OFF + (16 * ti + lr) * 144 + (32 * kb + 8 * qd) * 2); acc = __builtin_amdgcn_mfma_f32_16x16x32_bf16(Vf[kb], B, acc, 0, 0, 0); }
                const int tt = 16 * ti + lr; const size_t R = dir ? Rlo + 63 - tt : Rlo + tt;
                u32x2 wv; wv.x = pk(acc[0], acc[1]); wv.y = pk(acc[2], acc[3]);
                *(u32x2*)(outp + R * 512) = wv;
            }
#pragma unroll
            for (int i = 0; i < 8; ++i) { const f32x4 g4 = *(const LAS f32x4*)(lds + G_OFF + (16 * i + 4 * qd) * 4); f32x4 acc = S[i] * g4;
#pragma unroll
                for (int kb = 0; kb < 2; ++kb) { const bf16x8 A = *(const LAS bf16x8*)(lds + KET_OFF + (16 * i + lr) * 144 + (32 * kb + 8 * qd) * 2); acc = __builtin_amdgcn_mfma_f32_16x16x32_bf16(A, Vf[kb], acc, 0, 0, 0); }
                S[i] = acc; }
            if (cc + 1 < 36) HG_TAKE();
        }
#undef HG_TAKE
#undef HG_LOAD
#undef HG_BAR
        __syncthreads();
    }
}
__device__ __forceinline__ void f_ada(const PF& p, LAS unsigned char* lds) {
    const int t = tidx(), lane = t & 63, wv = t >> 6;
    constexpr int D = DmF::D, NR = DmF::B + 1, NITEM = DmF::DEPTH * 6 * D / 64;
    if ((int)blockIdx.x >= NITEM) return;
    LAS float* S = (LAS float*)lds;
    LAS float* PR = S + NR * D;
    for (int i = t; i < NR * D; i += NTHREADS) { const int r = i / D, k = i % D; const float c = r < DmF::B ? p.c[r * D + k] : p.c_ctx[k]; S[i] = c / (1.f + __expf(-c)); }
    __syncthreads();
    for (int q = blockIdx.x; q < NITEM; q += gridDim.x) {
        const int layer = q / (6 * D / 64), j = (q % (6 * D / 64)) * 64 + lane;
        const float* w = p.ada_w + (size_t)layer * D * 6 * D + j;
        float acc[NR];
#pragma unroll
        for (int r = 0; r < NR; ++r) acc[r] = 0.f;
#pragma unroll 2
        for (int k = wv * 128; k < wv * 128 + 128; k += 8) {
            float wq[8];
#pragma unroll
            for (int u = 0; u < 8; ++u) wq[u] = w[(size_t)(k + u) * 6 * D];
#pragma unroll
            for (int u = 0; u < 8; u += 4)
#pragma unroll
                for (int r = 0; r < NR; ++r) { const f32x4 s4 = *(const LAS f32x4*)(S + r * D + k + u); acc[r] += s4[0] * wq[u] + s4[1] * wq[u + 1] + s4[2] * wq[u + 2] + s4[3] * wq[u + 3]; }
        }
#pragma unroll
        for (int r = 0; r < NR; ++r) PR[(wv * NR + r) * 64 + lane] = acc[r];
        __syncthreads();
        for (int i = t; i < NR * 64; i += NTHREADS) { const int r = i >> 6, l2 = i & 63; float sum = 0.f;
#pragma unroll
            for (int w8 = 0; w8 < 8; ++w8) sum += PR[(w8 * NR + r) * 64 + l2];
            const int jj = (q % (6 * D / 64)) * 64 + l2; p.mod[((size_t)layer * NR + r) * 6 * D + jj] = sum + p.ada_b[layer * 6 * D + jj]; }
        __syncthreads();
    }
}
__device__ __forceinline__ void f_gen_postab(const PF& p, float* postab) {
    const long tid = (long)blockIdx.x * NTHREADS + tidx(), nth = (long)gridDim.x * NTHREADS;
    constexpr int D = DmF::D, L = DmF::L, Q4 = D / 4;
    for (long i = tid; i < (long)L * (D / 4); i += nth) {
        const int l = (int)(i / (D / 4)), k = (int)(i % (D / 4)) * 4, wq = k / Q4;
        const float pos = (float)(wq < 2 ? l / DmF::GRID_W : l % DmF::GRID_W);
        f32x4 pe;
#pragma unroll
        for (int e = 0; e < 4; ++e) { const int ix = (k + e) % Q4; const float omega = 1.0f / powf(10000.0f, (float)ix / (float)Q4); const float a = pos * omega; pe[e] = (wq & 1) ? cosf(a) : sinf(a); }
        *(f32x4*)(postab + (size_t)l * D + k) = pe;
    }
}
__device__ __forceinline__ void f_gen_krt3(const PF& p, LAS unsigned char* lds) {
    const int t = tidx(), cl = t & 63, lg = t >> 6;
    constexpr int NC = DmF::NC, L = DmF::L, C = DmF::C, FH = DmF::FH, NLB = (NC + L) / 64, NOB = 4 * C / 64;
    const float max_decay = logf(1e-2f) / 0.3f, min_decay = logf(1e-2f) / 1.5f;
    LAS float* T = (LAS float*)lds;
    constexpr int NCOMBO = DmF::DEPTH * NOB;
    const int combo = (int)blockIdx.x % NCOMBO, grp = (int)blockIdx.x / NCOMBO, ngrp = ((int)gridDim.x - combo + NCOMBO - 1) / NCOMBO;
    const int layer = combo / NOB, ob = combo % NOB, oc = ob * 64 + cl, c = oc % C;
    float wr[FH];
    { const float* w3 = p.hy_w3 + (size_t)layer * FH * 4 * C + oc;
#pragma unroll
      for (int k = 0; k < FH; ++k) wr[k] = w3[(size_t)k * 4 * C]; }
    for (int lb = grp; lb < NLB; lb += ngrp) {
        const int isx = lb >= NC / 64, Lw = isx ? L : NC, l0 = (isx ? lb - NC / 64 : lb) * 64;
        const float delta = fabsf(min_decay + (max_decay - min_decay) * (float)c / (float)(C - 1));
#pragma unroll
        for (int i = 0; i < 8; ++i) { const int l = l0 + lg * 8 + i; const float* h2 = p.hf2 + ((size_t)layer * (NC + L) + lb * 64 + lg * 8 + i) * FH;
            float acc = 0.f;
#pragma unroll
            for (int k = 0; k < FH; k += 4) { const f32x4 h = *(const f32x4*)(h2 + k); acc += h[0] * wr[k] + h[1] * wr[k + 1] + h[2] * wr[k + 2] + h[3] * wr[k + 3]; }
            T[cl * 65 + lg * 8 + i] = acc * expf(-((float)l / (float)(Lw - 1)) * delta); }
        lds_barrier();
        { const int c2 = t >> 3, sg = t & 7, oc2 = ob * 64 + c2, cc = oc2 % C, fdir = oc2 / C, order = fdir >> 1, bwd = fdir & 1;
          bf16s* kr = (isx ? p.krt_x : p.krt_c) + ((size_t)(layer * 2 + order) * 256 + cc) * 2 * Lw;
#pragma unroll
          for (int i = 0; i < 8; ++i) { const int l = l0 + sg * 8 + i; float v = T[c2 * 65 + sg * 8 + i];
              if (!bwd) { if (l == 0) v += p.hy_bias[(layer * 2 + order) * C + cc]; kr[(Lw - 1) - l] = f2bf(v); }
              else { if (l > 0) kr[(Lw - 1) + l] = f2bf(v); else kr[2 * Lw - 1] = 0; } } }
        lds_barrier();
    }
}

#define XB_TMO      128
#define XB_XCNT(j)  (256  + 64 * (j))
#define XB_XSUB(j)  (1280 + 64 * (j))
#define XB_XGEN(j)  (2304 + 64 * (j))
#define XB_TOP      3328
#define XB_TOPGEN   3392
#define XCD_BAR_WORDS 3456
#define XB_SPIN_CAP (1u << 21)

__device__ __forceinline__ unsigned xb_ld(unsigned* p)              { return __hip_atomic_load(p, __ATOMIC_RELAXED, __HIP_MEMORY_SCOPE_AGENT); }
__device__ __forceinline__ unsigned xb_add(unsigned* p, unsigned v) { return __hip_atomic_fetch_add(p, v, __ATOMIC_RELAXED, __HIP_MEMORY_SCOPE_AGENT); }
__device__ __forceinline__ unsigned xb_xcc_id() { return (unsigned)__builtin_amdgcn_s_getreg((3 << 11) | 20) & 0xFu; }
#define XB_SPIN(cond, bar) do { unsigned _sp = 0; while (cond) { __builtin_amdgcn_s_sleep(1); \
    if ((++_sp & 255u) == 0u) { if (xb_ld(&(bar)[XB_TMO])) break; if (_sp > XB_SPIN_CAP) { atomicAdd(&(bar)[XB_TMO], 1u); break; } } } } while (0)

struct XcdBarrier { unsigned* bar; unsigned x; volatile LAS unsigned* st; };

__device__ __forceinline__ XcdBarrier xcd_barrier_post(unsigned* bar, volatile LAS unsigned* st) {
    XcdBarrier b; b.bar = bar; b.x = xb_xcc_id(); b.st = st;
    if (threadIdx.x == 0) (void)xb_add(&bar[XB_XCNT(b.x)], 1u);
    return b;
}
__device__ __forceinline__ void xcd_barrier_complete(unsigned* bar, unsigned x, unsigned& nloc, unsigned& nx) {
    const unsigned G = gridDim.x * gridDim.y * gridDim.z;
    unsigned sum, cnt, mine, sp = 0u;
    for (;;) {
        sum = 0u; cnt = 0u; mine = 0u;
#pragma unroll
        for (unsigned j = 0; j < 16; ++j) { const unsigned c = xb_ld(&bar[XB_XCNT(j)]); sum += c; cnt += (c > 0u) ? 1u : 0u; mine = (j == x) ? c : mine; }
        if (sum == G) break;
        __builtin_amdgcn_s_sleep(1);
        if ((++sp & 255u) == 0u) { if (xb_ld(&bar[XB_TMO])) break; if (sp > XB_SPIN_CAP) { atomicAdd(&bar[XB_TMO], 1u); break; } }
    }
    nloc = mine > 0u ? mine : 1u; nx = cnt > 0u ? cnt : 1u;
}
__device__ __forceinline__ void xcd_barrier(const XcdBarrier& b) {
    asm volatile("s_waitcnt vmcnt(0)" ::: "memory");
    __syncthreads();
    if (threadIdx.x == 0) {
        unsigned* bar = b.bar;
        __builtin_amdgcn_s_waitcnt(0);
        unsigned nloc = b.st[0], nx = b.st[1];
        if (nloc == 0u) { xcd_barrier_complete(bar, b.x, nloc, nx); b.st[0] = nloc; b.st[1] = nx; }
        const unsigned old = xb_add(&bar[XB_XSUB(b.x)], 1u);
        const unsigned gen = old / nloc;
        if (old + 1u == (gen + 1u) * nloc) {
            __builtin_amdgcn_fence(__ATOMIC_RELEASE, "agent");
            asm volatile("s_waitcnt vmcnt(0)" ::: "memory");
            const unsigned og = xb_add(&bar[XB_TOP], 1u);
            const unsigned tg = og / nx;
            if (og + 1u == (tg + 1u) * nx) xb_add(&bar[XB_TOPGEN], 1u);
            else XB_SPIN(xb_ld(&bar[XB_TOPGEN]) == tg, bar);
            __builtin_amdgcn_fence(__ATOMIC_ACQUIRE, "agent");
            xb_add(&bar[XB_XGEN(b.x)], 1u);
            asm volatile("s_waitcnt vmcnt(0)" ::: "memory");
        } else {
            XB_SPIN(xb_ld(&bar[XB_XGEN(b.x)]) == gen, bar);
            __builtin_amdgcn_fence(__ATOMIC_ACQUIRE, "agent");
            asm volatile("s_waitcnt vmcnt(0)" ::: "memory");
        }
    }
    __syncthreads();
}

constexpr int NPH = 3 + 9 * DmF::DEPTH + 1;
#ifndef ONE_LAUNCH
#define ONE_LAUNCH 1
#endif

#ifndef REP_ADA
#define REP_ADA 1
#endif
#ifndef REP_PA
#define REP_PA 1
#endif
#ifndef REP_INIT
#define REP_INIT 1
#endif
#ifndef REP_DFT
#define REP_DFT 1
#endif
#ifndef REP_PB
#define REP_PB 1
#endif
#ifndef REP_KRT
#define REP_KRT 1
#endif
#ifndef REP_DOWN
#define REP_DOWN 1
#endif
#ifndef REP_WOUT
#define REP_WOUT 1
#endif
#ifndef REP_NM2N
#define REP_NM2N 1
#endif
#ifndef REP_BAR
#define REP_BAR 0
#endif
#ifndef REP_PRO
#define REP_PRO 1
#endif
#ifndef REP_NM1
#define REP_NM1 1
#endif
#ifndef REP_INPROJ
#define REP_INPROJ 1
#endif
#ifndef REP_FNET
#define REP_FNET 1
#endif
#ifndef REP_HGRN
#define REP_HGRN 1
#endif
#ifndef REP_HYENA
#define REP_HYENA 1
#endif
#ifndef REP_MIX
#define REP_MIX 1
#endif
#ifndef REP_CVTMOE
#define REP_CVTMOE 1
#endif
#ifndef REP_GATHER
#define REP_GATHER 1
#endif
#ifndef REP_GATEUP
#define REP_GATEUP 1
#endif
#ifndef FAST_HGRN
#define FAST_HGRN 1
#endif
#ifndef FAST_GEMM
#define FAST_GEMM 1
#endif
struct KArgs { PF p; FastWs f; unsigned* bar; int lo, hi; };
typedef const __attribute__((address_space(4))) KArgs* KP;

__global__ void __launch_bounds__(NTHREADS, 2) mega(KArgs a) {
    extern __shared__ __attribute__((aligned(16))) unsigned char lds_raw[];
    LAS unsigned char* lds = (LAS unsigned char*)lds_raw;
    volatile LAS unsigned* xbw = (volatile LAS unsigned*)(lds + LDS_MISC_OFF);
    if (threadIdx.x < 4) xbw[threadIdx.x] = 0u;
    __syncthreads();
    const int lo = a.lo, hi = a.hi;
    XcdBarrier bar; bar.bar = a.bar; bar.x = 0; bar.st = xbw;
    if (hi - lo > 1) bar = xcd_barrier_post(a.bar, xbw);
    int ph = 0;
#define PHASE(...) do { int lo_ = lo, hi_ = hi; asm volatile("" : "+s"(lo_), "+s"(hi_)); if (ph >= lo_ && ph < hi_) { { KP kp_ = (KP)__builtin_amdgcn_kernarg_segment_ptr(); asm volatile("" : "+s"(kp_)); PF p; FastWs f; __builtin_memcpy(&p, &kp_->p, sizeof(PF)); __builtin_memcpy(&f, &kp_->f, sizeof(FastWs)); (void)f; \
        const long tid = (long)blockIdx.x * NTHREADS + tidx(), nth = (long)gridDim.x * NTHREADS; (void)tid; (void)nth; __VA_ARGS__; } if (ph + 1 < hi_) xcd_barrier(bar); } ++ph; } while (0)
    for (int rep_ = 0; rep_ < REP_PRO; ++rep_) { if (rep_) ph -= 3;
    PHASE({ for (int q_ = 0; q_ < REP_ADA; ++q_) f_ada(p, lds); for (int q_ = 0; q_ < REP_PA; ++q_) NVF::p_pro_a(p, tid, nth); for (int q_ = 0; q_ < REP_INIT; ++q_) f_gen_postab(p, (float*)p.z); for (int q_ = 0; q_ < REP_DFT; ++q_) f_gen_dft(p, lds); });
    PHASE({ for (int q_ = 0; q_ < REP_PB; ++q_) NVF::p_pro_b(p, tid, nth); });
    PHASE({ for (int q_ = 0; q_ < REP_KRT; ++q_) f_gen_krt3(p, lds); }); }
    for (int q_ = 0; q_ < REP_BAR; ++q_) { PHASE({}); --ph; }
    for (int layer = 0; layer < DmF::DEPTH; ++layer) {
        const int last = layer == DmF::DEPTH - 1, r0 = last ? NVF::RC : 0;
        PHASE({ for (int rep_ = 0; rep_ < REP_NM1; ++rep_) { if (layer == 0) f_normmod<false, false, true>(p, f.hxs, layer, 0, 0, lds, (const float*)p.z); else f_normmod<false, true>(p, f.hxs, layer, 0, 0, lds); f_cvt_inout(p, f, layer, lds); } });
        PHASE({ for (int rep_ = 0; rep_ < REP_INPROJ; ++rep_) f_inproj(p, f, layer, last, lds); });
        PHASE({ const bool g256 = gridDim.x == 256;
                for (int rep_ = 0; rep_ < REP_FNET; ++rep_) f_fnet(p, layer, !last, lds);
                for (int rep_ = 0; rep_ < REP_HGRN; ++rep_) f_hgrn(p, lds);
                for (int rep_ = 0; rep_ < REP_HYENA; ++rep_) f_hyena(p, layer, !last, lds, 0, g256 ? 128 : (int)gridDim.x); });
        PHASE({ for (int rep_ = 0; rep_ < REP_MIX; ++rep_) f_mix2(p, layer, r0, lds); });
        PHASE({ for (int q_ = 1; q_ < REP_WOUT; ++q_) f_wout(p, f, layer, r0, lds, 0.f); f_wout(p, f, layer, r0, lds);
                { const int G_ = (int)gridDim.x, j_ = (int)blockIdx.x >> 3, x_ = (int)blockIdx.x & 7; int rank_ = (int)blockIdx.x, nw_ = G_;
                  if (!last && G_ == 256) { rank_ = j_ < 8 ? -1 : (j_ - 8) * 8 + x_; nw_ = 192; }
                  for (int rep_ = 0; rep_ < REP_CVTMOE; ++rep_) { NVF::p_moe_reset(p, tid, nth); f_cvt_moe(p, f, layer, lds, rank_, nw_); } } });
        PHASE({ for (int q_ = 1; q_ < REP_NM2N; ++q_) f_normmod<false, false>(p, f.hxs, layer, 1, r0, lds); f_normmod<true, false>(p, f.hxs, layer, 1, r0, lds); });
        PHASE({ for (int rep_ = 0; rep_ < REP_GATHER; ++rep_) f_place_gather(p, f, r0); });
        PHASE({ for (int rep_ = 0; rep_ < REP_GATEUP; ++rep_) f_gateup(p, f, lds); });
        PHASE({ for (int q_ = 0; q_ < REP_DOWN; ++q_) f_down(p, f, layer, lds); });
    }
    PHASE(f_final(p, f.hxs));
#undef PHASE
}

static inline size_t al256(size_t x) { return (x + 255) & ~(size_t)255; }
extern "C" void kernel_launch(void* const* d_in, const int* in_sizes, int n_in, void* d_out, int out_size, void* d_ws, size_t ws_size, hipStream_t stream) {
    typedef DmF Dm; constexpr size_t RALL = NVF::RALL, D = Dm::D;
    KArgs a{};
    PF& p = a.p;
    const float** ip = (const float**)&p.x;
    for (int i = 0; i < 31; ++i) ip[i] = (const float*)d_in[i];
    p.out = (float*)d_out;
    size_t off = 0; char* ws = (char*)d_ws;
    auto carve = [&](size_t bytes) { char* r = ws + off; off += al256(bytes); return r; };
    unsigned* ctl = (unsigned*)carve(65536);
    a.bar = ctl; p.cnt = (int*)(ctl + 8192);
    p.mod = (float*)carve((size_t)Dm::DEPTH * (Dm::B + 1) * 6 * D * 4);
    p.lbv = (float*)carve((size_t)Dm::DEPTH * 2 * Dm::DHG * 4);
    p.wcs = (float*)carve((size_t)Dm::DEPTH * Dm::G * Dm::GD * 2 * Dm::GD * 4);
    p.wfn = (float*)carve((size_t)Dm::DEPTH * D * 2 * Dm::CFN * 4);
    p.hf1 = (float*)carve((size_t)Dm::DEPTH * (Dm::NC + Dm::L) * Dm::FH * 4);
    p.hf2 = (float*)carve((size_t)Dm::DEPTH * (Dm::NC + Dm::L) * Dm::FH * 4);
    p.hfil = nullptr;
    p.krt_x = (bf16s*)carve((size_t)Dm::DEPTH * 2 * Dm::C * 2 * Dm::L * 2); p.krt_c = (bf16s*)carve((size_t)Dm::DEPTH * 2 * Dm::C * 2 * Dm::NC * 2);
#if XBF16
    p.cw = nullptr;
#else
    p.cw = (float*)carve((size_t)NVF::RC * D * 4);
#endif
    p.rs = (float*)carve(RALL * 4);
#if XBF16
    p.xb = (bf16s*)carve(RALL * D * 2);
    p.hx = (bf16s*)d_out;
#else
    p.xb = nullptr; p.hx = (bf16s*)carve(RALL * D * 2);
#endif
    p.dft_x = (bf16s*)carve((size_t)2048 * 4096 * 2); p.dft_c = (bf16s*)carve((size_t)256 * 512 * 2);
    p.z = (bf16s*)carve(RALL * NVF::ZS * 2);
    p.zh_c = (bf16s*)carve((size_t)3 * Dm::C * NVF::RC * 2); p.zh_x = (bf16s*)carve((size_t)3 * Dm::C * NVF::RX * 2);
    p.pq_c = (bf16s*)carve((size_t)NVF::RC * Dm::CFN * 2 * 2); p.pq_x = (bf16s*)carve((size_t)NVF::RX * Dm::CFN * 2 * 2);
    p.uv = nullptr;
    p.y1 = nullptr; p.y2 = nullptr;
    p.y1t_c = p.hx; p.y1t_x = p.hx + (size_t)Dm::C * NVF::RC;
    p.y2t_c = (bf16s*)carve((size_t)Dm::C * NVF::RC * 2); p.y2t_x = (bf16s*)carve((size_t)Dm::C * NVF::RX * 2);
    p.o = (bf16s*)carve(RALL * Dm::DHG * 2); p.ob = (bf16s*)carve(RALL * Dm::DHG * 2); p.vit = (bf16s*)carve(RALL * Dm::DHG * 2);
    p.yfn = (bf16s*)carve(RALL * Dm::CFN * 2);
    p.ridx = (int*)carve(RALL * 2 * 4);
    p.rgp = (float*)carve(RALL * 2 * 4);
    p.perm = (int*)carve((2 * RALL + Dm::E * Dm::MPAD) * 4);
    p.rrank = (int*)carve(RALL * 2 * 4); p.rpos = (int*)carve(RALL * 2 * 4); p.wgbase = (int*)carve(4096 * 16 * 4);
    { char* big = (char*)p.z; const size_t npos = 2 * RALL + Dm::E * Dm::MPAD;
      a.f.hxs = (bf16s*)big; p.hmid = (bf16s*)(big + al256(npos * D * 2));
      a.f.wt_gu = (bf16s*)((char*)p.hmid + al256(npos * Dm::DE * 2)); a.f.wt_d = a.f.wt_gu + (size_t)Dm::E * 1024 * D;
      if ((char*)(a.f.wt_d + (size_t)Dm::E * D * Dm::DE) > (char*)(p.yfn + RALL * Dm::CFN)) { fprintf(stderr, "kernel_launch: MoE overlay does not fit\n"); return; } }
    a.f.wt_in = (bf16s*)carve((size_t)Dm::ZW * D * 2);
    a.f.wt_out = (bf16s*)carve((size_t)D * D * 2);
    if (off > ws_size || n_in != 31) { fprintf(stderr, "kernel_launch: workspace too small (%zu needed, %zu given) or n_in %d != 31; nothing launched\n", off, ws_size, n_in); return; }
    static int grid = 0;
    if (grid == 0) {
        int dev = 0, cus = 0, per_cu = 0;
        hipGetDevice(&dev); hipDeviceGetAttribute(&cus, hipDeviceAttributeMultiprocessorCount, dev);
        if (hipFuncSetAttribute((const void*)mega, hipFuncAttributeMaxDynamicSharedMemorySize, LDS_BYTES) != hipSuccess) { fprintf(stderr, "kernel_launch: hipFuncSetAttribute failed\n"); grid = -1; return; }
        hipOccupancyMaxActiveBlocksPerMultiprocessor(&per_cu, (const void*)mega, NTHREADS, LDS_BYTES);
        (void)hipGetLastError();
        if (per_cu < 1) fprintf(stderr, "kernel_launch: occupancy query says %d blocks per CU\n", per_cu);
        grid = cus > 0 ? cus : 256;
    }
    if (grid < 0) return;
    hipMemsetAsync(ctl, 0, 65536, stream);
#if ONE_LAUNCH
    a.lo = 0; a.hi = NPH;
    hipLaunchKernelGGL(mega, dim3(grid), dim3(NTHREADS), LDS_BYTES, stream, a);
#else
    for (int k = 0; k < NPH; ++k) { a.lo = k; a.hi = k + 1; hipLaunchKernelGGL(mega, dim3(grid), dim3(NTHREADS), LDS_BYTES, stream, a); }
#endif
}
```

```cpp
#include <hip/hip_runtime.h>
#include <cstdio>
#include <cstdint>
#include <stdint.h>
#include <math.h>

#ifndef HD
#ifdef CPU_SHIM
#define HD
#else
#define HD __host__ __device__ __forceinline__
#endif
#endif

typedef unsigned short bf16s;
HD float bf2f(bf16s v) { union { unsigned u; float f; } c; c.u = ((unsigned)v) << 16; return c.f; }
HD bf16s f2bf(float f) { union { unsigned u; float f; } c; c.f = f; unsigned u = c.u; u += 0x7FFFu + ((u >> 16) & 1u); return (bf16s)(u >> 16); }
HD float ldv(const float* p) { return *p; }
HD float ldv(const bf16s* p) { return bf2f(*p); }
HD void stv(float* p, float v) { *p = v; }
HD void stv(bf16s* p, float v) { *p = f2bf(v); }
HD float silu_f(float x) { return x / (1.f + expf(-x)); }
HD float sigm_f(float x) { return 1.f / (1.f + expf(-x)); }

#ifdef CPU_SHIM
static inline int atomic_add_i(int* p, int v) { int o = *p; *p = o + v; return o; }
static inline void atomic_add_f(float* p, float v) { *p += v; }
#else
__device__ __forceinline__ int atomic_add_i(int* p, int v) { return atomicAdd(p, v); }
__device__ __forceinline__ void atomic_add_f(float* p, float v) { unsafeAtomicAdd(p, v); }
#endif

struct DimsFull {
    static constexpr int D = 1024, B = 16, L = 2048, NC = 256, DEPTH = 2, GRID_W = 64;
    static constexpr int C = 256  , DHG = 512, CFN = 256, NB = 16, EMB = 33, FH = 64;
    static constexpr int HDIM = 128, H = 4, G = 4, GD = 64;
    static constexpr int DP = 3 * C + 5 * DHG + CFN;
    static constexpr int ZW = 3 * C + 5 * DHG + 2 * CFN;
    static constexpr int E = 16, NG = 4, EPG = 4, DE = 512;
    static constexpr int RB = 8, BB = 8, MPAD = 256;
    typedef bf16s st;
};
#ifdef CPU_SHIM
struct DimsTest {
    static constexpr int D = 64, B = 2, L = 64, NC = 16, DEPTH = 2, GRID_W = 8;
    static constexpr int C = 16, DHG = 32, CFN = 16, NB = 4, EMB = 9, FH = 8;
    static constexpr int HDIM = 8, H = 4, G = 2, GD = 8;
    static constexpr int DP = 3 * C + 5 * DHG + CFN;
    static constexpr int ZW = 3 * C + 5 * DHG + 2 * CFN;
    static constexpr int E = 16, NG = 4, EPG = 4, DE = 16;
    static constexpr int RB = 8, BB = 2, MPAD = 8;
#ifdef TEST_BF16
    typedef bf16s st;
#else
    typedef float st;
#endif
};
#endif

template <class Dm> struct Params {
    typedef typename Dm::st st;
    const float *x, *c, *ctx, *c_ctx, *ada_w, *ada_b, *norm1_g, *norm2_g, *w_in, *w_out, *hy_conv_w, *hy_conv_b, *hy_w1, *hy_b1, *hy_w2, *hy_b2, *hy_w3, *hy_freq,
        *hy_bias, *hy_norm_g, *hg_lb, *hg_norm_g, *fn_w, *fn_b, *fn_norm_g, *router_w, *router_b, *moe_wg, *moe_wu, *moe_wd, *final_g;
    float* out;
    float* cw;
    st* xb;
    float* mod;
    float* lbv;
    float* wcs;
    float* wfn;
    float* hf1;
    float* hf2;
    float* hfil;
    float* rs;
    st* hx;
    st* z;
    st* zh_c; st* zh_x;
    st* pq_c; st* pq_x;
    st* krt_c; st* krt_x;
    st* y1t_c; st* y1t_x; st* y2t_c; st* y2t_x;
    st* dft_c; st* dft_x;
    st* uv;
    st* y1;
    st* y2;
    st* o;
    st* ob;
    st* vit;
    st* yfn;
    int* ridx;
    float* rgp;
    int* cnt;
    int* perm;
    int* rrank;
    int* rpos;
    int* wgbase;
    st* hmid;
};

template <class Dm> struct NV {
    typedef Params<Dm> P;
    typedef typename Dm::st st;
    static constexpr int D = Dm::D, B = Dm::B, L = Dm::L, NC = Dm::NC, C = Dm::C, DHG = Dm::DHG, CFN = Dm::CFN, ZW = Dm::ZW, DP = Dm::DP;
    static constexpr int RC = B * NC, RX = B * L, RALL = RC + RX;
    static constexpr int ZS = 4 * DHG, OFF_Q = 0, OFF_FF = DHG, OFF_FB = 2 * DHG, OFF_G = 3 * DHG;
    static constexpr float EPS = 1e-6f;
    static constexpr float TWO_PI = 6.283185307179586f;

    static HD float* xrow(const P& p, int R) { return R < RC ? p.cw + (size_t)R * D : p.out + (size_t)(R - RC) * D; }
    static HD int row_b(int R) { return R < RC ? R / NC : (R - RC) / L; }
    static HD int row_l(int R) { return R < RC ? R % NC : (R - RC) % L; }
    static HD int row_modr(int R) { return R < RC ? B : (R - RC) / L; }
    static HD int row_of(int isx, int b, int l) { return isx ? RC + b * L + l : b * NC + l; }
    static HD const float* modp(const P& p, int layer, int mr, int which) { return p.mod + ((size_t)(layer * (B + 1) + mr) * 6 + which) * D; }

    static HD void p_pro_a(const P& p, long tid, long nth) {
        for (long i = tid; i < 2 * DHG; i += nth) {
            float mx = -1e30f;
            for (int l = 0; l < Dm::DEPTH; ++l) mx = fmaxf(mx, p.hg_lb[l * 2 * DHG + i]);
            float den = 0.f;
            for (int l = 0; l < Dm::DEPTH; ++l) den += expf(p.hg_lb[l * 2 * DHG + i] - mx);
            float cs = 0.f;
            for (int l = 0; l < Dm::DEPTH; ++l) { if (l > 0) cs += expf(p.hg_lb[l * 2 * DHG + i] - mx) / den; p.lbv[l * 2 * DHG + i] = cs; }
        }
        for (long i = tid; i < (long)Dm::DEPTH * Dm::G * Dm::GD * 2 * Dm::GD; i += nth) {
            const int GD = Dm::GD; const int d2 = (int)(i % (2 * GD)), c = (int)((i / (2 * GD)) % GD), g = (int)((i / (2 * GD * GD)) % Dm::G), layer = (int)(i / ((long)2 * GD * GD * Dm::G));
            const int d = d2 % GD, sn = d2 / GD;
            const float* w = p.fn_w + ((size_t)(layer * Dm::G + g) * GD) * GD + d;
            float acc = 0.f;
            for (int m = 0; m < GD; ++m) { const int cm = (c * m) % GD;
                const float ang = TWO_PI * (float)cm / (float)GD; acc += (sn ? __sinf(ang) : __cosf(ang)) * w[(size_t)m * GD]; }
            p.wcs[i] = acc;
        }
        for (long i = tid; i < (long)Dm::DEPTH * (NC + L) * Dm::FH; i += nth) {
            const int j = (int)(i % Dm::FH), ll = (int)((i / Dm::FH) % (NC + L)), layer = (int)(i / ((long)Dm::FH * (NC + L)));
            const int Lw = ll < NC ? NC : L, l = ll < NC ? ll : ll - NC;
            const float t = (float)l / (float)(Lw - 1), wv = TWO_PI * (float)l / (float)Lw;
            const float* w1 = p.hy_w1 + (size_t)layer * Dm::EMB * Dm::FH + j;
            float acc = t * w1[0];
            for (int bi = 0; bi < Dm::NB; ++bi) {
                const float band = 1e-4f + (float)bi * ((float)(Dm::NB - 1) - 1e-4f) / (float)(Dm::NB - 1);
                acc += cosf(band * wv) * w1[(size_t)(1 + bi) * Dm::FH] - sinf(band * wv) * w1[(size_t)(1 + Dm::NB + bi) * Dm::FH];
            }
            acc += p.hy_b1[layer * Dm::FH + j];
            p.hf1[i] = sinf(p.hy_freq[layer * Dm::FH + j] * acc);
        }
    }
    static HD void p_pro_b(const P& p, long tid, long nth) {
        for (long i = tid; i < (long)Dm::DEPTH * (NC + L) * Dm::FH; i += nth) {
            const int j = (int)(i % Dm::FH), layer = (int)(i / ((long)Dm::FH * (NC + L)));
            const float* h1 = p.hf1 + (i / Dm::FH) * Dm::FH;
            const float* w2 = p.hy_w2 + (size_t)layer * Dm::FH * Dm::FH + j;
            float acc = 0.f;
            for (int k = 0; k < Dm::FH; ++k) acc += h1[k] * w2[(size_t)k * Dm::FH];
            acc += p.hy_b2[layer * Dm::FH + j];
            p.hf2[i] = sinf(p.hy_freq[layer * Dm::FH + j] * acc);
        }
        for (long i = tid; i < (long)Dm::DEPTH * D * 2 * CFN; i += nth) {
            const int GD = Dm::GD; const int j = (int)(i % (2 * CFN)), k = (int)((i / (2 * CFN)) % D), layer = (int)(i / ((long)2 * CFN * D));
            const int sn = j / CFN, g = (j % CFN) / GD, d = j % GD;
            const float* wi = p.w_in + ((size_t)layer * D + k) * DP + 3 * C + 5 * DHG + g * GD;
            const float* wc = p.wcs + ((size_t)(layer * Dm::G + g) * GD) * 2 * GD + sn * GD + d;
            float acc = 0.f;
            for (int c = 0; c < GD; ++c) acc += wi[c] * wc[(size_t)c * 2 * GD];
            p.wfn[i] = acc;
        }
    }
    static HD void p_pro_c(const P& p, long tid, long nth) {
        const float max_decay = logf(1e-2f) / 0.3f, min_decay = logf(1e-2f) / 1.5f;
        for (long i = tid; i < (long)Dm::DEPTH * (NC + L) * 4 * C; i += nth) {
            const int oc = (int)(i % (4 * C)), ll = (int)((i / (4 * C)) % (NC + L)), layer = (int)(i / ((long)4 * C * (NC + L)));
            const int Lw = ll < NC ? NC : L, l = ll < NC ? ll : ll - NC, c = oc % C;
            const float t = (float)l / (float)(Lw - 1);
            const float* h2 = p.hf2 + (i / (4 * C)) * Dm::FH;
            const float* w3 = p.hy_w3 + (size_t)layer * Dm::FH * 4 * C + oc;
            float acc = 0.f;
            for (int k = 0; k < Dm::FH; ++k) acc += h2[k] * w3[(size_t)k * 4 * C];
            const float delta = min_decay + (max_decay - min_decay) * (float)c / (float)(C - 1);
            p.hfil[i] = acc * expf(-t * fabsf(delta));
        }
    }
    static HD float shortconv(const P& p, int layer, int R, int pc) {
        const int l = row_l(R), Lw = R < RC ? NC : L;
        const float* cwt = p.hy_conv_w + (size_t)layer * 3 * 3 * C + pc;
        const st* zr = R < RC ? p.zh_c + (size_t)pc * RC + R : p.zh_x + (size_t)pc * RX + (R - RC);
        float v = ldv(zr) * cwt[3 * C] + p.hy_conv_b[layer * 3 * C + pc];
        if (l > 0) v += ldv(zr - 1) * cwt[0];
        if (l < Lw - 1) v += ldv(zr + 1) * cwt[2 * 3 * C];
        return v;
    }
    static HD void p_uv(const P& p, int layer, int r0, long tid, long nth) {
        for (long i = (long)r0 * C + tid; i < (long)RALL * C; i += nth) { const int R = (int)(i / C), c = (int)(i % C); stv(p.uv + i, shortconv(p, layer, R, c)); }
    }
    static HD float hy_k(const P& p, int layer, int isx, int order, int d, int c) {
        const float* hf = p.hfil + ((size_t)layer * (NC + L) + (isx ? NC : 0)) * 4 * C;
        float v = d >= 0 ? hf[(size_t)d * 4 * C + (2 * order) * C + c] : hf[(size_t)(-d) * 4 * C + (2 * order + 1) * C + c];
        if (d == 0) v += p.hy_bias[(layer * 2 + order) * C + c];
        return v;
    }
    static HD void p_hyconv(const P& p, int layer, int order, int r0, long tid, long nth) {
        constexpr int BB = Dm::BB;
        const st* in = p.y1; st* outp = order == 0 ? p.y1 : p.y2;
        const long nc_items = (long)(B / BB) * NC * C, nx_items = (long)(B / BB) * L * C;
        for (long i = (r0 >= RC ? nc_items : 0) + tid; i < nc_items + nx_items; i += nth) {
            const int isx = i >= nc_items; const long ii = isx ? i - nc_items : i; const int Lw = isx ? L : NC;
            const int c = (int)(ii % C), t = (int)((ii / C) % Lw), b0 = (int)(ii / ((long)C * Lw)) * BB;
            float acc[BB];
#pragma unroll
            for (int r = 0; r < BB; ++r) acc[r] = 0.f;
            for (int s = 0; s < Lw; ++s) { const float kv = hy_k(p, layer, isx, order, t - s, c);
#pragma unroll
                for (int r = 0; r < BB; ++r) acc[r] += kv * (order == 0 ? shortconv(p, layer, row_of(isx, b0 + r, s), c) : ldv(in + (size_t)row_of(isx, b0 + r, s) * C + c)); }
#pragma unroll
            for (int r = 0; r < BB; ++r) { const int R = row_of(isx, b0 + r, t); stv(outp + (size_t)R * C + c, acc[r] * shortconv(p, layer, R, (order + 1) * C + c)); }
        }
    }
    static HD void p_hgscan(const P& p, long tid, long nth) {
        constexpr int HDM = Dm::HDIM;
        for (long i = tid; i < (long)B * Dm::H * HDM; i += nth) {
            const int v = (int)(i % HDM), h = (int)((i / HDM) % Dm::H), b = (int)(i / ((long)HDM * Dm::H));
            for (int dir = 0; dir < 2; ++dir) {
                float S[HDM];
#pragma unroll
                for (int d = 0; d < HDM; ++d) S[d] = 0.f;
                for (int seg = 0; seg < 2; ++seg) {
                    const int Lw = seg ? L : NC;
                    for (int tt = 0; tt < Lw; ++tt) {
                        const int t = dir ? Lw - 1 - tt : tt; const int R = row_of(seg, b, t);
                        const st* zr = p.z + (size_t)R * ZS;
                        const float vv = ldv(p.vit + (size_t)(h * HDM + v) * RALL + R);
                        const st* lf = zr + (dir ? OFF_FB : OFF_FF) + h * HDM; const st* q = zr + OFF_Q + h * HDM;
                        float o = 0.f;
#pragma unroll
                        for (int d = 0; d < HDM; ++d) { const float f = expf(ldv(lf + d)); S[d] = f * S[d] + (1.f - f) * vv; o += S[d] * ldv(q + d); }
                        stv((dir ? p.ob : p.o) + (size_t)R * DHG + h * HDM + v, o);
                    }
                }
            }
        }
    }
    static HD void p_moe_reset(const P& p, long tid, long nth) {
        for (long i = tid; i < 32; i += nth) p.cnt[i] = 0;
        for (long i = tid; i < (long)2 * RALL + Dm::E * Dm::MPAD; i += nth) p.perm[i] = -1;
    }
    static HD int moe_off(const P& p, int e) {
        int o = 0;
        for (int j = 0; j < e; ++j) o += (p.cnt[j] + Dm::MPAD - 1) / Dm::MPAD * Dm::MPAD;
        return o;
    }
    static HD void p_place(const P& p, int r0, long tid, long nth) {
        for (long ts = (long)r0 * 2 + tid; ts < (long)RALL * 2; ts += nth) {
            const int e = p.ridx[ts];
            const int pos = moe_off(p, e) + atomic_add_i(p.cnt + 16 + e, 1);
            p.perm[pos] = (int)ts;
        }
    }
    static HD void p_gather_dummy(const P&) {}
    static HD int moe_expert_of_unused(const P& p, int pos) { int e = 0; while (e + 1 < Dm::E && pos >= moe_off(p, e + 1)) ++e; return e; }
};
#define LAS __attribute__((address_space(3)))
typedef short bf16x8 __attribute__((ext_vector_type(8)));
typedef float f32x4 __attribute__((ext_vector_type(4)));
typedef float f32x2 __attribute__((ext_vector_type(2)));
typedef unsigned u32x4 __attribute__((ext_vector_type(4)));
typedef unsigned u32x2 __attribute__((ext_vector_type(2)));
typedef DimsFull DmF; typedef NV<DmF> NVF; typedef Params<DmF> PF;
constexpr int NTHREADS = 512;
constexpr int STAGE_BYTES = 131072;
constexpr int LDS_MISC_OFF = 143360;
constexpr int LDS_BYTES = LDS_MISC_OFF + 1024;

__device__ __forceinline__ unsigned cvt_pk_bf16(float lo, float hi) { unsigned r; asm volatile("v_cvt_pk_bf16_f32 %0, %1, %2" : "=v"(r) : "v"(lo), "v"(hi)); return r; }
__device__ __forceinline__ int tidx() { int t = threadIdx.x; asm volatile("" : "+v"(t)); return t; }
__device__ __forceinline__ void lds_barrier() { asm volatile("s_waitcnt lgkmcnt(0)" ::: "memory"); __builtin_amdgcn_s_barrier(); asm volatile("" ::: "memory"); }
__device__ __forceinline__ u32x2 pack4(f32x4 v) { u32x2 w; w.x = cvt_pk_bf16(v[0], v[1]); w.y = cvt_pk_bf16(v[2], v[3]); return w; }
__device__ __forceinline__ f32x4 unpack4(u32x2 w) { f32x4 v; v[0] = __uint_as_float(w.x << 16); v[1] = __uint_as_float(w.x & 0xffff0000u); v[2] = __uint_as_float(w.y << 16); v[3] = __uint_as_float(w.y & 0xffff0000u); return v; }
__device__ __forceinline__ int gdimx() { int g = (int)gridDim.x; asm volatile("" : "+s"(g)); return g; }
__device__ __forceinline__ float fast_silu(float x) { return x * __builtin_amdgcn_rcpf(1.f + __expf(-x)); }

#ifndef REP_EPI
#define REP_EPI 1
#endif
#ifndef RELAX_WAITS
#define RELAX_WAITS 0
#endif
namespace pg8 {
constexpr int BM = 256, BK = 64, HALF = 128, HTB = HALF * BK * 2;
__host__ __device__ __forceinline__ int lds_byte(int r, int c) { const int st = (r >> 4) * 2 + (c >> 5), rr = r & 15, cc = c & 31, ob = rr * 64 + cc * 2; return st * 1024 + (ob ^ (((ob >> 9) & 1) << 5)); }
__host__ __device__ __forceinline__ void stage_rc(int b, int& R, int& C) { const int st = b / 1024, sb = b % 1024, swz = sb ^ (((sb >> 9) & 1) << 5); R = (st >> 1) * 16 + swz / 64; C = (st & 1) * 32 + (swz % 64) / 2; }
__host__ __device__ __forceinline__ int perm32(int rho) { const int n = rho >> 4, i = rho & 15; return 8 * (i >> 2) + 4 * n + (i & 3); }
struct Unit { const char* a; const char* b; int i0, i1, i2, i3; const int* rows; };
struct Gemm { int K, lda, ldb; int* diag = nullptr; };
template <class Epi, class Sched, bool ALIGN_EPI = true, bool GATHER = false>
__device__ __forceinline__ void gemm_phase(LAS unsigned char* lds, const Gemm g, const Sched& S, const Epi& E) {
    const int tid = tidx(), wid = __builtin_amdgcn_readfirstlane(tid >> 6), lane = tid & 63, wr = wid >> 2, wc = wid & 3, fr = lane & 15, fq = lane >> 4;
    const int K = g.K, nt = K / BK;
    unsigned voffA[2], voffB[2];
#pragma unroll
    for (int i = 0; i < 2; ++i) { int R, C; stage_rc(tid * 16 + i * 8192, R, C); const int Rb = Epi::PERM ? ((R & ~31) + perm32(R & 31)) : R;
        voffA[i] = (unsigned)(R * g.lda + C) * 2u; voffB[i] = (unsigned)(Rb * g.ldb + C) * 2u; }
    const size_t kstep = (size_t)(BK * 2);
    const size_t hstepA = (size_t)HALF * g.lda * 2, hstepB = (size_t)HALF * g.ldb * 2;
    const unsigned ldsw = (unsigned)wid * 1024u;
    const int aoff = lds_byte(wr * 64 + fr, fq * 8), boff = lds_byte(wc * 32 + fr, fq * 8);
#define PG8_SA(b, h) (((b) * 2 + (h)) * HTB)
#define PG8_SB(b, h) ((4 + (b) * 2 + (h)) * HTB)
#define PG8_STAGE(bufoff, gbase, voff) do { _Pragma("unroll") for (int _i = 0; _i < 2; ++_i) \
        __builtin_amdgcn_global_load_lds((const unsigned*)((const char*)(gbase) + (voff)[_i]), (LAS unsigned*)(lds + (bufoff) + ldsw + _i * 8192), 16, 0, 0); } while (0)
#define PG8_TAB(k) (STAGE_BYTES + ((k) & 1) * 1024)
#define PG8_TABLOAD(k, u) do { if (wid == 0) __builtin_amdgcn_global_load_lds((const unsigned*)((u).rows + lane * 4), (LAS unsigned*)(lds + PG8_TAB(k)), 16, 0, 0); } while (0)
#define PG8_STAGEA(bufoff, gbase, h, k) do { if constexpr (GATHER) { _Pragma("unroll") for (int _i = 0; _i < 2; ++_i) { \
            const int ts_ = *(const LAS int*)(lds + PG8_TAB(k) + ((h) * 128 + (int)(voffA[_i] >> 11)) * 4); \
            __builtin_amdgcn_global_load_lds((const unsigned*)((const char*)(gbase) + ((unsigned)(ts_ < 0 ? 0 : ts_ >> 1) << 11) + (voffA[_i] & 2047u)), (LAS unsigned*)(lds + (bufoff) + ldsw + _i * 8192), 16, 0, 0); } } \
        else { PG8_STAGE(bufoff, (gbase) + (h) * hstepA, voffA); } } while (0)
#define PG8_LDA(dst, b, h) do { _Pragma("unroll") for (int m = 0; m < 4; ++m) _Pragma("unroll") for (int k = 0; k < 2; ++k) dst[m][k] = *(const LAS bf16x8*)(lds + PG8_SA(b, h) + aoff + m * 2048 + k * 1024); } while (0)
#define PG8_LDB(dst, b, h) do { _Pragma("unroll") for (int n = 0; n < 2; ++n) _Pragma("unroll") for (int k = 0; k < 2; ++k) dst[n][k] = *(const LAS bf16x8*)(lds + PG8_SB(b, h) + boff + n * 2048 + k * 1024); } while (0)
#define PG8_MMA(ai, bj, At, Bt) do { __builtin_amdgcn_s_setprio(1); _Pragma("unroll") for (int m = 0; m < 4; ++m) _Pragma("unroll") for (int n = 0; n < 2; ++n) _Pragma("unroll") for (int k = 0; k < 2; ++k) \
        acc[ai][bj][m][n] = __builtin_amdgcn_mfma_f32_16x16x32_bf16(Bt[n][k], At[m][k], acc[ai][bj][m][n], 0, 0, 0); __builtin_amdgcn_s_setprio(0); } while (0)
#define PG8_WAIT_V(n) asm volatile("s_waitcnt vmcnt(" #n ")" ::: "memory")
#define PG8_WAIT_V8R_(N) asm volatile("s_cmp_lg_u32 %0, 0\n\ts_cbranch_scc1 .Lrn%=\n\ts_cmp_eq_u32 %1, 0\n\ts_cbranch_scc1 .Lrn%=\n\ts_waitcnt vmcnt(" #N ")\n\ts_branch .Lrd%=\n.Lrn%=:\n\ts_waitcnt vmcnt(8)\n.Lrd%=:" :: "s"(t), "s"(ui) : "memory", "scc")
#define PG8_WAIT_V8R() do { if constexpr (!RELAX_WAITS) asm volatile("s_waitcnt vmcnt(8)" ::: "memory"); else if constexpr (Epi::NST == 16) PG8_WAIT_V8R_(24); else PG8_WAIT_V8R_(16); } while (0)
#define PG8_WAIT_L(n) asm volatile("s_waitcnt lgkmcnt(" #n ")" ::: "memory")
#define PG8_BAR __builtin_amdgcn_s_barrier()
#define PG8_SCHED __builtin_amdgcn_sched_barrier(0)
    Unit cur, nxt; int ui = 0;
    if (!S.next(0, cur)) return;
    f32x4 acc[2][2][4][2];
#pragma unroll
    for (int a = 0; a < 2; ++a)
#pragma unroll
        for (int b = 0; b < 2; ++b)
#pragma unroll
            for (int m = 0; m < 4; ++m)
#pragma unroll
                for (int n = 0; n < 2; ++n) acc[a][b][m][n] = (f32x4){0.f, 0.f, 0.f, 0.f};
    bf16x8 At[4][2], B0[2][2], B1[2][2];
    const char* cA = cur.a; const char* cB = cur.b;
    if constexpr (GATHER) { PG8_TABLOAD(0, cur); PG8_WAIT_V(0); __syncthreads(); }
    PG8_STAGE(PG8_SB(0, 0), cB, voffB); PG8_STAGE(PG8_SB(0, 1), cB + hstepB, voffB); PG8_STAGEA(PG8_SA(0, 0), cA, 0, 0); PG8_STAGEA(PG8_SA(0, 1), cA, 1, 0);
    if (wr == 1) PG8_BAR;
    PG8_WAIT_V(2); PG8_BAR;
    PG8_STAGE(PG8_SB(1, 0), cB + kstep, voffB); PG8_STAGEA(PG8_SA(1, 0), cA + kstep, 0, 0); PG8_STAGE(PG8_SB(1, 1), cB + hstepB + kstep, voffB);
    PG8_WAIT_V(6); PG8_BAR;
#ifdef DIAG_GEMMTIME
    unsigned long long tk_ = 0, te_ = 0, t0_ = 0, t1_ = 0;
#endif
    for (;;) {
        const bool has_next = S.next(ui + 1, nxt);
        const char* nA = has_next ? nxt.a : cA; const char* nB = has_next ? nxt.b : cB;
        const int kn = has_next ? ui + 1 : ui;
        if constexpr (GATHER) { if (has_next) PG8_TABLOAD(ui + 1, nxt); }
#ifdef DIAG_GEMMTIME
        t0_ = wall_clock64();
#endif
        for (int t = 0; t < nt; t += 2) {
            const bool last = (t == nt - 2);
            const char* a1 = cA + (size_t)(t + 1) * kstep;
            const char* a2 = last ? nA : cA + (size_t)(t + 2) * kstep; const char* b2 = last ? nB : cB + (size_t)(t + 2) * kstep;
            const char* a3 = a2 + kstep; const char* b3 = b2 + kstep;
            const int kl = last ? kn : ui;
            PG8_LDB(B0, 0, 0); PG8_LDB(B1, 0, 1); PG8_SCHED; PG8_LDA(At, 0, 0); PG8_STAGEA(PG8_SA(1, 1), a1, 1, ui);
            PG8_WAIT_V8R(); PG8_WAIT_L(0); PG8_BAR; PG8_MMA(0, 0, At, B0); PG8_MMA(0, 1, At, B1); PG8_BAR; PG8_SCHED;
            PG8_LDA(At, 0, 1); PG8_STAGE(PG8_SB(0, 0), b2, voffB); PG8_STAGE(PG8_SB(0, 1), b2 + hstepB, voffB); PG8_STAGEA(PG8_SA(0, 0), a2, 0, kl);
            PG8_WAIT_V8R(); PG8_WAIT_L(0); PG8_BAR; PG8_MMA(1, 0, At, B0); PG8_MMA(1, 1, At, B1); PG8_BAR; PG8_SCHED;
            PG8_LDB(B0, 1, 0); PG8_LDB(B1, 1, 1); PG8_SCHED; PG8_LDA(At, 1, 0); PG8_STAGEA(PG8_SA(0, 1), a2, 1, kl);
            PG8_WAIT_V8R(); PG8_WAIT_L(0); PG8_BAR; PG8_MMA(0, 0, At, B0); PG8_MMA(0, 1, At, B1); PG8_BAR; PG8_SCHED;
            PG8_LDA(At, 1, 1); PG8_STAGE(PG8_SB(1, 0), b3, voffB); PG8_STAGE(PG8_SB(1, 1), b3 + hstepB, voffB); PG8_STAGEA(PG8_SA(1, 0), a3, 0, kl);
            PG8_WAIT_V(8); PG8_WAIT_L(0); PG8_BAR; PG8_MMA(1, 0, At, B0); PG8_MMA(1, 1, At, B1); PG8_BAR; PG8_SCHED;
        }
#ifdef DIAG_GEMMTIME
        t1_ = wall_clock64(); tk_ += t1_ - t0_;
#endif
        if constexpr (ALIGN_EPI) { if (wr == 0) PG8_BAR; }
        for (int re_ = 0; re_ < (Epi::PERM ? REP_EPI : 1); ++re_) E(acc, cur, wr, wc, fr, fq);
#ifdef DIAG_GEMMTIME
        te_ += wall_clock64() - t1_;
        if (!has_next && g.diag && blockIdx.x == DIAG_BLOCK && tid == 0) { g.diag[0] = (int)tk_; g.diag[1] = (int)te_; g.diag[2] = ui + 1; }
#endif
        if (!has_next) break;
#pragma unroll
        for (int a = 0; a < 2; ++a)
#pragma unroll
            for (int b = 0; b < 2; ++b)
#pragma unroll
                for (int m = 0; m < 4; ++m)
#pragma unroll
                    for (int n = 0; n < 2; ++n) acc[a][b][m][n] = (f32x4){0.f, 0.f, 0.f, 0.f};
        cur = nxt; cA = nA; cB = nB; ++ui;
        if constexpr (ALIGN_EPI) { if (wr == 1) PG8_BAR; }
    }
    PG8_WAIT_V(0);
    if constexpr (!ALIGN_EPI) { if (wr == 0) PG8_BAR; }
    PG8_BAR;
#undef PG8_SA
#undef PG8_SB
#undef PG8_STAGE
#undef PG8_LDA
#undef PG8_STAGEA
#undef PG8_TAB
#undef PG8_TABLOAD
#undef PG8_LDB
#undef PG8_MMA
#undef PG8_WAIT_V
#undef PG8_WAIT_L
#undef PG8_WAIT_V8R
#undef PG8_WAIT_V8R_
#undef PG8_BAR
#undef PG8_SCHED
}
}

struct FastWs {
    bf16s* wt_in;
    bf16s* wt_out;
    bf16s* wt_gu;
    bf16s* wt_d;
    bf16s* hxs;
};

struct Deal { int x, j, W; __device__ __forceinline__ void init() { const int G = gridDim.x, c = blockIdx.x; x = c & 7; j = c >> 3; W = (G + 7) >> 3; } };

struct XpJob { const float* src; int sld, k0, n0; bf16s* dst; int dld, drow0; };
__device__ __forceinline__ void xpose_load(const XpJob& j, int t, f32x4 (&v)[2]) {
#pragma unroll
    for (int ps = 0; ps < 2; ++ps) { const int k = (t >> 4) + 32 * ps, n4 = (t & 15) * 4; v[ps] = *(const f32x4*)(j.src + (size_t)(j.k0 + k) * j.sld + j.n0 + n4); }
}
__device__ __forceinline__ void xpose_store(LAS float* tile, const XpJob& j, int t, const f32x4 (&v)[2]) {
#pragma unroll
    for (int ps = 0; ps < 2; ++ps) { const int k = (t >> 4) + 32 * ps, n4 = (t & 15) * 4;
        tile[k * 65 + n4 + 0] = v[ps][0]; tile[k * 65 + n4 + 1] = v[ps][1]; tile[k * 65 + n4 + 2] = v[ps][2]; tile[k * 65 + n4 + 3] = v[ps][3]; }
    lds_barrier();
    { const int n = t >> 3, k8 = (t & 7) * 8; u32x4 w;
      w.x = cvt_pk_bf16(tile[(k8 + 0) * 65 + n], tile[(k8 + 1) * 65 + n]); w.y = cvt_pk_bf16(tile[(k8 + 2) * 65 + n], tile[(k8 + 3) * 65 + n]);
      w.z = cvt_pk_bf16(tile[(k8 + 4) * 65 + n], tile[(k8 + 5) * 65 + n]); w.w = cvt_pk_bf16(tile[(k8 + 6) * 65 + n], tile[(k8 + 7) * 65 + n]);
      *(u32x4*)(j.dst + (size_t)(j.drow0 + n) * j.dld + j.k0 + k8) = w; }
    lds_barrier();
}
__device__ __forceinline__ XpJob job_inout(const PF& p, const FastWs& f, int layer, int it) {
    constexpr int D = DmF::D, T_IN = (3328 / 64) * (D / 64), T_FN = (512 / 64) * (D / 64);
    int r = it;
    if (r < T_IN) { const int nt = r / (D / 64), kt = r % (D / 64); return XpJob{p.w_in + (size_t)layer * D * DmF::DP, DmF::DP, kt * 64, nt * 64, f.wt_in, D, nt * 64}; } r -= T_IN;
    if (r < T_FN) { const int nt = r / (D / 64), kt = r % (D / 64); return XpJob{p.wfn + (size_t)layer * D * 512, 512, kt * 64, nt * 64, f.wt_in, D, 3328 + nt * 64}; } r -= T_FN;
    { const int nt = r / (D / 64), kt = r % (D / 64); return XpJob{p.w_out + (size_t)layer * D * D, D, kt * 64, nt * 64, f.wt_out, D, nt * 64}; }
}
__device__ __forceinline__ void f_cvt_inout(const PF& p, const FastWs& f, int layer, LAS unsigned char* lds) {
    LAS float* tile = (LAS float*)lds; const int t = tidx();
    constexpr int D = DmF::D, NT = (3328 / 64) * (D / 64) + (512 / 64) * (D / 64) + (D / 64) * (D / 64);
    int it = blockIdx.x; if (it >= NT) return;
    XpJob cur = job_inout(p, f, layer, it); f32x4 v[2]; xpose_load(cur, t, v);
    for (;;) { const int nx = it + (int)gridDim.x; const bool more = nx < NT; XpJob nj = cur; f32x4 nvv[2];
        if (more) { nj = job_inout(p, f, layer, nx); xpose_load(nj, t, nvv); }
        xpose_store(tile, cur, t, v);
        if (!more) break;
        cur = nj; v[0] = nvv[0]; v[1] = nvv[1]; it = nx; }
}
__device__ __forceinline__ XpJob job_moe(const PF& p, const FastWs& f, int layer, int it) {
    constexpr int D = DmF::D, DE = DmF::DE, TG = (DE / 64) * (D / 64)  , TD = (D / 64) * (DE / 64)  , PER_E = 2 * TG + TD;
    const int e = it / PER_E; int r = it % PER_E;
    if (r < 2 * TG) { const int up = r / TG; r %= TG; const int nt = r / (D / 64), kt = r % (D / 64); const int n0 = nt * 64;
        const float* src = (up ? p.moe_wu : p.moe_wg) + ((size_t)(layer * DmF::E + e) * D) * DE;
        return XpJob{src, DE, kt * 64, n0, f.wt_gu + (size_t)e * 1024 * D, D, (n0 / 128) * 256 + up * 128 + (n0 % 128)}; }
    r -= 2 * TG;
    { const int nt = r / (DE / 64), kt = r % (DE / 64);
      return XpJob{p.moe_wd + ((size_t)(layer * DmF::E + e) * DE) * D, D, kt * 64, nt * 64, f.wt_d + (size_t)e * D * DE, DE, nt * 64}; }
}
__device__ __forceinline__ void f_cvt_moe(const PF& p, const FastWs& f, int layer, LAS unsigned char* lds, int rank, int nwork) {
    LAS float* tile = (LAS float*)lds; const int t = tidx();
    constexpr int NT = DmF::E * (2 * 128 + 128);
    int it = rank; if (it < 0 || it >= NT) return;
    XpJob cur = job_moe(p, f, layer, it); f32x4 v[2]; xpose_load(cur, t, v);
    for (;;) { const int nx = it + nwork; const bool more = nx < NT; XpJob nj = cur; f32x4 nvv[2];
        if (more) { nj = job_moe(p, f, layer, nx); xpose_load(nj, t, nvv); }
        xpose_store(tile, cur, t, v);
        if (!more) break;
        cur = nj; v[0] = nvv[0]; v[1] = nvv[1]; it = nx; }
}

struct EpiInproj {
    static constexpr bool PERM = true; static constexpr int NST = 16;
    bf16s* z; bf16s* zh_c; bf16s* zh_x; bf16s* pq_c; bf16s* pq_x; bf16s* vit; const float* lbv;
    __device__ __forceinline__ void operator()(const f32x4 (&acc)[2][2][4][2], const pg8::Unit& u, int wr, int wc, int fr, int fq) const {
        const int tile = u.i1, pm = u.i0;
        if (u.i2) {
            const int tk = wc * 32 + 8 * fq;
            bf16s* base; size_t cstride;
            if (tile == 9 || tile == 10) { base = vit + (size_t)(tile - 9) * 256 * NVF::RALL + pm * 256; cstride = NVF::RALL; }
            else if (tile < 3) { if (pm < 16) { base = zh_c + (size_t)tile * 256 * NVF::RC + pm * 256; cstride = NVF::RC; } else { base = zh_x + (size_t)tile * 256 * NVF::RX + (pm - 16) * 256; cstride = NVF::RX; } }
            else { const int sn = tile - 13;
                if (pm < 16) { base = pq_c + ((size_t)pm * 256 * 2 + sn) * 256; cstride = 2 * 256; }
                else { const int b = (pm - 16) >> 3, l0 = ((pm - 16) & 7) * 256; base = pq_x + ((size_t)b * 256 * 2 + sn) * 2048 + l0; cstride = 2 * 2048; } }
#pragma unroll
            for (int ai = 0; ai < 2; ++ai)
#pragma unroll
                for (int m = 0; m < 4; ++m) { bf16s* rowp = base + (size_t)(ai * 128 + wr * 64 + m * 16 + fr) * cstride + tk;
#pragma unroll
                    for (int bj = 0; bj < 2; ++bj) { const f32x4 v0 = acc[ai][bj][m][0], v1 = acc[ai][bj][m][1];
                        u32x4 w; w.x = cvt_pk_bf16(v0[0], v0[1]); w.y = cvt_pk_bf16(v0[2], v0[3]); w.z = cvt_pk_bf16(v1[0], v1[1]); w.w = cvt_pk_bf16(v1[2], v1[3]);
                        *(u32x4*)(rowp + bj * 128) = w; } }
            return;
        }
        const int row0 = pm * 256 + wr * 64 + fr; const int colt = (tile < 9 ? tile - 3 : tile - 5) * 256 + wc * 32 + 8 * fq;
        const int kind = tile < 5 ? 1 : tile < 9 ? 2 : 3;
        const float qs = 0.08838834764831845f;
#pragma unroll
        for (int bj = 0; bj < 2; ++bj) {
            const int col = colt + bj * 128;
            float lb[8];
            if (kind == 2) { const float* lp = lbv + (col - NVF::OFF_FF);
#pragma unroll
                for (int j = 0; j < 8; ++j) lb[j] = 1.f - lp[j]; }
#pragma unroll
            for (int ai = 0; ai < 2; ++ai)
#pragma unroll
                for (int m = 0; m < 4; ++m) {
                    float v[8];
#pragma unroll
                    for (int j = 0; j < 4; ++j) { v[j] = acc[ai][bj][m][0][j]; v[4 + j] = acc[ai][bj][m][1][j]; }
                    if (kind == 1) {
#pragma unroll
                        for (int j = 0; j < 8; ++j) v[j] = fast_silu(v[j]) * qs;
                    } else if (kind == 2) {
#pragma unroll
                        for (int j = 0; j < 8; ++j) { const float k = lb[j] * __builtin_amdgcn_rcpf(1.f + __expf(v[j])); v[j] = fmaxf(__logf(1.f - k), -30.f); }
                    } else if (kind == 3) {
#pragma unroll
                        for (int j = 0; j < 8; ++j) v[j] = fast_silu(v[j]);
                    }
                    u32x4 w; w.x = cvt_pk_bf16(v[0], v[1]); w.y = cvt_pk_bf16(v[2], v[3]); w.z = cvt_pk_bf16(v[4], v[5]); w.w = cvt_pk_bf16(v[6], v[7]);
                    *(u32x4*)(z + (size_t)(row0 + ai * 128 + m * 16) * NVF::ZS + col) = w;
                }
        }
    }
};
struct SchedInproj {
    const bf16s* hx; const bf16s* wt; int last; Deal d;
    __device__ __forceinline__ bool next(int i, pg8::Unit& u) const {
        if (d.W != 32) return next_generic(i, u);
        int r = i; const int s = d.j;
        int seen = -1;
        for (r = 0; r <= 8; ++r) { if (valid(r, s)) { if (++seen == i) break; } }
        if (r > 8) return false;
        fill(r, s, u); return true;
    }
#ifndef INPROJ_PB
#define INPROJ_PB 2
#endif
    static constexpr int PB = INPROJ_PB, TBITS = 5 - PB, TPR = 1 << TBITS, RPG = 16 >> TBITS  ;
    __device__ __forceinline__ bool valid(int r, int s) const { if (r < 8) return ((r & (RPG - 1)) * TPR + (s & (TPR - 1))) < 15; const int tile = s & 15; return last ? (tile >= 3 && tile <= 12) : (tile < 15); }
    __device__ __forceinline__ void fill(int r, int s, pg8::Unit& u) const {
        int pm, tile;
        if (r < 8) { tile = (r & (RPG - 1)) * TPR + (s & (TPR - 1)); pm = 16 + d.x * 16 + (1 << PB) * (r / RPG) + (s >> TBITS); } else { tile = s & 15; pm = d.x * 2 + (s >> 4); }
        const char* pa = (const char*)(hx + (size_t)pm * 256 * DmF::D); const char* pb = (const char*)(wt + (size_t)tile * 256 * DmF::D); const bool sw = tile < 3 || tile >= 13 || tile == 9 || tile == 10;
        u.a = sw ? pb : pa; u.b = sw ? pa : pb; u.i0 = pm; u.i1 = tile; u.i2 = sw ? 1 : 0; u.i3 = 0; u.rows = nullptr;
    }
    __device__ __forceinline__ bool next_generic(int i, pg8::Unit& u) const {
        const int nx = 128 * 15, nc = last ? 160 : 240; const int li = i * (int)gridDim.x + (int)blockIdx.x; if (li >= nx + nc) return false;
        int pm, tile; if (li < nx) { const int q15 = (li * 34953) >> 19; pm = 16 + q15; tile = li - q15 * 15; } else { const int q = li - nx; if (last) { const int q10 = (q * 52429) >> 19; pm = q10; tile = 3 + q - q10 * 10; } else { const int q15 = (q * 34953) >> 19; pm = q15; tile = q - q15 * 15; } }
        const char* pa = (const char*)(hx + (size_t)pm * 256 * DmF::D); const char* pb = (const char*)(wt + (size_t)tile * 256 * DmF::D); const bool sw = tile < 3 || tile >= 13 || tile == 9 || tile == 10;
        u.a = sw ? pb : pa; u.b = sw ? pa : pb; u.i0 = pm; u.i1 = tile; u.i2 = sw ? 1 : 0; u.i3 = 0; u.rows = nullptr; return true;
    }
};
__device__ __forceinline__ void f_inproj(const PF& p, const FastWs& f, int layer, int last, LAS unsigned char* lds) {
    SchedInproj S; S.hx = p.hx; S.wt = f.wt_in; S.last = last; S.d.init();
    EpiInproj E{p.z, p.zh_c, p.zh_x, p.pq_c, p.pq_x, p.vit, p.lbv + layer * 2 * DmF::DHG};
#ifndef INPROJ_ALIGN
#define INPROJ_ALIGN true
#endif
#ifdef DIAG_GEMMTIME
    pg8::gemm_phase<EpiInproj, SchedInproj, INPROJ_ALIGN>(lds, pg8::Gemm{DmF::D, DmF::D, DmF::D, layer == 0 ? p.cnt + 48 : nullptr}, S, E);
#else
    pg8::gemm_phase<EpiInproj, SchedInproj, INPROJ_ALIGN>(lds, pg8::Gemm{DmF::D, DmF::D, DmF::D}, S, E);
#endif
}

#ifndef XBF16
#define XBF16 1
#endif
#if XBF16
struct EpiWout {
    static constexpr bool PERM = true; static constexpr int NST = 8;
    bf16s* xb; const float* mod; float scale;
    __device__ __forceinline__ void operator()(const f32x4 (&acc)[2][2][4][2], const pg8::Unit& u, int wr, int wc, int fr, int fq) const {
        const int pm = u.i0; const int col0 = u.i1 * 256 + wc * 32 + 8 * fq;
        const int mr = pm < 16 ? DmF::B : (pm - 16) / 8;
        bf16s* base = xb + (size_t)pm * 256 * DmF::D;
        const float* gate = mod + ((size_t)mr * 6 + 2) * DmF::D;
        f32x4 gv[2][2];
#pragma unroll
        for (int bj = 0; bj < 2; ++bj)
#pragma unroll
            for (int n = 0; n < 2; ++n) gv[bj][n] = *(const f32x4*)(gate + col0 + bj * 128 + n * 4) * scale;
#pragma unroll
        for (int ai = 0; ai < 2; ++ai) { u32x4 old[4][2];
#pragma unroll
            for (int m = 0; m < 4; ++m)
#pragma unroll
                for (int bj = 0; bj < 2; ++bj) old[m][bj] = *(const u32x4*)(base + (size_t)(ai * 128 + wr * 64 + m * 16 + fr) * DmF::D + col0 + bj * 128);
#pragma unroll
            for (int m = 0; m < 4; ++m)
#pragma unroll
                for (int bj = 0; bj < 2; ++bj) { const f32x4 v0 = unpack4((u32x2){old[m][bj].x, old[m][bj].y}) + gv[bj][0] * acc[ai][bj][m][0], v1 = unpack4((u32x2){old[m][bj].z, old[m][bj].w}) + gv[bj][1] * acc[ai][bj][m][1];
                    u32x4 w; w.x = cvt_pk_bf16(v0[0], v0[1]); w.y = cvt_pk_bf16(v0[2], v0[3]); w.z = cvt_pk_bf16(v1[0], v1[1]); w.w = cvt_pk_bf16(v1[2], v1[3]);
                    *(u32x4*)(base + (size_t)(ai * 128 + wr * 64 + m * 16 + fr) * DmF::D + col0 + bj * 128) = w; } }
    }
};
#else
struct EpiWout {
    static constexpr bool PERM = false; static constexpr int NST = 8;
    float* cw; float* out; const float* mod; float scale;
    __device__ __forceinline__ void operator()(const f32x4 (&acc)[2][2][4][2], const pg8::Unit& u, int wr, int wc, int fr, int fq) const {
        const int pm = u.i0; const int col0 = u.i1 * 256 + wc * 32 + 4 * fq;
        const int mr = pm < 16 ? DmF::B : (pm - 16) / 8;
        float* base = pm < 16 ? cw + (size_t)pm * 256 * DmF::D : out + (size_t)(pm - 16) * 256 * DmF::D;
        const float* gate = mod + ((size_t)mr * 6 + 2) * DmF::D;
        f32x4 gv[2][2];
#pragma unroll
        for (int bj = 0; bj < 2; ++bj)
#pragma unroll
            for (int n = 0; n < 2; ++n) gv[bj][n] = *(const f32x4*)(gate + col0 + bj * 128 + n * 16) * scale;
#pragma unroll
        for (int ai = 0; ai < 2; ++ai)
#pragma unroll
            for (int m0 = 0; m0 < 4; m0 += 2) { f32x4 old[2][2][2];
#pragma unroll
                for (int mm = 0; mm < 2; ++mm) { const float* rowp = base + (size_t)(ai * 128 + wr * 64 + (m0 + mm) * 16 + fr) * DmF::D + col0;
#pragma unroll
                    for (int bj = 0; bj < 2; ++bj)
#pragma unroll
                        for (int n = 0; n < 2; ++n) old[mm][bj][n] = *(const f32x4*)(rowp + bj * 128 + n * 16); }
#pragma unroll
                for (int mm = 0; mm < 2; ++mm) { float* rowp = base + (size_t)(ai * 128 + wr * 64 + (m0 + mm) * 16 + fr) * DmF::D + col0;
#pragma unroll
                    for (int bj = 0; bj < 2; ++bj)
#pragma unroll
                        for (int n = 0; n < 2; ++n) *(f32x4*)(rowp + bj * 128 + n * 16) = old[mm][bj][n] + gv[bj][n] * acc[ai][bj][m0 + mm][n]; } }
    }
};
#endif
struct SchedWout {
    const bf16s* mix; const bf16s* wt; int p0; Deal d;
    __device__ __forceinline__ bool next(int i, pg8::Unit& u) const {
        const int ppx = (144 - p0) >> 3; const int li = i * d.W + d.j; if (li >= ppx * 4) return false;
        const int pm = p0 + d.x * ppx + (li >> 2), tile = li & 3;
        u.a = (const char*)(mix + (size_t)pm * 256 * DmF::D); u.b = (const char*)(wt + (size_t)tile * 256 * DmF::D); u.i0 = pm; u.i1 = tile; u.i2 = 0; u.i3 = 0; u.rows = nullptr;
        return true;
    }
};
__device__ __forceinline__ void f_wout(const PF& p, const FastWs& f, int layer, int r0, LAS unsigned char* lds, float scale = 1.f) {
    SchedWout S; S.mix = p.hx; S.wt = f.wt_out; S.p0 = r0 / 256; S.d.init();
#if XBF16
    EpiWout E{p.xb, p.mod + (size_t)layer * (DmF::B + 1) * 6 * DmF::D, scale};
#else
    EpiWout E{p.cw, p.out, p.mod + (size_t)layer * (DmF::B + 1) * 6 * DmF::D, scale};
#endif
#ifndef WOUT_ALIGN
#define WOUT_ALIGN true
#endif
    pg8::gemm_phase<EpiWout, SchedWout, WOUT_ALIGN>(lds, pg8::Gemm{DmF::D, DmF::D, DmF::D}, S, E);
}

__device__ __forceinline__ void f_gather(const PF& p, const FastWs& f) {
    const int total = NVF::moe_off(p, DmF::E);
    const long items = (long)total * 128;
    for (long i = (long)blockIdx.x * NTHREADS + tidx(); i < items; i += (long)gridDim.x * NTHREADS) {
        const int pos = (int)(i >> 7), ch = (int)(i & 127); const int ts = p.perm[pos];
        u32x4 v = (u32x4){0u, 0u, 0u, 0u};
        if (ts >= 0) v = *(const u32x4*)(p.hx + (size_t)(ts >> 1) * DmF::D + ch * 8);
        *(u32x4*)(f.hxs + (size_t)pos * DmF::D + ch * 8) = v;
    }
}
struct SchedMoe {
    const char* abase; size_t apanel; const char* bbase; size_t bexp, btile; const int* cnt; int npanels; Deal d; const int* perm;
    int segend[16];
    __device__ __forceinline__ void init_segments() { int o = 0;
#pragma unroll
        for (int j = 0; j < DmF::E; ++j) { o += (cnt[j] + 255) / 256 * 256; segend[j] = o; } }
    __device__ __forceinline__ int expert_of(int pos) const { int e = 0;
#pragma unroll
        for (int j = 0; j < DmF::E - 1; ++j) e += (pos >= segend[j]) ? 1 : 0;
        return e; }
    __device__ __forceinline__ bool next(int i, pg8::Unit& u) const {
        const int li = i * d.W + d.j; const int mine = (npanels - d.x + 7) >> 3; if (li >= mine * 4) return false;
        const int pm = d.x + 8 * (li >> 2), tile = li & 3;
        const int e = expert_of(pm * 256);
        u.a = perm ? abase : abase + (size_t)pm * apanel; u.b = bbase + (size_t)e * bexp + (size_t)tile * btile; u.i0 = pm; u.i1 = tile; u.i2 = e; u.i3 = 0; u.rows = perm ? perm + pm * 256 : nullptr;
        return true;
    }
};
struct EpiGateUp {
    static constexpr bool PERM = true; static constexpr int NST = 8;
    bf16s* hmid;
    __device__ __forceinline__ void operator()(const f32x4 (&acc)[2][2][4][2], const pg8::Unit& u, int wr, int wc, int fr, int fq) const {
        const int row0 = u.i0 * 256 + wr * 64 + fr; const int col = u.i1 * 128 + wc * 32 + 8 * fq;
#pragma unroll
        for (int ai = 0; ai < 2; ++ai)
#pragma unroll
            for (int m = 0; m < 4; ++m) {
                float v[8];
#pragma unroll
                for (int j = 0; j < 4; ++j) { v[j] = fast_silu(acc[ai][0][m][0][j]) * acc[ai][1][m][0][j]; v[4 + j] = fast_silu(acc[ai][0][m][1][j]) * acc[ai][1][m][1][j]; }
                u32x4 w; w.x = cvt_pk_bf16(v[0], v[1]); w.y = cvt_pk_bf16(v[2], v[3]); w.z = cvt_pk_bf16(v[4], v[5]); w.w = cvt_pk_bf16(v[6], v[7]);
                *(u32x4*)(hmid + (size_t)(row0 + ai * 128 + m * 16) * DmF::DE + col) = w;
            }
    }
};
#ifndef YMOE_FP8
#define YMOE_FP8 0
#endif
__device__ __forceinline__ unsigned pack4_fp8(f32x4 v) {
    unsigned w = 0;
    w = __builtin_amdgcn_cvt_pk_fp8_f32(__builtin_amdgcn_fmed3f(v[0], -440.f, 440.f), __builtin_amdgcn_fmed3f(v[1], -440.f, 440.f), w, false);
    w = __builtin_amdgcn_cvt_pk_fp8_f32(__builtin_amdgcn_fmed3f(v[2], -440.f, 440.f), __builtin_amdgcn_fmed3f(v[3], -440.f, 440.f), w, true);
    return w;
}
__device__ __forceinline__ f32x4 unpack4_fp8(unsigned w) { const f32x2 a = __builtin_amdgcn_cvt_pk_f32_fp8(w, false), b = __builtin_amdgcn_cvt_pk_f32_fp8(w, true); return (f32x4){a[0], a[1], b[0], b[1]}; }
struct EpiDown {
    static constexpr bool PERM = true; static constexpr int NST = 16;
    bf16s* ymoe;
    __device__ __forceinline__ void operator()(const f32x4 (&acc)[2][2][4][2], const pg8::Unit& u, int wr, int wc, int fr, int fq) const {
        const int row0 = u.i0 * 256 + wr * 64 + fr; const int col = u.i1 * 256 + wc * 32 + 8 * fq;
#pragma unroll
        for (int ai = 0; ai < 2; ++ai)
#pragma unroll
            for (int m = 0; m < 4; ++m)
#pragma unroll
                for (int bj = 0; bj < 2; ++bj) { const f32x4 v0 = acc[ai][bj][m][0], v1 = acc[ai][bj][m][1];
#if YMOE_FP8
                    *(u32x2*)((unsigned char*)ymoe + (size_t)(row0 + ai * 128 + m * 16) * DmF::D + col + bj * 128) = (u32x2){pack4_fp8(v0), pack4_fp8(v1)};
#else
                    u32x4 w; w.x = cvt_pk_bf16(v0[0], v0[1]); w.y = cvt_pk_bf16(v0[2], v0[3]); w.z = cvt_pk_bf16(v1[0], v1[1]); w.w = cvt_pk_bf16(v1[2], v1[3]);
                    *(u32x4*)(ymoe + (size_t)(row0 + ai * 128 + m * 16) * DmF::D + col + bj * 128) = w;
#endif
                }
    }
};
__device__ __forceinline__ void f_gateup(const PF& p, const FastWs& f, LAS unsigned char* lds) {
    SchedMoe S; S.abase = (const char*)p.hx; S.perm = p.perm; S.apanel = 0; S.bbase = (const char*)f.wt_gu; S.bexp = (size_t)1024 * DmF::D * 2; S.btile = (size_t)256 * DmF::D * 2;
    S.cnt = p.cnt; S.init_segments(); S.npanels = S.segend[DmF::E - 1] / 256; S.d.init();
    EpiGateUp E{p.hmid};
#ifndef GATEUP_ALIGN
#define GATEUP_ALIGN true
#endif
    pg8::gemm_phase<EpiGateUp, SchedMoe, GATEUP_ALIGN, true>(lds, pg8::Gemm{DmF::D, DmF::D, DmF::D}, S, E);
}
__device__ __forceinline__ void f_down(const PF& p, const FastWs& f, int layer, LAS unsigned char* lds) {
    SchedMoe S; S.perm = nullptr; S.abase = (const char*)p.hmid; S.apanel = (size_t)256 * DmF::DE * 2; S.bbase = (const char*)f.wt_d; S.bexp = (size_t)DmF::D * DmF::DE * 2; S.btile = (size_t)256 * DmF::DE * 2;
    S.cnt = p.cnt; S.init_segments(); S.npanels = S.segend[DmF::E - 1] / 256; S.d.init();
    EpiDown E{f.hxs};
#ifndef DOWN_ALIGN
#define DOWN_ALIGN true
#endif
    pg8::gemm_phase<EpiDown, SchedMoe, DOWN_ALIGN>(lds, pg8::Gemm{DmF::DE, DmF::DE, DmF::DE}, S, E);
}

__device__ __forceinline__ void f_gen_dft(const PF& p, LAS unsigned char* lds) {
    LAS float* CT = (LAS float*)lds; LAS float* ST = CT + 2048;
    for (int m = tidx(); m < 2048; m += NTHREADS) { const float ang = 6.283185307179586f * (float)m / 2048.f; CT[m] = cosf(ang); ST[m] = sinf(ang); }
    __syncthreads();
    const long tid = (long)blockIdx.x * NTHREADS + tidx(), nth = (long)gridDim.x * NTHREADS;
    const float sx = 1.0f / sqrtf(64.f * 2048.f), sc = 1.0f / sqrtf(64.f * 256.f);
    for (long i = tid; i < ((long)2048 * 4096 + 256 * 512) / 2; i += nth) {
        const long e = i * 2; const bool isx = e < (long)2048 * 4096; const long ii = isx ? e : e - (long)2048 * 4096; const int Lw = isx ? 2048 : 256, sh = isx ? 0 : 3;
        const int k = (int)(ii / (2 * Lw)), lp = (int)(ii % (2 * Lw)), sn = lp >= Lw, l = sn ? lp - Lw : lp; const float s = isx ? sx : sc;
        const int m0 = ((k * l) & (Lw - 1)) << sh, m1 = ((k * (l + 1)) & (Lw - 1)) << sh;
        const float v0 = (sn ? -ST[m0] : CT[m0]) * s, v1 = (sn ? -ST[m1] : CT[m1]) * s;
        *(unsigned*)((isx ? p.dft_x : p.dft_c) + ii) = cvt_pk_bf16(v0, v1);
    }
    __syncthreads();
}
struct EpiFnet {
    static constexpr bool PERM = true; static constexpr int NST = 16;
    bf16s* yfn; const float* fn_b;
    __device__ __forceinline__ void operator()(const f32x4 (&acc)[2][2][4][2], const pg8::Unit& u, int wr, int wc, int fr, int fq) const {
        const int row0 = u.i0 + wr * 64 + fr; const int col0 = wc * 32 + 8 * fq;
#pragma unroll
        for (int bj = 0; bj < 2; ++bj) { const f32x4 b0 = *(const f32x4*)(fn_b + col0 + bj * 128), b1 = *(const f32x4*)(fn_b + col0 + bj * 128 + 4);
#pragma unroll
            for (int ai = 0; ai < 2; ++ai)
#pragma unroll
                for (int m = 0; m < 4; ++m) { const f32x4 v0 = acc[ai][bj][m][0] + b0, v1 = acc[ai][bj][m][1] + b1;
                    u32x4 w; w.x = cvt_pk_bf16(v0[0], v0[1]); w.y = cvt_pk_bf16(v0[2], v0[3]); w.z = cvt_pk_bf16(v1[0], v1[1]); w.w = cvt_pk_bf16(v1[2], v1[3]);
                    *(u32x4*)(yfn + (size_t)(row0 + ai * 128 + m * 16) * 256 + col0 + bj * 128) = w; } }
    }
};
struct SchedFnet {
    const bf16s* dft; const bf16s* pq; int first, n, npk_shift, rowbase, Lw;
    __device__ __forceinline__ bool next(int i, pg8::Unit& u) const {
        const int li = i * (int)gridDim.x + (int)blockIdx.x - first; if (li < 0 || li >= n) return false;
        const int b = li >> npk_shift, kp = li & ((1 << npk_shift) - 1);
        u.a = (const char*)(dft + (size_t)kp * 256 * 2 * Lw); u.b = (const char*)(pq + (size_t)b * 256 * 2 * Lw); u.i0 = rowbase + b * Lw + kp * 256; u.i1 = 0; u.i2 = 0; u.i3 = 0; u.rows = nullptr;
        return true;
    }
};
__device__ __forceinline__ void f_fnet(const PF& p, int layer, int with_ctx, LAS unsigned char* lds) {
    EpiFnet E{p.yfn, p.fn_b + layer * 256};
    { SchedFnet S{p.dft_x, p.pq_x, 0, 128, 3, NVF::RC, 2048}; pg8::gemm_phase<EpiFnet, SchedFnet>(lds, pg8::Gemm{4096, 4096, 4096}, S, E); }
    if (with_ctx) { SchedFnet S{p.dft_c, p.pq_c, 0, 16, 0, 0, 256}; pg8::gemm_phase<EpiFnet, SchedFnet>(lds, pg8::Gemm{512, 512, 512}, S, E); }
}
__device__ __forceinline__ float wave_sum(float v) {
#pragma unroll
    for (int o = 32; o >= 1; o >>= 1) v += __shfl_xor(v, o);
    return v;
}

#ifndef XBF16
#define XBF16 1
#endif
#if XBF16
#define XS_LOAD4(p, R, c) unpack4(*(const u32x2*)((p).xb + (size_t)(R) * DmF::D + (c)))
#define XS_STORE4(p, R, c, v) (*(u32x2*)((p).xb + (size_t)(R) * DmF::D + (c)) = pack4(v))
#else
#define XS_LOAD4(p, R, c) (*(const f32x4*)(NVF::xrow((p), (R)) + (c)))
#define XS_STORE4(p, R, c, v) (*(f32x4*)(NVF::xrow((p), (R)) + (c)) = (v))
#endif
struct MoePos { int p0, p1; float g0, g1; };
__device__ __forceinline__ MoePos moe_pos_load(const PF& p, int R) { MoePos m; m.p0 = p.rpos[R * 2]; m.p1 = p.rpos[R * 2 + 1]; m.g0 = p.rgp[R * 2]; m.g1 = p.rgp[R * 2 + 1]; return m; }
#if YMOE_FP8
struct MoeRows { unsigned a[4], b[4]; float g0, g1; };
__device__ __forceinline__ MoeRows moe_rows_load(const bf16s* ymoe, const MoePos& m, int lane) { MoeRows y; y.g0 = m.g0; y.g1 = m.g1; const unsigned char* yb = (const unsigned char*)ymoe;
#pragma unroll
    for (int i = 0; i < 4; ++i) { const int c = i * 256 + lane * 4; y.a[i] = *(const unsigned*)(yb + (size_t)m.p0 * DmF::D + c); y.b[i] = *(const unsigned*)(yb + (size_t)m.p1 * DmF::D + c); }
    return y; }
__device__ __forceinline__ void moe_combine_apply(const PF& p, const MoeRows& y, int player, int R, int lane, f32x4 (&v)[4]) {
    const float* m5 = NVF::modp(p, player, NVF::row_modr(R), 5);
#pragma unroll
    for (int i = 0; i < 4; ++i) { const int c = i * 256 + lane * 4; v[i] = v[i] + *(const f32x4*)(m5 + c) * (unpack4_fp8(y.a[i]) * y.g0 + unpack4_fp8(y.b[i]) * y.g1); }
}
#else
struct MoeRows { u32x2 a[4], b[4]; float g0, g1; };
__device__ __forceinline__ MoeRows moe_rows_load(const bf16s* ymoe, const MoePos& m, int lane) { MoeRows y; y.g0 = m.g0; y.g1 = m.g1;
#pragma unroll
    for (int i = 0; i < 4; ++i) { const int c = i * 256 + lane * 4; y.a[i] = *(const u32x2*)(ymoe + (size_t)m.p0 * DmF::D + c); y.b[i] = *(const u32x2*)(ymoe + (size_t)m.p1 * DmF::D + c); }
    return y; }
__device__ __forceinline__ void moe_combine_apply(const PF& p, const MoeRows& y, int player, int R, int lane, f32x4 (&v)[4]) {
    const float* m5 = NVF::modp(p, player, NVF::row_modr(R), 5);
#pragma unroll
    for (int i = 0; i < 4; ++i) { const int c = i * 256 + lane * 4; v[i] = v[i] + *(const f32x4*)(m5 + c) * (unpack4(y.a[i]) * y.g0 + unpack4(y.b[i]) * y.g1); }
}
#endif
template <bool ROUTER, bool COMBINE, bool INIT = false>
__device__ __forceinline__ void f_normmod(const PF& p, const bf16s* ymoe, int layer, int which, int r0, LAS unsigned char* lds, const float* postab = nullptr) {
    const int t = tidx(), lane = t & 63, gw = blockIdx.x * (NTHREADS / 64) + (t >> 6), NGW = gdimx() * (NTHREADS / 64);
    const float* g = (which ? p.norm2_g : p.norm1_g) + layer * DmF::D;
    LAS int* hist = (LAS int*)lds;
    LAS float* RW = (LAS float*)(lds + 256);
    if constexpr (ROUTER) { if (t < 16) hist[t] = 0;
        for (int i = t; i < DmF::D * 16; i += NTHREADS) { const int k = i >> 4, e = i & 15; RW[e * DmF::D + k] = p.router_w[i]; }
        __syncthreads(); }
    const int rpw = (NVF::RALL - r0 + NGW - 1) / NGW, Rb = r0 + gw * rpw, Re = (Rb + rpw < NVF::RALL) ? Rb + rpw : NVF::RALL;
    f32x4 nv[4];
#define NM_LOAD(RR, dst) do { _Pragma("unroll") for (int i_ = 0; i_ < 4; ++i_) { if constexpr (INIT) { if ((RR) < NVF::RC) dst[i_] = *(const f32x4*)(p.ctx + (size_t)(RR) * DmF::D + i_ * 256 + lane * 4); \
            else dst[i_] = *(const f32x4*)(p.x + (size_t)((RR) - NVF::RC) * DmF::D + i_ * 256 + lane * 4) + *(const f32x4*)(postab + (size_t)(((RR) - NVF::RC) % DmF::L) * DmF::D + i_ * 256 + lane * 4); } \
            else dst[i_] = XS_LOAD4(p, (RR), i_ * 256 + lane * 4); } } while (0)
    MoePos npos; MoeRows nrows; int cur_mr = -1; f32x4 scg[4], shv[4];
    float rb[16];
    if constexpr (ROUTER) {
#pragma unroll
        for (int e = 0; e < 16; ++e) rb[e] = p.router_b[e]; }
    if (Rb < Re) { NM_LOAD(Rb, nv); if constexpr (COMBINE) { npos = moe_pos_load(p, Rb); nrows = moe_rows_load(ymoe, npos, lane); if (Rb + 1 < Re) npos = moe_pos_load(p, Rb + 1); } }
    for (int R = Rb; R < Re; ++R) {
        f32x4 v[4]; float ss = 0.f; MoeRows crows;
#pragma unroll
        for (int i = 0; i < 4; ++i) v[i] = nv[i];
        if constexpr (COMBINE) crows = nrows;
        if (R + 1 < Re) { NM_LOAD(R + 1, nv); if constexpr (COMBINE) { nrows = moe_rows_load(ymoe, npos, lane); if (R + 2 < Re) npos = moe_pos_load(p, R + 2); } }
        if constexpr (COMBINE) moe_combine_apply(p, crows, layer - 1, R, lane, v);
        if constexpr (COMBINE || INIT) {
#pragma unroll
            for (int i = 0; i < 4; ++i) XS_STORE4(p, R, i * 256 + lane * 4, v[i]); }
#pragma unroll
        for (int i = 0; i < 4; ++i) ss += v[i][0] * v[i][0] + v[i][1] * v[i][1] + v[i][2] * v[i][2] + v[i][3] * v[i][3];
        ss = wave_sum(ss);
        const float rstd = 1.0f / sqrtf(ss * (1.0f / DmF::D) + 1e-6f);
        const int mr = NVF::row_modr(R);
        if (mr != cur_mr) { cur_mr = mr; const float* sh = NVF::modp(p, layer, mr, which ? 3 : 0); const float* sc = NVF::modp(p, layer, mr, which ? 4 : 1);
#pragma unroll
            for (int i = 0; i < 4; ++i) { const int c = i * 256 + lane * 4; scg[i] = (*(const f32x4*)(sc + c) + 1.0f) * *(const f32x4*)(g + c); shv[i] = *(const f32x4*)(sh + c); } }
        bf16s* h = p.hx + (size_t)R * DmF::D;
#pragma unroll
        for (int i = 0; i < 4; ++i) { const int c = i * 256 + lane * 4; v[i] = v[i] * rstd * scg[i] + shv[i]; *(u32x2*)(h + c) = pack4(v[i]); }
        if constexpr (ROUTER) {
            float lg[16];
#pragma unroll
            for (int e = 0; e < 16; ++e) { float a = 0.f;
#pragma unroll
                for (int i = 0; i < 4; ++i) { const f32x4 wv4 = *(const LAS f32x4*)(RW + e * DmF::D + i * 256 + lane * 4); a += v[i][0] * wv4[0] + v[i][1] * wv4[1] + v[i][2] * wv4[2] + v[i][3] * wv4[3]; }
                lg[e] = a; }
#pragma unroll
            for (int e = 0; e < 16; ++e) lg[e] = wave_sum(lg[e]);
            if (lane == 0) {
                float mx = lg[0];
#pragma unroll
                for (int e = 1; e < 16; ++e) mx = fmaxf(mx, lg[e]);
                float den = 0.f;
#pragma unroll
                for (int e = 0; e < 16; ++e) { lg[e] = __expf(lg[e] - mx); den += lg[e]; }
                const float rden = 1.0f / den;
                float bestg = -1e30f; int bi0 = 0, bi1 = 0; float bp0 = 0.f, bp1 = 0.f;
#pragma unroll
                for (int gI = 0; gI < 4; ++gI) {
                    float s0 = -1e30f, s1 = -1e30f, p0 = 0.f, p1 = 0.f; int i0 = 0, i1 = 0;
#pragma unroll
                    for (int j = 0; j < 4; ++j) { const int e = gI * 4 + j; const float pr = lg[e] * rden; const float s = pr + rb[e];
                        if (s > s0) { s1 = s0; i1 = i0; p1 = p0; s0 = s; i0 = e; p0 = pr; } else if (s > s1) { s1 = s; i1 = e; p1 = pr; } }
                    const float gs = s0 + s1;
                    if (gs > bestg) { bestg = gs; bi0 = i0; bi1 = i1; bp0 = p0; bp1 = p1; }
                }
                const float sum = bp0 + bp1;
                p.ridx[R * 2] = bi0; p.ridx[R * 2 + 1] = bi1; p.rgp[R * 2] = bp0 / sum; p.rgp[R * 2 + 1] = bp1 / sum;
                p.rrank[R * 2] = __hip_atomic_fetch_add(hist + bi0, 1, __ATOMIC_RELAXED, __HIP_MEMORY_SCOPE_WORKGROUP);
                p.rrank[R * 2 + 1] = __hip_atomic_fetch_add(hist + bi1, 1, __ATOMIC_RELAXED, __HIP_MEMORY_SCOPE_WORKGROUP);
            }
        }
    }
#undef NM_LOAD
    if constexpr (ROUTER) { __syncthreads(); if (t < 16) p.wgbase[blockIdx.x * 16 + t] = atomicAdd(p.cnt + t, hist[t]); __syncthreads(); }
}
__device__ __forceinline__ void f_place_gather(const PF& p, const FastWs& f, int r0) {
    const int t = tidx(), lane = t & 63, gw = blockIdx.x * (NTHREADS / 64) + (t >> 6), NGW = gdimx() * (NTHREADS / 64);
    const int rpw = (NVF::RALL - r0 + NGW - 1) / NGW, Rb = r0 + gw * rpw, Re = (Rb + rpw < NVF::RALL) ? Rb + rpw : NVF::RALL;
    for (int it = lane; it < (Re - Rb) * 2; it += 64) { const int ts = Rb * 2 + it, e = p.ridx[ts];
        const int pos = NVF::moe_off(p, e) + p.wgbase[blockIdx.x * 16 + e] + p.rrank[ts]; p.perm[pos] = ts; p.rpos[ts] = pos; }
}
__device__ __forceinline__ void f_mix(const PF& p, int layer, int r0) {
    const int t = tidx(), lane = t & 63, gw = blockIdx.x * (NTHREADS / 64) + (t >> 6), NGW = gdimx() * (NTHREADS / 64);
    for (int R = r0 + gw; R < NVF::RALL; R += NGW) {
        bf16s* m = p.hx + (size_t)R * DmF::D;
        { f32x4 v = unpack4(*(const u32x2*)(p.y2 + (size_t)R * 256 + lane * 4)); float ss = wave_sum(v[0] * v[0] + v[1] * v[1] + v[2] * v[2] + v[3] * v[3]);
          const float rstd = 1.0f / sqrtf(ss * (1.0f / 256.f) + 1e-6f); const f32x4 gv = *(const f32x4*)(p.hy_norm_g + layer * 256 + lane * 4);
          *(u32x2*)(m + lane * 4) = pack4(v * rstd * gv); }
        {
          const u32x4 w = *(const u32x4*)(p.o + (size_t)R * 512 + lane * 8); f32x4 a = unpack4((u32x2){w.x, w.y}), b = unpack4((u32x2){w.z, w.w});
          float ss = a[0] * a[0] + a[1] * a[1] + a[2] * a[2] + a[3] * a[3] + b[0] * b[0] + b[1] * b[1] + b[2] * b[2] + b[3] * b[3];
#pragma unroll
          for (int o = 8; o >= 1; o >>= 1) ss += __shfl_xor(ss, o);
          const float rstd = 1.0f / sqrtf(ss * (1.0f / 128.f) + 1e-6f);
          const u32x4 gw4 = *(const u32x4*)(p.z + (size_t)R * NVF::ZS + NVF::OFF_G + lane * 8); const f32x4 ga = unpack4((u32x2){gw4.x, gw4.y}), gb = unpack4((u32x2){gw4.z, gw4.w});
          const f32x4 na = *(const f32x4*)(p.hg_norm_g + layer * 512 + lane * 8), nb = *(const f32x4*)(p.hg_norm_g + layer * 512 + lane * 8 + 4);
          const u32x2 o0 = pack4(a * rstd * na * ga), o1 = pack4(b * rstd * nb * gb);
          *(u32x4*)(m + 256 + lane * 8) = (u32x4){o0.x, o0.y, o1.x, o1.y}; }
        { f32x4 v = unpack4(*(const u32x2*)(p.yfn + (size_t)R * 256 + lane * 4)); float ss = wave_sum(v[0] * v[0] + v[1] * v[1] + v[2] * v[2] + v[3] * v[3]);
          const float rstd = 1.0f / sqrtf(ss * (1.0f / 256.f) + 1e-6f); const f32x4 gv = *(const f32x4*)(p.fn_norm_g + layer * 256 + lane * 4);
          *(u32x2*)(m + 768 + lane * 4) = pack4(v * rstd * gv); }
    }
}
__device__ __forceinline__ void f_final(const PF& p, const bf16s* ymoe) {
    const int t = tidx(), lane = t & 63, gw = blockIdx.x * (NTHREADS / 64) + (t >> 6), NGW = gdimx() * (NTHREADS / 64);
    const int rpw = (NVF::RX + NGW - 1) / NGW, Rb = gw * rpw, Re = (Rb + rpw < NVF::RX) ? Rb + rpw : NVF::RX;
    f32x4 gfin[4];
#pragma unroll
    for (int i = 0; i < 4; ++i) gfin[i] = *(const f32x4*)(p.final_g + i * 256 + lane * 4);
    f32x4 nv[4]; MoePos npos; MoeRows nrows;
#define FN_LOAD(RR) do { _Pragma("unroll") for (int i_ = 0; i_ < 4; ++i_) nv[i_] = XS_LOAD4(p, NVF::RC + (RR), i_ * 256 + lane * 4); } while (0)
    if (Rb < Re) { FN_LOAD(Rb); npos = moe_pos_load(p, NVF::RC + Rb); nrows = moe_rows_load(ymoe, npos, lane); if (Rb + 1 < Re) npos = moe_pos_load(p, NVF::RC + Rb + 1); }
    for (int R = Rb; R < Re; ++R) {
        float* xr = p.out + (size_t)R * DmF::D;
        f32x4 v[4]; float ss = 0.f; const MoeRows crows = nrows;
#pragma unroll
        for (int i = 0; i < 4; ++i) v[i] = nv[i];
        if (R + 1 < Re) { FN_LOAD(R + 1); nrows = moe_rows_load(ymoe, npos, lane); if (R + 2 < Re) npos = moe_pos_load(p, NVF::RC + R + 2); }
        moe_combine_apply(p, crows, DmF::DEPTH - 1, NVF::RC + R, lane, v);
#pragma unroll
        for (int i = 0; i < 4; ++i) ss += v[i][0] * v[i][0] + v[i][1] * v[i][1] + v[i][2] * v[i][2] + v[i][3] * v[i][3];
        ss = wave_sum(ss);
        const float rstd = 1.0f / sqrtf(ss * (1.0f / DmF::D) + 1e-6f);
#pragma unroll
        for (int i = 0; i < 4; ++i) *(f32x4*)(xr + i * 256 + lane * 4) = v[i] * rstd * gfin[i];
    }
#undef FN_LOAD
#ifdef DIAG_OUT
    __syncthreads();
    if (blockIdx.x == 0 && t == 0) { asm volatile("s_waitcnt vmcnt(0)" ::: "memory"); p.out[0] = 1.0e4f * (1.0f + (float)__hip_atomic_load(p.cnt + DIAG_OUT, __ATOMIC_RELAXED, __HIP_MEMORY_SCOPE_AGENT)); }
#endif
#ifdef DIAG_SANITIZE
    __syncthreads();
    if (blockIdx.x == 0 && t == 0) { asm volatile("s_waitcnt vmcnt(0)" ::: "memory"); p.out[0] = 1.0e4f * (1.0f + (float)__hip_atomic_load(p.cnt + 40, __ATOMIC_RELAXED, __HIP_MEMORY_SCOPE_AGENT)); }
#endif
}
#ifndef REP_HYCONV
#define REP_HYCONV 1
#endif
template <int L> struct HyG {
    static_assert(8 * (2 * L * 2 + 32) + 16 * (L * 2 + 16) <= LDS_MISC_OFF, "Hyena LDS image does not fit");
    static constexpr int TB = L / 128;
    static constexpr int CS = 2 * L * 2 + 32;
    static constexpr int RSB = L * 2 + 16;
    static constexpr int U_OFF = 8 * CS;
    static constexpr int BYTES = U_OFF + 16 * RSB;
};
__device__ __forceinline__ float bflo(unsigned w) { return __uint_as_float(w << 16); }
__device__ __forceinline__ float bfhi(unsigned w) { return __uint_as_float(w & 0xffff0000u); }

template <int L> __device__ __forceinline__ void hy_build_copies(LAS unsigned char* lds, const bf16s* kr, int t) {
    constexpr int NCH = 2 * L / 8;
    for (int w = t; w < NCH; w += NTHREADS) {
        unsigned S[8];
        const u32x4 c0 = *(const u32x4*)(kr + w * 8); u32x4 c1 = (u32x4){0u, 0u, 0u, 0u};
        if (w + 1 < NCH) c1 = *(const u32x4*)(kr + w * 8 + 8);
        S[0] = c0.x; S[1] = c0.y; S[2] = c0.z; S[3] = c0.w; S[4] = c1.x; S[5] = c1.y; S[6] = c1.z; S[7] = c1.w;
#pragma unroll
        for (int a = 0; a < 8; ++a) { u32x4 o;
            if ((a & 1) == 0) { o.x = S[a / 2]; o.y = S[a / 2 + 1]; o.z = S[a / 2 + 2]; o.w = S[a / 2 + 3]; }
            else { const int h = (a - 1) / 2; o.x = (S[h] >> 16) | (S[h + 1] << 16); o.y = (S[h + 1] >> 16) | (S[h + 2] << 16); o.z = (S[h + 2] >> 16) | (S[h + 3] << 16); o.w = (S[h + 3] >> 16) | (S[h + 4] << 16); }
            *(LAS u32x4*)(lds + a * HyG<L>::CS + w * 16) = o; }
    }
}
template <int L, bool RAW> __device__ __forceinline__ void hy_stage_u(LAS unsigned char* lds, const bf16s* zrow, float w0, float w1, float w2, float bias, int t) {
    constexpr int NCH = 16 * L / 8, CPR = L / 8, PT = (NCH + NTHREADS - 1) / NTHREADS, G = PT < 4 ? PT : 4;
    static_assert(PT % G == 0, "chunk batching");
    for (int q0 = t; q0 < NCH; q0 += G * NTHREADS) {
        u32x4 v[G]; bf16s pv[G], nx[G];
#pragma unroll
        for (int u = 0; u < G; ++u) { const int q = q0 + u * NTHREADS; const bool ok = q < NCH; const int qq = ok ? q : 0; const int b = qq / CPR, s0 = (qq % CPR) * 8; const bf16s* src = zrow + (size_t)b * L + s0;
            v[u] = *(const u32x4*)src;
            if (!RAW) { pv[u] = src[s0 > 0 ? -1 : 0]; nx[u] = src[s0 + 8 < L ? 8 : 7]; } }
#pragma unroll
        for (int u = 0; u < G; ++u) { const int q = q0 + u * NTHREADS; if (q >= NCH) continue; const int b = q / CPR, s0 = (q % CPR) * 8;
            u32x4 o = v[u];
            if (!RAW) {
                const float prev = s0 > 0 ? bf2f(pv[u]) : 0.f, nxt = s0 + 8 < L ? bf2f(nx[u]) : 0.f;
                float z[10]; z[0] = prev; z[1] = bflo(o.x); z[2] = bfhi(o.x); z[3] = bflo(o.y); z[4] = bfhi(o.y); z[5] = bflo(o.z); z[6] = bfhi(o.z); z[7] = bflo(o.w); z[8] = bfhi(o.w); z[9] = nxt;
                float uu[8];
#pragma unroll
                for (int e = 0; e < 8; ++e) uu[e] = w0 * z[e] + w1 * z[e + 1] + w2 * z[e + 2] + bias;
                o.x = cvt_pk_bf16(uu[0], uu[1]); o.y = cvt_pk_bf16(uu[2], uu[3]); o.z = cvt_pk_bf16(uu[4], uu[5]); o.w = cvt_pk_bf16(uu[6], uu[7]);
            }
            *(LAS u32x4*)(lds + HyG<L>::U_OFF + b * HyG<L>::RSB + s0 * 2) = o; }
    }
}
template <int L, bool TO_LDS> __device__ __forceinline__ void hy_conv(LAS unsigned char* lds, const bf16s* zg, float g0, float g1, float g2, float gb, bf16s* outp, int t) {
    constexpr int TB = HyG<L>::TB, CS = HyG<L>::CS, RSB = HyG<L>::RSB, U_OFF = HyG<L>::U_OFF, NJ = L / 32;
    const int lane = t & 63, w = __builtin_amdgcn_readfirstlane(t >> 6), r = lane & 15, q = lane >> 4;
    const int a = 7 - (r & 7);
    const int baseA = a * CS + 2 * (L - 8 - 8 * (r >> 3) + 8 * q) - 32 * TB * w;
    const int baseB = U_OFF + r * RSB + 16 * q;
    f32x4 acc[TB]; bf16x8 F[TB];
#pragma unroll
    for (int ii = 0; ii < TB; ++ii) acc[ii] = (f32x4){0.f, 0.f, 0.f, 0.f};
#pragma unroll
    for (int ii = 2; ii < TB; ++ii) F[ii] = *(const LAS bf16x8*)(lds + baseA - 32 * ii);
    constexpr int PER = TB / 2;
    for (int j0 = 0; j0 < NJ; j0 += PER) {
        const int pA = baseA + 64 * j0, pB = baseB + 64 * j0;
#pragma unroll
        for (int jj = 0; jj < PER; ++jj) {
            F[(0 - 2 * jj) & (TB - 1)] = *(const LAS bf16x8*)(lds + pA + 64 * jj);
            F[(1 - 2 * jj) & (TB - 1)] = *(const LAS bf16x8*)(lds + pA + 64 * jj - 32);
            const bf16x8 Bf = *(const LAS bf16x8*)(lds + pB + 64 * jj);
#pragma unroll
            for (int ii = 0; ii < TB; ++ii) acc[ii] = __builtin_amdgcn_mfma_f32_16x16x32_bf16(F[(ii - 2 * jj) & (TB - 1)], Bf, acc[ii], 0, 0, 0);
        }
    }
    if constexpr (TO_LDS) lds_barrier();
    constexpr int EG = TB < 4 ? TB : 4;
#pragma unroll
    for (int i0 = 0; i0 < TB; i0 += EG) {
        u32x2 gv[EG]; bf16s pv[EG], nx[EG];
#pragma unroll
        for (int u = 0; u < EG; ++u) { const int t0 = 16 * (TB * w + i0 + u) + 4 * q; const bf16s* gp = zg + (size_t)r * L + t0;
            gv[u] = *(const u32x2*)gp; pv[u] = gp[t0 > 0 ? -1 : 0]; nx[u] = gp[t0 + 4 < L ? 4 : 3]; }
#pragma unroll
        for (int u = 0; u < EG; ++u) { const int ii = i0 + u; const int t0 = 16 * (TB * w + ii) + 4 * q;
            const float prev = t0 > 0 ? bf2f(pv[u]) : 0.f, nxt = t0 + 4 < L ? bf2f(nx[u]) : 0.f;
            float z[6]; z[0] = prev; z[1] = bflo(gv[u].x); z[2] = bfhi(gv[u].x); z[3] = bflo(gv[u].y); z[4] = bfhi(gv[u].y); z[5] = nxt;
            float o[4];
#pragma unroll
            for (int e = 0; e < 4; ++e) o[e] = acc[ii][e] * (g0 * z[e] + g1 * z[e + 1] + g2 * z[e + 2] + gb);
            u32x2 wv; wv.x = cvt_pk_bf16(o[0], o[1]); wv.y = cvt_pk_bf16(o[2], o[3]);
            if constexpr (TO_LDS) *(LAS u32x2*)(lds + U_OFF + r * RSB + t0 * 2) = wv; else *(u32x2*)(outp + (size_t)r * L + t0) = wv; }
    }
}
template <int L> __device__ __forceinline__ void hy_unit(const PF& p, int layer, int c, LAS unsigned char* lds, const bf16s* zh, size_t zstride, const bf16s* krt, bf16s* y1t, bf16s* y2t) {
    const int t = tidx();
    const float* cw = p.hy_conv_w + (size_t)layer * 9 * 256; const float* cb = p.hy_conv_b + (size_t)layer * 3 * 256;
    const bf16s* zv = zh + (size_t)c * zstride; const bf16s* z1 = zh + (size_t)(256 + c) * zstride; const bf16s* z2 = zh + (size_t)(512 + c) * zstride;
    hy_build_copies<L>(lds, krt + (size_t)c * 2 * L, t);
    hy_stage_u<L, false>(lds, zv, cw[c], cw[768 + c], cw[1536 + c], cb[c], t);
    lds_barrier();
    for (int q_ = 0; q_ < REP_HYCONV; ++q_) hy_conv<L, true>(lds, z1, cw[256 + c], cw[768 + 256 + c], cw[1536 + 256 + c], cb[256 + c], nullptr, t);
    hy_build_copies<L>(lds, krt + (size_t)(256 + c) * 2 * L, t);
    lds_barrier();
    for (int q_ = 0; q_ < REP_HYCONV; ++q_) hy_conv<L, false>(lds, z2, cw[512 + c], cw[768 + 512 + c], cw[1536 + 512 + c], cb[512 + c], y2t + (size_t)c * zstride, t);
    lds_barrier();
}
__device__ __forceinline__ void f_hyena(const PF& p, int layer, int with_ctx, LAS unsigned char* lds, int wg0, int nwg) {
    const int me = (int)blockIdx.x - wg0; if (me < 0 || me >= nwg) return;
    for (int c = me; c < 256; c += nwg)
        hy_unit<2048>(p, layer, c, lds, p.zh_x, NVF::RX, p.krt_x + (size_t)layer * 2 * 256 * 4096, p.y1t_x, p.y2t_x);
    if (with_ctx)
        for (int c = me; c < 256; c += nwg)
            hy_unit<256>(p, layer, c, lds, p.zh_c, NVF::RC, p.krt_c + (size_t)layer * 2 * 256 * 512, p.y1t_c, p.y2t_c);
}
__device__ __forceinline__ void f_gen_krt(const PF& p) {
    const long tid = (long)blockIdx.x * NTHREADS + tidx(), nth = (long)gridDim.x * NTHREADS;
    constexpr int NC = DmF::NC, L = DmF::L, C = DmF::C, FH = DmF::FH;
    const float max_decay = logf(1e-2f) / 0.3f, min_decay = logf(1e-2f) / 1.5f;
    for (long i = tid; i < (long)DmF::DEPTH * (NC + L) * 4 * C; i += nth) {
        const int oc = (int)(i % (4 * C)), ll = (int)((i / (4 * C)) % (NC + L)), layer = (int)(i / ((long)4 * C * (NC + L)));
        const int isx = ll >= NC, Lw = isx ? L : NC, l = isx ? ll - NC : ll, c = oc % C, fdir = oc / C, order = fdir >> 1, bwd = fdir & 1;
        const float tt = (float)l / (float)(Lw - 1);
        const float* h2 = p.hf2 + (i / (4 * C)) * FH;
        const float* w3 = p.hy_w3 + (size_t)layer * FH * 4 * C + oc;
        float acc = 0.f;
        for (int k = 0; k < FH; ++k) acc += h2[k] * w3[(size_t)k * 4 * C];
        const float delta = min_decay + (max_decay - min_decay) * (float)c / (float)(C - 1);
        float v = acc * expf(-tt * fabsf(delta));
        bf16s* kr = (isx ? p.krt_x : p.krt_c) + ((size_t)(layer * 2 + order) * 256 + c) * 2 * Lw;
        if (!bwd) { if (l == 0) v += p.hy_bias[(layer * 2 + order) * C + c]; kr[(Lw - 1) - l] = f2bf(v); }
        else { if (l > 0) kr[(Lw - 1) + l] = f2bf(v); else kr[2 * Lw - 1] = 0; }
    }
}
__device__ __forceinline__ void f_mix2(const PF& p, int layer, int r0, LAS unsigned char* lds) {
    const int t = tidx(), lane = t & 63, wv = t >> 6;
    constexpr int TS = 132;
    LAS float* ssb = (LAS float*)(lds + 256 * TS);
    float gq[32];
#pragma unroll
    for (int k = 0; k < 32; ++k) gq[k] = p.hy_norm_g[layer * 256 + wv * 32 + k];
    for (int tile = r0 / 64 + blockIdx.x; tile < NVF::RALL / 64; tile += gridDim.x) {
        const int R0 = tile * 64; const bool isc = R0 < NVF::RC;
        const bf16s* src = isc ? p.y2t_c + R0 : p.y2t_x + (R0 - NVF::RC); const size_t stride = isc ? NVF::RC : NVF::RX;
        for (int q = t; q < 2048; q += NTHREADS) { const int ch = q >> 3, k = q & 7; const u32x4 v = *(const u32x4*)(src + (size_t)ch * stride + k * 8);
            LAS unsigned* d = (LAS unsigned*)(lds + ch * TS + k * 16); d[0] = v.x; d[1] = v.y; d[2] = v.z; d[3] = v.w; }
        lds_barrier();
        float hv[32]; float ss = 0.f;
#pragma unroll
        for (int k = 0; k < 32; ++k) { hv[k] = bf2f(*(const LAS bf16s*)(lds + (wv * 32 + k) * TS + lane * 2)); ss += hv[k] * hv[k]; }
        ssb[wv * 64 + lane] = ss;
        lds_barrier();
        float tot = 0.f;
#pragma unroll
        for (int k = 0; k < 8; ++k) tot += ssb[k * 64 + lane];
        { const float rstd = 1.0f / sqrtf(tot * (1.0f / 256.f) + 1e-6f); bf16s* m = p.hx + (size_t)(R0 + lane) * DmF::D + wv * 32;
#pragma unroll
          for (int k = 0; k < 32; k += 8) { u32x4 w; w.x = cvt_pk_bf16(hv[k] * rstd * gq[k], hv[k + 1] * rstd * gq[k + 1]); w.y = cvt_pk_bf16(hv[k + 2] * rstd * gq[k + 2], hv[k + 3] * rstd * gq[k + 3]);
              w.z = cvt_pk_bf16(hv[k + 4] * rstd * gq[k + 4], hv[k + 5] * rstd * gq[k + 5]); w.w = cvt_pk_bf16(hv[k + 6] * rstd * gq[k + 6], hv[k + 7] * rstd * gq[k + 7]); *(u32x4*)(m + k) = w; } }
        { const f32x4 na = *(const f32x4*)(p.hg_norm_g + layer * 512 + lane * 8), nb = *(const f32x4*)(p.hg_norm_g + layer * 512 + lane * 8 + 4), gf = *(const f32x4*)(p.fn_norm_g + layer * 256 + lane * 4);
#pragma unroll
          for (int r4 = 0; r4 < 8; r4 += 4) {
            u32x4 wo[4], wb[4], wg[4]; u32x2 wf[4];
#pragma unroll
            for (int u = 0; u < 4; ++u) { const size_t R = (size_t)(R0 + wv * 8 + r4 + u);
                wo[u] = *(const u32x4*)(p.o + R * 512 + lane * 8); wb[u] = *(const u32x4*)(p.ob + R * 512 + lane * 8);
                wg[u] = *(const u32x4*)(p.z + R * NVF::ZS + NVF::OFF_G + lane * 8); wf[u] = *(const u32x2*)(p.yfn + R * 256 + lane * 4); }
#pragma unroll
            for (int u = 0; u < 4; ++u) { const int R = R0 + wv * 8 + r4 + u; bf16s* m = p.hx + (size_t)R * DmF::D;
                f32x4 a = unpack4((u32x2){wo[u].x, wo[u].y}) + unpack4((u32x2){wb[u].x, wb[u].y}), b = unpack4((u32x2){wo[u].z, wo[u].w}) + unpack4((u32x2){wb[u].z, wb[u].w});
                float s2 = a[0] * a[0] + a[1] * a[1] + a[2] * a[2] + a[3] * a[3] + b[0] * b[0] + b[1] * b[1] + b[2] * b[2] + b[3] * b[3];
#pragma unroll
                for (int o = 8; o >= 1; o >>= 1) s2 += __shfl_xor(s2, o);
                const float rstd = 1.0f / sqrtf(s2 * (1.0f / 128.f) + 1e-6f);
                const f32x4 ga = unpack4((u32x2){wg[u].x, wg[u].y}), gb = unpack4((u32x2){wg[u].z, wg[u].w});
                const u32x2 o0 = pack4(a * rstd * na * ga), o1 = pack4(b * rstd * nb * gb);
                *(u32x4*)(m + 256 + lane * 8) = (u32x4){o0.x, o0.y, o1.x, o1.y};
                f32x4 v = unpack4(wf[u]); float s3 = wave_sum(v[0] * v[0] + v[1] * v[1] + v[2] * v[2] + v[3] * v[3]);
                const float rstd3 = 1.0f / sqrtf(s3 * (1.0f / 256.f) + 1e-6f);
                *(u32x2*)(m + 768 + lane * 4) = pack4(v * rstd3 * gf); }
          } }
        lds_barrier();
    }
}
#ifndef REP_HG3
#define REP_HG3 1
#endif
namespace hg {
constexpr int RS = 272, QE_OFF = 0, QM_OFF = QE_OFF + 64 * RS, KM_OFF = QM_OFF + 64 * RS  ,
              KET_OFF = KM_OFF + 160 * RS, PT_OFF = KET_OFF + 128 * 144, TOT_OFF = PT_OFF + 64 * 144  , G_OFF = TOT_OFF + 4096, END = G_OFF + 512;
static_assert(END <= LDS_MISC_OFF, "HGRN LDS image does not fit");
typedef __bf16 bf16x2n __attribute__((ext_vector_type(2)));
__device__ __forceinline__ unsigned pk(float a, float b) { f32x2 v = {a, b}; bf16x2n r = __builtin_convertvector(v, bf16x2n); return __builtin_bit_cast(unsigned, r); }
__device__ __forceinline__ unsigned swp(unsigned x) { return (x >> 16) | (x << 16); }
__device__ __forceinline__ int chunk_rlo(int cc, int b, int dir) {
    const int seg = cc >= 4, ck = seg ? cc - 4 : cc, nck = seg ? 32 : 4, r0 = seg ? NVF::RC + b * 2048 : b * 256;
    return dir ? r0 + 64 * (nck - 1 - ck) : r0 + 64 * ck;
}
}
__device__ __forceinline__ void f_hgrn(const PF& p, LAS unsigned char* lds) {
    using namespace hg;
    const int t = tidx(), lane = t & 63, w = __builtin_amdgcn_readfirstlane(t >> 6), lr = lane & 15, qd = lane >> 4;
    const int sg = w >> 1, hh = w & 1, tau0 = 16 * sg + 8 * hh, d0 = 2 * lane;
    constexpr int ZS = NVF::ZS; constexpr size_t RALL = NVF::RALL;
    for (int ci = (int)gridDim.x - 1 - (int)blockIdx.x; ci < 128; ci += gridDim.x) {
        const int dir = ci & 1, h = (ci >> 1) & 3, b = ci >> 3;
        const bf16s* zq = p.z + NVF::OFF_Q + h * 128 + d0; const bf16s* zl = p.z + (dir ? NVF::OFF_FB : NVF::OFF_FF) + h * 128 + d0;
        const bf16s* vrow = p.vit + (size_t)(h * 128 + 16 * w + lr) * RALL;
        bf16s* outp = (dir ? p.ob : p.o) + h * 128 + 16 * w + 4 * qd;
        f32x4 S[8];
#pragma unroll
        for (int i = 0; i < 8; ++i) S[i] = (f32x4){0.f, 0.f, 0.f, 0.f};
        for (int i = t; i < 64 * 144 / 16; i += NTHREADS) *(LAS u32x4*)(lds + PT_OFF + i * 16) = (u32x4){0u, 0u, 0u, 0u};
#define HG_BAR() do { asm volatile("s_waitcnt lgkmcnt(0)" ::: "memory"); __builtin_amdgcn_s_barrier(); asm volatile("" ::: "memory"); } while (0)
        unsigned nq[8], nl[8]; u32x4 nv[2];
#define HG_LOAD(cc) do { const int rlo_ = chunk_rlo((cc), b, dir); _Pragma("unroll") for (int i_ = 0; i_ < 8; ++i_) { const size_t R_ = dir ? rlo_ + 63 - (tau0 + i_) : rlo_ + tau0 + i_; \
            nq[i_] = *(const unsigned*)(zq + R_ * ZS); nl[i_] = *(const unsigned*)(zl + R_ * ZS); } \
            _Pragma("unroll") for (int kb_ = 0; kb_ < 2; ++kb_) nv[kb_] = *(const u32x4*)(vrow + (dir ? rlo_ + 56 - 32 * kb_ - 8 * qd : rlo_ + 32 * kb_ + 8 * qd)); } while (0)
        unsigned cq[8], cl[8]; bf16x8 Vf[2];
#define HG_TAKE() do { _Pragma("unroll") for (int i_ = 0; i_ < 8; ++i_) { cq[i_] = nq[i_]; cl[i_] = nl[i_]; } \
            _Pragma("unroll") for (int kb_ = 0; kb_ < 2; ++kb_) { u32x4 x_ = nv[kb_]; if (dir) x_ = (u32x4){swp(x_.w), swp(x_.z), swp(x_.y), swp(x_.x)}; Vf[kb_] = __builtin_bit_cast(bf16x8, x_); } } while (0)
        HG_LOAD(0);
        HG_TAKE();
        HG_BAR();
        for (int cc = 0; cc < 36; ++cc) {
            const int Rlo = chunk_rlo(cc, b, dir);
            if (cc + 1 < 36) HG_LOAD(cc + 1);
            float c0[8], c1[8];
            { float a0 = 0.f, a1 = 0.f;
#pragma unroll
              for (int i = 0; i < 8; ++i) { a0 += bflo(cl[i]); a1 += bfhi(cl[i]); c0[i] = a0; c1[i] = a1; }
              *(LAS f32x2*)(lds + TOT_OFF + (w * 128 + d0) * 4) = (f32x2){a0, a1}; }
            HG_BAR();
            for (int rq_ = 0; rq_ < REP_HG3; ++rq_) { asm volatile("" ::: "memory");
            { f32x2 T[8];
#pragma unroll
              for (int j = 0; j < 8; ++j) T[j] = *(const LAS f32x2*)(lds + TOT_OFF + (j * 128 + d0) * 4);
              f32x2 pre[9]; pre[0] = (f32x2){0.f, 0.f};
#pragma unroll
              for (int j = 0; j < 8; ++j) pre[j + 1] = pre[j] + T[j];
              const f32x2 rt = sg == 0 ? pre[0] : sg == 1 ? pre[2] : sg == 2 ? pre[4] : pre[6];
              const f32x2 hoff = hh ? (sg == 0 ? T[0] : sg == 1 ? T[2] : sg == 2 ? T[4] : T[6]) : (f32x2){0.f, 0.f};
              const f32x2 bend = pre[8];
              const f32x2 Eoff = {__expf(rt[0]), __expf(rt[1])}, Fend = {__expf(bend[0] - rt[0]), __expf(bend[1] - rt[1])};
              const f32x2 F1 = {__expf(pre[2][0] - rt[0]), __expf(pre[2][1] - rt[1])}, F2 = {__expf(pre[4][0] - rt[0]), __expf(pre[4][1] - rt[1])}, F3 = {__expf(pre[6][0] - rt[0]), __expf(pre[6][1] - rt[1])};
              const int tl0 = sg == 0 ? 0 : sg == 1 ? 4 : sg == 2 ? 7 : 9;
              float ke0[8], ke1[8], kv0[8], kv1[8];
#pragma unroll
              for (int i = 0; i < 8; ++i) { const int tau = tau0 + i, trow = 8 * hh + i;
                  const float q0 = bflo(cq[i]), q1 = bfhi(cq[i]);
                  const float k0 = 1.f - __expf(bflo(cl[i])), k1 = 1.f - __expf(bfhi(cl[i]));
                  const float A0 = __expf(hoff[0] + c0[i]), A1 = __expf(hoff[1] + c1[i]);
                  const float ki0 = k0 * __builtin_amdgcn_rcpf(fmaxf(A0, 1.8e-35f)), ki1 = k1 * __builtin_amdgcn_rcpf(fmaxf(A1, 1.8e-35f));
                  const float qa0 = q0 * A0, qa1 = q1 * A1;
                  *(LAS unsigned*)(lds + QM_OFF + tau * RS + d0 * 2) = pk(qa0, qa1);
                  *(LAS unsigned*)(lds + QE_OFF + tau * RS + d0 * 2) = pk(qa0 * Eoff[0], qa1 * Eoff[1]);
                  *(LAS unsigned*)(lds + KM_OFF + (tl0 * 16 + trow) * RS + d0 * 2) = pk(ki0, ki1);
                  kv0[i] = ki0; kv1[i] = ki1; ke0[i] = ki0 * Fend[0]; ke1[i] = ki1 * Fend[1]; }
              if (sg < 1) {
#pragma unroll
                  for (int i = 0; i < 8; ++i) *(LAS unsigned*)(lds + KM_OFF + ((tl0 + 1 - sg) * 16 + 8 * hh + i) * RS + d0 * 2) = pk(kv0[i] * F1[0], kv1[i] * F1[1]); }
              if (sg < 2) {
#pragma unroll
                  for (int i = 0; i < 8; ++i) *(LAS unsigned*)(lds + KM_OFF + ((tl0 + 2 - sg) * 16 + 8 * hh + i) * RS + d0 * 2) = pk(kv0[i] * F2[0], kv1[i] * F2[1]); }
              if (sg < 3) {
#pragma unroll
                  for (int i = 0; i < 8; ++i) *(LAS unsigned*)(lds + KM_OFF + ((tl0 + 3 - sg) * 16 + 8 * hh + i) * RS + d0 * 2) = pk(kv0[i] * F3[0], kv1[i] * F3[1]); }
              u32x4 x0, x1; x0.x = pk(ke0[0], ke0[1]); x0.y = pk(ke0[2], ke0[3]); x0.z = pk(ke0[4], ke0[5]); x0.w = pk(ke0[6], ke0[7]); x1.x = pk(ke1[0], ke1[1]); x1.y = pk(ke1[2], ke1[3]); x1.z = pk(ke1[4], ke1[5]); x1.w = pk(ke1[6], ke1[7]);
              *(LAS u32x4*)(lds + KET_OFF + d0 * 144 + tau0 * 2) = x0; *(LAS u32x4*)(lds + KET_OFF + (d0 + 1) * 144 + tau0 * 2) = x1;
              if (w == 0) *(LAS f32x2*)(lds + G_OFF + d0 * 4) = (f32x2){__expf(bend[0]), __expf(bend[1])}; }
            }
            HG_BAR();
            for (int tl = w; tl < 10; tl += 8) {
                const int si = (int)((0x3221110000ull >> (4 * tl)) & 0xF), ti = (int)((0x3323213210ull >> (4 * tl)) & 0xF);
                f32x4 acc = (f32x4){0.f, 0.f, 0.f, 0.f};
#pragma unroll
                for (int kb = 0; kb < 4; ++kb) { const bf16x8 A = *(const LAS bf16x8*)(lds + KM_OFF + (16 * tl + lr) * RS + (32 * kb + 8 * qd) * 2); const bf16x8 B = *(const LAS bf16x8*)(lds + QM_OFF + (16 * ti + lr) * RS + (32 * kb + 8 * qd) * 2);
                    acc = __builtin_amdgcn_mfma_f32_16x16x32_bf16(A, B, acc, 0, 0, 0); }
                if (si == ti) {
#pragma unroll
                    for (int e = 0; e < 4; ++e) if (4 * qd + e > lr) acc[e] = 0.f; }
                u32x2 wv; wv.x = pk(acc[0], acc[1]); wv.y = pk(acc[2], acc[3]);
                *(LAS u32x2*)(lds + PT_OFF + (16 * ti + lr) * 144 + (16 * si + 4 * qd) * 2) = wv;
            }
            bf16x8 As[4];
#pragma unroll
            for (int kb = 0; kb < 4; ++kb) { u32x4 x; x.x = pk(S[2 * kb][0], S[2 * kb][1]); x.y = pk(S[2 * kb][2], S[2 * kb][3]); x.z = pk(S[2 * kb + 1][0], S[2 * kb + 1][1]); x.w = pk(S[2 * kb + 1][2], S[2 * kb + 1][3]); As[kb] = __builtin_bit_cast(bf16x8, x); }
            HG_BAR();
#pragma unroll
            for (int ti = 0; ti < 4; ++ti) {
                f32x4 acc = (f32x4){0.f, 0.f, 0.f, 0.f};
#pragma unroll
                for (int kb = 0; kb < 4; ++kb) { const u32x2 lo = *(const LAS u32x2*)(lds + QE_OFF + (16 * ti + lr) * RS + (32 * kb + 4 * qd) * 2), hi = *(const LAS u32x2*)(lds + QE_OFF + (16 * ti + lr) * RS + (32 * kb + 16 + 4 * qd) * 2);
                    const bf16x8 B = __builtin_bit_cast(bf16x8, (u32x4){lo.x, lo.y, hi.x, hi.y}); acc = __builtin_amdgcn_mfma_f32_16x16x32_bf16(As[kb], B, acc, 0, 0, 0); }
#pragma unroll
                for (int kb = 0; kb < 2; ++kb) if (kb == 0 || ti >= 2) { const bf16x8 B = *(const LAS bf16x8*)(lds + PT_OFF + (16 * ti + lr) * 144 + (32 * kb + 8 * qd) * 2); acc = __builtin_amdgcn_mfma_f32_16x16x32_bf16(Vf[kb], B, acc, 0, 0, 0); }
                const int tt = 16 * ti + lr; const size_t R = dir ? Rlo + 63 - tt : Rlo + tt;
                u32x2 wv; wv.x = pk(acc[0], acc[1]); wv.y = pk(acc[2], acc[3]);
                *(u32x2*)(outp + R * 512) = wv;
            }
#pragma unroll
            for (int i = 0; i < 8; ++i) { const f32x4 g4 = *(const LAS f32x4*)(lds + G_OFF + (16 * i + 4 * qd) * 4); f32x4 acc = S[i] * g4;
#pragma unroll
                for (int kb = 0; kb < 2; ++kb) { const bf16x8 A = *(const LAS bf16x8*)(lds + KET_OFF + (16 * i + lr) * 144 + (32 * kb + 8 * qd) * 2); acc = __builtin_amdgcn_mfma_f32_16x16x32_bf16(A, Vf[kb], acc, 0, 0, 0); }
                S[i] = acc; }
            if (cc + 1 < 36) HG_TAKE();
        }
#undef HG_TAKE
#undef HG_LOAD
#undef HG_BAR
        __syncthreads();
    }
}
__device__ __forceinline__ void f_ada(const PF& p, LAS unsigned char* lds) {
    const int t = tidx(), lane = t & 63, wv = t >> 6;
    constexpr int D = DmF::D, NR = DmF::B + 1, NITEM = DmF::DEPTH * 6 * D / 64;
    if ((int)blockIdx.x >= NITEM) return;
    LAS float* S = (LAS float*)lds;
    LAS float* PR = S + NR * D;
    for (int i = t; i < NR * D; i += NTHREADS) { const int r = i / D, k = i % D; const float c = r < DmF::B ? p.c[r * D + k] : p.c_ctx[k]; S[i] = c / (1.f + __expf(-c)); }
    __syncthreads();
    for (int q = blockIdx.x; q < NITEM; q += gridDim.x) {
        const int layer = q / (6 * D / 64), j = (q % (6 * D / 64)) * 64 + lane;
        const float* w = p.ada_w + (size_t)layer * D * 6 * D + j;
        float acc[NR];
#pragma unroll
        for (int r = 0; r < NR; ++r) acc[r] = 0.f;
#pragma unroll 2
        for (int k = wv * 128; k < wv * 128 + 128; k += 8) {
            float wq[8];
#pragma unroll
            for (int u = 0; u < 8; ++u) wq[u] = w[(size_t)(k + u) * 6 * D];
#pragma unroll
            for (int u = 0; u < 8; u += 4)
#pragma unroll
                for (int r = 0; r < NR; ++r) { const f32x4 s4 = *(const LAS f32x4*)(S + r * D + k + u); acc[r] += s4[0] * wq[u] + s4[1] * wq[u + 1] + s4[2] * wq[u + 2] + s4[3] * wq[u + 3]; }
        }
#pragma unroll
        for (int r = 0; r < NR; ++r) PR[(wv * NR + r) * 64 + lane] = acc[r];
        __syncthreads();
        for (int i = t; i < NR * 64; i += NTHREADS) { const int r = i >> 6, l2 = i & 63; float sum = 0.f;
#pragma unroll
            for (int w8 = 0; w8 < 8; ++w8) sum += PR[(w8 * NR + r) * 64 + l2];
            const int jj = (q % (6 * D / 64)) * 64 + l2; p.mod[((size_t)layer * NR + r) * 6 * D + jj] = sum + p.ada_b[layer * 6 * D + jj]; }
        __syncthreads();
    }
}
__device__ __forceinline__ void f_gen_postab(const PF& p, float* postab) {
    const long tid = (long)blockIdx.x * NTHREADS + tidx(), nth = (long)gridDim.x * NTHREADS;
    constexpr int D = DmF::D, L = DmF::L, Q4 = D / 4;
    for (long i = tid; i < (long)L * (D / 4); i += nth) {
        const int l = (int)(i / (D / 4)), k = (int)(i % (D / 4)) * 4, wq = k / Q4;
        const float pos = (float)(wq < 2 ? l / DmF::GRID_W : l % DmF::GRID_W);
        f32x4 pe;
#pragma unroll
        for (int e = 0; e < 4; ++e) { const int ix = (k + e) % Q4; const float omega = 1.0f / powf(10000.0f, (float)ix / (float)Q4); const float a = pos * omega; pe[e] = (wq & 1) ? cosf(a) : sinf(a); }
        *(f32x4*)(postab + (size_t)l * D + k) = pe;
    }
}
__device__ __forceinline__ void f_gen_krt3(const PF& p, LAS unsigned char* lds) {
    const int t = tidx(), cl = t & 63, lg = t >> 6;
    constexpr int NC = DmF::NC, L = DmF::L, C = DmF::C, FH = DmF::FH, NLB = (NC + L) / 64, NOB = 4 * C / 64;
    const float max_decay = logf(1e-2f) / 0.3f, min_decay = logf(1e-2f) / 1.5f;
    LAS float* T = (LAS float*)lds;
    constexpr int NCOMBO = DmF::DEPTH * NOB;
    const int combo = (int)blockIdx.x % NCOMBO, grp = (int)blockIdx.x / NCOMBO, ngrp = ((int)gridDim.x - combo + NCOMBO - 1) / NCOMBO;
    const int layer = combo / NOB, ob = combo % NOB, oc = ob * 64 + cl, c = oc % C;
    float wr[FH];
    { const float* w3 = p.hy_w3 + (size_t)layer * FH * 4 * C + oc;
#pragma unroll
      for (int k = 0; k < FH; ++k) wr[k] = w3[(size_t)k * 4 * C]; }
    for (int lb = grp; lb < NLB; lb += ngrp) {
        const int isx = lb >= NC / 64, Lw = isx ? L : NC, l0 = (isx ? lb - NC / 64 : lb) * 64;
        const float delta = fabsf(min_decay + (max_decay - min_decay) * (float)c / (float)(C - 1));
#pragma unroll
        for (int i = 0; i < 8; ++i) { const int l = l0 + lg * 8 + i; const float* h2 = p.hf2 + ((size_t)layer * (NC + L) + lb * 64 + lg * 8 + i) * FH;
            float acc = 0.f;
#pragma unroll
            for (int k = 0; k < FH; k += 4) { const f32x4 h = *(const f32x4*)(h2 + k); acc += h[0] * wr[k] + h[1] * wr[k + 1] + h[2] * wr[k + 2] + h[3] * wr[k + 3]; }
            T[cl * 65 + lg * 8 + i] = acc * expf(-((float)l / (float)(Lw - 1)) * delta); }
        lds_barrier();
        { const int c2 = t >> 3, sg = t & 7, oc2 = ob * 64 + c2, cc = oc2 % C, fdir = oc2 / C, order = fdir >> 1, bwd = fdir & 1;
          bf16s* kr = (isx ? p.krt_x : p.krt_c) + ((size_t)(layer * 2 + order) * 256 + cc) * 2 * Lw;
#pragma unroll
          for (int i = 0; i < 8; ++i) { const int l = l0 + sg * 8 + i; float v = T[c2 * 65 + sg * 8 + i];
              if (!bwd) { if (l == 0) v += p.hy_bias[(layer * 2 + order) * C + cc]; kr[(Lw - 1) - l] = f2bf(v); }
              else { if (l > 0) kr[(Lw - 1) + l] = f2bf(v); else kr[2 * Lw - 1] = 0; } } }
        lds_barrier();
    }
}

#define XB_TMO      128
#define XB_XCNT(j)  (256  + 64 * (j))
#define XB_XSUB(j)  (1280 + 64 * (j))
#define XB_XGEN(j)  (2304 + 64 * (j))
#define XB_TOP      3328
#define XB_TOPGEN   3392
#define XCD_BAR_WORDS 3456
#define XB_SPIN_CAP (1u << 21)

__device__ __forceinline__ unsigned xb_ld(unsigned* p)              { return __hip_atomic_load(p, __ATOMIC_RELAXED, __HIP_MEMORY_SCOPE_AGENT); }
__device__ __forceinline__ unsigned xb_add(unsigned* p, unsigned v) { return __hip_atomic_fetch_add(p, v, __ATOMIC_RELAXED, __HIP_MEMORY_SCOPE_AGENT); }
__device__ __forceinline__ unsigned xb_xcc_id() { return (unsigned)__builtin_amdgcn_s_getreg((3 << 11) | 20) & 0xFu; }
#define XB_SPIN(cond, bar) do { unsigned _sp = 0; while (cond) { __builtin_amdgcn_s_sleep(1); \
    if ((++_sp & 255u) == 0u) { if (xb_ld(&(bar)[XB_TMO])) break; if (_sp > XB_SPIN_CAP) { atomicAdd(&(bar)[XB_TMO], 1u); break; } } } } while (0)

struct XcdBarrier { unsigned* bar; unsigned x; volatile LAS unsigned* st; };

__device__ __forceinline__ XcdBarrier xcd_barrier_post(unsigned* bar, volatile LAS unsigned* st) {
    XcdBarrier b; b.bar = bar; b.x = xb_xcc_id(); b.st = st;
    if (threadIdx.x == 0) (void)xb_add(&bar[XB_XCNT(b.x)], 1u);
    return b;
}
__device__ __forceinline__ void xcd_barrier_complete(unsigned* bar, unsigned x, unsigned& nloc, unsigned& nx) {
    const unsigned G = gridDim.x * gridDim.y * gridDim.z;
    unsigned sum, cnt, mine, sp = 0u;
    for (;;) {
        sum = 0u; cnt = 0u; mine = 0u;
#pragma unroll
        for (unsigned j = 0; j < 16; ++j) { const unsigned c = xb_ld(&bar[XB_XCNT(j)]); sum += c; cnt += (c > 0u) ? 1u : 0u; mine = (j == x) ? c : mine; }
        if (sum == G) break;
        __builtin_amdgcn_s_sleep(1);
        if ((++sp & 255u) == 0u) { if (xb_ld(&bar[XB_TMO])) break; if (sp > XB_SPIN_CAP) { atomicAdd(&bar[XB_TMO], 1u); break; } }
    }
    nloc = mine > 0u ? mine : 1u; nx = cnt > 0u ? cnt : 1u;
}
__device__ __forceinline__ void xcd_barrier(const XcdBarrier& b) {
    asm volatile("s_waitcnt vmcnt(0)" ::: "memory");
    __syncthreads();
    if (threadIdx.x == 0) {
        unsigned* bar = b.bar;
        __builtin_amdgcn_s_waitcnt(0);
        unsigned nloc = b.st[0], nx = b.st[1];
        if (nloc == 0u) { xcd_barrier_complete(bar, b.x, nloc, nx); b.st[0] = nloc; b.st[1] = nx; }
        const unsigned old = xb_add(&bar[XB_XSUB(b.x)], 1u);
        const unsigned gen = old / nloc;
        if (old + 1u == (gen + 1u) * nloc) {
            __builtin_amdgcn_fence(__ATOMIC_RELEASE, "agent");
            asm volatile("s_waitcnt vmcnt(0)" ::: "memory");
            const unsigned og = xb_add(&bar[XB_TOP], 1u);
            const unsigned tg = og / nx;
            if (og + 1u == (tg + 1u) * nx) xb_add(&bar[XB_TOPGEN], 1u);
            else XB_SPIN(xb_ld(&bar[XB_TOPGEN]) == tg, bar);
            __builtin_amdgcn_fence(__ATOMIC_ACQUIRE, "agent");
            xb_add(&bar[XB_XGEN(b.x)], 1u);
            asm volatile("s_waitcnt vmcnt(0)" ::: "memory");
        } else {
            XB_SPIN(xb_ld(&bar[XB_XGEN(b.x)]) == gen, bar);
            __builtin_amdgcn_fence(__ATOMIC_ACQUIRE, "agent");
            asm volatile("s_waitcnt vmcnt(0)" ::: "memory");
        }
    }
    __syncthreads();
}

constexpr int NPH = 2 + 9 * DmF::DEPTH + 1;
#ifndef ONE_LAUNCH
#define ONE_LAUNCH 1
#endif

#ifndef REP_ADA
#define REP_ADA 1
#endif
#ifndef REP_PA
#define REP_PA 1
#endif
#ifndef REP_INIT
#define REP_INIT 1
#endif
#ifndef REP_DFT
#define REP_DFT 1
#endif
#ifndef REP_PB
#define REP_PB 1
#endif
#ifndef REP_KRT
#define REP_KRT 1
#endif
#ifndef REP_DOWN
#define REP_DOWN 1
#endif
#ifndef REP_WOUT
#define REP_WOUT 1
#endif
#ifndef REP_NM2N
#define REP_NM2N 1
#endif
#ifndef REP_BAR
#define REP_BAR 0
#endif
#ifndef REP_PRO
#define REP_PRO 1
#endif
#ifndef REP_NM1
#define REP_NM1 1
#endif
#ifndef REP_INPROJ
#define REP_INPROJ 1
#endif
#ifndef REP_FNET
#define REP_FNET 1
#endif
#ifndef REP_HGRN
#define REP_HGRN 1
#endif
#ifndef REP_HYENA
#define REP_HYENA 1
#endif
#ifndef REP_MIX
#define REP_MIX 1
#endif
#ifndef REP_CVTMOE
#define REP_CVTMOE 1
#endif
#ifndef REP_GATHER
#define REP_GATHER 1
#endif
#ifndef REP_GATEUP
#define REP_GATEUP 1
#endif
#ifndef FAST_HGRN
#define FAST_HGRN 1
#endif
#ifndef FAST_GEMM
#define FAST_GEMM 1
#endif
struct KArgs { PF p; FastWs f; unsigned* bar; int lo, hi; };
typedef const __attribute__((address_space(4))) KArgs* KP;

__global__ void __launch_bounds__(NTHREADS, 2) mega(KArgs a) {
    extern __shared__ __attribute__((aligned(16))) unsigned char lds_raw[];
    LAS unsigned char* lds = (LAS unsigned char*)lds_raw;
    volatile LAS unsigned* xbw = (volatile LAS unsigned*)(lds + LDS_MISC_OFF);
    if (threadIdx.x < 4) xbw[threadIdx.x] = 0u;
    __syncthreads();
    const int lo = a.lo, hi = a.hi;
    XcdBarrier bar; bar.bar = a.bar; bar.x = 0; bar.st = xbw;
    if (hi - lo > 1) bar = xcd_barrier_post(a.bar, xbw);
    int ph = 0;
#define PHASE(...) do { int lo_ = lo, hi_ = hi; asm volatile("" : "+s"(lo_), "+s"(hi_)); if (ph >= lo_ && ph < hi_) { { KP kp_ = (KP)__builtin_amdgcn_kernarg_segment_ptr(); asm volatile("" : "+s"(kp_)); PF p; FastWs f; __builtin_memcpy(&p, &kp_->p, sizeof(PF)); __builtin_memcpy(&f, &kp_->f, sizeof(FastWs)); (void)f; \
        const long tid = (long)blockIdx.x * NTHREADS + tidx(), nth = (long)gridDim.x * NTHREADS; (void)tid; (void)nth; __VA_ARGS__; } if (ph + 1 < hi_) xcd_barrier(bar); } ++ph; } while (0)
    for (int rep_ = 0; rep_ < REP_PRO; ++rep_) { if (rep_) ph -= 2;
    PHASE({ for (int q_ = 0; q_ < REP_ADA; ++q_) f_ada(p, lds); for (int q_ = 0; q_ < REP_PA; ++q_) NVF::p_pro_a(p, tid, nth); for (int q_ = 0; q_ < REP_INIT; ++q_) f_gen_postab(p, (float*)p.z); for (int q_ = 0; q_ < REP_DFT; ++q_) f_gen_dft(p, lds); });
    PHASE({ for (int q_ = 0; q_ < REP_PB; ++q_) NVF::p_pro_b(p, tid, nth); });
    }
    for (int q_ = 0; q_ < REP_BAR; ++q_) { PHASE({}); --ph; }
    for (int layer = 0; layer < DmF::DEPTH; ++layer) {
        const int last = layer == DmF::DEPTH - 1, r0 = last ? NVF::RC : 0;
        PHASE({ for (int rep_ = 0; rep_ < REP_NM1; ++rep_) { if (layer == 0) f_normmod<false, false, true>(p, f.hxs, layer, 0, 0, lds, (const float*)p.z); else f_normmod<false, true>(p, f.hxs, layer, 0, 0, lds); f_cvt_inout(p, f, layer, lds); }
                if (layer == 0) { for (int q_ = 0; q_ < REP_KRT; ++q_) f_gen_krt3(p, lds); } });
        PHASE({ for (int rep_ = 0; rep_ < REP_INPROJ; ++rep_) f_inproj(p, f, layer, last, lds); });
        PHASE({ const bool g256 = gridDim.x == 256;
                for (int rep_ = 0; rep_ < REP_FNET; ++rep_) f_fnet(p, layer, !last, lds);
                for (int rep_ = 0; rep_ < REP_HGRN; ++rep_) f_hgrn(p, lds);
                for (int rep_ = 0; rep_ < REP_HYENA; ++rep_) f_hyena(p, layer, !last, lds, 0, g256 ? 128 : (int)gridDim.x); });
        PHASE({ for (int rep_ = 0; rep_ < REP_MIX; ++rep_) f_mix2(p, layer, r0, lds); });
        PHASE({ for (int q_ = 1; q_ < REP_WOUT; ++q_) f_wout(p, f, layer, r0, lds, 0.f); f_wout(p, f, layer, r0, lds);
                { const int G_ = (int)gridDim.x, j_ = (int)blockIdx.x >> 3, x_ = (int)blockIdx.x & 7; int rank_ = (int)blockIdx.x, nw_ = G_;
                  if (!last && G_ == 256) { rank_ = j_ < 8 ? -1 : (j_ - 8) * 8 + x_; nw_ = 192; }
                  for (int rep_ = 0; rep_ < REP_CVTMOE; ++rep_) { NVF::p_moe_reset(p, tid, nth); f_cvt_moe(p, f, layer, lds, rank_, nw_); } } });
        PHASE({ for (int q_ = 1; q_ < REP_NM2N; ++q_) f_normmod<false, false>(p, f.hxs, layer, 1, r0, lds); f_normmod<true, false>(p, f.hxs, layer, 1, r0, lds); });
        PHASE({ for (int rep_ = 0; rep_ < REP_GATHER; ++rep_) f_place_gather(p, f, r0); });
        PHASE({ for (int rep_ = 0; rep_ < REP_GATEUP; ++rep_) f_gateup(p, f, lds); });
        PHASE({ for (int q_ = 0; q_ < REP_DOWN; ++q_) f_down(p, f, layer, lds); });
    }
    PHASE(f_final(p, f.hxs));
#undef PHASE
}

static inline size_t al256(size_t x) { return (x + 255) & ~(size_t)255; }
extern "C" void kernel_launch(void* const* d_in, const int* in_sizes, int n_in, void* d_out, int out_size, void* d_ws, size_t ws_size, hipStream_t stream) {
    typedef DmF Dm; constexpr size_t RALL = NVF::RALL, D = Dm::D;
    KArgs a{};
    PF& p = a.p;
    const float** ip = (const float**)&p.x;
    for (int i = 0; i < 31; ++i) ip[i] = (const float*)d_in[i];
    p.out = (float*)d_out;
    size_t off = 0; char* ws = (char*)d_ws;
    auto carve = [&](size_t bytes) { char* r = ws + off; off += al256(bytes); return r; };
    unsigned* ctl = (unsigned*)carve(65536);
    a.bar = ctl; p.cnt = (int*)(ctl + 8192);
    p.mod = (float*)carve((size_t)Dm::DEPTH * (Dm::B + 1) * 6 * D * 4);
    p.lbv = (float*)carve((size_t)Dm::DEPTH * 2 * Dm::DHG * 4);
    p.wcs = (float*)carve((size_t)Dm::DEPTH * Dm::G * Dm::GD * 2 * Dm::GD * 4);
    p.wfn = (float*)carve((size_t)Dm::DEPTH * D * 2 * Dm::CFN * 4);
    p.hf1 = (float*)carve((size_t)Dm::DEPTH * (Dm::NC + Dm::L) * Dm::FH * 4);
    p.hf2 = (float*)carve((size_t)Dm::DEPTH * (Dm::NC + Dm::L) * Dm::FH * 4);
    p.hfil = nullptr;
    p.krt_x = (bf16s*)carve((size_t)Dm::DEPTH * 2 * Dm::C * 2 * Dm::L * 2); p.krt_c = (bf16s*)carve((size_t)Dm::DEPTH * 2 * Dm::C * 2 * Dm::NC * 2);
#if XBF16
    p.cw = nullptr;
#else
    p.cw = (float*)carve((size_t)NVF::RC * D * 4);
#endif
    p.rs = (float*)carve(RALL * 4);
#if XBF16
    p.xb = (bf16s*)carve(RALL * D * 2);
    p.hx = (bf16s*)d_out;
#else
    p.xb = nullptr; p.hx = (bf16s*)carve(RALL * D * 2);
#endif
    p.dft_x = (bf16s*)carve((size_t)2048 * 4096 * 2); p.dft_c = (bf16s*)carve((size_t)256 * 512 * 2);
    p.z = (bf16s*)carve(RALL * NVF::ZS * 2);
    p.zh_c = (bf16s*)carve((size_t)3 * Dm::C * NVF::RC * 2); p.zh_x = (bf16s*)carve((size_t)3 * Dm::C * NVF::RX * 2);
    p.pq_c = (bf16s*)carve((size_t)NVF::RC * Dm::CFN * 2 * 2); p.pq_x = (bf16s*)carve((size_t)NVF::RX * Dm::CFN * 2 * 2);
    p.uv = nullptr;
    p.y1 = nullptr; p.y2 = nullptr;
    p.y1t_c = p.hx; p.y1t_x = p.hx + (size_t)Dm::C * NVF::RC;
    p.y2t_c = (bf16s*)carve((size_t)Dm::C * NVF::RC * 2); p.y2t_x = (bf16s*)carve((size_t)Dm::C * NVF::RX * 2);
    p.o = (bf16s*)carve(RALL * Dm::DHG * 2); p.ob = (bf16s*)carve(RALL * Dm::DHG * 2); p.vit = (bf16s*)carve(RALL * Dm::DHG * 2);
    p.yfn = (bf16s*)carve(RALL * Dm::CFN * 2);
    p.ridx = (int*)carve(RALL * 2 * 4);
    p.rgp = (float*)carve(RALL * 2 * 4);
    p.perm = (int*)carve((2 * RALL + Dm::E * Dm::MPAD) * 4);
    p.rrank = (int*)carve(RALL * 2 * 4); p.rpos = (int*)carve(RALL * 2 * 4); p.wgbase = (int*)carve(4096 * 16 * 4);
    { char* big = (char*)p.z; const size_t npos = 2 * RALL + Dm::E * Dm::MPAD;
      a.f.hxs = (bf16s*)big; p.hmid = (bf16s*)(big + al256(npos * D * 2));
      a.f.wt_gu = (bf16s*)((char*)p.hmid + al256(npos * Dm::DE * 2)); a.f.wt_d = a.f.wt_gu + (size_t)Dm::E * 1024 * D;
      if ((char*)(a.f.wt_d + (size_t)Dm::E * D * Dm::DE) > (char*)(p.yfn + RALL * Dm::CFN)) { fprintf(stderr, "kernel_launch: MoE overlay does not fit\n"); return; } }
    a.f.wt_in = (bf16s*)carve((size_t)Dm::ZW * D * 2);
    a.f.wt_out = (bf16s*)carve((size_t)D * D * 2);
    if (off > ws_size || n_in != 31) { fprintf(stderr, "kernel_launch: workspace too small (%zu needed, %zu given) or n_in %d != 31; nothing launched\n", off, ws_size, n_in); return; }
    static int grid = 0;
    if (grid == 0) {
        int dev = 0, cus = 0, per_cu = 0;
        hipGetDevice(&dev); hipDeviceGetAttribute(&cus, hipDeviceAttributeMultiprocessorCount, dev);
        if (hipFuncSetAttribute((const void*)mega, hipFuncAttributeMaxDynamicSharedMemorySize, LDS_BYTES) != hipSuccess) { fprintf(stderr, "kernel_launch: hipFuncSetAttribute failed\n"); grid = -1; return; }
        hipOccupancyMaxActiveBlocksPerMultiprocessor(&per_cu, (const void*)mega, NTHREADS, LDS_BYTES);
        (void)hipGetLastError();
        if (per_cu < 1) fprintf(stderr, "kernel_launch: occupancy query says %d blocks per CU\n", per_cu);
        grid = cus > 0 ? cus : 256;
    }
    if (grid < 0) return;
    hipMemsetAsync(ctl, 0, 65536, stream);
#if ONE_LAUNCH
    a.lo = 0; a.hi = NPH;
    hipLaunchKernelGGL(mega, dim3(grid), dim3(NTHREADS), LDS_BYTES, stream, a);
#else
    for (int k = 0; k < NPH; ++k) { a.lo = k; a.hi = k + 1; hipLaunchKernelGGL(mega, dim3(grid), dim3(NTHREADS), LDS_BYTES, stream, a); }
#endif
}
```

```cpp
#include <hip/hip_runtime.h>
#include <cstdio>
#include <cstdint>
#include <stdint.h>
#include <math.h>

#ifndef HD
#ifdef CPU_SHIM
#define HD
#else
#define HD __host__ __device__ __forceinline__
#endif
#endif

typedef unsigned short bf16s;
HD float bf2f(bf16s v) { union { unsigned u; float f; } c; c.u = ((unsigned)v) << 16; return c.f; }
HD bf16s f2bf(float f) { union { unsigned u; float f; } c; c.f = f; unsigned u = c.u; u += 0x7FFFu + ((u >> 16) & 1u); return (bf16s)(u >> 16); }
HD float ldv(const float* p) { return *p; }
HD float ldv(const bf16s* p) { return bf2f(*p); }
HD void stv(float* p, float v) { *p = v; }
HD void stv(bf16s* p, float v) { *p = f2bf(v); }
HD float silu_f(float x) { return x / (1.f + expf(-x)); }
HD float sigm_f(float x) { return 1.f / (1.f + expf(-x)); }

#ifdef CPU_SHIM
static inline int atomic_add_i(int* p, int v) { int o = *p; *p = o + v; return o; }
static inline void atomic_add_f(float* p, float v) { *p += v; }
#else
__device__ __forceinline__ int atomic_add_i(int* p, int v) { return atomicAdd(p, v); }
__device__ __forceinline__ void atomic_add_f(float* p, float v) { unsafeAtomicAdd(p, v); }
#endif

struct DimsFull {
    static constexpr int D = 1024, B = 16, L = 2048, NC = 256, DEPTH = 2, GRID_W = 64;
    static constexpr int C = 256  , DHG = 512, CFN = 256, NB = 16, EMB = 33, FH = 64;
    static constexpr int HDIM = 128, H = 4, G = 4, GD = 64;
    static constexpr int DP = 3 * C + 5 * DHG + CFN;
    static constexpr int ZW = 3 * C + 5 * DHG + 2 * CFN;
    static constexpr int E = 16, NG = 4, EPG = 4, DE = 512;
    static constexpr int RB = 8, BB = 8, MPAD = 256;
    typedef bf16s st;
};
#ifdef CPU_SHIM
struct DimsTest {
    static constexpr int D = 64, B = 2, L = 64, NC = 16, DEPTH = 2, GRID_W = 8;
    static constexpr int C = 16, DHG = 32, CFN = 16, NB = 4, EMB = 9, FH = 8;
    static constexpr int HDIM = 8, H = 4, G = 2, GD = 8;
    static constexpr int DP = 3 * C + 5 * DHG + CFN;
    static constexpr int ZW = 3 * C + 5 * DHG + 2 * CFN;
    static constexpr int E = 16, NG = 4, EPG = 4, DE = 16;
    static constexpr int RB = 8, BB = 2, MPAD = 8;
#ifdef TEST_BF16
    typedef bf16s st;
#else
    typedef float st;
#endif
};
#endif

template <class Dm> struct Params {
    typedef typename Dm::st st;
    const float *x, *c, *ctx, *c_ctx, *ada_w, *ada_b, *norm1_g, *norm2_g, *w_in, *w_out, *hy_conv_w, *hy_conv_b, *hy_w1, *hy_b1, *hy_w2, *hy_b2, *hy_w3, *hy_freq,
        *hy_bias, *hy_norm_g, *hg_lb, *hg_norm_g, *fn_w, *fn_b, *fn_norm_g, *router_w, *router_b, *moe_wg, *moe_wu, *moe_wd, *final_g;
    float* out;
    float* cw;
    st* xb;
    float* mod;
    float* lbv;
    float* wcs;
    float* wfn;
    float* hf1;
    float* hf2;
    float* hfil;
    float* rs;
    st* hx;
    st* z;
    st* zh_c; st* zh_x;
    st* pq_c; st* pq_x;
    st* krt_c; st* krt_x;
    st* y1t_c; st* y1t_x; st* y2t_c; st* y2t_x;
    st* dft_c; st* dft_x;
    st* uv;
    st* y1;
    st* y2;
    st* o;
    st* ob;
    st* vit;
    st* yfn;
    int* ridx;
    float* rgp;
    int* cnt;
    int* perm;
    int* rrank;
    int* rpos;
    int* wgbase;
    st* hmid;
};

template <class Dm> struct NV {
    typedef Params<Dm> P;
    typedef typename Dm::st st;
    static constexpr int D = Dm::D, B = Dm::B, L = Dm::L, NC = Dm::NC, C = Dm::C, DHG = Dm::DHG, CFN = Dm::CFN, ZW = Dm::ZW, DP = Dm::DP;
    static constexpr int RC = B * NC, RX = B * L, RALL = RC + RX;
    static constexpr int ZS = 4 * DHG, OFF_Q = 0, OFF_FF = DHG, OFF_FB = 2 * DHG, OFF_G = 3 * DHG;
    static constexpr float EPS = 1e-6f;
    static constexpr float TWO_PI = 6.283185307179586f;

    static HD float* xrow(const P& p, int R) { return R < RC ? p.cw + (size_t)R * D : p.out + (size_t)(R - RC) * D; }
    static HD int row_b(int R) { return R < RC ? R / NC : (R - RC) / L; }
    static HD int row_l(int R) { return R < RC ? R % NC : (R - RC) % L; }
    static HD int row_modr(int R) { return R < RC ? B : (R - RC) / L; }
    static HD int row_of(int isx, int b, int l) { return isx ? RC + b * L + l : b * NC + l; }
    static HD const float* modp(const P& p, int layer, int mr, int which) { return p.mod + ((size_t)(layer * (B + 1) + mr) * 6 + which) * D; }

    static HD void p_pro_a(const P& p, long tid, long nth) {
        for (long i = tid; i < 2 * DHG; i += nth) {
            float mx = -1e30f;
            for (int l = 0; l < Dm::DEPTH; ++l) mx = fmaxf(mx, p.hg_lb[l * 2 * DHG + i]);
            float den = 0.f;
            for (int l = 0; l < Dm::DEPTH; ++l) den += expf(p.hg_lb[l * 2 * DHG + i] - mx);
            float cs = 0.f;
            for (int l = 0; l < Dm::DEPTH; ++l) { if (l > 0) cs += expf(p.hg_lb[l * 2 * DHG + i] - mx) / den; p.lbv[l * 2 * DHG + i] = cs; }
        }
        for (long i = tid; i < (long)Dm::DEPTH * Dm::G * Dm::GD * 2 * Dm::GD; i += nth) {
            const int GD = Dm::GD; const int d2 = (int)(i % (2 * GD)), c = (int)((i / (2 * GD)) % GD), g = (int)((i / (2 * GD * GD)) % Dm::G), layer = (int)(i / ((long)2 * GD * GD * Dm::G));
            const int d = d2 % GD, sn = d2 / GD;
            const float* w = p.fn_w + ((size_t)(layer * Dm::G + g) * GD) * GD + d;
            float acc = 0.f;
            for (int m = 0; m < GD; ++m) { const int cm = (c * m) % GD;
                const float ang = TWO_PI * (float)cm / (float)GD; acc += (sn ? __sinf(ang) : __cosf(ang)) * w[(size_t)m * GD]; }
            p.wcs[i] = acc;
        }
        for (long i = tid; i < (long)Dm::DEPTH * (NC + L) * Dm::FH; i += nth) {
            const int j = (int)(i % Dm::FH), ll = (int)((i / Dm::FH) % (NC + L)), layer = (int)(i / ((long)Dm::FH * (NC + L)));
            const int Lw = ll < NC ? NC : L, l = ll < NC ? ll : ll - NC;
            const float t = (float)l / (float)(Lw - 1), wv = TWO_PI * (float)l / (float)Lw;
            const float* w1 = p.hy_w1 + (size_t)layer * Dm::EMB * Dm::FH + j;
            float acc = t * w1[0];
            for (int bi = 0; bi < Dm::NB; ++bi) {
                const float band = 1e-4f + (float)bi * ((float)(Dm::NB - 1) - 1e-4f) / (float)(Dm::NB - 1);
                acc += cosf(band * wv) * w1[(size_t)(1 + bi) * Dm::FH] - sinf(band * wv) * w1[(size_t)(1 + Dm::NB + bi) * Dm::FH];
            }
            acc += p.hy_b1[layer * Dm::FH + j];
            p.hf1[i] = sinf(p.hy_freq[layer * Dm::FH + j] * acc);
        }
    }
    static HD void p_pro_b(const P& p, long tid, long nth) {
        for (long i = tid; i < (long)Dm::DEPTH * (NC + L) * Dm::FH; i += nth) {
            const int j = (int)(i % Dm::FH), layer = (int)(i / ((long)Dm::FH * (NC + L)));
            const float* h1 = p.hf1 + (i / Dm::FH) * Dm::FH;
            const float* w2 = p.hy_w2 + (size_t)layer * Dm::FH * Dm::FH + j;
            float acc = 0.f;
            for (int k = 0; k < Dm::FH; ++k) acc += h1[k] * w2[(size_t)k * Dm::FH];
            acc += p.hy_b2[layer * Dm::FH + j];
            p.hf2[i] = sinf(p.hy_freq[layer * Dm::FH + j] * acc);
        }
        for (long i = tid; i < (long)Dm::DEPTH * D * 2 * CFN; i += nth) {
            const int GD = Dm::GD; const int j = (int)(i % (2 * CFN)), k = (int)((i / (2 * CFN)) % D), layer = (int)(i / ((long)2 * CFN * D));
            const int sn = j / CFN, g = (j % CFN) / GD, d = j % GD;
            const float* wi = p.w_in + ((size_t)layer * D + k) * DP + 3 * C + 5 * DHG + g * GD;
            const float* wc = p.wcs + ((size_t)(layer * Dm::G + g) * GD) * 2 * GD + sn * GD + d;
            float acc = 0.f;
            for (int c = 0; c < GD; ++c) acc += wi[c] * wc[(size_t)c * 2 * GD];
            p.wfn[i] = acc;
        }
    }
    static HD void p_pro_c(const P& p, long tid, long nth) {
        const float max_decay = logf(1e-2f) / 0.3f, min_decay = logf(1e-2f) / 1.5f;
        for (long i = tid; i < (long)Dm::DEPTH * (NC + L) * 4 * C; i += nth) {
            const int oc = (int)(i % (4 * C)), ll = (int)((i / (4 * C)) % (NC + L)), layer = (int)(i / ((long)4 * C * (NC + L)));
            const int Lw = ll < NC ? NC : L, l = ll < NC ? ll : ll - NC, c = oc % C;
            const float t = (float)l / (float)(Lw - 1);
            const float* h2 = p.hf2 + (i / (4 * C)) * Dm::FH;
            const float* w3 = p.hy_w3 + (size_t)layer * Dm::FH * 4 * C + oc;
            float acc = 0.f;
            for (int k = 0; k < Dm::FH; ++k) acc += h2[k] * w3[(size_t)k * 4 * C];
            const float delta = min_decay + (max_decay - min_decay) * (float)c / (float)(C - 1);
            p.hfil[i] = acc * expf(-t * fabsf(delta));
        }
    }
    static HD float shortconv(const P& p, int layer, int R, int pc) {
        const int l = row_l(R), Lw = R < RC ? NC : L;
        const float* cwt = p.hy_conv_w + (size_t)layer * 3 * 3 * C + pc;
        const st* zr = R < RC ? p.zh_c + (size_t)pc * RC + R : p.zh_x + (size_t)pc * RX + (R - RC);
        float v = ldv(zr) * cwt[3 * C] + p.hy_conv_b[layer * 3 * C + pc];
        if (l > 0) v += ldv(zr - 1) * cwt[0];
        if (l < Lw - 1) v += ldv(zr + 1) * cwt[2 * 3 * C];
        return v;
    }
    static HD void p_uv(const P& p, int layer, int r0, long tid, long nth) {
        for (long i = (long)r0 * C + tid; i < (long)RALL * C; i += nth) { const int R = (int)(i / C), c = (int)(i % C); stv(p.uv + i, shortconv(p, layer, R, c)); }
    }
    static HD float hy_k(const P& p, int layer, int isx, int order, int d, int c) {
        const float* hf = p.hfil + ((size_t)layer * (NC + L) + (isx ? NC : 0)) * 4 * C;
        float v = d >= 0 ? hf[(size_t)d * 4 * C + (2 * order) * C + c] : hf[(size_t)(-d) * 4 * C + (2 * order + 1) * C + c];
        if (d == 0) v += p.hy_bias[(layer * 2 + order) * C + c];
        return v;
    }
    static HD void p_hyconv(const P& p, int layer, int order, int r0, long tid, long nth) {
        constexpr int BB = Dm::BB;
        const st* in = p.y1; st* outp = order == 0 ? p.y1 : p.y2;
        const long nc_items = (long)(B / BB) * NC * C, nx_items = (long)(B / BB) * L * C;
        for (long i = (r0 >= RC ? nc_items : 0) + tid; i < nc_items + nx_items; i += nth) {
            const int isx = i >= nc_items; const long ii = isx ? i - nc_items : i; const int Lw = isx ? L : NC;
            const int c = (int)(ii % C), t = (int)((ii / C) % Lw), b0 = (int)(ii / ((long)C * Lw)) * BB;
            float acc[BB];
#pragma unroll
            for (int r = 0; r < BB; ++r) acc[r] = 0.f;
            for (int s = 0; s < Lw; ++s) { const float kv = hy_k(p, layer, isx, order, t - s, c);
#pragma unroll
                for (int r = 0; r < BB; ++r) acc[r] += kv * (order == 0 ? shortconv(p, layer, row_of(isx, b0 + r, s), c) : ldv(in + (size_t)row_of(isx, b0 + r, s) * C + c)); }
#pragma unroll
            for (int r = 0; r < BB; ++r) { const int R = row_of(isx, b0 + r, t); stv(outp + (size_t)R * C + c, acc[r] * shortconv(p, layer, R, (order + 1) * C + c)); }
        }
    }
    static HD void p_hgscan(const P& p, long tid, long nth) {
        constexpr int HDM = Dm::HDIM;
        for (long i = tid; i < (long)B * Dm::H * HDM; i += nth) {
            const int v = (int)(i % HDM), h = (int)((i / HDM) % Dm::H), b = (int)(i / ((long)HDM * Dm::H));
            for (int dir = 0; dir < 2; ++dir) {
                float S[HDM];
#pragma unroll
                for (int d = 0; d < HDM; ++d) S[d] = 0.f;
                for (int seg = 0; seg < 2; ++seg) {
                    const int Lw = seg ? L : NC;
                    for (int tt = 0; tt < Lw; ++tt) {
                        const int t = dir ? Lw - 1 - tt : tt; const int R = row_of(seg, b, t);
                        const st* zr = p.z + (size_t)R * ZS;
                        const float vv = ldv(p.vit + (size_t)(h * HDM + v) * RALL + R);
                        const st* lf = zr + (dir ? OFF_FB : OFF_FF) + h * HDM; const st* q = zr + OFF_Q + h * HDM;
                        float o = 0.f;
#pragma unroll
                        for (int d = 0; d < HDM; ++d) { const float f = expf(ldv(lf + d)); S[d] = f * S[d] + (1.f - f) * vv; o += S[d] * ldv(q + d); }
                        stv((dir ? p.ob : p.o) + (size_t)R * DHG + h * HDM + v, o);
                    }
                }
            }
        }
    }
    static HD void p_moe_reset(const P& p, long tid, long nth) {
        for (long i = tid; i < 32; i += nth) p.cnt[i] = 0;
        for (long i = tid; i < (long)2 * RALL + Dm::E * Dm::MPAD; i += nth) p.perm[i] = -1;
    }
    static HD int moe_off(const P& p, int e) {
        int o = 0;
        for (int j = 0; j < e; ++j) o += (p.cnt[j] + Dm::MPAD - 1) / Dm::MPAD * Dm::MPAD;
        return o;
    }
    static HD void p_place(const P& p, int r0, long tid, long nth) {
        for (long ts = (long)r0 * 2 + tid; ts < (long)RALL * 2; ts += nth) {
            const int e = p.ridx[ts];
            const int pos = moe_off(p, e) + atomic_add_i(p.cnt + 16 + e, 1);
            p.perm[pos] = (int)ts;
        }
    }
    static HD void p_gather_dummy(const P&) {}
    static HD int moe_expert_of_unused(const P& p, int pos) { int e = 0; while (e + 1 < Dm::E && pos >= moe_off(p, e + 1)) ++e; return e; }
};
#define LAS __attribute__((address_space(3)))
typedef short bf16x8 __attribute__((ext_vector_type(8)));
typedef float f32x4 __attribute__((ext_vector_type(4)));
typedef float f32x2 __attribute__((ext_vector_type(2)));
typedef unsigned u32x4 __attribute__((ext_vector_type(4)));
typedef unsigned u32x2 __attribute__((ext_vector_type(2)));
typedef DimsFull DmF; typedef NV<DmF> NVF; typedef Params<DmF> PF;
constexpr int NTHREADS = 512;
constexpr int STAGE_BYTES = 131072;
constexpr int LDS_MISC_OFF = 143360;
constexpr int LDS_BYTES = LDS_MISC_OFF + 1024;

__device__ __forceinline__ unsigned cvt_pk_bf16(float lo, float hi) { unsigned r; asm volatile("v_cvt_pk_bf16_f32 %0, %1, %2" : "=v"(r) : "v"(lo), "v"(hi)); return r; }
__device__ __forceinline__ int tidx() { int t = threadIdx.x; asm volatile("" : "+v"(t)); return t; }
__device__ __forceinline__ void lds_barrier() { asm volatile("s_waitcnt lgkmcnt(0)" ::: "memory"); __builtin_amdgcn_s_barrier(); asm volatile("" ::: "memory"); }
__device__ __forceinline__ u32x2 pack4(f32x4 v) { u32x2 w; w.x = cvt_pk_bf16(v[0], v[1]); w.y = cvt_pk_bf16(v[2], v[3]); return w; }
__device__ __forceinline__ f32x4 unpack4(u32x2 w) { f32x4 v; v[0] = __uint_as_float(w.x << 16); v[1] = __uint_as_float(w.x & 0xffff0000u); v[2] = __uint_as_float(w.y << 16); v[3] = __uint_as_float(w.y & 0xffff0000u); return v; }
__device__ __forceinline__ int gdimx() { int g = (int)gridDim.x; asm volatile("" : "+s"(g)); return g; }
__device__ __forceinline__ float fast_silu(float x) { return x * __builtin_amdgcn_rcpf(1.f + __expf(-x)); }

#ifndef REP_EPI
#define REP_EPI 1
#endif
#ifndef RELAX_WAITS
#define RELAX_WAITS 0
#endif
namespace pg8 {
constexpr int BM = 256, BK = 64, HALF = 128, HTB = HALF * BK * 2;
__host__ __device__ __forceinline__ int lds_byte(int r, int c) { const int st = (r >> 4) * 2 + (c >> 5), rr = r & 15, cc = c & 31, ob = rr * 64 + cc * 2; return st * 1024 + (ob ^ (((ob >> 9) & 1) << 5)); }
__host__ __device__ __forceinline__ void stage_rc(int b, int& R, int& C) { const int st = b / 1024, sb = b % 1024, swz = sb ^ (((sb >> 9) & 1) << 5); R = (st >> 1) * 16 + swz / 64; C = (st & 1) * 32 + (swz % 64) / 2; }
__host__ __device__ __forceinline__ int perm32(int rho) { const int n = rho >> 4, i = rho & 15; return 8 * (i >> 2) + 4 * n + (i & 3); }
struct Unit { const char* a; const char* b; int i0, i1, i2, i3; const int* rows; };
struct Gemm { int K, lda, ldb; int* diag = nullptr; };
template <class Epi, class Sched, bool ALIGN_EPI = true, bool GATHER = false>
__device__ __forceinline__ void gemm_phase(LAS unsigned char* lds, const Gemm g, const Sched& S, const Epi& E) {
    const int tid = tidx(), wid = __builtin_amdgcn_readfirstlane(tid >> 6), lane = tid & 63, wr = wid >> 2, wc = wid & 3, fr = lane & 15, fq = lane >> 4;
    const int K = g.K, nt = K / BK;
    unsigned voffA[2], voffB[2];
#pragma unroll
    for (int i = 0; i < 2; ++i) { int R, C; stage_rc(tid * 16 + i * 8192, R, C); const int Rb = Epi::PERM ? ((R & ~31) + perm32(R & 31)) : R;
        voffA[i] = (unsigned)(R * g.lda + C) * 2u; voffB[i] = (unsigned)(Rb * g.ldb + C) * 2u; }
    const size_t kstep = (size_t)(BK * 2);
    const size_t hstepA = (size_t)HALF * g.lda * 2, hstepB = (size_t)HALF * g.ldb * 2;
    const unsigned ldsw = (unsigned)wid * 1024u;
    const int aoff = lds_byte(wr * 64 + fr, fq * 8), boff = lds_byte(wc * 32 + fr, fq * 8);
#define PG8_SA(b, h) (((b) * 2 + (h)) * HTB)
#define PG8_SB(b, h) ((4 + (b) * 2 + (h)) * HTB)
#define PG8_STAGE(bufoff, gbase, voff) do { _Pragma("unroll") for (int _i = 0; _i < 2; ++_i) \
        __builtin_amdgcn_global_load_lds((const unsigned*)((const char*)(gbase) + (voff)[_i]), (LAS unsigned*)(lds + (bufoff) + ldsw + _i * 8192), 16, 0, 0); } while (0)
#define PG8_TAB(k) (STAGE_BYTES + ((k) & 1) * 1024)
#define PG8_TABLOAD(k, u) do { if (wid == 0) __builtin_amdgcn_global_load_lds((const unsigned*)((u).rows + lane * 4), (LAS unsigned*)(lds + PG8_TAB(k)), 16, 0, 0); } while (0)
#define PG8_STAGEA(bufoff, gbase, h, k) do { if constexpr (GATHER) { _Pragma("unroll") for (int _i = 0; _i < 2; ++_i) { \
            const int ts_ = *(const LAS int*)(lds + PG8_TAB(k) + ((h) * 128 + (int)(voffA[_i] >> 11)) * 4); \
            __builtin_amdgcn_global_load_lds((const unsigned*)((const char*)(gbase) + ((unsigned)(ts_ < 0 ? 0 : ts_ >> 1) << 11) + (voffA[_i] & 2047u)), (LAS unsigned*)(lds + (bufoff) + ldsw + _i * 8192), 16, 0, 0); } } \
        else { PG8_STAGE(bufoff, (gbase) + (h) * hstepA, voffA); } } while (0)
#define PG8_LDA(dst, b, h) do { _Pragma("unroll") for (int m = 0; m < 4; ++m) _Pragma("unroll") for (int k = 0; k < 2; ++k) dst[m][k] = *(const LAS bf16x8*)(lds + PG8_SA(b, h) + aoff + m * 2048 + k * 1024); } while (0)
#define PG8_LDB(dst, b, h) do { _Pragma("unroll") for (int n = 0; n < 2; ++n) _Pragma("unroll") for (int k = 0; k < 2; ++k) dst[n][k] = *(const LAS bf16x8*)(lds + PG8_SB(b, h) + boff + n * 2048 + k * 1024); } while (0)
#define PG8_MMA(ai, bj, At, Bt) do { __builtin_amdgcn_s_setprio(1); _Pragma("unroll") for (int m = 0; m < 4; ++m) _Pragma("unroll") for (int n = 0; n < 2; ++n) _Pragma("unroll") for (int k = 0; k < 2; ++k) \
        acc[ai][bj][m][n] = __builtin_amdgcn_mfma_f32_16x16x32_bf16(Bt[n][k], At[m][k], acc[ai][bj][m][n], 0, 0, 0); __builtin_amdgcn_s_setprio(0); } while (0)
#define PG8_WAIT_V(n) asm volatile("s_waitcnt vmcnt(" #n ")" ::: "memory")
#define PG8_WAIT_V8R_(N) asm volatile("s_cmp_lg_u32 %0, 0\n\ts_cbranch_scc1 .Lrn%=\n\ts_cmp_eq_u32 %1, 0\n\ts_cbranch_scc1 .Lrn%=\n\ts_waitcnt vmcnt(" #N ")\n\ts_branch .Lrd%=\n.Lrn%=:\n\ts_waitcnt vmcnt(8)\n.Lrd%=:" :: "s"(t), "s"(ui) : "memory", "scc")
#define PG8_WAIT_V8R() do { if constexpr (!RELAX_WAITS) asm volatile("s_waitcnt vmcnt(8)" ::: "memory"); else if constexpr (Epi::NST == 16) PG8_WAIT_V8R_(24); else PG8_WAIT_V8R_(16); } while (0)
#define PG8_WAIT_L(n) asm volatile("s_waitcnt lgkmcnt(" #n ")" ::: "memory")
#define PG8_BAR __builtin_amdgcn_s_barrier()
#define PG8_SCHED __builtin_amdgcn_sched_barrier(0)
    Unit cur, nxt; int ui = 0;
    if (!S.next(0, cur)) return;
    f32x4 acc[2][2][4][2];
#pragma unroll
    for (int a = 0; a < 2; ++a)
#pragma unroll
        for (int b = 0; b < 2; ++b)
#pragma unroll
            for (int m = 0; m < 4; ++m)
#pragma unroll
                for (int n = 0; n < 2; ++n) acc[a][b][m][n] = (f32x4){0.f, 0.f, 0.f, 0.f};
    bf16x8 At[4][2], B0[2][2], B1[2][2];
    const char* cA = cur.a; const char* cB = cur.b;
    if constexpr (GATHER) { PG8_TABLOAD(0, cur); PG8_WAIT_V(0); __syncthreads(); }
    PG8_STAGE(PG8_SB(0, 0), cB, voffB); PG8_STAGE(PG8_SB(0, 1), cB + hstepB, voffB); PG8_STAGEA(PG8_SA(0, 0), cA, 0, 0); PG8_STAGEA(PG8_SA(0, 1), cA, 1, 0);
    if (wr == 1) PG8_BAR;
    PG8_WAIT_V(2); PG8_BAR;
    PG8_STAGE(PG8_SB(1, 0), cB + kstep, voffB); PG8_STAGEA(PG8_SA(1, 0), cA + kstep, 0, 0); PG8_STAGE(PG8_SB(1, 1), cB + hstepB + kstep, voffB);
    PG8_WAIT_V(6); PG8_BAR;
#ifdef DIAG_GEMMTIME
    unsigned long long tk_ = 0, te_ = 0, t0_ = 0, t1_ = 0;
#endif
    for (;;) {
        const bool has_next = S.next(ui + 1, nxt);
        const char* nA = has_next ? nxt.a : cA; const char* nB = has_next ? nxt.b : cB;
        const int kn = has_next ? ui + 1 : ui;
        if constexpr (GATHER) { if (has_next) PG8_TABLOAD(ui + 1, nxt); }
#ifdef DIAG_GEMMTIME
        t0_ = wall_clock64();
#endif
        for (int t = 0; t < nt; t += 2) {
            const bool last = (t == nt - 2);
            const char* a1 = cA + (size_t)(t + 1) * kstep;
            const char* a2 = last ? nA : cA + (size_t)(t + 2) * kstep; const char* b2 = last ? nB : cB + (size_t)(t + 2) * kstep;
            const char* a3 = a2 + kstep; const char* b3 = b2 + kstep;
            const int kl = last ? kn : ui;
            PG8_LDB(B0, 0, 0); PG8_LDB(B1, 0, 1); PG8_SCHED; PG8_LDA(At, 0, 0); PG8_STAGEA(PG8_SA(1, 1), a1, 1, ui);
            PG8_WAIT_V8R(); PG8_WAIT_L(0); PG8_BAR; PG8_MMA(0, 0, At, B0); PG8_MMA(0, 1, At, B1); PG8_BAR; PG8_SCHED;
            PG8_LDA(At, 0, 1); PG8_STAGE(PG8_SB(0, 0), b2, voffB); PG8_STAGE(PG8_SB(0, 1), b2 + hstepB, voffB); PG8_STAGEA(PG8_SA(0, 0), a2, 0, kl);
            PG8_WAIT_V8R(); PG8_WAIT_L(0); PG8_BAR; PG8_MMA(1, 0, At, B0); PG8_MMA(1, 1, At, B1); PG8_BAR; PG8_SCHED;
            PG8_LDB(B0, 1, 0); PG8_LDB(B1, 1, 1); PG8_SCHED; PG8_LDA(At, 1, 0); PG8_STAGEA(PG8_SA(0, 1), a2, 1, kl);
            PG8_WAIT_V8R(); PG8_WAIT_L(0); PG8_BAR; PG8_MMA(0, 0, At, B0); PG8_MMA(0, 1, At, B1); PG8_BAR; PG8_SCHED;
            PG8_LDA(At, 1, 1); PG8_STAGE(PG8_SB(1, 0), b3, voffB); PG8_STAGE(PG8_SB(1, 1), b3 + hstepB, voffB); PG8_STAGEA(PG8_SA(1, 0), a3, 0, kl);
            PG8_WAIT_V(8); PG8_WAIT_L(0); PG8_BAR; PG8_MMA(1, 0, At, B0); PG8_MMA(1, 1, At, B1); PG8_BAR; PG8_SCHED;
        }
#ifdef DIAG_GEMMTIME
        t1_ = wall_clock64(); tk_ += t1_ - t0_;
#endif
        if constexpr (ALIGN_EPI) { if (wr == 0) PG8_BAR; }
        E(acc, cur, wr, wc, fr, fq);
#ifdef DUP_EPI_INPROJ
        if constexpr (Epi::NST == 16 && sizeof(Epi) > 40) { asm volatile("" ::: "memory"); E(acc, cur, wr, wc, fr, fq); }
#endif
#ifdef DIAG_GEMMTIME
        te_ += wall_clock64() - t1_;
        if (!has_next && g.diag && blockIdx.x == DIAG_BLOCK && tid == 0) { g.diag[0] = (int)tk_; g.diag[1] = (int)te_; g.diag[2] = ui + 1; }
#endif
        if (!has_next) break;
#pragma unroll
        for (int a = 0; a < 2; ++a)
#pragma unroll
            for (int b = 0; b < 2; ++b)
#pragma unroll
                for (int m = 0; m < 4; ++m)
#pragma unroll
                    for (int n = 0; n < 2; ++n) acc[a][b][m][n] = (f32x4){0.f, 0.f, 0.f, 0.f};
        cur = nxt; cA = nA; cB = nB; ++ui;
        if constexpr (ALIGN_EPI) { if (wr == 1) PG8_BAR; }
    }
    PG8_WAIT_V(0);
    if constexpr (!ALIGN_EPI) { if (wr == 0) PG8_BAR; }
    PG8_BAR;
#undef PG8_SA
#undef PG8_SB
#undef PG8_STAGE
#undef PG8_LDA
#undef PG8_STAGEA
#undef PG8_TAB
#undef PG8_TABLOAD
#undef PG8_LDB
#undef PG8_MMA
#undef PG8_WAIT_V
#undef PG8_WAIT_L
#undef PG8_WAIT_V8R
#undef PG8_WAIT_V8R_
#undef PG8_BAR
#undef PG8_SCHED
}
}

struct FastWs {
    bf16s* wt_in;
    bf16s* wt_out;
    bf16s* wt_gu;
    bf16s* wt_d;
    bf16s* hxs;
};

struct Deal { int x, j, W; __device__ __forceinline__ void init() { const int G = gridDim.x, c = blockIdx.x; x = c & 7; j = c >> 3; W = (G + 7) >> 3; } };

struct XpJob { const float* src; int sld, k0, n0; bf16s* dst; int dld, drow0; };
__device__ __forceinline__ void xpose_load(const XpJob& j, int t, f32x4 (&v)[2]) {
#pragma unroll
    for (int ps = 0; ps < 2; ++ps) { const int k = (t >> 4) + 32 * ps, n4 = (t & 15) * 4; v[ps] = *(const f32x4*)(j.src + (size_t)(j.k0 + k) * j.sld + j.n0 + n4); }
}
__device__ __forceinline__ void xpose_store(LAS float* tile, const XpJob& j, int t, const f32x4 (&v)[2]) {
#pragma unroll
    for (int ps = 0; ps < 2; ++ps) { const int k = (t >> 4) + 32 * ps, n4 = (t & 15) * 4;
        tile[k * 65 + n4 + 0] = v[ps][0]; tile[k * 65 + n4 + 1] = v[ps][1]; tile[k * 65 + n4 + 2] = v[ps][2]; tile[k * 65 + n4 + 3] = v[ps][3]; }
    lds_barrier();
    { const int n = t >> 3, k8 = (t & 7) * 8; u32x4 w;
      w.x = cvt_pk_bf16(tile[(k8 + 0) * 65 + n], tile[(k8 + 1) * 65 + n]); w.y = cvt_pk_bf16(tile[(k8 + 2) * 65 + n], tile[(k8 + 3) * 65 + n]);
      w.z = cvt_pk_bf16(tile[(k8 + 4) * 65 + n], tile[(k8 + 5) * 65 + n]); w.w = cvt_pk_bf16(tile[(k8 + 6) * 65 + n], tile[(k8 + 7) * 65 + n]);
      *(u32x4*)(j.dst + (size_t)(j.drow0 + n) * j.dld + j.k0 + k8) = w; }
    lds_barrier();
}
__device__ __forceinline__ XpJob job_inout(const PF& p, const FastWs& f, int layer, int it) {
    constexpr int D = DmF::D, T_IN = (3328 / 64) * (D / 64), T_FN = (512 / 64) * (D / 64);
    int r = it;
    if (r < T_IN) { const int nt = r / (D / 64), kt = r % (D / 64); return XpJob{p.w_in + (size_t)layer * D * DmF::DP, DmF::DP, kt * 64, nt * 64, f.wt_in, D, nt * 64}; } r -= T_IN;
    if (r < T_FN) { const int nt = r / (D / 64), kt = r % (D / 64); return XpJob{p.wfn + (size_t)layer * D * 512, 512, kt * 64, nt * 64, f.wt_in, D, 3328 + nt * 64}; } r -= T_FN;
    { const int nt = r / (D / 64), kt = r % (D / 64); return XpJob{p.w_out + (size_t)layer * D * D, D, kt * 64, nt * 64, f.wt_out, D, nt * 64}; }
}
__device__ __forceinline__ void f_cvt_inout(const PF& p, const FastWs& f, int layer, LAS unsigned char* lds) {
    LAS float* tile = (LAS float*)lds; const int t = tidx();
    constexpr int D = DmF::D, NT = (3328 / 64) * (D / 64) + (512 / 64) * (D / 64) + (D / 64) * (D / 64);
    int it = blockIdx.x; if (it >= NT) return;
    XpJob cur = job_inout(p, f, layer, it); f32x4 v[2]; xpose_load(cur, t, v);
    for (;;) { const int nx = it + (int)gridDim.x; const bool more = nx < NT; XpJob nj = cur; f32x4 nvv[2];
        if (more) { nj = job_inout(p, f, layer, nx); xpose_load(nj, t, nvv); }
        xpose_store(tile, cur, t, v);
        if (!more) break;
        cur = nj; v[0] = nvv[0]; v[1] = nvv[1]; it = nx; }
}
__device__ __forceinline__ XpJob job_moe(const PF& p, const FastWs& f, int layer, int it) {
    constexpr int D = DmF::D, DE = DmF::DE, TG = (DE / 64) * (D / 64)  , TD = (D / 64) * (DE / 64)  , PER_E = 2 * TG + TD;
    const int e = it / PER_E; int r = it % PER_E;
    if (r < 2 * TG) { const int up = r / TG; r %= TG; const int nt = r / (D / 64), kt = r % (D / 64); const int n0 = nt * 64;
        const float* src = (up ? p.moe_wu : p.moe_wg) + ((size_t)(layer * DmF::E + e) * D) * DE;
        return XpJob{src, DE, kt * 64, n0, f.wt_gu + (size_t)e * 1024 * D, D, (n0 / 128) * 256 + up * 128 + (n0 % 128)}; }
    r -= 2 * TG;
    { const int nt = r / (DE / 64), kt = r % (DE / 64);
      return XpJob{p.moe_wd + ((size_t)(layer * DmF::E + e) * DE) * D, D, kt * 64, nt * 64, f.wt_d + (size_t)e * D * DE, DE, nt * 64}; }
}
__device__ __forceinline__ void f_cvt_moe(const PF& p, const FastWs& f, int layer, LAS unsigned char* lds, int rank, int nwork) {
    LAS float* tile = (LAS float*)lds; const int t = tidx();
    constexpr int NT = DmF::E * (2 * 128 + 128);
    int it = rank; if (it < 0 || it >= NT) return;
    XpJob cur = job_moe(p, f, layer, it); f32x4 v[2]; xpose_load(cur, t, v);
    for (;;) { const int nx = it + nwork; const bool more = nx < NT; XpJob nj = cur; f32x4 nvv[2];
        if (more) { nj = job_moe(p, f, layer, nx); xpose_load(nj, t, nvv); }
        xpose_store(tile, cur, t, v);
        if (!more) break;
        cur = nj; v[0] = nvv[0]; v[1] = nvv[1]; it = nx; }
}

struct EpiInproj {
    static constexpr bool PERM = true; static constexpr int NST = 16;
    bf16s* z; bf16s* zh_c; bf16s* zh_x; bf16s* pq_c; bf16s* pq_x; bf16s* vit; const float* lbv;
    __device__ __forceinline__ void operator()(const f32x4 (&acc)[2][2][4][2], const pg8::Unit& u, int wr, int wc, int fr, int fq) const {
        const int tile = u.i1, pm = u.i0;
        if (u.i2) {
            const int tk = wc * 32 + 8 * fq;
            bf16s* base; size_t cstride;
            if (tile == 9 || tile == 10) { base = vit + (size_t)(tile - 9) * 256 * NVF::RALL + pm * 256; cstride = NVF::RALL; }
            else if (tile < 3) { if (pm < 16) { base = zh_c + (size_t)tile * 256 * NVF::RC + pm * 256; cstride = NVF::RC; } else { base = zh_x + (size_t)tile * 256 * NVF::RX + (pm - 16) * 256; cstride = NVF::RX; } }
            else { const int sn = tile - 13;
                if (pm < 16) { base = pq_c + ((size_t)pm * 256 * 2 + sn) * 256; cstride = 2 * 256; }
                else { const int b = (pm - 16) >> 3, l0 = ((pm - 16) & 7) * 256; base = pq_x + ((size_t)b * 256 * 2 + sn) * 2048 + l0; cstride = 2 * 2048; } }
#pragma unroll
            for (int ai = 0; ai < 2; ++ai)
#pragma unroll
                for (int m = 0; m < 4; ++m) { bf16s* rowp = base + (size_t)(ai * 128 + wr * 64 + m * 16 + fr) * cstride + tk;
#pragma unroll
                    for (int bj = 0; bj < 2; ++bj) { const f32x4 v0 = acc[ai][bj][m][0], v1 = acc[ai][bj][m][1];
                        u32x4 w; w.x = cvt_pk_bf16(v0[0], v0[1]); w.y = cvt_pk_bf16(v0[2], v0[3]); w.z = cvt_pk_bf16(v1[0], v1[1]); w.w = cvt_pk_bf16(v1[2], v1[3]);
                        *(u32x4*)(rowp + bj * 128) = w; } }
            return;
        }
        const int row0 = pm * 256 + wr * 64 + fr; const int colt = (tile < 9 ? tile - 3 : tile - 5) * 256 + wc * 32 + 8 * fq;
        const int kind = tile < 5 ? 1 : tile < 9 ? 2 : 3;
        const float qs = 0.08838834764831845f;
#pragma unroll
        for (int bj = 0; bj < 2; ++bj) {
            const int col = colt + bj * 128;
            float lb[8];
            if (kind == 2) { const float* lp = lbv + (col - NVF::OFF_FF);
#pragma unroll
                for (int j = 0; j < 8; ++j) lb[j] = 1.f - lp[j]; }
#pragma unroll
            for (int ai = 0; ai < 2; ++ai)
#pragma unroll
                for (int m = 0; m < 4; ++m) {
                    float v[8];
#pragma unroll
                    for (int j = 0; j < 4; ++j) { v[j] = acc[ai][bj][m][0][j]; v[4 + j] = acc[ai][bj][m][1][j]; }
                    if (kind == 1) {
#pragma unroll
                        for (int j = 0; j < 8; ++j) v[j] = fast_silu(v[j]) * qs;
                    } else if (kind == 2) {
#pragma unroll
                        for (int j = 0; j < 8; ++j) { const float k = lb[j] * __builtin_amdgcn_rcpf(1.f + __expf(v[j])); v[j] = fmaxf(__logf(1.f - k), -30.f); }
                    } else if (kind == 3) {
#pragma unroll
                        for (int j = 0; j < 8; ++j) v[j] = fast_silu(v[j]);
                    }
                    u32x4 w; w.x = cvt_pk_bf16(v[0], v[1]); w.y = cvt_pk_bf16(v[2], v[3]); w.z = cvt_pk_bf16(v[4], v[5]); w.w = cvt_pk_bf16(v[6], v[7]);
                    *(u32x4*)(z + (size_t)(row0 + ai * 128 + m * 16) * NVF::ZS + col) = w;
                }
        }
    }
};
struct SchedInproj {
    const bf16s* hx; const bf16s* wt; int last; Deal d;
    __device__ __forceinline__ bool next(int i, pg8::Unit& u) const {
        if (d.W != 32) return next_generic(i, u);
        int r = i; const int s = d.j;
        int seen = -1;
        for (r = 0; r <= 8; ++r) { if (valid(r, s)) { if (++seen == i) break; } }
        if (r > 8) return false;
        fill(r, s, u); return true;
    }
#ifndef INPROJ_PB
#define INPROJ_PB 2
#endif
    static constexpr int PB = INPROJ_PB, TBITS = 5 - PB, TPR = 1 << TBITS, RPG = 16 >> TBITS  ;
    __device__ __forceinline__ bool valid(int r, int s) const { if (r < 8) return ((r & (RPG - 1)) * TPR + (s & (TPR - 1))) < 15; const int tile = s & 15; return last ? (tile >= 3 && tile <= 12) : (tile < 15); }
    __device__ __forceinline__ void fill(int r, int s, pg8::Unit& u) const {
        int pm, tile;
        if (r < 8) { tile = (r & (RPG - 1)) * TPR + (s & (TPR - 1)); pm = 16 + d.x * 16 + (1 << PB) * (r / RPG) + (s >> TBITS); } else { tile = s & 15; pm = d.x * 2 + (s >> 4); }
        const char* pa = (const char*)(hx + (size_t)pm * 256 * DmF::D); const char* pb = (const char*)(wt + (size_t)tile * 256 * DmF::D); const bool sw = tile < 3 || tile >= 13 || tile == 9 || tile == 10;
        u.a = sw ? pb : pa; u.b = sw ? pa : pb; u.i0 = pm; u.i1 = tile; u.i2 = sw ? 1 : 0; u.i3 = 0; u.rows = nullptr;
    }
    __device__ __forceinline__ bool next_generic(int i, pg8::Unit& u) const {
        const int nx = 128 * 15, nc = last ? 160 : 240; const int li = i * (int)gridDim.x + (int)blockIdx.x; if (li >= nx + nc) return false;
        int pm, tile; if (li < nx) { const int q15 = (li * 34953) >> 19; pm = 16 + q15; tile = li - q15 * 15; } else { const int q = li - nx; if (last) { const int q10 = (q * 52429) >> 19; pm = q10; tile = 3 + q - q10 * 10; } else { const int q15 = (q * 34953) >> 19; pm = q15; tile = q - q15 * 15; } }
        const char* pa = (const char*)(hx + (size_t)pm * 256 * DmF::D); const char* pb = (const char*)(wt + (size_t)tile * 256 * DmF::D); const bool sw = tile < 3 || tile >= 13 || tile == 9 || tile == 10;
        u.a = sw ? pb : pa; u.b = sw ? pa : pb; u.i0 = pm; u.i1 = tile; u.i2 = sw ? 1 : 0; u.i3 = 0; u.rows = nullptr; return true;
    }
};
__device__ __forceinline__ void f_inproj(const PF& p, const FastWs& f, int layer, int last, LAS unsigned char* lds) {
    SchedInproj S; S.hx = p.hx; S.wt = f.wt_in; S.last = last; S.d.init();
    EpiInproj E{p.z, p.zh_c, p.zh_x, p.pq_c, p.pq_x, p.vit, p.lbv + layer * 2 * DmF::DHG};
#ifndef INPROJ_ALIGN
#define INPROJ_ALIGN true
#endif
#ifdef DIAG_GEMMTIME
    pg8::gemm_phase<EpiInproj, SchedInproj, INPROJ_ALIGN>(lds, pg8::Gemm{DmF::D, DmF::D, DmF::D, layer == 0 ? p.cnt + 48 : nullptr}, S, E);
#else
    pg8::gemm_phase<EpiInproj, SchedInproj, INPROJ_ALIGN>(lds, pg8::Gemm{DmF::D, DmF::D, DmF::D}, S, E);
#endif
}

#ifndef XBF16
#define XBF16 1
#endif
#if XBF16
struct EpiWout {
    static constexpr bool PERM = true; static constexpr int NST = 8;
    bf16s* xb; const float* mod; float scale;
    __device__ __forceinline__ void operator()(const f32x4 (&acc)[2][2][4][2], const pg8::Unit& u, int wr, int wc, int fr, int fq) const {
        const int pm = u.i0; const int col0 = u.i1 * 256 + wc * 32 + 8 * fq;
        const int mr = pm < 16 ? DmF::B : (pm - 16) / 8;
        bf16s* base = xb + (size_t)pm * 256 * DmF::D;
        const float* gate = mod + ((size_t)mr * 6 + 2) * DmF::D;
        f32x4 gv[2][2];
#pragma unroll
        for (int bj = 0; bj < 2; ++bj)
#pragma unroll
            for (int n = 0; n < 2; ++n) gv[bj][n] = *(const f32x4*)(gate + col0 + bj * 128 + n * 4) * scale;
#pragma unroll
        for (int ai = 0; ai < 2; ++ai) { u32x4 old[4][2];
#pragma unroll
            for (int m = 0; m < 4; ++m)
#pragma unroll
                for (int bj = 0; bj < 2; ++bj) old[m][bj] = *(const u32x4*)(base + (size_t)(ai * 128 + wr * 64 + m * 16 + fr) * DmF::D + col0 + bj * 128);
#pragma unroll
            for (int m = 0; m < 4; ++m)
#pragma unroll
                for (int bj = 0; bj < 2; ++bj) { const f32x4 v0 = unpack4((u32x2){old[m][bj].x, old[m][bj].y}) + gv[bj][0] * acc[ai][bj][m][0], v1 = unpack4((u32x2){old[m][bj].z, old[m][bj].w}) + gv[bj][1] * acc[ai][bj][m][1];
                    u32x4 w; w.x = cvt_pk_bf16(v0[0], v0[1]); w.y = cvt_pk_bf16(v0[2], v0[3]); w.z = cvt_pk_bf16(v1[0], v1[1]); w.w = cvt_pk_bf16(v1[2], v1[3]);
                    *(u32x4*)(base + (size_t)(ai * 128 + wr * 64 + m * 16 + fr) * DmF::D + col0 + bj * 128) = w; } }
    }
};
#else
struct EpiWout {
    static constexpr bool PERM = false; static constexpr int NST = 8;
    float* cw; float* out; const float* mod; float scale;
    __device__ __forceinline__ void operator()(const f32x4 (&acc)[2][2][4][2], const pg8::Unit& u, int wr, int wc, int fr, int fq) const {
        const int pm = u.i0; const int col0 = u.i1 * 256 + wc * 32 + 4 * fq;
        const int mr = pm < 16 ? DmF::B : (pm - 16) / 8;
        float* base = pm < 16 ? cw + (size_t)pm * 256 * DmF::D : out + (size_t)(pm - 16) * 256 * DmF::D;
        const float* gate = mod + ((size_t)mr * 6 + 2) * DmF::D;
        f32x4 gv[2][2];
#pragma unroll
        for (int bj = 0; bj < 2; ++bj)
#pragma unroll
            for (int n = 0; n < 2; ++n) gv[bj][n] = *(const f32x4*)(gate + col0 + bj * 128 + n * 16) * scale;
#pragma unroll
        for (int ai = 0; ai < 2; ++ai)
#pragma unroll
            for (int m0 = 0; m0 < 4; m0 += 2) { f32x4 old[2][2][2];
#pragma unroll
                for (int mm = 0; mm < 2; ++mm) { const float* rowp = base + (size_t)(ai * 128 + wr * 64 + (m0 + mm) * 16 + fr) * DmF::D + col0;
#pragma unroll
                    for (int bj = 0; bj < 2; ++bj)
#pragma unroll
                        for (int n = 0; n < 2; ++n) old[mm][bj][n] = *(const f32x4*)(rowp + bj * 128 + n * 16); }
#pragma unroll
                for (int mm = 0; mm < 2; ++mm) { float* rowp = base + (size_t)(ai * 128 + wr * 64 + (m0 + mm) * 16 + fr) * DmF::D + col0;
#pragma unroll
                    for (int bj = 0; bj < 2; ++bj)
#pragma unroll
                        for (int n = 0; n < 2; ++n) *(f32x4*)(rowp + bj * 128 + n * 16) = old[mm][bj][n] + gv[bj][n] * acc[ai][bj][m0 + mm][n]; } }
    }
};
#endif
struct SchedWout {
    const bf16s* mix; const bf16s* wt; int p0; Deal d;
    __device__ __forceinline__ bool next(int i, pg8::Unit& u) const {
        const int ppx = (144 - p0) >> 3; const int li = i * d.W + d.j; if (li >= ppx * 4) return false;
        const int pm = p0 + d.x * ppx + (li >> 2), tile = li & 3;
        u.a = (const char*)(mix + (size_t)pm * 256 * DmF::D); u.b = (const char*)(wt + (size_t)tile * 256 * DmF::D); u.i0 = pm; u.i1 = tile; u.i2 = 0; u.i3 = 0; u.rows = nullptr;
        return true;
    }
};
__device__ __forceinline__ void f_wout(const PF& p, const FastWs& f, int layer, int r0, LAS unsigned char* lds, float scale = 1.f) {
    SchedWout S; S.mix = p.hx; S.wt = f.wt_out; S.p0 = r0 / 256; S.d.init();
#if XBF16
    EpiWout E{p.xb, p.mod + (size_t)layer * (DmF::B + 1) * 6 * DmF::D, scale};
#else
    EpiWout E{p.cw, p.out, p.mod + (size_t)layer * (DmF::B + 1) * 6 * DmF::D, scale};
#endif
#ifndef WOUT_ALIGN
#define WOUT_ALIGN true
#endif
    pg8::gemm_phase<EpiWout, SchedWout, WOUT_ALIGN>(lds, pg8::Gemm{DmF::D, DmF::D, DmF::D}, S, E);
}

__device__ __forceinline__ void f_gather(const PF& p, const FastWs& f) {
    const int total = NVF::moe_off(p, DmF::E);
    const long items = (long)total * 128;
    for (long i = (long)blockIdx.x * NTHREADS + tidx(); i < items; i += (long)gridDim.x * NTHREADS) {
        const int pos = (int)(i >> 7), ch = (int)(i & 127); const int ts = p.perm[pos];
        u32x4 v = (u32x4){0u, 0u, 0u, 0u};
        if (ts >= 0) v = *(const u32x4*)(p.hx + (size_t)(ts >> 1) * DmF::D + ch * 8);
        *(u32x4*)(f.hxs + (size_t)pos * DmF::D + ch * 8) = v;
    }
}
struct SchedMoe {
    const char* abase; size_t apanel; const char* bbase; size_t bexp, btile; const int* cnt; int npanels; Deal d; const int* perm;
    int segend[16];
    __device__ __forceinline__ void init_segments() { int o = 0;
#pragma unroll
        for (int j = 0; j < DmF::E; ++j) { o += (cnt[j] + 255) / 256 * 256; segend[j] = o; } }
    __device__ __forceinline__ int expert_of(int pos) const { int e = 0;
#pragma unroll
        for (int j = 0; j < DmF::E - 1; ++j) e += (pos >= segend[j]) ? 1 : 0;
        return e; }
    __device__ __forceinline__ bool next(int i, pg8::Unit& u) const {
        const int li = i * d.W + d.j; const int mine = (npanels - d.x + 7) >> 3; if (li >= mine * 4) return false;
        const int pm = d.x + 8 * (li >> 2), tile = li & 3;
        const int e = expert_of(pm * 256);
        u.a = perm ? abase : abase + (size_t)pm * apanel; u.b = bbase + (size_t)e * bexp + (size_t)tile * btile; u.i0 = pm; u.i1 = tile; u.i2 = e; u.i3 = 0; u.rows = perm ? perm + pm * 256 : nullptr;
        return true;
    }
};
struct EpiGateUp {
    static constexpr bool PERM = true; static constexpr int NST = 8;
    bf16s* hmid;
    __device__ __forceinline__ void operator()(const f32x4 (&acc)[2][2][4][2], const pg8::Unit& u, int wr, int wc, int fr, int fq) const {
        const int row0 = u.i0 * 256 + wr * 64 + fr; const int col = u.i1 * 128 + wc * 32 + 8 * fq;
#pragma unroll
        for (int ai = 0; ai < 2; ++ai)
#pragma unroll
            for (int m = 0; m < 4; ++m) {
                float v[8];
#pragma unroll
                for (int j = 0; j < 4; ++j) { v[j] = fast_silu(acc[ai][0][m][0][j]) * acc[ai][1][m][0][j]; v[4 + j] = fast_silu(acc[ai][0][m][1][j]) * acc[ai][1][m][1][j]; }
                u32x4 w; w.x = cvt_pk_bf16(v[0], v[1]); w.y = cvt_pk_bf16(v[2], v[3]); w.z = cvt_pk_bf16(v[4], v[5]); w.w = cvt_pk_bf16(v[6], v[7]);
                *(u32x4*)(hmid + (size_t)(row0 + ai * 128 + m * 16) * DmF::DE + col) = w;
            }
    }
};
#ifndef YMOE_FP8
#define YMOE_FP8 0
#endif
__device__ __forceinline__ unsigned pack4_fp8(f32x4 v) {
    unsigned w = 0;
    w = __builtin_amdgcn_cvt_pk_fp8_f32(__builtin_amdgcn_fmed3f(v[0], -440.f, 440.f), __builtin_amdgcn_fmed3f(v[1], -440.f, 440.f), w, false);
    w = __builtin_amdgcn_cvt_pk_fp8_f32(__builtin_amdgcn_fmed3f(v[2], -440.f, 440.f), __builtin_amdgcn_fmed3f(v[3], -440.f, 440.f), w, true);
    return w;
}
__device__ __forceinline__ f32x4 unpack4_fp8(unsigned w) { const f32x2 a = __builtin_amdgcn_cvt_pk_f32_fp8(w, false), b = __builtin_amdgcn_cvt_pk_f32_fp8(w, true); return (f32x4){a[0], a[1], b[0], b[1]}; }
struct EpiDown {
    static constexpr bool PERM = true; static constexpr int NST = 16;
    bf16s* ymoe;
    __device__ __forceinline__ void operator()(const f32x4 (&acc)[2][2][4][2], const pg8::Unit& u, int wr, int wc, int fr, int fq) const {
        const int row0 = u.i0 * 256 + wr * 64 + fr; const int col = u.i1 * 256 + wc * 32 + 8 * fq;
#pragma unroll
        for (int ai = 0; ai < 2; ++ai)
#pragma unroll
            for (int m = 0; m < 4; ++m)
#pragma unroll
                for (int bj = 0; bj < 2; ++bj) { const f32x4 v0 = acc[ai][bj][m][0], v1 = acc[ai][bj][m][1];
#if YMOE_FP8
                    *(u32x2*)((unsigned char*)ymoe + (size_t)(row0 + ai * 128 + m * 16) * DmF::D + col + bj * 128) = (u32x2){pack4_fp8(v0), pack4_fp8(v1)};
#else
                    u32x4 w; w.x = cvt_pk_bf16(v0[0], v0[1]); w.y = cvt_pk_bf16(v0[2], v0[3]); w.z = cvt_pk_bf16(v1[0], v1[1]); w.w = cvt_pk_bf16(v1[2], v1[3]);
                    *(u32x4*)(ymoe + (size_t)(row0 + ai * 128 + m * 16) * DmF::D + col + bj * 128) = w;
#endif
                }
    }
};
__device__ __forceinline__ void f_gateup(const PF& p, const FastWs& f, LAS unsigned char* lds) {
    SchedMoe S; S.abase = (const char*)p.hx; S.perm = p.perm; S.apanel = 0; S.bbase = (const char*)f.wt_gu; S.bexp = (size_t)1024 * DmF::D * 2; S.btile = (size_t)256 * DmF::D * 2;
    S.cnt = p.cnt; S.init_segments(); S.npanels = S.segend[DmF::E - 1] / 256; S.d.init();
    EpiGateUp E{p.hmid};
#ifndef GATEUP_ALIGN
#define GATEUP_ALIGN true
#endif
    pg8::gemm_phase<EpiGateUp, SchedMoe, GATEUP_ALIGN, true>(lds, pg8::Gemm{DmF::D, DmF::D, DmF::D}, S, E);
}
__device__ __forceinline__ void f_down(const PF& p, const FastWs& f, int layer, LAS unsigned char* lds) {
    SchedMoe S; S.perm = nullptr; S.abase = (const char*)p.hmid; S.apanel = (size_t)256 * DmF::DE * 2; S.bbase = (const char*)f.wt_d; S.bexp = (size_t)DmF::D * DmF::DE * 2; S.btile = (size_t)256 * DmF::DE * 2;
    S.cnt = p.cnt; S.init_segments(); S.npanels = S.segend[DmF::E - 1] / 256; S.d.init();
    EpiDown E{f.hxs};
#ifndef DOWN_ALIGN
#define DOWN_ALIGN true
#endif
    pg8::gemm_phase<EpiDown, SchedMoe, DOWN_ALIGN>(lds, pg8::Gemm{DmF::DE, DmF::DE, DmF::DE}, S, E);
}

__device__ __forceinline__ void f_gen_dft(const PF& p, LAS unsigned char* lds) {
    LAS float* CT = (LAS float*)lds; LAS float* ST = CT + 2048;
    for (int m = tidx(); m < 2048; m += NTHREADS) { const float ang = 6.283185307179586f * (float)m / 2048.f; CT[m] = cosf(ang); ST[m] = sinf(ang); }
    __syncthreads();
    const long tid = (long)blockIdx.x * NTHREADS + tidx(), nth = (long)gridDim.x * NTHREADS;
    const float sx = 1.0f / sqrtf(64.f * 2048.f), sc = 1.0f / sqrtf(64.f * 256.f);
    for (long i = tid; i < ((long)2048 * 4096 + 256 * 512) / 2; i += nth) {
        const long e = i * 2; const bool isx = e < (long)2048 * 4096; const long ii = isx ? e : e - (long)2048 * 4096; const int Lw = isx ? 2048 : 256, sh = isx ? 0 : 3;
        const int k = (int)(ii / (2 * Lw)), lp = (int)(ii % (2 * Lw)), sn = lp >= Lw, l = sn ? lp - Lw : lp; const float s = isx ? sx : sc;
        const int m0 = ((k * l) & (Lw - 1)) << sh, m1 = ((k * (l + 1)) & (Lw - 1)) << sh;
        const float v0 = (sn ? -ST[m0] : CT[m0]) * s, v1 = (sn ? -ST[m1] : CT[m1]) * s;
        *(unsigned*)((isx ? p.dft_x : p.dft_c) + ii) = cvt_pk_bf16(v0, v1);
    }
    __syncthreads();
}
__device__ __forceinline__ float bflo(unsigned w) { return __uint_as_float(w << 16); }
__device__ __forceinline__ float bfhi(unsigned w) { return __uint_as_float(w & 0xffff0000u); }
#ifndef FNET_CTX_WG0
#define FNET_CTX_WG0 64
#endif
struct EpiFnet {
    static constexpr bool PERM = true; static constexpr int NST = 16;
    bf16s* yfn; const float* fn_b;
    __device__ __forceinline__ void operator()(const f32x4 (&acc)[2][2][4][2], const pg8::Unit& u, int wr, int wc, int fr, int fq) const {
        const int row0 = u.i0 + wr * 64 + fr; const int col0 = wc * 32 + 8 * fq;
#pragma unroll
        for (int bj = 0; bj < 2; ++bj) { const f32x4 b0 = *(const f32x4*)(fn_b + col0 + bj * 128), b1 = *(const f32x4*)(fn_b + col0 + bj * 128 + 4);
#pragma unroll
            for (int ai = 0; ai < 2; ++ai)
#pragma unroll
                for (int m = 0; m < 4; ++m) { const f32x4 v0 = acc[ai][bj][m][0] + b0, v1 = acc[ai][bj][m][1] + b1;
                    u32x4 w; w.x = cvt_pk_bf16(v0[0], v0[1]); w.y = cvt_pk_bf16(v0[2], v0[3]); w.z = cvt_pk_bf16(v1[0], v1[1]); w.w = cvt_pk_bf16(v1[2], v1[3]);
                    *(u32x4*)(yfn + (size_t)(row0 + ai * 128 + m * 16) * 256 + col0 + bj * 128) = w; } }
    }
};
struct SchedFnet {
    const bf16s* dft; const bf16s* pq; int first, n, npk_shift, rowbase, Lw;
    __device__ __forceinline__ bool next(int i, pg8::Unit& u) const {
        const int li = i * (int)gridDim.x + (int)blockIdx.x - first; if (li < 0 || li >= n) return false;
        const int b = li >> npk_shift, kp = li & ((1 << npk_shift) - 1);
        u.a = (const char*)(dft + (size_t)kp * 256 * 2 * Lw); u.b = (const char*)(pq + (size_t)b * 256 * 2 * Lw); u.i0 = rowbase + b * Lw + kp * 256; u.i1 = 0; u.i2 = 0; u.i3 = 0; u.rows = nullptr;
        return true;
    }
};
struct EpiFnetFold {
    static constexpr bool PERM = true; static constexpr int NST = 16;
    bf16s* yfn; const float* fn_b;
    __device__ __forceinline__ void operator()(const f32x4 (&acc)[2][2][4][2], const pg8::Unit& u, int wr, int wc, int fr, int fq) const {
        const int lr0 = wr * 64 + fr, row0 = u.i0 + lr0; const int col0 = wc * 32 + 8 * fq;
        if (u.i1 == 0) {
#pragma unroll
            for (int bj = 0; bj < 2; ++bj)
#pragma unroll
                for (int ai = 0; ai < 2; ++ai)
#pragma unroll
                    for (int m = 0; m < 4; ++m) { const f32x4 v0 = acc[ai][bj][m][0], v1 = acc[ai][bj][m][1];
                        u32x4 w; w.x = cvt_pk_bf16(v0[0], v0[1]); w.y = cvt_pk_bf16(v0[2], v0[3]); w.z = cvt_pk_bf16(v1[0], v1[1]); w.w = cvt_pk_bf16(v1[2], v1[3]);
                        *(u32x4*)(yfn + (size_t)(row0 + ai * 128 + m * 16) * 256 + col0 + bj * 128) = w; }
        } else {
            const int mr0 = u.i2 - lr0;
#pragma unroll
            for (int bj = 0; bj < 2; ++bj) { const f32x4 b0 = *(const f32x4*)(fn_b + col0 + bj * 128), b1 = *(const f32x4*)(fn_b + col0 + bj * 128 + 4);
                u32x4 cw[2][4];
#pragma unroll
                for (int ai = 0; ai < 2; ++ai)
#pragma unroll
                    for (int m = 0; m < 4; ++m) cw[ai][m] = *(const u32x4*)(yfn + (size_t)(row0 + ai * 128 + m * 16) * 256 + col0 + bj * 128);
#pragma unroll
                for (int ai = 0; ai < 2; ++ai)
#pragma unroll
                    for (int m = 0; m < 4; ++m) { const u32x4 c = cw[ai][m];
                        const f32x4 c0 = (f32x4){bflo(c.x), bfhi(c.x), bflo(c.y), bfhi(c.y)} + b0, c1 = (f32x4){bflo(c.z), bfhi(c.z), bflo(c.w), bfhi(c.w)} + b1;
                        const f32x4 p0 = c0 + acc[ai][bj][m][0], p1 = c1 + acc[ai][bj][m][1], q0 = c0 - acc[ai][bj][m][0], q1 = c1 - acc[ai][bj][m][1];
                        u32x4 w; w.x = cvt_pk_bf16(p0[0], p0[1]); w.y = cvt_pk_bf16(p0[2], p0[3]); w.z = cvt_pk_bf16(p1[0], p1[1]); w.w = cvt_pk_bf16(p1[2], p1[3]);
                        *(u32x4*)(yfn + (size_t)(row0 + ai * 128 + m * 16) * 256 + col0 + bj * 128) = w;
                        const int mr = mr0 - ai * 128 - m * 16;
                        if (mr < u.i3) { u32x4 x; x.x = cvt_pk_bf16(q0[0], q0[1]); x.y = cvt_pk_bf16(q0[2], q0[3]); x.z = cvt_pk_bf16(q1[0], q1[1]); x.w = cvt_pk_bf16(q1[2], q1[3]);
                            *(u32x4*)(yfn + (size_t)mr * 256 + col0 + bj * 128) = x; } } }
        }
    }
};
struct SchedFnetFold {
    const bf16s* dft; const bf16s* pq; int first;
    __device__ __forceinline__ bool next(int i, pg8::Unit& u) const {
        const int li = (int)blockIdx.x - first; if (i >= 2 || li < 0 || li >= 64) return false;
        const int b = li >> 2, kp = li & 3;
        u.a = (const char*)(dft + (size_t)kp * 256 * 4096 + i * 2048); u.b = (const char*)(pq + (size_t)b * 256 * 4096 + i * 2048);
        u.i0 = NVF::RC + b * 2048 + kp * 256; u.i1 = i; u.i2 = NVF::RC + b * 2048 + 2048 - kp * 256; u.i3 = NVF::RC + (b + 1) * 2048; u.rows = nullptr;
        return true;
    }
};
__device__ __forceinline__ void f_fnet(const PF& p, int layer, int with_ctx, LAS unsigned char* lds) {
    { EpiFnetFold E{p.yfn, p.fn_b + layer * 256}; SchedFnetFold S{p.dft_x, p.pq_x, 0}; pg8::gemm_phase<EpiFnetFold, SchedFnetFold>(lds, pg8::Gemm{2048, 4096, 4096}, S, E); }
    if (with_ctx) { EpiFnet E{p.yfn, p.fn_b + layer * 256}; SchedFnet S{p.dft_c, p.pq_c, FNET_CTX_WG0, 16, 0, 0, 256}; pg8::gemm_phase<EpiFnet, SchedFnet>(lds, pg8::Gemm{512, 512, 512}, S, E); }
}
__device__ __forceinline__ float wave_sum(float v) {
#pragma unroll
    for (int o = 32; o >= 1; o >>= 1) v += __shfl_xor(v, o);
    return v;
}

#ifndef XBF16
#define XBF16 1
#endif
#if XBF16
#define XS_LOAD4(p, R, c) unpack4(*(const u32x2*)((p).xb + (size_t)(R) * DmF::D + (c)))
#define XS_STORE4(p, R, c, v) (*(u32x2*)((p).xb + (size_t)(R) * DmF::D + (c)) = pack4(v))
#else
#define XS_LOAD4(p, R, c) (*(const f32x4*)(NVF::xrow((p), (R)) + (c)))
#define XS_STORE4(p, R, c, v) (*(f32x4*)(NVF::xrow((p), (R)) + (c)) = (v))
#endif
struct MoePos { int p0, p1; float g0, g1; };
__device__ __forceinline__ MoePos moe_pos_load(const PF& p, int R) { MoePos m; m.p0 = p.rpos[R * 2]; m.p1 = p.rpos[R * 2 + 1]; m.g0 = p.rgp[R * 2]; m.g1 = p.rgp[R * 2 + 1]; return m; }
#if YMOE_FP8
struct MoeRows { unsigned a[4], b[4]; float g0, g1; };
__device__ __forceinline__ MoeRows moe_rows_load(const bf16s* ymoe, const MoePos& m, int lane) { MoeRows y; y.g0 = m.g0; y.g1 = m.g1; const unsigned char* yb = (const unsigned char*)ymoe;
#pragma unroll
    for (int i = 0; i < 4; ++i) { const int c = i * 256 + lane * 4; y.a[i] = *(const unsigned*)(yb + (size_t)m.p0 * DmF::D + c); y.b[i] = *(const unsigned*)(yb + (size_t)m.p1 * DmF::D + c); }
    return y; }
__device__ __forceinline__ void moe_combine_apply(const PF& p, const MoeRows& y, int player, int R, int lane, f32x4 (&v)[4]) {
    const float* m5 = NVF::modp(p, player, NVF::row_modr(R), 5);
#pragma unroll
    for (int i = 0; i < 4; ++i) { const int c = i * 256 + lane * 4; v[i] = v[i] + *(const f32x4*)(m5 + c) * (unpack4_fp8(y.a[i]) * y.g0 + unpack4_fp8(y.b[i]) * y.g1); }
}
#else
struct MoeRows { u32x2 a[4], b[4]; float g0, g1; };
__device__ __forceinline__ MoeRows moe_rows_load(const bf16s* ymoe, const MoePos& m, int lane) { MoeRows y; y.g0 = m.g0; y.g1 = m.g1;
#pragma unroll
    for (int i = 0; i < 4; ++i) { const int c = i * 256 + lane * 4; y.a[i] = *(const u32x2*)(ymoe + (size_t)m.p0 * DmF::D + c); y.b[i] = *(const u32x2*)(ymoe + (size_t)m.p1 * DmF::D + c); }
    return y; }
__device__ __forceinline__ void moe_combine_apply(const PF& p, const MoeRows& y, int player, int R, int lane, f32x4 (&v)[4]) {
    const float* m5 = NVF::modp(p, player, NVF::row_modr(R), 5);
#pragma unroll
    for (int i = 0; i < 4; ++i) { const int c = i * 256 + lane * 4; v[i] = v[i] + *(const f32x4*)(m5 + c) * (unpack4(y.a[i]) * y.g0 + unpack4(y.b[i]) * y.g1); }
}
#endif
template <bool ROUTER, bool COMBINE, bool INIT = false>
__device__ __forceinline__ void f_normmod(const PF& p, const bf16s* ymoe, int layer, int which, int r0, LAS unsigned char* lds, const float* postab = nullptr) {
    const int t = tidx(), lane = t & 63, gw = blockIdx.x * (NTHREADS / 64) + (t >> 6), NGW = gdimx() * (NTHREADS / 64);
    const float* g = (which ? p.norm2_g : p.norm1_g) + layer * DmF::D;
    LAS int* hist = (LAS int*)lds;
    LAS float* RW = (LAS float*)(lds + 256);
    if constexpr (ROUTER) { if (t < 16) hist[t] = 0;
        for (int i = t; i < DmF::D * 16; i += NTHREADS) { const int k = i >> 4, e = i & 15; RW[e * DmF::D + k] = p.router_w[i]; }
        __syncthreads(); }
    const int rpw = (NVF::RALL - r0 + NGW - 1) / NGW, Rb = r0 + gw * rpw, Re = (Rb + rpw < NVF::RALL) ? Rb + rpw : NVF::RALL;
    f32x4 nv[4];
#define NM_LOAD(RR, dst) do { _Pragma("unroll") for (int i_ = 0; i_ < 4; ++i_) { if constexpr (INIT) { if ((RR) < NVF::RC) dst[i_] = *(const f32x4*)(p.ctx + (size_t)(RR) * DmF::D + i_ * 256 + lane * 4); \
            else dst[i_] = *(const f32x4*)(p.x + (size_t)((RR) - NVF::RC) * DmF::D + i_ * 256 + lane * 4) + *(const f32x4*)(postab + (size_t)(((RR) - NVF::RC) % DmF::L) * DmF::D + i_ * 256 + lane * 4); } \
            else dst[i_] = XS_LOAD4(p, (RR), i_ * 256 + lane * 4); } } while (0)
    MoePos npos; MoeRows nrows; int cur_mr = -1; f32x4 scg[4], shv[4];
    float rb[16];
    if constexpr (ROUTER) {
#pragma unroll
        for (int e = 0; e < 16; ++e) rb[e] = p.router_b[e]; }
    if (Rb < Re) { NM_LOAD(Rb, nv); if constexpr (COMBINE) { npos = moe_pos_load(p, Rb); nrows = moe_rows_load(ymoe, npos, lane); if (Rb + 1 < Re) npos = moe_pos_load(p, Rb + 1); } }
    for (int R = Rb; R < Re; ++R) {
        f32x4 v[4]; float ss = 0.f; MoeRows crows;
#pragma unroll
        for (int i = 0; i < 4; ++i) v[i] = nv[i];
        if constexpr (COMBINE) crows = nrows;
        if (R + 1 < Re) { NM_LOAD(R + 1, nv); if constexpr (COMBINE) { nrows = moe_rows_load(ymoe, npos, lane); if (R + 2 < Re) npos = moe_pos_load(p, R + 2); } }
        if constexpr (COMBINE) moe_combine_apply(p, crows, layer - 1, R, lane, v);
        if constexpr (COMBINE || INIT) {
#pragma unroll
            for (int i = 0; i < 4; ++i) XS_STORE4(p, R, i * 256 + lane * 4, v[i]); }
#pragma unroll
        for (int i = 0; i < 4; ++i) ss += v[i][0] * v[i][0] + v[i][1] * v[i][1] + v[i][2] * v[i][2] + v[i][3] * v[i][3];
        ss = wave_sum(ss);
        const float rstd = 1.0f / sqrtf(ss * (1.0f / DmF::D) + 1e-6f);
        const int mr = NVF::row_modr(R);
        if (mr != cur_mr) { cur_mr = mr; const float* sh = NVF::modp(p, layer, mr, which ? 3 : 0); const float* sc = NVF::modp(p, layer, mr, which ? 4 : 1);
#pragma unroll
            for (int i = 0; i < 4; ++i) { const int c = i * 256 + lane * 4; scg[i] = (*(const f32x4*)(sc + c) + 1.0f) * *(const f32x4*)(g + c); shv[i] = *(const f32x4*)(sh + c); } }
        bf16s* h = p.hx + (size_t)R * DmF::D;
#pragma unroll
        for (int i = 0; i < 4; ++i) { const int c = i * 256 + lane * 4; v[i] = v[i] * rstd * scg[i] + shv[i]; *(u32x2*)(h + c) = pack4(v[i]); }
        if constexpr (ROUTER) {
            float lg[16];
#pragma unroll
            for (int e = 0; e < 16; ++e) { float a = 0.f;
#pragma unroll
                for (int i = 0; i < 4; ++i) { const f32x4 wv4 = *(const LAS f32x4*)(RW + e * DmF::D + i * 256 + lane * 4); a += v[i][0] * wv4[0] + v[i][1] * wv4[1] + v[i][2] * wv4[2] + v[i][3] * wv4[3]; }
                lg[e] = a; }
#pragma unroll
            for (int e = 0; e < 16; ++e) lg[e] = wave_sum(lg[e]);
            if (lane == 0) {
                float mx = lg[0];
#pragma unroll
                for (int e = 1; e < 16; ++e) mx = fmaxf(mx, lg[e]);
                float den = 0.f;
#pragma unroll
                for (int e = 0; e < 16; ++e) { lg[e] = __expf(lg[e] - mx); den += lg[e]; }
                const float rden = 1.0f / den;
                float bestg = -1e30f; int bi0 = 0, bi1 = 0; float bp0 = 0.f, bp1 = 0.f;
#pragma unroll
                for (int gI = 0; gI < 4; ++gI) {
                    float s0 = -1e30f, s1 = -1e30f, p0 = 0.f, p1 = 0.f; int i0 = 0, i1 = 0;
#pragma unroll
                    for (int j = 0; j < 4; ++j) { const int e = gI * 4 + j; const float pr = lg[e] * rden; const float s = pr + rb[e];
                        if (s > s0) { s1 = s0; i1 = i0; p1 = p0; s0 = s; i0 = e; p0 = pr; } else if (s > s1) { s1 = s; i1 = e; p1 = pr; } }
                    const float gs = s0 + s1;
                    if (gs > bestg) { bestg = gs; bi0 = i0; bi1 = i1; bp0 = p0; bp1 = p1; }
                }
                const float sum = bp0 + bp1;
                p.ridx[R * 2] = bi0; p.ridx[R * 2 + 1] = bi1; p.rgp[R * 2] = bp0 / sum; p.rgp[R * 2 + 1] = bp1 / sum;
                p.rrank[R * 2] = __hip_atomic_fetch_add(hist + bi0, 1, __ATOMIC_RELAXED, __HIP_MEMORY_SCOPE_WORKGROUP);
                p.rrank[R * 2 + 1] = __hip_atomic_fetch_add(hist + bi1, 1, __ATOMIC_RELAXED, __HIP_MEMORY_SCOPE_WORKGROUP);
            }
        }
    }
#undef NM_LOAD
    if constexpr (ROUTER) { __syncthreads(); if (t < 16) p.wgbase[blockIdx.x * 16 + t] = atomicAdd(p.cnt + t, hist[t]); __syncthreads(); }
}
__device__ __forceinline__ void f_place_gather(const PF& p, const FastWs& f, int r0) {
    const int t = tidx(), lane = t & 63, gw = blockIdx.x * (NTHREADS / 64) + (t >> 6), NGW = gdimx() * (NTHREADS / 64);
    const int rpw = (NVF::RALL - r0 + NGW - 1) / NGW, Rb = r0 + gw * rpw, Re = (Rb + rpw < NVF::RALL) ? Rb + rpw : NVF::RALL;
    for (int it = lane; it < (Re - Rb) * 2; it += 64) { const int ts = Rb * 2 + it, e = p.ridx[ts];
        const int pos = NVF::moe_off(p, e) + p.wgbase[blockIdx.x * 16 + e] + p.rrank[ts]; p.perm[pos] = ts; p.rpos[ts] = pos; }
}
__device__ __forceinline__ void f_mix(const PF& p, int layer, int r0) {
    const int t = tidx(), lane = t & 63, gw = blockIdx.x * (NTHREADS / 64) + (t >> 6), NGW = gdimx() * (NTHREADS / 64);
    for (int R = r0 + gw; R < NVF::RALL; R += NGW) {
        bf16s* m = p.hx + (size_t)R * DmF::D;
        { f32x4 v = unpack4(*(const u32x2*)(p.y2 + (size_t)R * 256 + lane * 4)); float ss = wave_sum(v[0] * v[0] + v[1] * v[1] + v[2] * v[2] + v[3] * v[3]);
          const float rstd = 1.0f / sqrtf(ss * (1.0f / 256.f) + 1e-6f); const f32x4 gv = *(const f32x4*)(p.hy_norm_g + layer * 256 + lane * 4);
          *(u32x2*)(m + lane * 4) = pack4(v * rstd * gv); }
        {
          const u32x4 w = *(const u32x4*)(p.o + (size_t)R * 512 + lane * 8); f32x4 a = unpack4((u32x2){w.x, w.y}), b = unpack4((u32x2){w.z, w.w});
          float ss = a[0] * a[0] + a[1] * a[1] + a[2] * a[2] + a[3] * a[3] + b[0] * b[0] + b[1] * b[1] + b[2] * b[2] + b[3] * b[3];
#pragma unroll
          for (int o = 8; o >= 1; o >>= 1) ss += __shfl_xor(ss, o);
          const float rstd = 1.0f / sqrtf(ss * (1.0f / 128.f) + 1e-6f);
          const u32x4 gw4 = *(const u32x4*)(p.z + (size_t)R * NVF::ZS + NVF::OFF_G + lane * 8); const f32x4 ga = unpack4((u32x2){gw4.x, gw4.y}), gb = unpack4((u32x2){gw4.z, gw4.w});
          const f32x4 na = *(const f32x4*)(p.hg_norm_g + layer * 512 + lane * 8), nb = *(const f32x4*)(p.hg_norm_g + layer * 512 + lane * 8 + 4);
          const u32x2 o0 = pack4(a * rstd * na * ga), o1 = pack4(b * rstd * nb * gb);
          *(u32x4*)(m + 256 + lane * 8) = (u32x4){o0.x, o0.y, o1.x, o1.y}; }
        { f32x4 v = unpack4(*(const u32x2*)(p.yfn + (size_t)R * 256 + lane * 4)); float ss = wave_sum(v[0] * v[0] + v[1] * v[1] + v[2] * v[2] + v[3] * v[3]);
          const float rstd = 1.0f / sqrtf(ss * (1.0f / 256.f) + 1e-6f); const f32x4 gv = *(const f32x4*)(p.fn_norm_g + layer * 256 + lane * 4);
          *(u32x2*)(m + 768 + lane * 4) = pack4(v * rstd * gv); }
    }
}
__device__ __forceinline__ void f_final(const PF& p, const bf16s* ymoe) {
    const int t = tidx(), lane = t & 63, gw = blockIdx.x * (NTHREADS / 64) + (t >> 6), NGW = gdimx() * (NTHREADS / 64);
    const int rpw = (NVF::RX + NGW - 1) / NGW, Rb = gw * rpw, Re = (Rb + rpw < NVF::RX) ? Rb + rpw : NVF::RX;
    f32x4 gfin[4];
#pragma unroll
    for (int i = 0; i < 4; ++i) gfin[i] = *(const f32x4*)(p.final_g + i * 256 + lane * 4);
    f32x4 nv[4]; MoePos npos; MoeRows nrows;
#define FN_LOAD(RR) do { _Pragma("unroll") for (int i_ = 0; i_ < 4; ++i_) nv[i_] = XS_LOAD4(p, NVF::RC + (RR), i_ * 256 + lane * 4); } while (0)
    if (Rb < Re) { FN_LOAD(Rb); npos = moe_pos_load(p, NVF::RC + Rb); nrows = moe_rows_load(ymoe, npos, lane); if (Rb + 1 < Re) npos = moe_pos_load(p, NVF::RC + Rb + 1); }
    for (int R = Rb; R < Re; ++R) {
        float* xr = p.out + (size_t)R * DmF::D;
        f32x4 v[4]; float ss = 0.f; const MoeRows crows = nrows;
#pragma unroll
        for (int i = 0; i < 4; ++i) v[i] = nv[i];
        if (R + 1 < Re) { FN_LOAD(R + 1); nrows = moe_rows_load(ymoe, npos, lane); if (R + 2 < Re) npos = moe_pos_load(p, NVF::RC + R + 2); }
        moe_combine_apply(p, crows, DmF::DEPTH - 1, NVF::RC + R, lane, v);
#pragma unroll
        for (int i = 0; i < 4; ++i) ss += v[i][0] * v[i][0] + v[i][1] * v[i][1] + v[i][2] * v[i][2] + v[i][3] * v[i][3];
        ss = wave_sum(ss);
        const float rstd = 1.0f / sqrtf(ss * (1.0f / DmF::D) + 1e-6f);
#pragma unroll
        for (int i = 0; i < 4; ++i) *(f32x4*)(xr + i * 256 + lane * 4) = v[i] * rstd * gfin[i];
    }
#undef FN_LOAD
#ifdef DIAG_OUT
    __syncthreads();
    if (blockIdx.x == 0 && t == 0) { asm volatile("s_waitcnt vmcnt(0)" ::: "memory"); p.out[0] = 1.0e4f * (1.0f + (float)__hip_atomic_load(p.cnt + DIAG_OUT, __ATOMIC_RELAXED, __HIP_MEMORY_SCOPE_AGENT)); }
#endif
#ifdef DIAG_SANITIZE
    __syncthreads();
    if (blockIdx.x == 0 && t == 0) { asm volatile("s_waitcnt vmcnt(0)" ::: "memory"); p.out[0] = 1.0e4f * (1.0f + (float)__hip_atomic_load(p.cnt + 40, __ATOMIC_RELAXED, __HIP_MEMORY_SCOPE_AGENT)); }
#endif
}
#ifndef REP_HYCONV
#define REP_HYCONV 1
#endif
template <int L> struct HyG {
    static_assert(8 * (2 * L * 2 + 32) + 16 * (L * 2 + 16) <= LDS_MISC_OFF, "Hyena LDS image does not fit");
    static constexpr int TB = L / 128;
    static constexpr int CS = 2 * L * 2 + 32;
    static constexpr int RSB = L * 2 + 16;
    static constexpr int U_OFF = 8 * CS;
    static constexpr int BYTES = U_OFF + 16 * RSB;
};

template <int L> __device__ __forceinline__ void hy_build_copies(LAS unsigned char* lds, const bf16s* kr, int t) {
    constexpr int NCH = 2 * L / 8;
    for (int w = t; w < NCH; w += NTHREADS) {
        unsigned S[8];
        const u32x4 c0 = *(const u32x4*)(kr + w * 8); u32x4 c1 = (u32x4){0u, 0u, 0u, 0u};
        if (w + 1 < NCH) c1 = *(const u32x4*)(kr + w * 8 + 8);
        S[0] = c0.x; S[1] = c0.y; S[2] = c0.z; S[3] = c0.w; S[4] = c1.x; S[5] = c1.y; S[6] = c1.z; S[7] = c1.w;
#pragma unroll
        for (int a = 0; a < 8; ++a) { u32x4 o;
            if ((a & 1) == 0) { o.x = S[a / 2]; o.y = S[a / 2 + 1]; o.z = S[a / 2 + 2]; o.w = S[a / 2 + 3]; }
            else { const int h = (a - 1) / 2; o.x = (S[h] >> 16) | (S[h + 1] << 16); o.y = (S[h + 1] >> 16) | (S[h + 2] << 16); o.z = (S[h + 2] >> 16) | (S[h + 3] << 16); o.w = (S[h + 3] >> 16) | (S[h + 4] << 16); }
            *(LAS u32x4*)(lds + a * HyG<L>::CS + w * 16) = o; }
    }
}
template <int L, bool RAW> __device__ __forceinline__ void hy_stage_u(LAS unsigned char* lds, const bf16s* zrow, float w0, float w1, float w2, float bias, int t) {
    constexpr int NCH = 16 * L / 8, CPR = L / 8, PT = (NCH + NTHREADS - 1) / NTHREADS, G = PT < 4 ? PT : 4;
    static_assert(PT % G == 0, "chunk batching");
    for (int q0 = t; q0 < NCH; q0 += G * NTHREADS) {
        u32x4 v[G]; bf16s pv[G], nx[G];
#pragma unroll
        for (int u = 0; u < G; ++u) { const int q = q0 + u * NTHREADS; const bool ok = q < NCH; const int qq = ok ? q : 0; const int b = qq / CPR, s0 = (qq % CPR) * 8; const bf16s* src = zrow + (size_t)b * L + s0;
            v[u] = *(const u32x4*)src;
            if (!RAW) { pv[u] = src[s0 > 0 ? -1 : 0]; nx[u] = src[s0 + 8 < L ? 8 : 7]; } }
#pragma unroll
        for (int u = 0; u < G; ++u) { const int q = q0 + u * NTHREADS; if (q >= NCH) continue; const int b = q / CPR, s0 = (q % CPR) * 8;
            u32x4 o = v[u];
            if (!RAW) {
                const float prev = s0 > 0 ? bf2f(pv[u]) : 0.f, nxt = s0 + 8 < L ? bf2f(nx[u]) : 0.f;
                float z[10]; z[0] = prev; z[1] = bflo(o.x); z[2] = bfhi(o.x); z[3] = bflo(o.y); z[4] = bfhi(o.y); z[5] = bflo(o.z); z[6] = bfhi(o.z); z[7] = bflo(o.w); z[8] = bfhi(o.w); z[9] = nxt;
                float uu[8];
#pragma unroll
                for (int e = 0; e < 8; ++e) uu[e] = w0 * z[e] + w1 * z[e + 1] + w2 * z[e + 2] + bias;
                o.x = cvt_pk_bf16(uu[0], uu[1]); o.y = cvt_pk_bf16(uu[2], uu[3]); o.z = cvt_pk_bf16(uu[4], uu[5]); o.w = cvt_pk_bf16(uu[6], uu[7]);
            }
            *(LAS u32x4*)(lds + HyG<L>::U_OFF + b * HyG<L>::RSB + s0 * 2) = o; }
    }
}
template <int L, bool TO_LDS> __device__ __forceinline__ void hy_conv(LAS unsigned char* lds, const bf16s* zg, float g0, float g1, float g2, float gb, bf16s* outp, int t) {
    constexpr int TB = HyG<L>::TB, CS = HyG<L>::CS, RSB = HyG<L>::RSB, U_OFF = HyG<L>::U_OFF, NJ = L / 32;
    const int lane = t & 63, w = __builtin_amdgcn_readfirstlane(t >> 6), r = lane & 15, q = lane >> 4;
    const int a = 7 - (r & 7);
    const int baseA = a * CS + 2 * (L - 8 - 8 * (r >> 3) + 8 * q) - 32 * TB * w;
    const int baseB = U_OFF + r * RSB + 16 * q;
    f32x4 acc[TB]; bf16x8 F[TB];
#pragma unroll
    for (int ii = 0; ii < TB; ++ii) acc[ii] = (f32x4){0.f, 0.f, 0.f, 0.f};
#pragma unroll
    for (int ii = 2; ii < TB; ++ii) F[ii] = *(const LAS bf16x8*)(lds + baseA - 32 * ii);
    constexpr int PER = TB / 2;
    for (int j0 = 0; j0 < NJ; j0 += PER) {
        const int pA = baseA + 64 * j0, pB = baseB + 64 * j0;
#pragma unroll
        for (int jj = 0; jj < PER; ++jj) {
            F[(0 - 2 * jj) & (TB - 1)] = *(const LAS bf16x8*)(lds + pA + 64 * jj);
            F[(1 - 2 * jj) & (TB - 1)] = *(const LAS bf16x8*)(lds + pA + 64 * jj - 32);
            const bf16x8 Bf = *(const LAS bf16x8*)(lds + pB + 64 * jj);
#pragma unroll
            for (int ii = 0; ii < TB; ++ii) acc[ii] = __builtin_amdgcn_mfma_f32_16x16x32_bf16(F[(ii - 2 * jj) & (TB - 1)], Bf, acc[ii], 0, 0, 0);
        }
    }
    if constexpr (TO_LDS) lds_barrier();
    constexpr int EG = TB < 4 ? TB : 4;
#pragma unroll
    for (int i0 = 0; i0 < TB; i0 += EG) {
        u32x2 gv[EG]; bf16s pv[EG], nx[EG];
#pragma unroll
        for (int u = 0; u < EG; ++u) { const int t0 = 16 * (TB * w + i0 + u) + 4 * q; const bf16s* gp = zg + (size_t)r * L + t0;
            gv[u] = *(const u32x2*)gp; pv[u] = gp[t0 > 0 ? -1 : 0]; nx[u] = gp[t0 + 4 < L ? 4 : 3]; }
#pragma unroll
        for (int u = 0; u < EG; ++u) { const int ii = i0 + u; const int t0 = 16 * (TB * w + ii) + 4 * q;
            const float prev = t0 > 0 ? bf2f(pv[u]) : 0.f, nxt = t0 + 4 < L ? bf2f(nx[u]) : 0.f;
            float z[6]; z[0] = prev; z[1] = bflo(gv[u].x); z[2] = bfhi(gv[u].x); z[3] = bflo(gv[u].y); z[4] = bfhi(gv[u].y); z[5] = nxt;
            float o[4];
#pragma unroll
            for (int e = 0; e < 4; ++e) o[e] = acc[ii][e] * (g0 * z[e] + g1 * z[e + 1] + g2 * z[e + 2] + gb);
            u32x2 wv; wv.x = cvt_pk_bf16(o[0], o[1]); wv.y = cvt_pk_bf16(o[2], o[3]);
            if constexpr (TO_LDS) *(LAS u32x2*)(lds + U_OFF + r * RSB + t0 * 2) = wv; else *(u32x2*)(outp + (size_t)r * L + t0) = wv; }
    }
}
template <int L> __device__ __forceinline__ void hy_unit(const PF& p, int layer, int c, LAS unsigned char* lds, const bf16s* zh, size_t zstride, const bf16s* krt, bf16s* y1t, bf16s* y2t) {
    const int t = tidx();
    const float* cw = p.hy_conv_w + (size_t)layer * 9 * 256; const float* cb = p.hy_conv_b + (size_t)layer * 3 * 256;
    const bf16s* zv = zh + (size_t)c * zstride; const bf16s* z1 = zh + (size_t)(256 + c) * zstride; const bf16s* z2 = zh + (size_t)(512 + c) * zstride;
    hy_build_copies<L>(lds, krt + (size_t)c * 2 * L, t);
    hy_stage_u<L, false>(lds, zv, cw[c], cw[768 + c], cw[1536 + c], cb[c], t);
    lds_barrier();
    for (int q_ = 0; q_ < REP_HYCONV; ++q_) hy_conv<L, true>(lds, z1, cw[256 + c], cw[768 + 256 + c], cw[1536 + 256 + c], cb[256 + c], nullptr, t);
    hy_build_copies<L>(lds, krt + (size_t)(256 + c) * 2 * L, t);
    lds_barrier();
    for (int q_ = 0; q_ < REP_HYCONV; ++q_) hy_conv<L, false>(lds, z2, cw[512 + c], cw[768 + 512 + c], cw[1536 + 512 + c], cb[512 + c], y2t + (size_t)c * zstride, t);
    lds_barrier();
}
#ifndef HY_NA
#define HY_NA 1
#endif
__device__ __forceinline__ void f_hyena(const PF& p, int layer, int with_ctx, LAS unsigned char* lds, int wg0, int nwg) {
    const int me = (int)blockIdx.x - wg0; if (me < 0 || me >= nwg) return;
    if (nwg == 128) {
        constexpr int NB = (256 - 64 * HY_NA) / 64; static_assert(64 * HY_NA + 64 * NB == 256, "HY_NA");
        const int c0 = me < 64 ? me * HY_NA : 64 * HY_NA + (me - 64) * NB, n = me < 64 ? HY_NA : NB;
        for (int c = c0; c < c0 + n; ++c)
            hy_unit<2048>(p, layer, c, lds, p.zh_x, NVF::RX, p.krt_x + (size_t)layer * 2 * 256 * 4096, p.y1t_x, p.y2t_x);
    } else {
        for (int c = me; c < 256; c += nwg)
            hy_unit<2048>(p, layer, c, lds, p.zh_x, NVF::RX, p.krt_x + (size_t)layer * 2 * 256 * 4096, p.y1t_x, p.y2t_x);
    }
    if (with_ctx)
        for (int c = me; c < 256; c += nwg)
            hy_unit<256>(p, layer, c, lds, p.zh_c, NVF::RC, p.krt_c + (size_t)layer * 2 * 256 * 512, p.y1t_c, p.y2t_c);
}
__device__ __forceinline__ void f_gen_krt(const PF& p) {
    const long tid = (long)blockIdx.x * NTHREADS + tidx(), nth = (long)gridDim.x * NTHREADS;
    constexpr int NC = DmF::NC, L = DmF::L, C = DmF::C, FH = DmF::FH;
    const float max_decay = logf(1e-2f) / 0.3f, min_decay = logf(1e-2f) / 1.5f;
    for (long i = tid; i < (long)DmF::DEPTH * (NC + L) * 4 * C; i += nth) {
        const int oc = (int)(i % (4 * C)), ll = (int)((i / (4 * C)) % (NC + L)), layer = (int)(i / ((long)4 * C * (NC + L)));
        const int isx = ll >= NC, Lw = isx ? L : NC, l = isx ? ll - NC : ll, c = oc % C, fdir = oc / C, order = fdir >> 1, bwd = fdir & 1;
        const float tt = (float)l / (float)(Lw - 1);
        const float* h2 = p.hf2 + (i / (4 * C)) * FH;
        const float* w3 = p.hy_w3 + (size_t)layer * FH * 4 * C + oc;
        float acc = 0.f;
        for (int k = 0; k < FH; ++k) acc += h2[k] * w3[(size_t)k * 4 * C];
        const float delta = min_decay + (max_decay - min_decay) * (float)c / (float)(C - 1);
        float v = acc * expf(-tt * fabsf(delta));
        bf16s* kr = (isx ? p.krt_x : p.krt_c) + ((size_t)(layer * 2 + order) * 256 + c) * 2 * Lw;
        if (!bwd) { if (l == 0) v += p.hy_bias[(layer * 2 + order) * C + c]; kr[(Lw - 1) - l] = f2bf(v); }
        else { if (l > 0) kr[(Lw - 1) + l] = f2bf(v); else kr[2 * Lw - 1] = 0; }
    }
}
__device__ __forceinline__ void f_mix2(const PF& p, int layer, int r0, LAS unsigned char* lds) {
    const int t = tidx(), lane = t & 63, wv = t >> 6;
    constexpr int TS = 132;
    LAS float* ssb = (LAS float*)(lds + 256 * TS);
    float gq[32];
#pragma unroll
    for (int k = 0; k < 32; ++k) gq[k] = p.hy_norm_g[layer * 256 + wv * 32 + k];
    for (int tile = r0 / 64 + blockIdx.x; tile < NVF::RALL / 64; tile += gridDim.x) {
        const int R0 = tile * 64; const bool isc = R0 < NVF::RC;
        const bf16s* src = isc ? p.y2t_c + R0 : p.y2t_x + (R0 - NVF::RC); const size_t stride = isc ? NVF::RC : NVF::RX;
        for (int q = t; q < 2048; q += NTHREADS) { const int ch = q >> 3, k = q & 7; const u32x4 v = *(const u32x4*)(src + (size_t)ch * stride + k * 8);
            LAS unsigned* d = (LAS unsigned*)(lds + ch * TS + k * 16); d[0] = v.x; d[1] = v.y; d[2] = v.z; d[3] = v.w; }
        lds_barrier();
        float hv[32]; float ss = 0.f;
#pragma unroll
        for (int k = 0; k < 32; ++k) { hv[k] = bf2f(*(const LAS bf16s*)(lds + (wv * 32 + k) * TS + lane * 2)); ss += hv[k] * hv[k]; }
        ssb[wv * 64 + lane] = ss;
        lds_barrier();
        float tot = 0.f;
#pragma unroll
        for (int k = 0; k < 8; ++k) tot += ssb[k * 64 + lane];
        { const float rstd = 1.0f / sqrtf(tot * (1.0f / 256.f) + 1e-6f); bf16s* m = p.hx + (size_t)(R0 + lane) * DmF::D + wv * 32;
#pragma unroll
          for (int k = 0; k < 32; k += 8) { u32x4 w; w.x = cvt_pk_bf16(hv[k] * rstd * gq[k], hv[k + 1] * rstd * gq[k + 1]); w.y = cvt_pk_bf16(hv[k + 2] * rstd * gq[k + 2], hv[k + 3] * rstd * gq[k + 3]);
              w.z = cvt_pk_bf16(hv[k + 4] * rstd * gq[k + 4], hv[k + 5] * rstd * gq[k + 5]); w.w = cvt_pk_bf16(hv[k + 6] * rstd * gq[k + 6], hv[k + 7] * rstd * gq[k + 7]); *(u32x4*)(m + k) = w; } }
        { const f32x4 na = *(const f32x4*)(p.hg_norm_g + layer * 512 + lane * 8), nb = *(const f32x4*)(p.hg_norm_g + layer * 512 + lane * 8 + 4), gf = *(const f32x4*)(p.fn_norm_g + layer * 256 + lane * 4);
#pragma unroll
          for (int r4 = 0; r4 < 8; r4 += 4) {
            u32x4 wo[4], wb[4], wg[4]; u32x2 wf[4];
#pragma unroll
            for (int u = 0; u < 4; ++u) { const size_t R = (size_t)(R0 + wv * 8 + r4 + u);
                wo[u] = *(const u32x4*)(p.o + R * 512 + lane * 8); wb[u] = *(const u32x4*)(p.ob + R * 512 + lane * 8);
                wg[u] = *(const u32x4*)(p.z + R * NVF::ZS + NVF::OFF_G + lane * 8); wf[u] = *(const u32x2*)(p.yfn + R * 256 + lane * 4); }
#pragma unroll
            for (int u = 0; u < 4; ++u) { const int R = R0 + wv * 8 + r4 + u; bf16s* m = p.hx + (size_t)R * DmF::D;
                f32x4 a = unpack4((u32x2){wo[u].x, wo[u].y}) + unpack4((u32x2){wb[u].x, wb[u].y}), b = unpack4((u32x2){wo[u].z, wo[u].w}) + unpack4((u32x2){wb[u].z, wb[u].w});
                float s2 = a[0] * a[0] + a[1] * a[1] + a[2] * a[2] + a[3] * a[3] + b[0] * b[0] + b[1] * b[1] + b[2] * b[2] + b[3] * b[3];
#pragma unroll
                for (int o = 8; o >= 1; o >>= 1) s2 += __shfl_xor(s2, o);
                const float rstd = 1.0f / sqrtf(s2 * (1.0f / 128.f) + 1e-6f);
                const f32x4 ga = unpack4((u32x2){wg[u].x, wg[u].y}), gb = unpack4((u32x2){wg[u].z, wg[u].w});
                const u32x2 o0 = pack4(a * rstd * na * ga), o1 = pack4(b * rstd * nb * gb);
                *(u32x4*)(m + 256 + lane * 8) = (u32x4){o0.x, o0.y, o1.x, o1.y};
                f32x4 v = unpack4(wf[u]); float s3 = wave_sum(v[0] * v[0] + v[1] * v[1] + v[2] * v[2] + v[3] * v[3]);
                const float rstd3 = 1.0f / sqrtf(s3 * (1.0f / 256.f) + 1e-6f);
                *(u32x2*)(m + 768 + lane * 4) = pack4(v * rstd3 * gf); }
          } }
        lds_barrier();
    }
}
#ifndef REP_HG3
#define REP_HG3 1
#endif
namespace hg {
constexpr int RS = 272, QE_OFF = 0, QM_OFF = QE_OFF + 64 * RS, KM_OFF = QM_OFF + 64 * RS  ,
              KET_OFF = KM_OFF + 160 * RS, PT_OFF = KET_OFF + 128 * 144, TOT_OFF = PT_OFF + 64 * 144  , G_OFF = TOT_OFF + 4096, END = G_OFF + 512;
static_assert(END <= LDS_MISC_OFF, "HGRN LDS image does not fit");
typedef __bf16 bf16x2n __attribute__((ext_vector_type(2)));
__device__ __forceinline__ unsigned pk(float a, float b) { f32x2 v = {a, b}; bf16x2n r = __builtin_convertvector(v, bf16x2n); return __builtin_bit_cast(unsigned, r); }
__device__ __forceinline__ unsigned swp(unsigned x) { return (x >> 16) | (x << 16); }
__device__ __forceinline__ int chunk_rlo(int cc, int b, int dir) {
    const int seg = cc >= 4, ck = seg ? cc - 4 : cc, nck = seg ? 32 : 4, r0 = seg ? NVF::RC + b * 2048 : b * 256;
    return dir ? r0 + 64 * (nck - 1 - ck) : r0 + 64 * ck;
}
}
__device__ __forceinline__ void f_hgrn(const PF& p, LAS unsigned char* lds) {
    using namespace hg;
    const int t = tidx(), lane = t & 63, w = __builtin_amdgcn_readfirstlane(t >> 6), lr = lane & 15, qd = lane >> 4;
    const int sg = w >> 1, hh = w & 1, tau0 = 16 * sg + 8 * hh, d0 = 2 * lane;
    constexpr int ZS = NVF::ZS; constexpr size_t RALL = NVF::RALL;
    for (int ci = (int)gridDim.x - 1 - (int)blockIdx.x; ci < 128; ci += gridDim.x) {
        const int dir = ci & 1, h = (ci >> 1) & 3, b = ci >> 3;
        const bf16s* zq = p.z + NVF::OFF_Q + h * 128 + d0; const bf16s* zl = p.z + (dir ? NVF::OFF_FB : NVF::OFF_FF) + h * 128 + d0;
        const bf16s* vrow = p.vit + (size_t)(h * 128 + 16 * w + lr) * RALL;
        bf16s* outp = (dir ? p.ob : p.o) + h * 128 + 16 * w + 4 * qd;
        f32x4 S[8];
#pragma unroll
        for (int i = 0; i < 8; ++i) S[i] = (f32x4){0.f, 0.f, 0.f, 0.f};
        for (int i = t; i < 64 * 144 / 16; i += NTHREADS) *(LAS u32x4*)(lds + PT_OFF + i * 16) = (u32x4){0u, 0u, 0u, 0u};
#define HG_BAR() do { asm volatile("s_waitcnt lgkmcnt(0)" ::: "memory"); __builtin_amdgcn_s_barrier(); asm volatile("" ::: "memory"); } while (0)
        unsigned nq[8], nl[8]; u32x4 nv[2];
#define HG_LOAD(cc) do { const int rlo_ = chunk_rlo((cc), b, dir); _Pragma("unroll") for (int i_ = 0; i_ < 8; ++i_) { const size_t R_ = dir ? rlo_ + 63 - (tau0 + i_) : rlo_ + tau0 + i_; \
            nq[i_] = *(const unsigned*)(zq + R_ * ZS); nl[i_] = *(const unsigned*)(zl + R_ * ZS); } \
            _Pragma("unroll") for (int kb_ = 0; kb_ < 2; ++kb_) nv[kb_] = *(const u32x4*)(vrow + (dir ? rlo_ + 56 - 32 * kb_ - 8 * qd : rlo_ + 32 * kb_ + 8 * qd)); } while (0)
        unsigned cq[8], cl[8]; bf16x8 Vf[2];
#define HG_TAKE() do { _Pragma("unroll") for (int i_ = 0; i_ < 8; ++i_) { cq[i_] = nq[i_]; cl[i_] = nl[i_]; } \
            _Pragma("unroll") for (int kb_ = 0; kb_ < 2; ++kb_) { u32x4 x_ = nv[kb_]; if (dir) x_ = (u32x4){swp(x_.w), swp(x_.z), swp(x_.y), swp(x_.x)}; Vf[kb_] = __builtin_bit_cast(bf16x8, x_); } } while (0)
        HG_LOAD(0);
        HG_TAKE();
        HG_BAR();
        for (int cc = 0; cc < 36; ++cc) {
            const int Rlo = chunk_rlo(cc, b, dir);
            if (cc + 1 < 36) HG_LOAD(cc + 1);
            float c0[8], c1[8];
            { float a0 = 0.f, a1 = 0.f;
#pragma unroll
              for (int i = 0; i < 8; ++i) { a0 += bflo(cl[i]); a1 += bfhi(cl[i]); c0[i] = a0; c1[i] = a1; }
              *(LAS f32x2*)(lds + TOT_OFF + (w * 128 + d0) * 4) = (f32x2){a0, a1}; }
            HG_BAR();
            for (int rq_ = 0; rq_ < REP_HG3; ++rq_) { asm volatile("" ::: "memory");
            { f32x2 T[8];
#pragma unroll
              for (int j = 0; j < 8; ++j) T[j] = *(const LAS f32x2*)(lds + TOT_OFF + (j * 128 + d0) * 4);
              f32x2 pre[9]; pre[0] = (f32x2){0.f, 0.f};
#pragma unroll
              for (int j = 0; j < 8; ++j) pre[j + 1] = pre[j] + T[j];
              const f32x2 rt = sg == 0 ? pre[0] : sg == 1 ? pre[2] : sg == 2 ? pre[4] : pre[6];
              const f32x2 hoff = hh ? (sg == 0 ? T[0] : sg == 1 ? T[2] : sg == 2 ? T[4] : T[6]) : (f32x2){0.f, 0.f};
              const f32x2 bend = pre[8];
              const f32x2 Eoff = {__expf(rt[0]), __expf(rt[1])}, Fend = {__expf(bend[0] - rt[0]), __expf(bend[1] - rt[1])};
              const f32x2 F1 = {__expf(pre[2][0] - rt[0]), __expf(pre[2][1] - rt[1])}, F2 = {__expf(pre[4][0] - rt[0]), __expf(pre[4][1] - rt[1])}, F3 = {__expf(pre[6][0] - rt[0]), __expf(pre[6][1] - rt[1])};
              const int tl0 = sg == 0 ? 0 : sg == 1 ? 4 : sg == 2 ? 7 : 9;
              float ke0[8], ke1[8], kv0[8], kv1[8];
#pragma unroll
              for (int i = 0; i < 8; ++i) { const int tau = tau0 + i, trow = 8 * hh + i;
                  const float q0 = bflo(cq[i]), q1 = bfhi(cq[i]);
                  const float k0 = 1.f - __expf(bflo(cl[i])), k1 = 1.f - __expf(bfhi(cl[i]));
                  const float A0 = __expf(hoff[0] + c0[i]), A1 = __expf(hoff[1] + c1[i]);
                  const float ki0 = k0 * __builtin_amdgcn_rcpf(fmaxf(A0, 1.8e-35f)), ki1 = k1 * __builtin_amdgcn_rcpf(fmaxf(A1, 1.8e-35f));
                  const float qa0 = q0 * A0, qa1 = q1 * A1;
                  *(LAS unsigned*)(lds + QM_OFF + tau * RS + d0 * 2) = pk(qa0, qa1);
                  *(LAS unsigned*)(lds + QE_OFF + tau * RS + d0 * 2) = pk(qa0 * Eoff[0], qa1 * Eoff[1]);
                  *(LAS unsigned*)(lds + KM_OFF + (tl0 * 16 + trow) * RS + d0 * 2) = pk(ki0, ki1);
                  kv0[i] = ki0; kv1[i] = ki1; ke0[i] = ki0 * Fend[0]; ke1[i] = ki1 * Fend[1]; }
              if (sg < 1) {
#pragma unroll
                  for (int i = 0; i < 8; ++i) *(LAS unsigned*)(lds + KM_OFF + ((tl0 + 1 - sg) * 16 + 8 * hh + i) * RS + d0 * 2) = pk(kv0[i] * F1[0], kv1[i] * F1[1]); }
              if (sg < 2) {
#pragma unroll
                  for (int i = 0; i < 8; ++i) *(LAS unsigned*)(lds + KM_OFF + ((tl0 + 2 - sg) * 16 + 8 * hh + i) * RS + d0 * 2) = pk(kv0[i] * F2[0], kv1[i] * F2[1]); }
              if (sg < 3) {
#pragma unroll
                  for (int i = 0; i < 8; ++i) *(LAS unsigned*)(lds + KM_OFF + ((tl0 + 3 - sg) * 16 + 8 * hh + i) * RS + d0 * 2) = pk(kv0[i] * F3[0], kv1[i] * F3[1]); }
              u32x4 x0, x1; x0.x = pk(ke0[0], ke0[1]); x0.y = pk(ke0[2], ke0[3]); x0.z = pk(ke0[4], ke0[5]); x0.w = pk(ke0[6], ke0[7]); x1.x = pk(ke1[0], ke1[1]); x1.y = pk(ke1[2], ke1[3]); x1.z = pk(ke1[4], ke1[5]); x1.w = pk(ke1[6], ke1[7]);
              *(LAS u32x4*)(lds + KET_OFF + d0 * 144 + tau0 * 2) = x0; *(LAS u32x4*)(lds + KET_OFF + (d0 + 1) * 144 + tau0 * 2) = x1;
              if (w == 0) *(LAS f32x2*)(lds + G_OFF + d0 * 4) = (f32x2){__expf(bend[0]), __expf(bend[1])}; }
            }
            HG_BAR();
            for (int tl = w; tl < 10; tl += 8) {
                const int si = (int)((0x3221110000ull >> (4 * tl)) & 0xF), ti = (int)((0x3323213210ull >> (4 * tl)) & 0xF);
                f32x4 acc = (f32x4){0.f, 0.f, 0.f, 0.f};
#pragma unroll
                for (int kb = 0; kb < 4; ++kb) { const bf16x8 A = *(const LAS bf16x8*)(lds + KM_OFF + (16 * tl + lr) * RS + (32 * kb + 8 * qd) * 2); const bf16x8 B = *(const LAS bf16x8*)(lds + QM_OFF + (16 * ti + lr) * RS + (32 * kb + 8 * qd) * 2);
                    acc = __builtin_amdgcn_mfma_f32_16x16x32_bf16(A, B, acc, 0, 0, 0); }
                if (si == ti) {
#pragma unroll
                    for (int e = 0; e < 4; ++e) if (4 * qd + e > lr) acc[e] = 0.f; }
                u32x2 wv; wv.x = pk(acc[0], acc[1]); wv.y = pk(acc[2], acc[3]);
                *(LAS u32x2*)(lds + PT_OFF + (16 * ti + lr) * 144 + (16 * si + 4 * qd) * 2) = wv;
            }
            bf16x8 As[4];
#pragma unroll
            for (int kb = 0; kb < 4; ++kb) { u32x4 x; x.x = pk(S[2 * kb][0], S[2 * kb][1]); x.y = pk(S[2 * kb][2], S[2 * kb][3]); x.z = pk(S[2 * kb + 1][0], S[2 * kb + 1][1]); x.w = pk(S[2 * kb + 1][2], S[2 * kb + 1][3]); As[kb] = __builtin_bit_cast(bf16x8, x); }
            HG_BAR();
#pragma unroll
            for (int ti = 0; ti < 4; ++ti) {
                f32x4 acc = (f32x4){0.f, 0.f, 0.f, 0.f};
#pragma unroll
                for (int kb = 0; kb < 4; ++kb) { const u32x2 lo = *(const LAS u32x2*)(lds + QE_OFF + (16 * ti + lr) * RS + (32 * kb + 4 * qd) * 2), hi = *(const LAS u32x2*)(lds + QE_OFF + (16 * ti + lr) * RS + (32 * kb + 16 + 4 * qd) * 2);
                    const bf16x8 B = __builtin_bit_cast(bf16x8, (u32x4){lo.x, lo.y, hi.x, hi.y}); acc = __builtin_amdgcn_mfma_f32_16x16x32_bf16(As[kb], B, acc, 0, 0, 0); }
#pragma unroll
                for (int kb = 0; kb < 2; ++kb) if (kb == 0 || ti >= 2) { const bf16x8 B = *(const LAS bf16x8*)(lds + PT_OFF + (16 * ti + lr) * 144 + (32 * kb + 8 * qd) * 2); acc = __builtin_amdgcn_mfma_f32_16x16x32_bf16(Vf[kb], B, acc, 0, 0, 0); }
                const int tt = 16 * ti + lr; const size_t R = dir ? Rlo + 63 - tt : Rlo + tt;
                u32x2 wv; wv.x = pk(acc[0], acc[1]); wv.y = pk(acc[2], acc[3]);
                *(u32x2*)(outp + R * 512) = wv;
            }
#pragma unroll
            for (int i = 0; i < 8; ++i) { const f32x4 g4 = *(const LAS f32x4*)(lds + G_OFF + (16 * i + 4 * qd) * 4); f32x4 acc = S[i] * g4;
#pragma unroll
                for (int kb = 0; kb < 2; ++kb) { const bf16x8 A = *(const LAS bf16x8*)(lds + KET_OFF + (16 * i + lr) * 144 + (32 * kb + 8 * qd) * 2); acc = __builtin_amdgcn_mfma_f32_16x16x32_bf16(A, Vf[kb], acc, 0, 0, 0); }
                S[i] = acc; }
            if (cc + 1 < 36) HG_TAKE();
        }
#undef HG_TAKE
#undef HG_LOAD
#undef HG_BAR
        __syncthreads();
    }
}
__device__ __forceinline__ void f_ada(const PF& p, LAS unsigned char* lds) {
    const int t = tidx(), lane = t & 63, wv = t >> 6;
    constexpr int D = DmF::D, NR = DmF::B + 1, NITEM = DmF::DEPTH * 6 * D / 64;
    if ((int)blockIdx.x >= NITEM) return;
    LAS float* S = (LAS float*)lds;
    LAS float* PR = S + NR * D;
    for (int i = t; i < NR * D; i += NTHREADS) { const int r = i / D, k = i % D; const float c = r < DmF::B ? p.c[r * D + k] : p.c_ctx[k]; S[i] = c / (1.f + __expf(-c)); }
    __syncthreads();
    for (int q = blockIdx.x; q < NITEM; q += gridDim.x) {
        const int layer = q / (6 * D / 64), j = (q % (6 * D / 64)) * 64 + lane;
        const float* w = p.ada_w + (size_t)layer * D * 6 * D + j;
        float acc[NR];
#pragma unroll
        for (int r = 0; r < NR; ++r) acc[r] = 0.f;
#pragma unroll 2
        for (int k = wv * 128; k < wv * 128 + 128; k += 8) {
            float wq[8];
#pragma unroll
            for (int u = 0; u < 8; ++u) wq[u] = w[(size_t)(k + u) * 6 * D];
#pragma unroll
            for (int u = 0; u < 8; u += 4)
#pragma unroll
                for (int r = 0; r < NR; ++r) { const f32x4 s4 = *(const LAS f32x4*)(S + r * D + k + u); acc[r] += s4[0] * wq[u] + s4[1] * wq[u + 1] + s4[2] * wq[u + 2] + s4[3] * wq[u + 3]; }
        }
#pragma unroll
        for (int r = 0; r < NR; ++r) PR[(wv * NR + r) * 64 + lane] = acc[r];
        __syncthreads();
        for (int i = t; i < NR * 64; i += NTHREADS) { const int r = i >> 6, l2 = i & 63; float sum = 0.f;
#pragma unroll
            for (int w8 = 0; w8 < 8; ++w8) sum += PR[(w8 * NR + r) * 64 + l2];
            const int jj = (q % (6 * D / 64)) * 64 + l2; p.mod[((size_t)layer * NR + r) * 6 * D + jj] = sum + p.ada_b[layer * 6 * D + jj]; }
        __syncthreads();
    }
}
__device__ __forceinline__ void f_gen_postab(const PF& p, float* postab) {
    const long tid = (long)blockIdx.x * NTHREADS + tidx(), nth = (long)gridDim.x * NTHREADS;
    constexpr int D = DmF::D, L = DmF::L, Q4 = D / 4;
    for (long i = tid; i < (long)L * (D / 4); i += nth) {
        const int l = (int)(i / (D / 4)), k = (int)(i % (D / 4)) * 4, wq = k / Q4;
        const float pos = (float)(wq < 2 ? l / DmF::GRID_W : l % DmF::GRID_W);
        f32x4 pe;
#pragma unroll
        for (int e = 0; e < 4; ++e) { const int ix = (k + e) % Q4; const float omega = 1.0f / powf(10000.0f, (float)ix / (float)Q4); const float a = pos * omega; pe[e] = (wq & 1) ? cosf(a) : sinf(a); }
        *(f32x4*)(postab + (size_t)l * D + k) = pe;
    }
}
__device__ __forceinline__ void f_gen_krt3(const PF& p, LAS unsigned char* lds) {
    const int t = tidx(), cl = t & 63, lg = t >> 6;
    constexpr int NC = DmF::NC, L = DmF::L, C = DmF::C, FH = DmF::FH, NLB = (NC + L) / 64, NOB = 4 * C / 64;
    const float max_decay = logf(1e-2f) / 0.3f, min_decay = logf(1e-2f) / 1.5f;
    LAS float* T = (LAS float*)lds;
    constexpr int NCOMBO = DmF::DEPTH * NOB;
    const int combo = (int)blockIdx.x % NCOMBO, grp = (int)blockIdx.x / NCOMBO, ngrp = ((int)gridDim.x - combo + NCOMBO - 1) / NCOMBO;
    const int layer = combo / NOB, ob = combo % NOB, oc = ob * 64 + cl, c = oc % C;
    float wr[FH];
    { const float* w3 = p.hy_w3 + (size_t)layer * FH * 4 * C + oc;
#pragma unroll
      for (int k = 0; k < FH; ++k) wr[k] = w3[(size_t)k * 4 * C]; }
    for (int lb = grp; lb < NLB; lb += ngrp) {
        const int isx = lb >= NC / 64, Lw = isx ? L : NC, l0 = (isx ? lb - NC / 64 : lb) * 64;
        const float delta = fabsf(min_decay + (max_decay - min_decay) * (float)c / (float)(C - 1));
#pragma unroll
        for (int i = 0; i < 8; ++i) { const int l = l0 + lg * 8 + i; const float* h2 = p.hf2 + ((size_t)layer * (NC + L) + lb * 64 + lg * 8 + i) * FH;
            float acc = 0.f;
#pragma unroll
            for (int k = 0; k < FH; k += 4) { const f32x4 h = *(const f32x4*)(h2 + k); acc += h[0] * wr[k] + h[1] * wr[k + 1] + h[2] * wr[k + 2] + h[3] * wr[k + 3]; }
            T[cl * 65 + lg * 8 + i] = acc * expf(-((float)l / (float)(Lw - 1)) * delta); }
        lds_barrier();
        { const int c2 = t >> 3, sg = t & 7, oc2 = ob * 64 + c2, cc = oc2 % C, fdir = oc2 / C, order = fdir >> 1, bwd = fdir & 1;
          bf16s* kr = (isx ? p.krt_x : p.krt_c) + ((size_t)(layer * 2 + order) * 256 + cc) * 2 * Lw;
#pragma unroll
          for (int i = 0; i < 8; ++i) { const int l = l0 + sg * 8 + i; float v = T[c2 * 65 + sg * 8 + i];
              if (!bwd) { if (l == 0) v += p.hy_bias[(layer * 2 + order) * C + cc]; kr[(Lw - 1) - l] = f2bf(v); }
              else { if (l > 0) kr[(Lw - 1) + l] = f2bf(v); else kr[2 * Lw - 1] = 0; } } }
        lds_barrier();
    }
}


__device__ __forceinline__ void f_fnet_nyq(const PF& p, int layer, int wg0) {
    const int me = (int)blockIdx.x - wg0; if (me < 0 || me >= 64) return;
    const int t = tidx(), lane = t & 63, w = t >> 6;
    const float sx = 1.0f / sqrtf(64.f * 2048.f);
#pragma unroll
    for (int h = 0; h < 2; ++h) {
        u32x4 v[4][4];
#pragma unroll
        for (int j = 0; j < 4; ++j) { const bf16s* src = p.pq_x + (size_t)(me * 64 + w * 8 + h * 4 + j) * 4096;
#pragma unroll
            for (int q = 0; q < 4; ++q) v[j][q] = *(const u32x4*)(src + q * 512 + lane * 8); }
#pragma unroll
        for (int j = 0; j < 4; ++j) { float a = 0.f;
#pragma unroll
            for (int q = 0; q < 4; ++q) { const u32x4 x = v[j][q]; a += (bflo(x.x) - bfhi(x.x)) + (bflo(x.y) - bfhi(x.y)) + (bflo(x.z) - bfhi(x.z)) + (bflo(x.w) - bfhi(x.w)); }
            a = wave_sum(a);
            const int rc = me * 64 + w * 8 + h * 4 + j, b = rc >> 8, c = rc & 255;
            if (lane == 0) p.yfn[(size_t)(NVF::RC + b * 2048 + 1024) * 256 + c] = f2bf(a * sx + p.fn_b[layer * 256 + c]); }
    }
}
#define XB_TMO      128
#define XB_XCNT(j)  (256  + 64 * (j))
#define XB_XSUB(j)  (1280 + 64 * (j))
#define XB_XGEN(j)  (2304 + 64 * (j))
#define XB_TOP      3328
#define XB_TOPGEN   3392
#define XCD_BAR_WORDS 3456
#define XB_SPIN_CAP (1u << 21)

__device__ __forceinline__ unsigned xb_ld(unsigned* p)              { return __hip_atomic_load(p, __ATOMIC_RELAXED, __HIP_MEMORY_SCOPE_AGENT); }
__device__ __forceinline__ unsigned xb_add(unsigned* p, unsigned v) { return __hip_atomic_fetch_add(p, v, __ATOMIC_RELAXED, __HIP_MEMORY_SCOPE_AGENT); }
__device__ __forceinline__ unsigned xb_xcc_id() { return (unsigned)__builtin_amdgcn_s_getreg((3 << 11) | 20) & 0xFu; }
#define XB_SPIN(cond, bar) do { unsigned _sp = 0; while (cond) { __builtin_amdgcn_s_sleep(1); \
    if ((++_sp & 255u) == 0u) { if (xb_ld(&(bar)[XB_TMO])) break; if (_sp > XB_SPIN_CAP) { atomicAdd(&(bar)[XB_TMO], 1u); break; } } } } while (0)

struct XcdBarrier { unsigned* bar; unsigned x; volatile LAS unsigned* st; };

__device__ __forceinline__ XcdBarrier xcd_barrier_post(unsigned* bar, volatile LAS unsigned* st) {
    XcdBarrier b; b.bar = bar; b.x = xb_xcc_id(); b.st = st;
    if (threadIdx.x == 0) (void)xb_add(&bar[XB_XCNT(b.x)], 1u);
    return b;
}
__device__ __forceinline__ void xcd_barrier_complete(unsigned* bar, unsigned x, unsigned& nloc, unsigned& nx) {
    const unsigned G = gridDim.x * gridDim.y * gridDim.z;
    unsigned sum, cnt, mine, sp = 0u;
    for (;;) {
        sum = 0u; cnt = 0u; mine = 0u;
#pragma unroll
        for (unsigned j = 0; j < 16; ++j) { const unsigned c = xb_ld(&bar[XB_XCNT(j)]); sum += c; cnt += (c > 0u) ? 1u : 0u; mine = (j == x) ? c : mine; }
        if (sum == G) break;
        __builtin_amdgcn_s_sleep(1);
        if ((++sp & 255u) == 0u) { if (xb_ld(&bar[XB_TMO])) break; if (sp > XB_SPIN_CAP) { atomicAdd(&bar[XB_TMO], 1u); break; } }
    }
    nloc = mine > 0u ? mine : 1u; nx = cnt > 0u ? cnt : 1u;
}
__device__ __forceinline__ void xcd_barrier(const XcdBarrier& b) {
    asm volatile("s_waitcnt vmcnt(0)" ::: "memory");
    __syncthreads();
    if (threadIdx.x == 0) {
        unsigned* bar = b.bar;
        __builtin_amdgcn_s_waitcnt(0);
        unsigned nloc = b.st[0], nx = b.st[1];
        if (nloc == 0u) { xcd_barrier_complete(bar, b.x, nloc, nx); b.st[0] = nloc; b.st[1] = nx; }
        const unsigned old = xb_add(&bar[XB_XSUB(b.x)], 1u);
        const unsigned gen = old / nloc;
        if (old + 1u == (gen + 1u) * nloc) {
            __builtin_amdgcn_fence(__ATOMIC_RELEASE, "agent");
            asm volatile("s_waitcnt vmcnt(0)" ::: "memory");
            const unsigned og = xb_add(&bar[XB_TOP], 1u);
            const unsigned tg = og / nx;
            if (og + 1u == (tg + 1u) * nx) xb_add(&bar[XB_TOPGEN], 1u);
            else XB_SPIN(xb_ld(&bar[XB_TOPGEN]) == tg, bar);
            __builtin_amdgcn_fence(__ATOMIC_ACQUIRE, "agent");
            xb_add(&bar[XB_XGEN(b.x)], 1u);
            asm volatile("s_waitcnt vmcnt(0)" ::: "memory");
        } else {
            XB_SPIN(xb_ld(&bar[XB_XGEN(b.x)]) == gen, bar);
            __builtin_amdgcn_fence(__ATOMIC_ACQUIRE, "agent");
            asm volatile("s_waitcnt vmcnt(0)" ::: "memory");
        }
    }
    __syncthreads();
}

constexpr int NPH = 2 + 9 * DmF::DEPTH + 1;
#ifndef ONE_LAUNCH
#define ONE_LAUNCH 1
#endif

#ifndef REP_ADA
#define REP_ADA 1
#endif
#ifndef REP_PA
#define REP_PA 1
#endif
#ifndef REP_INIT
#define REP_INIT 1
#endif
#ifndef REP_DFT
#define REP_DFT 1
#endif
#ifndef REP_PB
#define REP_PB 1
#endif
#ifndef REP_KRT
#define REP_KRT 1
#endif
#ifndef REP_DOWN
#define REP_DOWN 1
#endif
#ifndef REP_WOUT
#define REP_WOUT 1
#endif
#ifndef REP_NM2N
#define REP_NM2N 1
#endif
#ifndef REP_BAR
#define REP_BAR 0
#endif
#ifndef REP_PRO
#define REP_PRO 1
#endif
#ifndef REP_NM1
#define REP_NM1 1
#endif
#ifndef REP_INPROJ
#define REP_INPROJ 1
#endif
#ifndef REP_FNET
#define REP_FNET 1
#endif
#ifndef REP_HGRN
#define REP_HGRN 1
#endif
#ifndef REP_HYENA
#define REP_HYENA 1
#endif
#ifndef REP_MIX
#define REP_MIX 1
#endif
#ifndef REP_CVTMOE
#define REP_CVTMOE 1
#endif
#ifndef REP_GATHER
#define REP_GATHER 1
#endif
#ifndef REP_GATEUP
#define REP_GATEUP 1
#endif
#ifndef FAST_HGRN
#define FAST_HGRN 1
#endif
#ifndef FAST_GEMM
#define FAST_GEMM 1
#endif
struct KArgs { PF p; FastWs f; unsigned* bar; int lo, hi; };
typedef const __attribute__((address_space(4))) KArgs* KP;

__global__ void __launch_bounds__(NTHREADS, 2) mega(KArgs a) {
    extern __shared__ __attribute__((aligned(16))) unsigned char lds_raw[];
    LAS unsigned char* lds = (LAS unsigned char*)lds_raw;
    volatile LAS unsigned* xbw = (volatile LAS unsigned*)(lds + LDS_MISC_OFF);
    if (threadIdx.x < 4) xbw[threadIdx.x] = 0u;
    __syncthreads();
    const int lo = a.lo, hi = a.hi;
    XcdBarrier bar; bar.bar = a.bar; bar.x = 0; bar.st = xbw;
    if (hi - lo > 1) bar = xcd_barrier_post(a.bar, xbw);
    int ph = 0;
#define PHASE(...) do { int lo_ = lo, hi_ = hi; asm volatile("" : "+s"(lo_), "+s"(hi_)); if (ph >= lo_ && ph < hi_) { { KP kp_ = (KP)__builtin_amdgcn_kernarg_segment_ptr(); asm volatile("" : "+s"(kp_)); PF p; FastWs f; __builtin_memcpy(&p, &kp_->p, sizeof(PF)); __builtin_memcpy(&f, &kp_->f, sizeof(FastWs)); (void)f; \
        const long tid = (long)blockIdx.x * NTHREADS + tidx(), nth = (long)gridDim.x * NTHREADS; (void)tid; (void)nth; __VA_ARGS__; } if (ph + 1 < hi_) xcd_barrier(bar); } ++ph; } while (0)
    for (int rep_ = 0; rep_ < REP_PRO; ++rep_) { if (rep_) ph -= 2;
    PHASE({ for (int q_ = 0; q_ < REP_ADA; ++q_) f_ada(p, lds); for (int q_ = 0; q_ < REP_PA; ++q_) NVF::p_pro_a(p, tid, nth); for (int q_ = 0; q_ < REP_INIT; ++q_) f_gen_postab(p, (float*)p.z); for (int q_ = 0; q_ < REP_DFT; ++q_) f_gen_dft(p, lds); });
    PHASE({ for (int q_ = 0; q_ < REP_PB; ++q_) NVF::p_pro_b(p, tid, nth); });
    }
    for (int q_ = 0; q_ < REP_BAR; ++q_) { PHASE({}); --ph; }
    for (int layer = 0; layer < DmF::DEPTH; ++layer) {
        const int last = layer == DmF::DEPTH - 1, r0 = last ? NVF::RC : 0;
        PHASE({ for (int rep_ = 0; rep_ < REP_NM1; ++rep_) { if (layer == 0) f_normmod<false, false, true>(p, f.hxs, layer, 0, 0, lds, (const float*)p.z); else f_normmod<false, true>(p, f.hxs, layer, 0, 0, lds); f_cvt_inout(p, f, layer, lds); }
                if (layer == 0) { for (int q_ = 0; q_ < REP_KRT; ++q_) f_gen_krt3(p, lds); } });
        PHASE({ for (int rep_ = 0; rep_ < REP_INPROJ; ++rep_) f_inproj(p, f, layer, last, lds); });
        PHASE({ const bool g256 = gridDim.x == 256;
                for (int rep_ = 0; rep_ < REP_FNET; ++rep_) { f_fnet(p, layer, !last, lds); f_fnet_nyq(p, layer, 64); }
                for (int rep_ = 0; rep_ < REP_HGRN; ++rep_) f_hgrn(p, lds);
                for (int rep_ = 0; rep_ < REP_HYENA; ++rep_) f_hyena(p, layer, !last, lds, 0, g256 ? 128 : (int)gridDim.x); });
        PHASE({ for (int rep_ = 0; rep_ < REP_MIX; ++rep_) f_mix2(p, layer, r0, lds); });
        PHASE({ for (int q_ = 1; q_ < REP_WOUT; ++q_) f_wout(p, f, layer, r0, lds, 0.f); f_wout(p, f, layer, r0, lds);
                { const int G_ = (int)gridDim.x, j_ = (int)blockIdx.x >> 3, x_ = (int)blockIdx.x & 7; int rank_ = (int)blockIdx.x, nw_ = G_;
                  if (!last && G_ == 256) { rank_ = j_ < 8 ? -1 : (j_ - 8) * 8 + x_; nw_ = 192; }
                  for (int rep_ = 0; rep_ < REP_CVTMOE; ++rep_) { NVF::p_moe_reset(p, tid, nth); f_cvt_moe(p, f, layer, lds, rank_, nw_); } } });
        PHASE({ for (int q_ = 1; q_ < REP_NM2N; ++q_) f_normmod<false, false>(p, f.hxs, layer, 1, r0, lds); f_normmod<true, false>(p, f.hxs, layer, 1, r0, lds); });
        PHASE({ for (int rep_ = 0; rep_ < REP_GATHER; ++rep_) f_place_gather(p, f, r0); });
        PHASE({ for (int rep_ = 0; rep_ < REP_GATEUP; ++rep_) f_gateup(p, f, lds); });
        PHASE({ for (int q_ = 0; q_ < REP_DOWN; ++q_) f_down(p, f, layer, lds); });
    }
    PHASE(f_final(p, f.hxs));
#undef PHASE
}

static inline size_t al256(size_t x) { return (x + 255) & ~(size_t)255; }
extern "C" void kernel_launch(void* const* d_in, const int* in_sizes, int n_in, void* d_out, int out_size, void* d_ws, size_t ws_size, hipStream_t stream) {
    typedef DmF Dm; constexpr size_t RALL = NVF::RALL, D = Dm::D;
    KArgs a{};
    PF& p = a.p;
    const float** ip = (const float**)&p.x;
    for (int i = 0; i < 31; ++i) ip[i] = (const float*)d_in[i];
    p.out = (float*)d_out;
    size_t off = 0; char* ws = (char*)d_ws;
    auto carve = [&](size_t bytes) { char* r = ws + off; off += al256(bytes); return r; };
    unsigned* ctl = (unsigned*)carve(65536);
    a.bar = ctl; p.cnt = (int*)(ctl + 8192);
    p.mod = (float*)carve((size_t)Dm::DEPTH * (Dm::B + 1) * 6 * D * 4);
    p.lbv = (float*)carve((size_t)Dm::DEPTH * 2 * Dm::DHG * 4);
    p.wcs = (float*)carve((size_t)Dm::DEPTH * Dm::G * Dm::GD * 2 * Dm::GD * 4);
    p.wfn = (float*)carve((size_t)Dm::DEPTH * D * 2 * Dm::CFN * 4);
    p.hf1 = (float*)carve((size_t)Dm::DEPTH * (Dm::NC + Dm::L) * Dm::FH * 4);
    p.hf2 = (float*)carve((size_t)Dm::DEPTH * (Dm::NC + Dm::L) * Dm::FH * 4);
    p.hfil = nullptr;
    p.krt_x = (bf16s*)carve((size_t)Dm::DEPTH * 2 * Dm::C * 2 * Dm::L * 2); p.krt_c = (bf16s*)carve((size_t)Dm::DEPTH * 2 * Dm::C * 2 * Dm::NC * 2);
#if XBF16
    p.cw = nullptr;
#else
    p.cw = (float*)carve((size_t)NVF::RC * D * 4);
#endif
    p.rs = (float*)carve(RALL * 4);
#if XBF16
    p.xb = (bf16s*)carve(RALL * D * 2);
    p.hx = (bf16s*)d_out;
#else
    p.xb = nullptr; p.hx = (bf16s*)carve(RALL * D * 2);
#endif
    p.dft_x = (bf16s*)carve((size_t)2048 * 4096 * 2); p.dft_c = (bf16s*)carve((size_t)256 * 512 * 2);
    p.z = (bf16s*)carve(RALL * NVF::ZS * 2);
    p.zh_c = (bf16s*)carve((size_t)3 * Dm::C * NVF::RC * 2); p.zh_x = (bf16s*)carve((size_t)3 * Dm::C * NVF::RX * 2);
    p.pq_c = (bf16s*)carve((size_t)NVF::RC * Dm::CFN * 2 * 2); p.pq_x = (bf16s*)carve((size_t)NVF::RX * Dm::CFN * 2 * 2);
    p.uv = nullptr;
    p.y1 = nullptr; p.y2 = nullptr;
    p.y1t_c = p.hx; p.y1t_x = p.hx + (size_t)Dm::C * NVF::RC;
    p.y2t_c = (bf16s*)carve((size_t)Dm::C * NVF::RC * 2); p.y2t_x = (bf16s*)carve((size_t)Dm::C * NVF::RX * 2);
    p.o = (bf16s*)carve(RALL * Dm::DHG * 2); p.ob = (bf16s*)carve(RALL * Dm::DHG * 2); p.vit = (bf16s*)carve(RALL * Dm::DHG * 2);
    p.yfn = (bf16s*)carve(RALL * Dm::CFN * 2);
    p.ridx = (int*)carve(RALL * 2 * 4);
    p.rgp = (float*)carve(RALL * 2 * 4);
    p.perm = (int*)carve((2 * RALL + Dm::E * Dm::MPAD) * 4);
    p.rrank = (int*)carve(RALL * 2 * 4); p.rpos = (int*)carve(RALL * 2 * 4); p.wgbase = (int*)carve(4096 * 16 * 4);
    { char* big = (char*)p.z; const size_t npos = 2 * RALL + Dm::E * Dm::MPAD;
      a.f.hxs = (bf16s*)big; p.hmid = (bf16s*)(big + al256(npos * D * 2));
      a.f.wt_gu = (bf16s*)((char*)p.hmid + al256(npos * Dm::DE * 2)); a.f.wt_d = a.f.wt_gu + (size_t)Dm::E * 1024 * D;
      if ((char*)(a.f.wt_d + (size_t)Dm::E * D * Dm::DE) > (char*)(p.yfn + RALL * Dm::CFN)) { fprintf(stderr, "kernel_launch: MoE overlay does not fit\n"); return; } }
    a.f.wt_in = (bf16s*)carve((size_t)Dm::ZW * D * 2);
    a.f.wt_out = (bf16s*)carve((size_t)D * D * 2);
    if (off > ws_size || n_in != 31) { fprintf(stderr, "kernel_launch: workspace too small (%zu needed, %zu given) or n_in %d != 31; nothing launched\n", off, ws_size, n_in); return; }
    static int grid = 0;
    if (grid == 0) {
        int dev = 0, cus = 0, per_cu = 0;
        hipGetDevice(&dev); hipDeviceGetAttribute(&cus, hipDeviceAttributeMultiprocessorCount, dev);
        if (hipFuncSetAttribute((const void*)mega, hipFuncAttributeMaxDynamicSharedMemorySize, LDS_BYTES) != hipSuccess) { fprintf(stderr, "kernel_launch: hipFuncSetAttribute failed\n"); grid = -1; return; }
        hipOccupancyMaxActiveBlocksPerMultiprocessor(&per_cu, (const void*)mega, NTHREADS, LDS_BYTES);
        (void)hipGetLastError();
        if (per_cu < 1) fprintf(stderr, "kernel_launch: occupancy query says %d blocks per CU\n", per_cu);
        grid = cus > 0 ? cus : 256;
    }
    if (grid < 0) return;
    hipMemsetAsync(ctl, 0, 65536, stream);
#if ONE_LAUNCH
    a.lo = 0; a.hi = NPH;
    hipLaunchKernelGGL(mega, dim3(grid), dim3(NTHREADS), LDS_BYTES, stream, a);
#else
    for (int k = 0; k < NPH; ++k) { a.lo = k; a.hi = k + 1; hipLaunchKernelGGL(mega, dim3(grid), dim3(NTHREADS), LDS_BYTES, stream, a); }
#endif
}
```

```cpp
#include <hip/hip_runtime.h>
#include <cstdio>
#include <cstdint>
#include <stdint.h>
#include <math.h>

#ifndef HD
#ifdef CPU_SHIM
#define HD
#else
#define HD __host__ __device__ __forceinline__
#endif
#endif

typedef unsigned short bf16s;
HD float bf2f(bf16s v) { union { unsigned u; float f; } c; c.u = ((unsigned)v) << 16; return c.f; }
HD bf16s f2bf(float f) { union { unsigned u; float f; } c; c.f = f; unsigned u = c.u; u += 0x7FFFu + ((u >> 16) & 1u); return (bf16s)(u >> 16); }
HD float ldv(const float* p) { return *p; }
HD float ldv(const bf16s* p) { return bf2f(*p); }
HD void stv(float* p, float v) { *p = v; }
HD void stv(bf16s* p, float v) { *p = f2bf(v); }
HD float silu_f(float x) { return x / (1.f + expf(-x)); }
HD float sigm_f(float x) { return 1.f / (1.f + expf(-x)); }

#ifdef CPU_SHIM
static inline int atomic_add_i(int* p, int v) { int o = *p; *p = o + v; return o; }
static inline void atomic_add_f(float* p, float v) { *p += v; }
#else
__device__ __forceinline__ int atomic_add_i(int* p, int v) { return atomicAdd(p, v); }
__device__ __forceinline__ void atomic_add_f(float* p, float v) { unsafeAtomicAdd(p, v); }
#endif

struct DimsFull {
    static constexpr int D = 1024, B = 16, L = 2048, NC = 256, DEPTH = 2, GRID_W = 64;
    static constexpr int C = 256  , DHG = 512, CFN = 256, NB = 16, EMB = 33, FH = 64;
    static constexpr int HDIM = 128, H = 4, G = 4, GD = 64;
    static constexpr int DP = 3 * C + 5 * DHG + CFN;
    static constexpr int ZW = 3 * C + 5 * DHG + 2 * CFN;
    static constexpr int E = 16, NG = 4, EPG = 4, DE = 512;
    static constexpr int RB = 8, BB = 8, MPAD = 256;
    typedef bf16s st;
};
#ifdef CPU_SHIM
struct DimsTest {
    static constexpr int D = 64, B = 2, L = 64, NC = 16, DEPTH = 2, GRID_W = 8;
    static constexpr int C = 16, DHG = 32, CFN = 16, NB = 4, EMB = 9, FH = 8;
    static constexpr int HDIM = 8, H = 4, G = 2, GD = 8;
    static constexpr int DP = 3 * C + 5 * DHG + CFN;
    static constexpr int ZW = 3 * C + 5 * DHG + 2 * CFN;
    static constexpr int E = 16, NG = 4, EPG = 4, DE = 16;
    static constexpr int RB = 8, BB = 2, MPAD = 8;
#ifdef TEST_BF16
    typedef bf16s st;
#else
    typedef float st;
#endif
};
#endif

template <class Dm> struct Params {
    typedef typename Dm::st st;
    const float *x, *c, *ctx, *c_ctx, *ada_w, *ada_b, *norm1_g, *norm2_g, *w_in, *w_out, *hy_conv_w, *hy_conv_b, *hy_w1, *hy_b1, *hy_w2, *hy_b2, *hy_w3, *hy_freq,
        *hy_bias, *hy_norm_g, *hg_lb, *hg_norm_g, *fn_w, *fn_b, *fn_norm_g, *router_w, *router_b, *moe_wg, *moe_wu, *moe_wd, *final_g;
    float* out;
    float* cw;
    st* xb;
    float* mod;
    float* lbv;
    float* wcs;
    float* wfn;
    float* hf1;
    float* hf2;
    float* hfil;
    float* rs;
    st* hx;
    st* z;
    st* zh_c; st* zh_x;
    st* pq_c; st* pq_x;
    st* krt_c; st* krt_x;
    st* y1t_c; st* y1t_x; st* y2t_c; st* y2t_x;
    st* dft_c; st* dft_x;
    st* uv;
    st* y1;
    st* y2;
    st* o;
    st* ob;
    st* vit;
    st* yfn;
    int* ridx;
    float* rgp;
    int* cnt;
    int* perm;
    int* rrank;
    int* rpos;
    int* wgbase;
    st* hmid;
};

template <class Dm> struct NV {
    typedef Params<Dm> P;
    typedef typename Dm::st st;
    static constexpr int D = Dm::D, B = Dm::B, L = Dm::L, NC = Dm::NC, C = Dm::C, DHG = Dm::DHG, CFN = Dm::CFN, ZW = Dm::ZW, DP = Dm::DP;
    static constexpr int RC = B * NC, RX = B * L, RALL = RC + RX;
    static constexpr int ZS = 4 * DHG, OFF_Q = 0, OFF_FF = DHG, OFF_FB = 2 * DHG, OFF_G = 3 * DHG;
    static constexpr float EPS = 1e-6f;
    static constexpr float TWO_PI = 6.283185307179586f;

    static HD float* xrow(const P& p, int R) { return R < RC ? p.cw + (size_t)R * D : p.out + (size_t)(R - RC) * D; }
    static HD int row_b(int R) { return R < RC ? R / NC : (R - RC) / L; }
    static HD int row_l(int R) { return R < RC ? R % NC : (R - RC) % L; }
    static HD int row_modr(int R) { return R < RC ? B : (R - RC) / L; }
    static HD int row_of(int isx, int b, int l) { return isx ? RC + b * L + l : b * NC + l; }
    static HD const float* modp(const P& p, int layer, int mr, int which) { return p.mod + ((size_t)(layer * (B + 1) + mr) * 6 + which) * D; }

    static HD void p_pro_a(const P& p, long tid, long nth) {
        for (long i = tid; i < 2 * DHG; i += nth) {
            float mx = -1e30f;
            for (int l = 0; l < Dm::DEPTH; ++l) mx = fmaxf(mx, p.hg_lb[l * 2 * DHG + i]);
            float den = 0.f;
            for (int l = 0; l < Dm::DEPTH; ++l) den += expf(p.hg_lb[l * 2 * DHG + i] - mx);
            float cs = 0.f;
            for (int l = 0; l < Dm::DEPTH; ++l) { if (l > 0) cs += expf(p.hg_lb[l * 2 * DHG + i] - mx) / den; p.lbv[l * 2 * DHG + i] = cs; }
        }
        for (long i = tid; i < (long)Dm::DEPTH * Dm::G * Dm::GD * 2 * Dm::GD; i += nth) {
            const int GD = Dm::GD; const int d2 = (int)(i % (2 * GD)), c = (int)((i / (2 * GD)) % GD), g = (int)((i / (2 * GD * GD)) % Dm::G), layer = (int)(i / ((long)2 * GD * GD * Dm::G));
            const int d = d2 % GD, sn = d2 / GD;
            const float* w = p.fn_w + ((size_t)(layer * Dm::G + g) * GD) * GD + d;
            float acc = 0.f;
            for (int m = 0; m < GD; ++m) { const int cm = (c * m) % GD;
                const float ang = TWO_PI * (float)cm / (float)GD; acc += (sn ? __sinf(ang) : __cosf(ang)) * w[(size_t)m * GD]; }
            p.wcs[i] = acc;
        }
        for (long i = tid; i < (long)Dm::DEPTH * (NC + L) * Dm::FH; i += nth) {
            const int j = (int)(i % Dm::FH), ll = (int)((i / Dm::FH) % (NC + L)), layer = (int)(i / ((long)Dm::FH * (NC + L)));
            const int Lw = ll < NC ? NC : L, l = ll < NC ? ll : ll - NC;
            const float t = (float)l / (float)(Lw - 1), wv = TWO_PI * (float)l / (float)Lw;
            const float* w1 = p.hy_w1 + (size_t)layer * Dm::EMB * Dm::FH + j;
            float acc = t * w1[0];
            for (int bi = 0; bi < Dm::NB; ++bi) {
                const float band = 1e-4f + (float)bi * ((float)(Dm::NB - 1) - 1e-4f) / (float)(Dm::NB - 1);
                acc += cosf(band * wv) * w1[(size_t)(1 + bi) * Dm::FH] - sinf(band * wv) * w1[(size_t)(1 + Dm::NB + bi) * Dm::FH];
            }
            acc += p.hy_b1[layer * Dm::FH + j];
            p.hf1[i] = sinf(p.hy_freq[layer * Dm::FH + j] * acc);
        }
    }
    static HD void p_pro_b(const P& p, long tid, long nth) {
        for (long i = tid; i < (long)Dm::DEPTH * (NC + L) * Dm::FH; i += nth) {
            const int j = (int)(i % Dm::FH), layer = (int)(i / ((long)Dm::FH * (NC + L)));
            const float* h1 = p.hf1 + (i / Dm::FH) * Dm::FH;
            const float* w2 = p.hy_w2 + (size_t)layer * Dm::FH * Dm::FH + j;
            float acc = 0.f;
            for (int k = 0; k < Dm::FH; ++k) acc += h1[k] * w2[(size_t)k * Dm::FH];
            acc += p.hy_b2[layer * Dm::FH + j];
            p.hf2[i] = sinf(p.hy_freq[layer * Dm::FH + j] * acc);
        }
        for (long i = tid; i < (long)Dm::DEPTH * D * 2 * CFN; i += nth) {
            const int GD = Dm::GD; const int j = (int)(i % (2 * CFN)), k = (int)((i / (2 * CFN)) % D), layer = (int)(i / ((long)2 * CFN * D));
            const int sn = j / CFN, g = (j % CFN) / GD, d = j % GD;
            const float* wi = p.w_in + ((size_t)layer * D + k) * DP + 3 * C + 5 * DHG + g * GD;
            const float* wc = p.wcs + ((size_t)(layer * Dm::G + g) * GD) * 2 * GD + sn * GD + d;
            float acc = 0.f;
            for (int c = 0; c < GD; ++c) acc += wi[c] * wc[(size_t)c * 2 * GD];
            p.wfn[i] = acc;
        }
    }
    static HD void p_pro_c(const P& p, long tid, long nth) {
        const float max_decay = logf(1e-2f) / 0.3f, min_decay = logf(1e-2f) / 1.5f;
        for (long i = tid; i < (long)Dm::DEPTH * (NC + L) * 4 * C; i += nth) {
            const int oc = (int)(i % (4 * C)), ll = (int)((i / (4 * C)) % (NC + L)), layer = (int)(i / ((long)4 * C * (NC + L)));
            const int Lw = ll < NC ? NC : L, l = ll < NC ? ll : ll - NC, c = oc % C;
            const float t = (float)l / (float)(Lw - 1);
            const float* h2 = p.hf2 + (i / (4 * C)) * Dm::FH;
            const float* w3 = p.hy_w3 + (size_t)layer * Dm::FH * 4 * C + oc;
            float acc = 0.f;
            for (int k = 0; k < Dm::FH; ++k) acc += h2[k] * w3[(size_t)k * 4 * C];
            const float delta = min_decay + (max_decay - min_decay) * (float)c / (float)(C - 1);
            p.hfil[i] = acc * expf(-t * fabsf(delta));
        }
    }
    static HD float shortconv(const P& p, int layer, int R, int pc) {
        const int l = row_l(R), Lw = R < RC ? NC : L;
        const float* cwt = p.hy_conv_w + (size_t)layer * 3 * 3 * C + pc;
        const st* zr = R < RC ? p.zh_c + (size_t)pc * RC + R : p.zh_x + (size_t)pc * RX + (R - RC);
        float v = ldv(zr) * cwt[3 * C] + p.hy_conv_b[layer * 3 * C + pc];
        if (l > 0) v += ldv(zr - 1) * cwt[0];
        if (l < Lw - 1) v += ldv(zr + 1) * cwt[2 * 3 * C];
        return v;
    }
    static HD void p_uv(const P& p, int layer, int r0, long tid, long nth) {
        for (long i = (long)r0 * C + tid; i < (long)RALL * C; i += nth) { const int R = (int)(i / C), c = (int)(i % C); stv(p.uv + i, shortconv(p, layer, R, c)); }
    }
    static HD float hy_k(const P& p, int layer, int isx, int order, int d, int c) {
        const float* hf = p.hfil + ((size_t)layer * (NC + L) + (isx ? NC : 0)) * 4 * C;
        float v = d >= 0 ? hf[(size_t)d * 4 * C + (2 * order) * C + c] : hf[(size_t)(-d) * 4 * C + (2 * order + 1) * C + c];
        if (d == 0) v += p.hy_bias[(layer * 2 + order) * C + c];
        return v;
    }
    static HD void p_hyconv(const P& p, int layer, int order, int r0, long tid, long nth) {
        constexpr int BB = Dm::BB;
        const st* in = p.y1; st* outp = order == 0 ? p.y1 : p.y2;
        const long nc_items = (long)(B / BB) * NC * C, nx_items = (long)(B / BB) * L * C;
        for (long i = (r0 >= RC ? nc_items : 0) + tid; i < nc_items + nx_items; i += nth) {
            const int isx = i >= nc_items; const long ii = isx ? i - nc_items : i; const int Lw = isx ? L : NC;
            const int c = (int)(ii % C), t = (int)((ii / C) % Lw), b0 = (int)(ii / ((long)C * Lw)) * BB;
            float acc[BB];
#pragma unroll
            for (int r = 0; r < BB; ++r) acc[r] = 0.f;
            for (int s = 0; s < Lw; ++s) { const float kv = hy_k(p, layer, isx, order, t - s, c);
#pragma unroll
                for (int r = 0; r < BB; ++r) acc[r] += kv * (order == 0 ? shortconv(p, layer, row_of(isx, b0 + r, s), c) : ldv(in + (size_t)row_of(isx, b0 + r, s) * C + c)); }
#pragma unroll
            for (int r = 0; r < BB; ++r) { const int R = row_of(isx, b0 + r, t); stv(outp + (size_t)R * C + c, acc[r] * shortconv(p, layer, R, (order + 1) * C + c)); }
        }
    }
    static HD void p_hgscan(const P& p, long tid, long nth) {
        constexpr int HDM = Dm::HDIM;
        for (long i = tid; i < (long)B * Dm::H * HDM; i += nth) {
            const int v = (int)(i % HDM), h = (int)((i / HDM) % Dm::H), b = (int)(i / ((long)HDM * Dm::H));
            for (int dir = 0; dir < 2; ++dir) {
                float S[HDM];
#pragma unroll
                for (int d = 0; d < HDM; ++d) S[d] = 0.f;
                for (int seg = 0; seg < 2; ++seg) {
                    const int Lw = seg ? L : NC;
                    for (int tt = 0; tt < Lw; ++tt) {
                        const int t = dir ? Lw - 1 - tt : tt; const int R = row_of(seg, b, t);
                        const st* zr = p.z + (size_t)R * ZS;
                        const float vv = ldv(p.vit + (size_t)(h * HDM + v) * RALL + R);
                        const st* lf = zr + (dir ? OFF_FB : OFF_FF) + h * HDM; const st* q = zr + OFF_Q + h * HDM;
                        float o = 0.f;
#pragma unroll
                        for (int d = 0; d < HDM; ++d) { const float f = expf(ldv(lf + d)); S[d] = f * S[d] + (1.f - f) * vv; o += S[d] * ldv(q + d); }
                        stv((dir ? p.ob : p.o) + (size_t)R * DHG + h * HDM + v, o);
                    }
                }
            }
        }
    }
    static HD void p_moe_reset(const P& p, long tid, long nth) {
        for (long i = tid; i < 32; i += nth) p.cnt[i] = 0;
        for (long i = tid; i < (long)2 * RALL + Dm::E * Dm::MPAD; i += nth) p.perm[i] = -1;
    }
    static HD int moe_off(const P& p, int e) {
        int o = 0;
        for (int j = 0; j < e; ++j) o += (p.cnt[j] + Dm::MPAD - 1) / Dm::MPAD * Dm::MPAD;
        return o;
    }
    static HD void p_place(const P& p, int r0, long tid, long nth) {
        for (long ts = (long)r0 * 2 + tid; ts < (long)RALL * 2; ts += nth) {
            const int e = p.ridx[ts];
            const int pos = moe_off(p, e) + atomic_add_i(p.cnt + 16 + e, 1);
            p.perm[pos] = (int)ts;
        }
    }
    static HD void p_gather_dummy(const P&) {}
    static HD int moe_expert_of_unused(const P& p, int pos) { int e = 0; while (e + 1 < Dm::E && pos >= moe_off(p, e + 1)) ++e; return e; }
};
#define LAS __attribute__((address_space(3)))
typedef short bf16x8 __attribute__((ext_vector_type(8)));
typedef float f32x4 __attribute__((ext_vector_type(4)));
typedef float f32x2 __attribute__((ext_vector_type(2)));
typedef unsigned u32x4 __attribute__((ext_vector_type(4)));
typedef unsigned u32x2 __attribute__((ext_vector_type(2)));
typedef DimsFull DmF; typedef NV<DmF> NVF; typedef Params<DmF> PF;
constexpr int NTHREADS = 512;
constexpr int STAGE_BYTES = 131072;
constexpr int LDS_MISC_OFF = 156672;
constexpr int LDS_BYTES = LDS_MISC_OFF + 1024;

__device__ __forceinline__ unsigned cvt_pk_bf16(float lo, float hi) { unsigned r; asm volatile("v_cvt_pk_bf16_f32 %0, %1, %2" : "=v"(r) : "v"(lo), "v"(hi)); return r; }
__device__ __forceinline__ int tidx() { int t = threadIdx.x; asm volatile("" : "+v"(t)); return t; }
__device__ __forceinline__ void lds_barrier() { asm volatile("s_waitcnt lgkmcnt(0)" ::: "memory"); __builtin_amdgcn_s_barrier(); asm volatile("" ::: "memory"); }
__device__ __forceinline__ u32x2 pack4(f32x4 v) { u32x2 w; w.x = cvt_pk_bf16(v[0], v[1]); w.y = cvt_pk_bf16(v[2], v[3]); return w; }
__device__ __forceinline__ f32x4 unpack4(u32x2 w) { f32x4 v; v[0] = __uint_as_float(w.x << 16); v[1] = __uint_as_float(w.x & 0xffff0000u); v[2] = __uint_as_float(w.y << 16); v[3] = __uint_as_float(w.y & 0xffff0000u); return v; }
__device__ __forceinline__ int gdimx() { int g = (int)gridDim.x; asm volatile("" : "+s"(g)); return g; }
__device__ __forceinline__ float fast_silu(float x) { return x * __builtin_amdgcn_rcpf(1.f + __expf(-x)); }

#ifndef REP_EPI
#define REP_EPI 1
#endif
#ifndef RELAX_WAITS
#define RELAX_WAITS 0
#endif

#ifndef TPROBE
#define TPROBE 0
#endif
#ifndef TPROBE_WG
#define TPROBE_WG 64
#endif
#ifndef TPROBE_TID
#define TPROBE_TID 0
#endif
#ifndef TPROBE_MUL
#define TPROBE_MUL 32
#endif
#define TP_OFF (LDS_MISC_OFF + 768)
#if TPROBE
#define TP_B(id) if ((id) == TPROBE && (int)blockIdx.x == TPROBE_WG && tidx() == TPROBE_TID) *(LAS unsigned*)(lds + TP_OFF + 4) = (unsigned)wall_clock64();
#define TP_E(id, lds) if ((id) == TPROBE && (int)blockIdx.x == TPROBE_WG && tidx() == TPROBE_TID) *(LAS unsigned*)((lds) + TP_OFF) += (unsigned)wall_clock64() - *(LAS unsigned*)((lds) + TP_OFF + 4);
#define TP_SPIN(lds) if ((int)blockIdx.x == TPROBE_WG && tidx() == TPROBE_TID) { const unsigned long long t0_ = wall_clock64(), d_ = (unsigned long long)TPROBE_MUL * *(LAS unsigned*)((lds) + TP_OFF); while (wall_clock64() - t0_ < d_) __builtin_amdgcn_s_sleep(16); *(LAS unsigned*)((lds) + TP_OFF) = 0; }
#define TP_ZERO(lds) if (tidx() == TPROBE_TID) *(LAS unsigned*)((lds) + TP_OFF) = 0;
#else
#define TP_B(id)
#define TP_E(id, lds)
#define TP_SPIN(lds)
#define TP_ZERO(lds)
#endif
namespace pg8 {
constexpr int BM = 256, BK = 64, HALF = 128, HTB = HALF * BK * 2;
__host__ __device__ __forceinline__ int lds_byte(int r, int c) { const int st = (r >> 4) * 2 + (c >> 5), rr = r & 15, cc = c & 31, ob = rr * 64 + cc * 2; return st * 1024 + (ob ^ (((ob >> 9) & 1) << 5)); }
__host__ __device__ __forceinline__ void stage_rc(int b, int& R, int& C) { const int st = b / 1024, sb = b % 1024, swz = sb ^ (((sb >> 9) & 1) << 5); R = (st >> 1) * 16 + swz / 64; C = (st & 1) * 32 + (swz % 64) / 2; }
__host__ __device__ __forceinline__ int perm32(int rho) { const int n = rho >> 4, i = rho & 15; return 8 * (i >> 2) + 4 * n + (i & 3); }
struct Unit { const char* a; const char* b; int i0, i1, i2, i3; const int* rows; };
struct Gemm { int K, lda, ldb; int* diag = nullptr; };
template <class Epi, class Sched, bool ALIGN_EPI = true, bool GATHER = false>
__device__ __forceinline__ void gemm_phase(LAS unsigned char* lds, const Gemm g, const Sched& S, const Epi& E) {
    const int tid = tidx(), wid = __builtin_amdgcn_readfirstlane(tid >> 6), lane = tid & 63, wr = wid >> 2, wc = wid & 3, fr = lane & 15, fq = lane >> 4;
    const int K = g.K, nt = K / BK;
    unsigned voffA[2], voffB[2];
#pragma unroll
    for (int i = 0; i < 2; ++i) { int R, C; stage_rc(tid * 16 + i * 8192, R, C); const int Rb = Epi::PERM ? ((R & ~31) + perm32(R & 31)) : R;
        voffA[i] = (unsigned)(R * g.lda + C) * 2u; voffB[i] = (unsigned)(Rb * g.ldb + C) * 2u; }
    const size_t kstep = (size_t)(BK * 2);
    const size_t hstepA = (size_t)HALF * g.lda * 2, hstepB = (size_t)HALF * g.ldb * 2;
    const unsigned ldsw = (unsigned)wid * 1024u;
    const int aoff = lds_byte(wr * 64 + fr, fq * 8), boff = lds_byte(wc * 32 + fr, fq * 8);
#define PG8_SA(b, h) (((b) * 2 + (h)) * HTB)
#define PG8_SB(b, h) ((4 + (b) * 2 + (h)) * HTB)
#define PG8_STAGE(bufoff, gbase, voff) do { _Pragma("unroll") for (int _i = 0; _i < 2; ++_i) \
        __builtin_amdgcn_global_load_lds((const unsigned*)((const char*)(gbase) + (voff)[_i]), (LAS unsigned*)(lds + (bufoff) + ldsw + _i * 8192), 16, 0, 0); } while (0)
#define PG8_TAB(k) (STAGE_BYTES + ((k) & 1) * 1024)
#define PG8_TABLOAD(k, u) do { if (wid == 0) __builtin_amdgcn_global_load_lds((const unsigned*)((u).rows + lane * 4), (LAS unsigned*)(lds + PG8_TAB(k)), 16, 0, 0); } while (0)
#define PG8_STAGEA(bufoff, gbase, h, k) do { if constexpr (GATHER) { _Pragma("unroll") for (int _i = 0; _i < 2; ++_i) { \
            const int ts_ = *(const LAS int*)(lds + PG8_TAB(k) + ((h) * 128 + (int)(voffA[_i] >> 11)) * 4); \
            __builtin_amdgcn_global_load_lds((const unsigned*)((const char*)(gbase) + ((unsigned)(ts_ < 0 ? 0 : ts_ >> 1) << 11) + (voffA[_i] & 2047u)), (LAS unsigned*)(lds + (bufoff) + ldsw + _i * 8192), 16, 0, 0); } } \
        else { PG8_STAGE(bufoff, (gbase) + (h) * hstepA, voffA); } } while (0)
#define PG8_LDA(dst, b, h) do { _Pragma("unroll") for (int m = 0; m < 4; ++m) _Pragma("unroll") for (int k = 0; k < 2; ++k) dst[m][k] = *(const LAS bf16x8*)(lds + PG8_SA(b, h) + aoff + m * 2048 + k * 1024); } while (0)
#define PG8_LDB(dst, b, h) do { _Pragma("unroll") for (int n = 0; n < 2; ++n) _Pragma("unroll") for (int k = 0; k < 2; ++k) dst[n][k] = *(const LAS bf16x8*)(lds + PG8_SB(b, h) + boff + n * 2048 + k * 1024); } while (0)
#define PG8_MMA(ai, bj, At, Bt) do { __builtin_amdgcn_s_setprio(1); _Pragma("unroll") for (int m = 0; m < 4; ++m) _Pragma("unroll") for (int n = 0; n < 2; ++n) _Pragma("unroll") for (int k = 0; k < 2; ++k) \
        acc[ai][bj][m][n] = __builtin_amdgcn_mfma_f32_16x16x32_bf16(Bt[n][k], At[m][k], acc[ai][bj][m][n], 0, 0, 0); __builtin_amdgcn_s_setprio(0); } while (0)
#define PG8_WAIT_V(n) asm volatile("s_waitcnt vmcnt(" #n ")" ::: "memory")
#define PG8_WAIT_V8R_(N) asm volatile("s_cmp_lg_u32 %0, 0\n\ts_cbranch_scc1 .Lrn%=\n\ts_cmp_eq_u32 %1, 0\n\ts_cbranch_scc1 .Lrn%=\n\ts_waitcnt vmcnt(" #N ")\n\ts_branch .Lrd%=\n.Lrn%=:\n\ts_waitcnt vmcnt(8)\n.Lrd%=:" :: "s"(t), "s"(ui) : "memory", "scc")
#define PG8_WAIT_V8R() do { if constexpr (!RELAX_WAITS) asm volatile("s_waitcnt vmcnt(8)" ::: "memory"); else if constexpr (Epi::NST == 16) PG8_WAIT_V8R_(24); else PG8_WAIT_V8R_(16); } while (0)
#define PG8_WAIT_L(n) asm volatile("s_waitcnt lgkmcnt(" #n ")" ::: "memory")
#define PG8_BAR __builtin_amdgcn_s_barrier()
#define PG8_SCHED __builtin_amdgcn_sched_barrier(0)
    Unit cur, nxt; int ui = 0;
    if (!S.next(0, cur)) return;
#if TPROBE >= 80 && TPROBE <= 89
#define PG8_GAP_B() if (TPROBE == 80 + Epi::TPK && (int)blockIdx.x == TPROBE_WG && tid == TPROBE_TID) *(LAS unsigned*)(lds + TP_OFF + 4) = (unsigned)wall_clock64();
#define PG8_GAP_E() if (TPROBE == 80 + Epi::TPK && (int)blockIdx.x == TPROBE_WG && tid == TPROBE_TID) *(LAS unsigned*)(lds + TP_OFF) += (unsigned)wall_clock64() - *(LAS unsigned*)(lds + TP_OFF + 4);
#else
#define PG8_GAP_B()
#define PG8_GAP_E()
#endif
    PG8_GAP_B()
    f32x4 acc[2][2][4][2];
#pragma unroll
    for (int a = 0; a < 2; ++a)
#pragma unroll
        for (int b = 0; b < 2; ++b)
#pragma unroll
            for (int m = 0; m < 4; ++m)
#pragma unroll
                for (int n = 0; n < 2; ++n) acc[a][b][m][n] = (f32x4){0.f, 0.f, 0.f, 0.f};
    bf16x8 At[4][2], B0[2][2], B1[2][2];
    const char* cA = cur.a; const char* cB = cur.b;
    if constexpr (GATHER) { PG8_TABLOAD(0, cur); PG8_WAIT_V(0); __syncthreads(); }
    PG8_STAGE(PG8_SB(0, 0), cB, voffB); PG8_STAGE(PG8_SB(0, 1), cB + hstepB, voffB); PG8_STAGEA(PG8_SA(0, 0), cA, 0, 0); PG8_STAGEA(PG8_SA(0, 1), cA, 1, 0);
    if (wr == 1) PG8_BAR;
    PG8_WAIT_V(2); PG8_BAR;
    PG8_STAGE(PG8_SB(1, 0), cB + kstep, voffB); PG8_STAGEA(PG8_SA(1, 0), cA + kstep, 0, 0); PG8_STAGE(PG8_SB(1, 1), cB + hstepB + kstep, voffB);
    PG8_WAIT_V(6); PG8_BAR;
#ifdef DIAG_GEMMTIME
    unsigned long long tk_ = 0, te_ = 0, t0_ = 0, t1_ = 0;
#endif
    for (;;) {
        const bool has_next = S.next(ui + 1, nxt);
        const char* nA = has_next ? nxt.a : cA; const char* nB = has_next ? nxt.b : cB;
        const int kn = has_next ? ui + 1 : ui;
        if constexpr (GATHER) { if (has_next) PG8_TABLOAD(ui + 1, nxt); }
#ifdef DIAG_GEMMTIME
        t0_ = wall_clock64();
#endif
#if TPROBE >= 50 && TPROBE <= 59
        if (TPROBE == 50 + Epi::TPK && (int)blockIdx.x == TPROBE_WG && tid == TPROBE_TID) *(LAS unsigned*)(lds + TP_OFF + 4) = (unsigned)wall_clock64();
#endif
        PG8_GAP_E()
        for (int t = 0; t < nt; t += 2) {
            const bool last = (t == nt - 2);
            const char* a1 = cA + (size_t)(t + 1) * kstep;
            const char* a2 = last ? nA : cA + (size_t)(t + 2) * kstep; const char* b2 = last ? nB : cB + (size_t)(t + 2) * kstep;
            const char* a3 = a2 + kstep; const char* b3 = b2 + kstep;
            const int kl = last ? kn : ui;
            PG8_LDB(B0, 0, 0); PG8_LDB(B1, 0, 1); PG8_SCHED; PG8_LDA(At, 0, 0); PG8_STAGEA(PG8_SA(1, 1), a1, 1, ui);
            PG8_WAIT_V8R(); PG8_WAIT_L(0); PG8_BAR; PG8_MMA(0, 0, At, B0); PG8_MMA(0, 1, At, B1); PG8_BAR; PG8_SCHED;
            PG8_LDA(At, 0, 1); PG8_STAGE(PG8_SB(0, 0), b2, voffB); PG8_STAGE(PG8_SB(0, 1), b2 + hstepB, voffB); PG8_STAGEA(PG8_SA(0, 0), a2, 0, kl);
            PG8_WAIT_V8R(); PG8_WAIT_L(0); PG8_BAR; PG8_MMA(1, 0, At, B0); PG8_MMA(1, 1, At, B1); PG8_BAR; PG8_SCHED;
            PG8_LDB(B0, 1, 0); PG8_LDB(B1, 1, 1); PG8_SCHED; PG8_LDA(At, 1, 0); PG8_STAGEA(PG8_SA(0, 1), a2, 1, kl);
            PG8_WAIT_V8R(); PG8_WAIT_L(0); PG8_BAR; PG8_MMA(0, 0, At, B0); PG8_MMA(0, 1, At, B1); PG8_BAR; PG8_SCHED;
            PG8_LDA(At, 1, 1); PG8_STAGE(PG8_SB(1, 0), b3, voffB); PG8_STAGE(PG8_SB(1, 1), b3 + hstepB, voffB); PG8_STAGEA(PG8_SA(1, 0), a3, 0, kl);
            PG8_WAIT_V(8); PG8_WAIT_L(0); PG8_BAR; PG8_MMA(1, 0, At, B0); PG8_MMA(1, 1, At, B1); PG8_BAR; PG8_SCHED;
        }
#ifdef DIAG_GEMMTIME
        t1_ = wall_clock64(); tk_ += t1_ - t0_;
#endif
#if TPROBE >= 50 && TPROBE <= 59
        if (TPROBE == 50 + Epi::TPK && (int)blockIdx.x == TPROBE_WG && tid == TPROBE_TID) *(LAS unsigned*)(lds + TP_OFF) += (unsigned)wall_clock64() - *(LAS unsigned*)(lds + TP_OFF + 4);
#endif
#if TPROBE >= 60 && TPROBE <= 69
        if (TPROBE == 60 + Epi::TPK && (int)blockIdx.x == TPROBE_WG && tid == TPROBE_TID) *(LAS unsigned*)(lds + TP_OFF + 4) = (unsigned)wall_clock64();
#endif
        if constexpr (ALIGN_EPI) { if (wr == 0) PG8_BAR; }
#if TPROBE >= 40 && TPROBE <= 49
        const bool tpk_ = (Epi::NST == 16 && sizeof(Epi) > 40) && (TPROBE == 40 || (TPROBE == 41 && cur.i2) || (TPROBE == 42 && !cur.i2 && cur.i1 >= 5 && cur.i1 <= 8) || (TPROBE == 43 && !cur.i2 && (cur.i1 < 5 || cur.i1 > 8)));
        if (tpk_ && (int)blockIdx.x == TPROBE_WG && tid == TPROBE_TID) *(LAS unsigned*)(lds + TP_OFF + 4) = (unsigned)wall_clock64();
#endif
        E(acc, cur, wr, wc, fr, fq);
#if TPROBE >= 40 && TPROBE <= 49
        if (tpk_ && (int)blockIdx.x == TPROBE_WG && tid == TPROBE_TID) *(LAS unsigned*)(lds + TP_OFF) += (unsigned)wall_clock64() - *(LAS unsigned*)(lds + TP_OFF + 4);
#endif
#ifdef DUP_EPI_INPROJ
        if constexpr (Epi::NST == 16 && sizeof(Epi) > 40) { asm volatile("" ::: "memory"); E(acc, cur, wr, wc, fr, fq); }
#endif
#if TPROBE >= 60 && TPROBE <= 69
        if (TPROBE == 60 + Epi::TPK && (int)blockIdx.x == TPROBE_WG && tid == TPROBE_TID) *(LAS unsigned*)(lds + TP_OFF) += (unsigned)wall_clock64() - *(LAS unsigned*)(lds + TP_OFF + 4);
#endif
        PG8_GAP_B()
#ifdef DIAG_GEMMTIME
        te_ += wall_clock64() - t1_;
        if (!has_next && g.diag && blockIdx.x == DIAG_BLOCK && tid == 0) { g.diag[0] = (int)tk_; g.diag[1] = (int)te_; g.diag[2] = ui + 1; }
#endif
        if (!has_next) break;
#pragma unroll
        for (int a = 0; a < 2; ++a)
#pragma unroll
            for (int b = 0; b < 2; ++b)
#pragma unroll
                for (int m = 0; m < 4; ++m)
#pragma unroll
                    for (int n = 0; n < 2; ++n) acc[a][b][m][n] = (f32x4){0.f, 0.f, 0.f, 0.f};
        cur = nxt; cA = nA; cB = nB; ++ui;
        if constexpr (ALIGN_EPI) { if (wr == 1) PG8_BAR; }
    }
    PG8_WAIT_V(0);
    if constexpr (!ALIGN_EPI) { if (wr == 0) PG8_BAR; }
    PG8_BAR;
    PG8_GAP_E()
#undef PG8_GAP_B
#undef PG8_GAP_E
#undef PG8_SA
#undef PG8_SB
#undef PG8_STAGE
#undef PG8_LDA
#undef PG8_STAGEA
#undef PG8_TAB
#undef PG8_TABLOAD
#undef PG8_LDB
#undef PG8_MMA
#undef PG8_WAIT_V
#undef PG8_WAIT_L
#undef PG8_WAIT_V8R
#undef PG8_WAIT_V8R_
#undef PG8_BAR
#undef PG8_SCHED
}
}

struct FastWs {
    bf16s* wt_in;
    bf16s* wt_out;
    bf16s* wt_gu;
    bf16s* wt_d;
    bf16s* hxs;
};

struct Deal { int x, j, W; __device__ __forceinline__ void init() { const int G = gridDim.x, c = blockIdx.x; x = c & 7; j = c >> 3; W = (G + 7) >> 3; } };

struct XpJob { const float* src; int sld, k0, n0; bf16s* dst; int dld, drow0; };
__device__ __forceinline__ void xpose_load(const XpJob& j, int t, f32x4 (&v)[2]) {
#pragma unroll
    for (int ps = 0; ps < 2; ++ps) { const int k = (t >> 4) + 32 * ps, n4 = (t & 15) * 4; v[ps] = *(const f32x4*)(j.src + (size_t)(j.k0 + k) * j.sld + j.n0 + n4); }
}
__device__ __forceinline__ void xpose_store(LAS float* tile, const XpJob& j, int t, const f32x4 (&v)[2]) {
#pragma unroll
    for (int ps = 0; ps < 2; ++ps) { const int k = (t >> 4) + 32 * ps, n4 = (t & 15) * 4;
        tile[k * 65 + n4 + 0] = v[ps][0]; tile[k * 65 + n4 + 1] = v[ps][1]; tile[k * 65 + n4 + 2] = v[ps][2]; tile[k * 65 + n4 + 3] = v[ps][3]; }
    lds_barrier();
    { const int n = t >> 3, k8 = (t & 7) * 8; u32x4 w;
      w.x = cvt_pk_bf16(tile[(k8 + 0) * 65 + n], tile[(k8 + 1) * 65 + n]); w.y = cvt_pk_bf16(tile[(k8 + 2) * 65 + n], tile[(k8 + 3) * 65 + n]);
      w.z = cvt_pk_bf16(tile[(k8 + 4) * 65 + n], tile[(k8 + 5) * 65 + n]); w.w = cvt_pk_bf16(tile[(k8 + 6) * 65 + n], tile[(k8 + 7) * 65 + n]);
      *(u32x4*)(j.dst + (size_t)(j.drow0 + n) * j.dld + j.k0 + k8) = w; }
    lds_barrier();
}
__device__ __forceinline__ XpJob job_inout(const PF& p, const FastWs& f, int layer, int it) {
    constexpr int D = DmF::D, T_IN = (3328 / 64) * (D / 64), T_FN = (512 / 64) * (D / 64);
    int r = it;
    if (r < T_IN) { const int nt = r / (D / 64), kt = r % (D / 64); return XpJob{p.w_in + (size_t)layer * D * DmF::DP, DmF::DP, kt * 64, nt * 64, f.wt_in, D, nt * 64}; } r -= T_IN;
    if (r < T_FN) { const int nt = r / (D / 64), kt = r % (D / 64); return XpJob{p.wfn + (size_t)layer * D * 512, 512, kt * 64, nt * 64, f.wt_in, D, 3328 + nt * 64}; } r -= T_FN;
    { const int nt = r / (D / 64), kt = r % (D / 64); return XpJob{p.w_out + (size_t)layer * D * D, D, kt * 64, nt * 64, f.wt_out, D, nt * 64}; }
}
__device__ __forceinline__ void f_cvt_inout(const PF& p, const FastWs& f, int layer, LAS unsigned char* lds) {
    LAS float* tile = (LAS float*)lds; const int t = tidx();
    constexpr int D = DmF::D, NT = (3328 / 64) * (D / 64) + (512 / 64) * (D / 64) + (D / 64) * (D / 64);
    int it = blockIdx.x; if (it >= NT) return;
    XpJob cur = job_inout(p, f, layer, it); f32x4 v[2]; xpose_load(cur, t, v);
    for (;;) { const int nx = it + (int)gridDim.x; const bool more = nx < NT; XpJob nj = cur; f32x4 nvv[2];
        if (more) { nj = job_inout(p, f, layer, nx); xpose_load(nj, t, nvv); }
        xpose_store(tile, cur, t, v);
        if (!more) break;
        cur = nj; v[0] = nvv[0]; v[1] = nvv[1]; it = nx; }
}
__device__ __forceinline__ XpJob job_moe(const PF& p, const FastWs& f, int layer, int it) {
    constexpr int D = DmF::D, DE = DmF::DE, TG = (DE / 64) * (D / 64)  , TD = (D / 64) * (DE / 64)  , PER_E = 2 * TG + TD;
    const int e = it / PER_E; int r = it % PER_E;
    if (r < 2 * TG) { const int up = r / TG; r %= TG; const int nt = r / (D / 64), kt = r % (D / 64); const int n0 = nt * 64;
        const float* src = (up ? p.moe_wu : p.moe_wg) + ((size_t)(layer * DmF::E + e) * D) * DE;
        return XpJob{src, DE, kt * 64, n0, f.wt_gu + (size_t)e * 1024 * D, D, (n0 / 128) * 256 + up * 128 + (n0 % 128)}; }
    r -= 2 * TG;
    { const int nt = r / (DE / 64), kt = r % (DE / 64);
      return XpJob{p.moe_wd + ((size_t)(layer * DmF::E + e) * DE) * D, D, kt * 64, nt * 64, f.wt_d + (size_t)e * D * DE, DE, nt * 64}; }
}
constexpr int CVT_MOE_NT = DmF::E * (2 * 128 + 128);
__device__ __forceinline__ void f_cvt_moe(const PF& p, const FastWs& f, int layer, LAS unsigned char* lds, int rank, int nwork, int jlo = 0, int jhi = CVT_MOE_NT) {
    LAS float* tile = (LAS float*)lds; const int t = tidx();
    const int NT = jhi;
    int it = jlo + rank; if (rank < 0 || it >= NT) return;
    XpJob cur = job_moe(p, f, layer, it); f32x4 v[2]; xpose_load(cur, t, v);
    for (;;) { const int nx = it + nwork; const bool more = nx < NT; XpJob nj = cur; f32x4 nvv[2];
        if (more) { nj = job_moe(p, f, layer, nx); xpose_load(nj, t, nvv); }
        xpose_store(tile, cur, t, v);
        if (!more) break;
        cur = nj; v[0] = nvv[0]; v[1] = nvv[1]; it = nx; }
}

struct EpiInproj {
    static constexpr int TPK = 1;
    static constexpr bool PERM = true; static constexpr int NST = 16;
    bf16s* z; bf16s* zh_c; bf16s* zh_x; bf16s* pq_c; bf16s* pq_x; bf16s* vit; const float* lbv;
    __device__ __forceinline__ void operator()(const f32x4 (&acc)[2][2][4][2], const pg8::Unit& u, int wr, int wc, int fr, int fq) const {
        const int tile = u.i1, pm = u.i0;
        if (u.i2) {
            const int tk = wc * 32 + 8 * fq;
            bf16s* base; size_t cstride;
            if (tile == 9 || tile == 10) { base = vit + (size_t)(tile - 9) * 256 * NVF::RALL + pm * 256; cstride = NVF::RALL; }
            else if (tile < 3) { if (pm < 16) { base = zh_c + (size_t)tile * 256 * NVF::RC + pm * 256; cstride = NVF::RC; } else { base = zh_x + (size_t)tile * 256 * NVF::RX + (pm - 16) * 256; cstride = NVF::RX; } }
            else { const int sn = tile - 13;
                if (pm < 16) { base = pq_c + ((size_t)pm * 256 * 2 + sn) * 256; cstride = 2 * 256; }
                else { const int b = (pm - 16) >> 3, l0 = ((pm - 16) & 7) * 256; base = pq_x + ((size_t)b * 256 * 2 + sn) * 2048 + l0; cstride = 2 * 2048; } }
#pragma unroll
            for (int ai = 0; ai < 2; ++ai)
#pragma unroll
                for (int m = 0; m < 4; ++m) { bf16s* rowp = base + (size_t)(ai * 128 + wr * 64 + m * 16 + fr) * cstride + tk;
#pragma unroll
                    for (int bj = 0; bj < 2; ++bj) { const f32x4 v0 = acc[ai][bj][m][0], v1 = acc[ai][bj][m][1];
                        u32x4 w; w.x = cvt_pk_bf16(v0[0], v0[1]); w.y = cvt_pk_bf16(v0[2], v0[3]); w.z = cvt_pk_bf16(v1[0], v1[1]); w.w = cvt_pk_bf16(v1[2], v1[3]);
                        *(u32x4*)(rowp + bj * 128) = w; } }
            return;
        }
        const int row0 = pm * 256 + wr * 64 + fr; const int colt = (tile < 9 ? tile - 3 : tile - 5) * 256 + wc * 32 + 8 * fq;
        const int kind = tile < 5 ? 1 : tile < 9 ? 2 : 3;
        const float qs = 0.08838834764831845f;
#pragma unroll
        for (int bj = 0; bj < 2; ++bj) {
            const int col = colt + bj * 128;
            float lb[8];
            if (kind == 2) { const float* lp = lbv + (col - NVF::OFF_FF);
#pragma unroll
                for (int j = 0; j < 8; ++j) lb[j] = 1.f - lp[j]; }
#pragma unroll
            for (int ai = 0; ai < 2; ++ai)
#pragma unroll
                for (int m = 0; m < 4; ++m) {
                    float v[8];
#pragma unroll
                    for (int j = 0; j < 4; ++j) { v[j] = acc[ai][bj][m][0][j]; v[4 + j] = acc[ai][bj][m][1][j]; }
                    if (kind == 1) {
#pragma unroll
                        for (int j = 0; j < 8; ++j) v[j] = fast_silu(v[j]) * qs;
                    } else if (kind == 2) {
#pragma unroll
                        for (int j = 0; j < 8; ++j) { const float k = lb[j] * __builtin_amdgcn_rcpf(1.f + __expf(v[j])); v[j] = fmaxf(__logf(1.f - k), -30.f); }
                    }
                    u32x4 w; w.x = cvt_pk_bf16(v[0], v[1]); w.y = cvt_pk_bf16(v[2], v[3]); w.z = cvt_pk_bf16(v[4], v[5]); w.w = cvt_pk_bf16(v[6], v[7]);
                    *(u32x4*)(z + (size_t)(row0 + ai * 128 + m * 16) * NVF::ZS + col) = w;
                }
        }
    }
};
struct SchedInproj {
    const bf16s* hx; const bf16s* wt; int last; Deal d;
    __device__ __forceinline__ bool next(int i, pg8::Unit& u) const {
        if (d.W != 32) return next_generic(i, u);
        int r = i; const int s = d.j;
        int seen = -1;
        for (r = 0; r <= 8; ++r) { if (valid(r, s)) { if (++seen == i) break; } }
        if (r > 8) return false;
        fill(r, s, u); return true;
    }
#ifndef INPROJ_ROT
#define INPROJ_ROT 2
#endif
#ifndef INPROJ_PB
#define INPROJ_PB 2
#endif
    static constexpr int PB = INPROJ_PB, TBITS = 5 - PB, TPR = 1 << TBITS, RPG = 16 >> TBITS  ;
    __device__ __forceinline__ int tcol(int r, int s) const { return PB == 2 ? ((s + INPROJ_ROT * (r >> 1)) & 7) : (s & (TPR - 1)); }
    __device__ __forceinline__ int ctx_idle(int r, int s) const { if (!last || PB != 2 || !(r & 1) || tcol(r, s) != 7) return -1; const int ci = (r >> 1) * 4 + (s >> 3); return ci < 12 ? ci : -1; }
    __device__ __forceinline__ bool valid(int r, int s) const { if (r < 8) return ((r & (RPG - 1)) * TPR + tcol(r, s)) < 15 || ctx_idle(r, s) >= 0; const int tile = s & 15; return last ? (PB != 2 && tile >= 5 && tile <= 10) : (tile < 15); }
    __device__ __forceinline__ void fill(int r, int s, pg8::Unit& u) const {
        int pm, tile;
        if (r < 8) { tile = (r & (RPG - 1)) * TPR + tcol(r, s); pm = 16 + d.x * 16 + (1 << PB) * (r / RPG) + (s >> TBITS);
                     if (tile >= 15) { const int ci = ctx_idle(r, s); tile = 5 + (ci < 6 ? ci : ci - 6); pm = d.x * 2 + (ci < 6 ? 0 : 1); } }
        else { tile = s & 15; pm = d.x * 2 + (s >> 4); }
        const char* pa = (const char*)(hx + (size_t)pm * 256 * DmF::D); const char* pb = (const char*)(wt + (size_t)tile * 256 * DmF::D); const bool sw = tile < 3 || tile >= 13 || tile == 9 || tile == 10;
        u.a = sw ? pb : pa; u.b = sw ? pa : pb; u.i0 = pm; u.i1 = tile; u.i2 = sw ? 1 : 0; u.i3 = 0; u.rows = nullptr;
    }
    __device__ __forceinline__ bool next_generic(int i, pg8::Unit& u) const {
        const int nx = 128 * 15, nc = last ? 96 : 240; const int li = i * (int)gridDim.x + (int)blockIdx.x; if (li >= nx + nc) return false;
        int pm, tile; if (li < nx) { const int q15 = (li * 34953) >> 19; pm = 16 + q15; tile = li - q15 * 15; } else { const int q = li - nx; if (last) { const int q6 = (q * 43) >> 8; pm = q6; tile = 5 + q - q6 * 6; } else { const int q15 = (q * 34953) >> 19; pm = q15; tile = q - q15 * 15; } }
        const char* pa = (const char*)(hx + (size_t)pm * 256 * DmF::D); const char* pb = (const char*)(wt + (size_t)tile * 256 * DmF::D); const bool sw = tile < 3 || tile >= 13 || tile == 9 || tile == 10;
        u.a = sw ? pb : pa; u.b = sw ? pa : pb; u.i0 = pm; u.i1 = tile; u.i2 = sw ? 1 : 0; u.i3 = 0; u.rows = nullptr; return true;
    }
};
__device__ __forceinline__ void f_inproj(const PF& p, const FastWs& f, int layer, int last, LAS unsigned char* lds) {
    SchedInproj S; S.hx = p.hx; S.wt = f.wt_in; S.last = last; S.d.init();
    EpiInproj E{p.z, p.zh_c, p.zh_x, p.pq_c, p.pq_x, p.vit, p.lbv + layer * 2 * DmF::DHG};
#ifdef STAG_US
    { const int xq = STAG_XCD ? ((int)blockIdx.x & 7) : ((int)blockIdx.x >> 3); const int g3 = (xq * 43) >> 7; const int r3 = xq - 3 * g3;
      if (r3) { const unsigned long long t0 = wall_clock64(), dt = (unsigned long long)(r3 * STAG_US * 100 / 3); while (wall_clock64() - t0 < dt) __builtin_amdgcn_s_sleep(8); } }
#endif
#ifndef INPROJ_ALIGN
#define INPROJ_ALIGN true
#endif
#ifdef DIAG_GEMMTIME
    pg8::gemm_phase<EpiInproj, SchedInproj, INPROJ_ALIGN>(lds, pg8::Gemm{DmF::D, DmF::D, DmF::D, layer == 0 ? p.cnt + 48 : nullptr}, S, E);
#else
    pg8::gemm_phase<EpiInproj, SchedInproj, INPROJ_ALIGN>(lds, pg8::Gemm{DmF::D, DmF::D, DmF::D}, S, E);
#endif
}

#ifndef XBF16
#define XBF16 1
#endif
#if XBF16
struct EpiWout {
    static constexpr int TPK = 2;
    static constexpr bool PERM = true; static constexpr int NST = 8;
    bf16s* xb; const float* mod; float scale;
    __device__ __forceinline__ void operator()(const f32x4 (&acc)[2][2][4][2], const pg8::Unit& u, int wr, int wc, int fr, int fq) const {
        const int pm = u.i0; const int col0 = u.i1 * 256 + wc * 32 + 8 * fq;
        const int mr = pm < 16 ? DmF::B : (pm - 16) / 8;
        bf16s* base = xb + (size_t)pm * 256 * DmF::D;
        const float* gate = mod + ((size_t)mr * 6 + 2) * DmF::D;
        f32x4 gv[2][2];
#pragma unroll
        for (int bj = 0; bj < 2; ++bj)
#pragma unroll
            for (int n = 0; n < 2; ++n) gv[bj][n] = *(const f32x4*)(gate + col0 + bj * 128 + n * 4) * scale;
#pragma unroll
        for (int ai = 0; ai < 2; ++ai) { u32x4 old[4][2];
#pragma unroll
            for (int m = 0; m < 4; ++m)
#pragma unroll
                for (int bj = 0; bj < 2; ++bj) old[m][bj] = *(const u32x4*)(base + (size_t)(ai * 128 + wr * 64 + m * 16 + fr) * DmF::D + col0 + bj * 128);
#pragma unroll
            for (int m = 0; m < 4; ++m)
#pragma unroll
                for (int bj = 0; bj < 2; ++bj) { const f32x4 v0 = unpack4((u32x2){old[m][bj].x, old[m][bj].y}) + gv[bj][0] * acc[ai][bj][m][0], v1 = unpack4((u32x2){old[m][bj].z, old[m][bj].w}) + gv[bj][1] * acc[ai][bj][m][1];
                    u32x4 w; w.x = cvt_pk_bf16(v0[0], v0[1]); w.y = cvt_pk_bf16(v0[2], v0[3]); w.z = cvt_pk_bf16(v1[0], v1[1]); w.w = cvt_pk_bf16(v1[2], v1[3]);
                    *(u32x4*)(base + (size_t)(ai * 128 + wr * 64 + m * 16 + fr) * DmF::D + col0 + bj * 128) = w; } }
    }
};
#else
struct EpiWout {
    static constexpr int TPK = 2;
    static constexpr bool PERM = false; static constexpr int NST = 8;
    float* cw; float* out; const float* mod; float scale;
    __device__ __forceinline__ void operator()(const f32x4 (&acc)[2][2][4][2], const pg8::Unit& u, int wr, int wc, int fr, int fq) const {
        const int pm = u.i0; const int col0 = u.i1 * 256 + wc * 32 + 4 * fq;
        const int mr = pm < 16 ? DmF::B : (pm - 16) / 8;
        float* base = pm < 16 ? cw + (size_t)pm * 256 * DmF::D : out + (size_t)(pm - 16) * 256 * DmF::D;
        const float* gate = mod + ((size_t)mr * 6 + 2) * DmF::D;
        f32x4 gv[2][2];
#pragma unroll
        for (int bj = 0; bj < 2; ++bj)
#pragma unroll
            for (int n = 0; n < 2; ++n) gv[bj][n] = *(const f32x4*)(gate + col0 + bj * 128 + n * 16) * scale;
#pragma unroll
        for (int ai = 0; ai < 2; ++ai)
#pragma unroll
            for (int m0 = 0; m0 < 4; m0 += 2) { f32x4 old[2][2][2];
#pragma unroll
                for (int mm = 0; mm < 2; ++mm) { const float* rowp = base + (size_t)(ai * 128 + wr * 64 + (m0 + mm) * 16 + fr) * DmF::D + col0;
#pragma unroll
                    for (int bj = 0; bj < 2; ++bj)
#pragma unroll
                        for (int n = 0; n < 2; ++n) old[mm][bj][n] = *(const f32x4*)(rowp + bj * 128 + n * 16); }
#pragma unroll
                for (int mm = 0; mm < 2; ++mm) { float* rowp = base + (size_t)(ai * 128 + wr * 64 + (m0 + mm) * 16 + fr) * DmF::D + col0;
#pragma unroll
                    for (int bj = 0; bj < 2; ++bj)
#pragma unroll
                        for (int n = 0; n < 2; ++n) *(f32x4*)(rowp + bj * 128 + n * 16) = old[mm][bj][n] + gv[bj][n] * acc[ai][bj][m0 + mm][n]; } }
    }
};
#endif
struct SchedWout {
    const bf16s* mix; const bf16s* wt; int p0; Deal d;
    __device__ __forceinline__ bool next(int i, pg8::Unit& u) const {
        const int ppx = (144 - p0) >> 3; const int li = i * d.W + d.j; if (li >= ppx * 4) return false;
        const int pm = p0 + d.x * ppx + (li >> 2), tile = li & 3;
        u.a = (const char*)(mix + (size_t)pm * 256 * DmF::D); u.b = (const char*)(wt + (size_t)tile * 256 * DmF::D); u.i0 = pm; u.i1 = tile; u.i2 = 0; u.i3 = 0; u.rows = nullptr;
        return true;
    }
};
__device__ __forceinline__ void f_wout(const PF& p, const FastWs& f, int layer, int r0, LAS unsigned char* lds, float scale = 1.f) {
    SchedWout S; S.mix = p.hx; S.wt = f.wt_out; S.p0 = r0 / 256; S.d.init();
#if XBF16
    EpiWout E{p.xb, p.mod + (size_t)layer * (DmF::B + 1) * 6 * DmF::D, scale};
#else
    EpiWout E{p.cw, p.out, p.mod + (size_t)layer * (DmF::B + 1) * 6 * DmF::D, scale};
#endif
#ifndef WOUT_ALIGN
#define WOUT_ALIGN true
#endif
    pg8::gemm_phase<EpiWout, SchedWout, WOUT_ALIGN>(lds, pg8::Gemm{DmF::D, DmF::D, DmF::D}, S, E);
}

__device__ __forceinline__ void f_gather(const PF& p, const FastWs& f) {
    const int total = NVF::moe_off(p, DmF::E);
    const long items = (long)total * 128;
    for (long i = (long)blockIdx.x * NTHREADS + tidx(); i < items; i += (long)gridDim.x * NTHREADS) {
        const int pos = (int)(i >> 7), ch = (int)(i & 127); const int ts = p.perm[pos];
        u32x4 v = (u32x4){0u, 0u, 0u, 0u};
        if (ts >= 0) v = *(const u32x4*)(p.hx + (size_t)(ts >> 1) * DmF::D + ch * 8);
        *(u32x4*)(f.hxs + (size_t)pos * DmF::D + ch * 8) = v;
    }
}
struct SchedMoe {
    const char* abase; size_t apanel; const char* bbase; size_t bexp, btile; const int* cnt; int npanels; Deal d; const int* perm;
    int segend[16];
    __device__ __forceinline__ void init_segments() { int o = 0;
#pragma unroll
        for (int j = 0; j < DmF::E; ++j) { o += (cnt[j] + 255) / 256 * 256; segend[j] = o; } }
    __device__ __forceinline__ int expert_of(int pos) const { int e = 0;
#pragma unroll
        for (int j = 0; j < DmF::E - 1; ++j) e += (pos >= segend[j]) ? 1 : 0;
        return e; }
    __device__ __forceinline__ bool next(int i, pg8::Unit& u) const {
        const int li = i * d.W + d.j; const int mine = (npanels - d.x + 7) >> 3; if (li >= mine * 4) return false;
        const int pm = d.x + 8 * (li >> 2), tile = li & 3;
        const int e = expert_of(pm * 256);
        u.a = perm ? abase : abase + (size_t)pm * apanel; u.b = bbase + (size_t)e * bexp + (size_t)tile * btile; u.i0 = pm; u.i1 = tile; u.i2 = e; u.i3 = 0; u.rows = perm ? perm + pm * 256 : nullptr;
        return true;
    }
};
struct EpiGateUp {
    static constexpr int TPK = 3;
    static constexpr bool PERM = true; static constexpr int NST = 8;
    bf16s* hmid;
    __device__ __forceinline__ void operator()(const f32x4 (&acc)[2][2][4][2], const pg8::Unit& u, int wr, int wc, int fr, int fq) const {
        const int row0 = u.i0 * 256 + wr * 64 + fr; const int col = u.i1 * 128 + wc * 32 + 8 * fq;
#pragma unroll
        for (int ai = 0; ai < 2; ++ai)
#pragma unroll
            for (int m = 0; m < 4; ++m) {
                float v[8];
#pragma unroll
                for (int j = 0; j < 4; ++j) { v[j] = fast_silu(acc[ai][0][m][0][j]) * acc[ai][1][m][0][j]; v[4 + j] = fast_silu(acc[ai][0][m][1][j]) * acc[ai][1][m][1][j]; }
                u32x4 w; w.x = cvt_pk_bf16(v[0], v[1]); w.y = cvt_pk_bf16(v[2], v[3]); w.z = cvt_pk_bf16(v[4], v[5]); w.w = cvt_pk_bf16(v[6], v[7]);
                *(u32x4*)(hmid + (size_t)(row0 + ai * 128 + m * 16) * DmF::DE + col) = w;
            }
    }
};
#ifndef YMOE_FP8
#define YMOE_FP8 1
#endif
__device__ __forceinline__ unsigned pack4_fp8(f32x4 v) {
    unsigned w = 0;
    w = __builtin_amdgcn_cvt_pk_fp8_f32(__builtin_amdgcn_fmed3f(v[0], -440.f, 440.f), __builtin_amdgcn_fmed3f(v[1], -440.f, 440.f), w, false);
    w = __builtin_amdgcn_cvt_pk_fp8_f32(__builtin_amdgcn_fmed3f(v[2], -440.f, 440.f), __builtin_amdgcn_fmed3f(v[3], -440.f, 440.f), w, true);
    return w;
}
__device__ __forceinline__ f32x4 unpack4_fp8(unsigned w) { const f32x2 a = __builtin_amdgcn_cvt_pk_f32_fp8(w, false), b = __builtin_amdgcn_cvt_pk_f32_fp8(w, true); return (f32x4){a[0], a[1], b[0], b[1]}; }
struct EpiDown {
    static constexpr int TPK = 4;
    static constexpr bool PERM = true; static constexpr int NST = 16;
    bf16s* ymoe;
    __device__ __forceinline__ void operator()(const f32x4 (&acc)[2][2][4][2], const pg8::Unit& u, int wr, int wc, int fr, int fq) const {
        const int row0 = u.i0 * 256 + wr * 64 + fr; const int col = u.i1 * 256 + wc * 32 + 8 * fq;
#pragma unroll
        for (int ai = 0; ai < 2; ++ai)
#pragma unroll
            for (int m = 0; m < 4; ++m)
#pragma unroll
                for (int bj = 0; bj < 2; ++bj) { const f32x4 v0 = acc[ai][bj][m][0], v1 = acc[ai][bj][m][1];
#if YMOE_FP8
                    *(u32x2*)((unsigned char*)ymoe + (size_t)(row0 + ai * 128 + m * 16) * DmF::D + col + bj * 128) = (u32x2){pack4_fp8(v0), pack4_fp8(v1)};
#else
                    u32x4 w; w.x = cvt_pk_bf16(v0[0], v0[1]); w.y = cvt_pk_bf16(v0[2], v0[3]); w.z = cvt_pk_bf16(v1[0], v1[1]); w.w = cvt_pk_bf16(v1[2], v1[3]);
                    *(u32x4*)(ymoe + (size_t)(row0 + ai * 128 + m * 16) * DmF::D + col + bj * 128) = w;
#endif
                }
    }
};
__device__ __forceinline__ void f_gateup(const PF& p, const FastWs& f, LAS unsigned char* lds) {
    SchedMoe S; S.abase = (const char*)p.hx; S.perm = p.perm; S.apanel = 0; S.bbase = (const char*)f.wt_gu; S.bexp = (size_t)1024 * DmF::D * 2; S.btile = (size_t)256 * DmF::D * 2;
    S.cnt = p.cnt; S.init_segments(); S.npanels = S.segend[DmF::E - 1] / 256; S.d.init();
    EpiGateUp E{p.hmid};
#ifndef GATEUP_ALIGN
#define GATEUP_ALIGN true
#endif
    pg8::gemm_phase<EpiGateUp, SchedMoe, GATEUP_ALIGN, true>(lds, pg8::Gemm{DmF::D, DmF::D, DmF::D}, S, E);
}
__device__ __forceinline__ void f_down(const PF& p, const FastWs& f, int layer, LAS unsigned char* lds) {
    SchedMoe S; S.perm = nullptr; S.abase = (const char*)p.hmid; S.apanel = (size_t)256 * DmF::DE * 2; S.bbase = (const char*)f.wt_d; S.bexp = (size_t)DmF::D * DmF::DE * 2; S.btile = (size_t)256 * DmF::DE * 2;
    S.cnt = p.cnt; S.init_segments(); S.npanels = S.segend[DmF::E - 1] / 256; S.d.init();
    EpiDown E{f.hxs};
#ifndef DOWN_ALIGN
#define DOWN_ALIGN true
#endif
    pg8::gemm_phase<EpiDown, SchedMoe, DOWN_ALIGN>(lds, pg8::Gemm{DmF::DE, DmF::DE, DmF::DE}, S, E);
}

#ifndef DFT_DOUBLE
#define DFT_DOUBLE 0
#endif
constexpr int DFT_ADA_ITEMS = DmF::DEPTH * 6 * DmF::D / 64;
__device__ __forceinline__ void f_gen_dft(const PF& p, LAS unsigned char* lds, int rank = -2, int nwork = 0) {
    if (rank == -1) return;
    LAS float* CT = (LAS float*)lds; LAS float* ST = CT + 2048;
    for (int m = tidx(); m < 2048; m += NTHREADS) { const float ang = 6.283185307179586f * (float)m / 2048.f; CT[m] = cosf(ang); ST[m] = sinf(ang); }
    __syncthreads();
    const int nvw_ = (DFT_DOUBLE && (int)gridDim.x > DFT_ADA_ITEMS) ? DFT_ADA_ITEMS + 2 * ((int)gridDim.x - DFT_ADA_ITEMS) : (int)gridDim.x;
    const long nth = (long)(rank >= 0 ? nwork : nvw_) * NTHREADS;
    const float sx = 1.0f / sqrtf(64.f * 2048.f), sc = 1.0f / sqrtf(64.f * 256.f);
    constexpr long NX = (long)1024 * 4096;
    for (int rep_ = 0; rep_ < 2; ++rep_) { const int b_ = (int)blockIdx.x; if (rep_ && (!DFT_DOUBLE || b_ < DFT_ADA_ITEMS)) break; const int vw_ = (!DFT_DOUBLE || b_ < DFT_ADA_ITEMS) ? b_ : DFT_ADA_ITEMS + 2 * (b_ - DFT_ADA_ITEMS) + rep_;
    if (rank >= 0 && rep_) break;
    for (long i = (long)(rank >= 0 ? rank : vw_) * NTHREADS + tidx(); i < (NX + 256 * 512) / 2; i += nth) {
        const long e = i * 2; const bool isx = e < NX; const long ii = isx ? e : e - NX; const int Lw = isx ? 2048 : 256, sh = isx ? 0 : 3;
        const int k = (int)(ii / (2 * Lw)), lp = (int)(ii % (2 * Lw)), sn = lp >= Lw, l = sn ? lp - Lw : lp; const float s = isx ? sx : sc;
        const int m0 = ((k * l) & (Lw - 1)) << sh, m1 = ((k * (l + 1)) & (Lw - 1)) << sh;
        const float v0 = (sn ? -ST[m0] : CT[m0]) * s, v1 = (sn ? -ST[m1] : CT[m1]) * s;
        *(unsigned*)((isx ? p.dft_x : p.dft_c) + ii) = cvt_pk_bf16(v0, v1);
    } }
    __syncthreads();
}
__device__ __forceinline__ float bflo(unsigned w) { return __uint_as_float(w << 16); }
__device__ __forceinline__ float bfhi(unsigned w) { return __uint_as_float(w & 0xffff0000u); }
#ifndef FNET_CTX_WG0
#define FNET_CTX_WG0 64
#endif
struct EpiFnet {
    static constexpr int TPK = 5;
    static constexpr bool PERM = true; static constexpr int NST = 16;
    bf16s* yfn; const float* fn_b;
    __device__ __forceinline__ void operator()(const f32x4 (&acc)[2][2][4][2], const pg8::Unit& u, int wr, int wc, int fr, int fq) const {
        const int row0 = u.i0 + wr * 64 + fr; const int col0 = wc * 32 + 8 * fq;
#pragma unroll
        for (int bj = 0; bj < 2; ++bj) { const f32x4 b0 = *(const f32x4*)(fn_b + col0 + bj * 128), b1 = *(const f32x4*)(fn_b + col0 + bj * 128 + 4);
#pragma unroll
            for (int ai = 0; ai < 2; ++ai)
#pragma unroll
                for (int m = 0; m < 4; ++m) { const f32x4 v0 = acc[ai][bj][m][0] + b0, v1 = acc[ai][bj][m][1] + b1;
                    u32x4 w; w.x = cvt_pk_bf16(v0[0], v0[1]); w.y = cvt_pk_bf16(v0[2], v0[3]); w.z = cvt_pk_bf16(v1[0], v1[1]); w.w = cvt_pk_bf16(v1[2], v1[3]);
                    *(u32x4*)(yfn + (size_t)(row0 + ai * 128 + m * 16) * 256 + col0 + bj * 128) = w; } }
    }
};
struct SchedFnet {
    const bf16s* dft; const bf16s* pq; int first, n, npk_shift, rowbase, Lw;
    __device__ __forceinline__ bool next(int i, pg8::Unit& u) const {
        const int li = i * (int)gridDim.x + (int)blockIdx.x - first; if (li < 0 || li >= n) return false;
        const int b = li >> npk_shift, kp = li & ((1 << npk_shift) - 1);
        u.a = (const char*)(dft + (size_t)kp * 256 * 2 * Lw); u.b = (const char*)(pq + (size_t)b * 256 * 2 * Lw); u.i0 = rowbase + b * Lw + kp * 256; u.i1 = 0; u.i2 = 0; u.i3 = 0; u.rows = nullptr;
        return true;
    }
};
struct EpiFnetFold {
    static constexpr int TPK = 6;
    static constexpr bool PERM = true; static constexpr int NST = 16;
    bf16s* yfn; const float* fn_b;
    __device__ __forceinline__ void operator()(const f32x4 (&acc)[2][2][4][2], const pg8::Unit& u, int wr, int wc, int fr, int fq) const {
        const int lr0 = wr * 64 + fr, row0 = u.i0 + lr0; const int col0 = wc * 32 + 8 * fq;
        if (u.i1 == 0) {
#pragma unroll
            for (int bj = 0; bj < 2; ++bj)
#pragma unroll
                for (int ai = 0; ai < 2; ++ai)
#pragma unroll
                    for (int m = 0; m < 4; ++m) { const f32x4 v0 = acc[ai][bj][m][0], v1 = acc[ai][bj][m][1];
                        u32x4 w; w.x = cvt_pk_bf16(v0[0], v0[1]); w.y = cvt_pk_bf16(v0[2], v0[3]); w.z = cvt_pk_bf16(v1[0], v1[1]); w.w = cvt_pk_bf16(v1[2], v1[3]);
                        *(u32x4*)(yfn + (size_t)(row0 + ai * 128 + m * 16) * 256 + col0 + bj * 128) = w; }
        } else {
            const int mr0 = u.i2 - lr0;
#pragma unroll
            for (int bj = 0; bj < 2; ++bj) { const f32x4 b0 = *(const f32x4*)(fn_b + col0 + bj * 128), b1 = *(const f32x4*)(fn_b + col0 + bj * 128 + 4);
                u32x4 cw[2][4];
#pragma unroll
                for (int ai = 0; ai < 2; ++ai)
#pragma unroll
                    for (int m = 0; m < 4; ++m) cw[ai][m] = *(const u32x4*)(yfn + (size_t)(row0 + ai * 128 + m * 16) * 256 + col0 + bj * 128);
#pragma unroll
                for (int ai = 0; ai < 2; ++ai)
#pragma unroll
                    for (int m = 0; m < 4; ++m) { const u32x4 c = cw[ai][m];
                        const f32x4 c0 = (f32x4){bflo(c.x), bfhi(c.x), bflo(c.y), bfhi(c.y)} + b0, c1 = (f32x4){bflo(c.z), bfhi(c.z), bflo(c.w), bfhi(c.w)} + b1;
                        const f32x4 p0 = c0 + acc[ai][bj][m][0], p1 = c1 + acc[ai][bj][m][1], q0 = c0 - acc[ai][bj][m][0], q1 = c1 - acc[ai][bj][m][1];
                        u32x4 w; w.x = cvt_pk_bf16(p0[0], p0[1]); w.y = cvt_pk_bf16(p0[2], p0[3]); w.z = cvt_pk_bf16(p1[0], p1[1]); w.w = cvt_pk_bf16(p1[2], p1[3]);
                        *(u32x4*)(yfn + (size_t)(row0 + ai * 128 + m * 16) * 256 + col0 + bj * 128) = w;
                        const int mr = mr0 - ai * 128 - m * 16;
                        if (mr < u.i3) { u32x4 x; x.x = cvt_pk_bf16(q0[0], q0[1]); x.y = cvt_pk_bf16(q0[2], q0[3]); x.z = cvt_pk_bf16(q1[0], q1[1]); x.w = cvt_pk_bf16(q1[2], q1[3]);
                            *(u32x4*)(yfn + (size_t)mr * 256 + col0 + bj * 128) = x; } } }
        }
    }
};
struct SchedFnetFold {
    const bf16s* dft; const bf16s* pq; int first;
    __device__ __forceinline__ bool next(int i, pg8::Unit& u) const {
        const int li = (int)blockIdx.x - first; if (i >= 2 || li < 0 || li >= 64) return false;
        const int b = li >> 2, kp = li & 3;
        u.a = (const char*)(dft + (size_t)kp * 256 * 4096 + i * 2048); u.b = (const char*)(pq + (size_t)b * 256 * 4096 + i * 2048);
        u.i0 = NVF::RC + b * 2048 + kp * 256; u.i1 = i; u.i2 = NVF::RC + b * 2048 + 2048 - kp * 256; u.i3 = NVF::RC + (b + 1) * 2048; u.rows = nullptr;
        return true;
    }
};
__device__ __forceinline__ void f_fnet(const PF& p, int layer, int with_ctx, LAS unsigned char* lds) {
    { TP_B(10) EpiFnetFold E{p.yfn, p.fn_b + layer * 256}; SchedFnetFold S{p.dft_x, p.pq_x, 0}; pg8::gemm_phase<EpiFnetFold, SchedFnetFold>(lds, pg8::Gemm{2048, 4096, 4096}, S, E); TP_E(10, lds) }
    if (with_ctx) { EpiFnet E{p.yfn, p.fn_b + layer * 256}; SchedFnet S{p.dft_c, p.pq_c, FNET_CTX_WG0, 16, 0, 0, 256}; pg8::gemm_phase<EpiFnet, SchedFnet>(lds, pg8::Gemm{512, 512, 512}, S, E); }
}
__device__ __forceinline__ float wave_sum(float v) {
#pragma unroll
    for (int o = 32; o >= 1; o >>= 1) v += __shfl_xor(v, o);
    return v;
}

#ifndef XBF16
#define XBF16 1
#endif
#if XBF16
#define XS_LOAD4(p, R, c) unpack4(*(const u32x2*)((p).xb + (size_t)(R) * DmF::D + (c)))
#define XS_STORE4(p, R, c, v) (*(u32x2*)((p).xb + (size_t)(R) * DmF::D + (c)) = pack4(v))
#else
#define XS_LOAD4(p, R, c) (*(const f32x4*)(NVF::xrow((p), (R)) + (c)))
#define XS_STORE4(p, R, c, v) (*(f32x4*)(NVF::xrow((p), (R)) + (c)) = (v))
#endif
struct MoePos { int p0, p1; float g0, g1; };
__device__ __forceinline__ MoePos moe_pos_load(const PF& p, int R) { MoePos m; m.p0 = p.rpos[R * 2]; m.p1 = p.rpos[R * 2 + 1]; m.g0 = p.rgp[R * 2]; m.g1 = p.rgp[R * 2 + 1]; return m; }
#if YMOE_FP8
struct MoeRows { unsigned a[4], b[4]; float g0, g1; };
__device__ __forceinline__ MoeRows moe_rows_load(const bf16s* ymoe, const MoePos& m, int lane) { MoeRows y; y.g0 = m.g0; y.g1 = m.g1; const unsigned char* yb = (const unsigned char*)ymoe;
#pragma unroll
    for (int i = 0; i < 4; ++i) { const int c = i * 256 + lane * 4; y.a[i] = *(const unsigned*)(yb + (size_t)m.p0 * DmF::D + c); y.b[i] = *(const unsigned*)(yb + (size_t)m.p1 * DmF::D + c); }
    return y; }
__device__ __forceinline__ void moe_combine_apply(const PF& p, const MoeRows& y, int player, int R, int lane, f32x4 (&v)[4]) {
    const float* m5 = NVF::modp(p, player, NVF::row_modr(R), 5);
#pragma unroll
    for (int i = 0; i < 4; ++i) { const int c = i * 256 + lane * 4; v[i] = v[i] + *(const f32x4*)(m5 + c) * (unpack4_fp8(y.a[i]) * y.g0 + unpack4_fp8(y.b[i]) * y.g1); }
}
#else
struct MoeRows { u32x2 a[4], b[4]; float g0, g1; };
__device__ __forceinline__ MoeRows moe_rows_load(const bf16s* ymoe, const MoePos& m, int lane) { MoeRows y; y.g0 = m.g0; y.g1 = m.g1;
#pragma unroll
    for (int i = 0; i < 4; ++i) { const int c = i * 256 + lane * 4; y.a[i] = *(const u32x2*)(ymoe + (size_t)m.p0 * DmF::D + c); y.b[i] = *(const u32x2*)(ymoe + (size_t)m.p1 * DmF::D + c); }
    return y; }
__device__ __forceinline__ void moe_combine_apply(const PF& p, const MoeRows& y, int player, int R, int lane, f32x4 (&v)[4]) {
    const float* m5 = NVF::modp(p, player, NVF::row_modr(R), 5);
#pragma unroll
    for (int i = 0; i < 4; ++i) { const int c = i * 256 + lane * 4; v[i] = v[i] + *(const f32x4*)(m5 + c) * (unpack4(y.a[i]) * y.g0 + unpack4(y.b[i]) * y.g1); }
}
#endif
template <bool ROUTER, bool COMBINE, bool INIT = false>
__device__ __forceinline__ void f_normmod(const PF& p, const bf16s* ymoe, int layer, int which, int r0, LAS unsigned char* lds, const float* postab = nullptr) {
    const int t = tidx(), lane = t & 63, gw = blockIdx.x * (NTHREADS / 64) + (t >> 6), NGW = gdimx() * (NTHREADS / 64);
    const float* g = (which ? p.norm2_g : p.norm1_g) + layer * DmF::D;
    LAS int* hist = (LAS int*)lds;
    LAS float* RW = (LAS float*)(lds + 256);
    LAS float* LG = (LAS float*)(lds + 256 + 16 * DmF::D * 4 + (t >> 6) * 2048);
    if constexpr (ROUTER) { if (t < 16) hist[t] = 0;
        for (int i = t; i < DmF::D * 16; i += NTHREADS) { const int k = i >> 4, e = i & 15; RW[e * DmF::D + k] = p.router_w[i]; }
        __syncthreads(); }
    const int rpw = (NVF::RALL - r0 + NGW - 1) / NGW, Rb = r0 + gw * rpw, Re = (Rb + rpw < NVF::RALL) ? Rb + rpw : NVF::RALL;
    f32x4 nv[4];
#define NM_LOAD(RR, dst) do { _Pragma("unroll") for (int i_ = 0; i_ < 4; ++i_) { if constexpr (INIT) { if ((RR) < NVF::RC) dst[i_] = *(const f32x4*)(p.ctx + (size_t)(RR) * DmF::D + i_ * 256 + lane * 4); \
            else dst[i_] = *(const f32x4*)(p.x + (size_t)((RR) - NVF::RC) * DmF::D + i_ * 256 + lane * 4) + *(const f32x4*)(postab + (size_t)(((RR) - NVF::RC) % DmF::L) * DmF::D + i_ * 256 + lane * 4); } \
            else dst[i_] = XS_LOAD4(p, (RR), i_ * 256 + lane * 4); } } while (0)
    MoePos npos; MoeRows nrows; int cur_mr = -1; f32x4 scg[4], shv[4];
    float rb[16];
    if constexpr (ROUTER) {
#pragma unroll
        for (int e = 0; e < 16; ++e) rb[e] = p.router_b[e]; }
    if (Rb < Re) { NM_LOAD(Rb, nv); if constexpr (COMBINE) { npos = moe_pos_load(p, Rb); nrows = moe_rows_load(ymoe, npos, lane); if (Rb + 1 < Re) npos = moe_pos_load(p, Rb + 1); } }
    for (int R = Rb; R < Re; ++R) {
        f32x4 v[4]; float ss = 0.f; MoeRows crows;
#pragma unroll
        for (int i = 0; i < 4; ++i) v[i] = nv[i];
        if constexpr (COMBINE) crows = nrows;
        if (R + 1 < Re) { NM_LOAD(R + 1, nv); if constexpr (COMBINE) { nrows = moe_rows_load(ymoe, npos, lane); if (R + 2 < Re) npos = moe_pos_load(p, R + 2); } }
        if constexpr (COMBINE) moe_combine_apply(p, crows, layer - 1, R, lane, v);
        if constexpr (COMBINE || INIT) {
#pragma unroll
            for (int i = 0; i < 4; ++i) XS_STORE4(p, R, i * 256 + lane * 4, v[i]); }
#pragma unroll
        for (int i = 0; i < 4; ++i) ss += v[i][0] * v[i][0] + v[i][1] * v[i][1] + v[i][2] * v[i][2] + v[i][3] * v[i][3];
        ss = wave_sum(ss);
        const float rstd = 1.0f / sqrtf(ss * (1.0f / DmF::D) + 1e-6f);
        const int mr = NVF::row_modr(R);
        if (mr != cur_mr) { cur_mr = mr; const float* sh = NVF::modp(p, layer, mr, which ? 3 : 0); const float* sc = NVF::modp(p, layer, mr, which ? 4 : 1);
#pragma unroll
            for (int i = 0; i < 4; ++i) { const int c = i * 256 + lane * 4; scg[i] = (*(const f32x4*)(sc + c) + 1.0f) * *(const f32x4*)(g + c); shv[i] = *(const f32x4*)(sh + c); } }
        bf16s* h = p.hx + (size_t)R * DmF::D;
#pragma unroll
        for (int i = 0; i < 4; ++i) { const int c = i * 256 + lane * 4; v[i] = v[i] * rstd * scg[i] + shv[i]; *(u32x2*)(h + c) = pack4(v[i]); }
        if constexpr (ROUTER) {
            f32x4 a4[16];
#pragma unroll
            for (int e = 0; e < 16; ++e) { a4[e] = v[0] * *(const LAS f32x4*)(RW + e * DmF::D + lane * 4);
#pragma unroll
                for (int i = 1; i < 4; ++i) a4[e] += v[i] * *(const LAS f32x4*)(RW + e * DmF::D + i * 256 + lane * 4); }
            float r8[8], r4[4], r2[2], r1;
            { const bool hi = (lane & 32) != 0;
#pragma unroll
              for (int j = 0; j < 8; ++j) { const float lo_ = (a4[j][0] + a4[j][1]) + (a4[j][2] + a4[j][3]), hi_ = (a4[8 + j][0] + a4[8 + j][1]) + (a4[8 + j][2] + a4[8 + j][3]);
                  r8[j] = (hi ? hi_ : lo_) + __shfl_xor(hi ? lo_ : hi_, 32); } }
            { const bool hi = (lane & 16) != 0;
#pragma unroll
              for (int j = 0; j < 4; ++j) r4[j] = (hi ? r8[4 + j] : r8[j]) + __shfl_xor(hi ? r8[j] : r8[4 + j], 16); }
            { const bool hi = (lane & 8) != 0;
#pragma unroll
              for (int j = 0; j < 2; ++j) r2[j] = (hi ? r4[2 + j] : r4[j]) + __shfl_xor(hi ? r4[j] : r4[2 + j], 8); }
            { const bool hi = (lane & 4) != 0; r1 = (hi ? r2[1] : r2[0]) + __shfl_xor(hi ? r2[0] : r2[1], 4); }
            r1 += __shfl_xor(r1, 2); r1 += __shfl_xor(r1, 1);
            const int slot = (R - Rb) & 31;
            if ((lane & 3) == 0) LG[slot * 16 + (((lane >> 5) & 1) * 8 + ((lane >> 4) & 1) * 4 + ((lane >> 3) & 1) * 2 + ((lane >> 2) & 1))] = r1;
            if (slot == 31 || R + 1 == Re) {
              if (lane <= slot) {
                const int RR = R - slot + lane;
                float lg[16];
#pragma unroll
                for (int q = 0; q < 4; ++q) { const f32x4 x = *(const LAS f32x4*)(LG + lane * 16 + q * 4); lg[q * 4] = x[0]; lg[q * 4 + 1] = x[1]; lg[q * 4 + 2] = x[2]; lg[q * 4 + 3] = x[3]; }
                float mx = lg[0];
#pragma unroll
                for (int e = 1; e < 16; ++e) mx = fmaxf(mx, lg[e]);
                float den = 0.f;
#pragma unroll
                for (int e = 0; e < 16; ++e) { lg[e] = __expf(lg[e] - mx); den += lg[e]; }
                const float rden = 1.0f / den;
                float bestg = -1e30f; int bi0 = 0, bi1 = 0; float bp0 = 0.f, bp1 = 0.f;
#pragma unroll
                for (int gI = 0; gI < 4; ++gI) {
                    float s0 = -1e30f, s1 = -1e30f, p0 = 0.f, p1 = 0.f; int i0 = 0, i1 = 0;
#pragma unroll
                    for (int j = 0; j < 4; ++j) { const int e = gI * 4 + j; const float pr = lg[e] * rden; const float s = pr + rb[e];
                        if (s > s0) { s1 = s0; i1 = i0; p1 = p0; s0 = s; i0 = e; p0 = pr; } else if (s > s1) { s1 = s; i1 = e; p1 = pr; } }
                    const float gs = s0 + s1;
                    if (gs > bestg) { bestg = gs; bi0 = i0; bi1 = i1; bp0 = p0; bp1 = p1; }
                }
                const float sum = bp0 + bp1;
                p.ridx[RR * 2] = bi0; p.ridx[RR * 2 + 1] = bi1; p.rgp[RR * 2] = bp0 / sum; p.rgp[RR * 2 + 1] = bp1 / sum;
                p.rrank[RR * 2] = __hip_atomic_fetch_add(hist + bi0, 1, __ATOMIC_RELAXED, __HIP_MEMORY_SCOPE_WORKGROUP);
                p.rrank[RR * 2 + 1] = __hip_atomic_fetch_add(hist + bi1, 1, __ATOMIC_RELAXED, __HIP_MEMORY_SCOPE_WORKGROUP);
              }
            }
        }
    }
#undef NM_LOAD
    if constexpr (ROUTER) { __syncthreads(); if (t < 16) p.wgbase[blockIdx.x * 16 + t] = atomicAdd(p.cnt + t, hist[t]); __syncthreads(); }
}
__device__ __forceinline__ void f_nm2_router(const PF& p, int layer, int r0, LAS unsigned char* lds) {
    const int t = tidx(), lane = t & 63, gw = blockIdx.x * (NTHREADS / 64) + (t >> 6), NGW = gdimx() * (NTHREADS / 64);
    const float* g = p.norm2_g + layer * DmF::D;
    LAS int* hist = (LAS int*)lds;
    LAS float* RW = (LAS float*)(lds + 256);
    LAS float* LG = (LAS float*)(lds + 256 + 16 * DmF::D * 4 + (t >> 6) * 2048);
    if (t < 16) hist[t] = 0;
    { constexpr int NE = DmF::D * 16 / 4 / NTHREADS; static_assert(DmF::D * 16 % (4 * NTHREADS) == 0, "router weight staging");
      f32x4 rv[NE];
#pragma unroll
      for (int e = 0; e < NE; ++e) rv[e] = *(const f32x4*)(p.router_w + (size_t)(t + e * NTHREADS) * 4);
#pragma unroll
      for (int e = 0; e < NE; ++e) { const int i4 = t + e * NTHREADS, k = i4 >> 2, e0 = 4 * (i4 & 3);
#pragma unroll
          for (int j = 0; j < 4; ++j) RW[(e0 + j) * DmF::D + k] = rv[e][j]; } }
    __syncthreads();
    const int rpw = (NVF::RALL - r0 + NGW - 1) / NGW, Rb = r0 + gw * rpw, Re = (Rb + rpw < NVF::RALL) ? Rb + rpw : NVF::RALL;
    u32x2 nA[4], nB[4], mA[4], mB[4];
#define NM2_LOADP(RR, dA, dB) do { const int ra_ = (RR) < Re ? (RR) : Re - 1, rb_ = ra_ + 1 < Re ? ra_ + 1 : ra_; _Pragma("unroll") for (int i_ = 0; i_ < 4; ++i_) { \
        dA[i_] = *(const u32x2*)(p.xb + (size_t)ra_ * DmF::D + i_ * 256 + lane * 4); dB[i_] = *(const u32x2*)(p.xb + (size_t)rb_ * DmF::D + i_ * 256 + lane * 4); } } while (0)
#define NM2_ADV(RR) ((RR) + ((((RR) + 1 < Re) && NVF::row_modr((RR) + 1) == NVF::row_modr(RR)) ? 2 : 1))
    int cur_mr = -1; f32x4 scg[4], shv[4];
    float rb[16];
#pragma unroll
    for (int e = 0; e < 16; ++e) rb[e] = p.router_b[e];
    if (Rb < Re) { NM2_LOADP(Rb, nA, nB); const int r1_ = NM2_ADV(Rb); NM2_LOADP(r1_, mA, mB); }
    int base = Rb, R = Rb;
    TP_B(70)
    auto trip = [&](u32x2 (&cA)[4], u32x2 (&cB)[4]) {
        const int mr = NVF::row_modr(R);
        const bool two = (R + 1 < Re) && NVF::row_modr(R + 1) == mr;
        const int Rn = R + (two ? 2 : 1);
        f32x4 vA[4], vB[4];
#pragma unroll
        for (int i = 0; i < 4; ++i) { vA[i] = unpack4(cA[i]); vB[i] = unpack4(cB[i]); }
        { const int r2_ = Rn < Re ? NM2_ADV(Rn) : Rn; NM2_LOADP(r2_, cA, cB); }
        float sA = 0.f, sB = 0.f;
#pragma unroll
        for (int i = 0; i < 4; ++i) { sA += vA[i][0] * vA[i][0] + vA[i][1] * vA[i][1] + vA[i][2] * vA[i][2] + vA[i][3] * vA[i][3]; sB += vB[i][0] * vB[i][0] + vB[i][1] * vB[i][1] + vB[i][2] * vB[i][2] + vB[i][3] * vB[i][3]; }
#pragma unroll
        for (int o = 32; o >= 1; o >>= 1) { sA += __shfl_xor(sA, o); sB += __shfl_xor(sB, o); }
        const float rsA = 1.0f / sqrtf(sA * (1.0f / DmF::D) + 1e-6f), rsB = 1.0f / sqrtf(sB * (1.0f / DmF::D) + 1e-6f);
        if (mr != cur_mr) { cur_mr = mr; const float* sh = NVF::modp(p, layer, mr, 3); const float* sc = NVF::modp(p, layer, mr, 4);
#pragma unroll
            for (int i = 0; i < 4; ++i) { const int c = i * 256 + lane * 4; scg[i] = (*(const f32x4*)(sc + c) + 1.0f) * *(const f32x4*)(g + c); shv[i] = *(const f32x4*)(sh + c); } }
        bf16s* hA = p.hx + (size_t)R * DmF::D; bf16s* hB = p.hx + (size_t)(R + 1) * DmF::D;
#pragma unroll
        for (int i = 0; i < 4; ++i) { const int c = i * 256 + lane * 4; vA[i] = vA[i] * rsA * scg[i] + shv[i]; *(u32x2*)(hA + c) = pack4(vA[i]); vB[i] = vB[i] * rsB * scg[i] + shv[i]; if (two) *(u32x2*)(hB + c) = pack4(vB[i]); }
        TP_B(71)
        float lA[16], lB[16];
#pragma unroll
        for (int e = 0; e < 16; ++e) {
            const f32x4 w0 = *(const LAS f32x4*)(RW + e * DmF::D + lane * 4), w1 = *(const LAS f32x4*)(RW + e * DmF::D + 256 + lane * 4), w2 = *(const LAS f32x4*)(RW + e * DmF::D + 512 + lane * 4), w3 = *(const LAS f32x4*)(RW + e * DmF::D + 768 + lane * 4);
            const f32x4 a = vA[0] * w0 + vA[1] * w1 + vA[2] * w2 + vA[3] * w3, b = vB[0] * w0 + vB[1] * w1 + vB[2] * w2 + vB[3] * w3;
            lA[e] = (a[0] + a[1]) + (a[2] + a[3]); lB[e] = (b[0] + b[1]) + (b[2] + b[3]); }
        float r8[8], q8[8], r4[4], q4[4], r2[2], q2[2], r1, q1;
        { const bool hi = (lane & 32) != 0;
#pragma unroll
          for (int j = 0; j < 8; ++j) { r8[j] = (hi ? lA[8 + j] : lA[j]) + __shfl_xor(hi ? lA[j] : lA[8 + j], 32); q8[j] = (hi ? lB[8 + j] : lB[j]) + __shfl_xor(hi ? lB[j] : lB[8 + j], 32); } }
        { const bool hi = (lane & 16) != 0;
#pragma unroll
          for (int j = 0; j < 4; ++j) { r4[j] = (hi ? r8[4 + j] : r8[j]) + __shfl_xor(hi ? r8[j] : r8[4 + j], 16); q4[j] = (hi ? q8[4 + j] : q8[j]) + __shfl_xor(hi ? q8[j] : q8[4 + j], 16); } }
        { const bool hi = (lane & 8) != 0;
#pragma unroll
          for (int j = 0; j < 2; ++j) { r2[j] = (hi ? r4[2 + j] : r4[j]) + __shfl_xor(hi ? r4[j] : r4[2 + j], 8); q2[j] = (hi ? q4[2 + j] : q4[j]) + __shfl_xor(hi ? q4[j] : q4[2 + j], 8); } }
        { const bool hi = (lane & 4) != 0; r1 = (hi ? r2[1] : r2[0]) + __shfl_xor(hi ? r2[0] : r2[1], 4); q1 = (hi ? q2[1] : q2[0]) + __shfl_xor(hi ? q2[0] : q2[1], 4); }
        r1 += __shfl_xor(r1, 2); q1 += __shfl_xor(q1, 2); r1 += __shfl_xor(r1, 1); q1 += __shfl_xor(q1, 1);
        const int slot = R - base, ex = ((lane >> 5) & 1) * 8 + ((lane >> 4) & 1) * 4 + ((lane >> 3) & 1) * 2 + ((lane >> 2) & 1);
        if ((lane & 3) == 0) { LG[slot * 16 + ex] = r1; if (two) LG[(slot + 1) * 16 + ex] = q1; }
        TP_E(71, lds)
        if (Rn - base >= 31 || Rn >= Re) {
            if (lane < Rn - base) {
                const int RR = base + lane;
                float lg[16];
#pragma unroll
                for (int q = 0; q < 4; ++q) { const f32x4 x = *(const LAS f32x4*)(LG + lane * 16 + q * 4); lg[q * 4] = x[0]; lg[q * 4 + 1] = x[1]; lg[q * 4 + 2] = x[2]; lg[q * 4 + 3] = x[3]; }
                float mx = lg[0];
#pragma unroll
                for (int e = 1; e < 16; ++e) mx = fmaxf(mx, lg[e]);
                float den = 0.f;
#pragma unroll
                for (int e = 0; e < 16; ++e) { lg[e] = __expf(lg[e] - mx); den += lg[e]; }
                const float rden = 1.0f / den;
                float bestg = -1e30f; int bi0 = 0, bi1 = 0; float bp0 = 0.f, bp1 = 0.f;
#pragma unroll
                for (int gI = 0; gI < 4; ++gI) {
                    float s0 = -1e30f, s1 = -1e30f, p0 = 0.f, p1 = 0.f; int i0 = 0, i1 = 0;
#pragma unroll
                    for (int j = 0; j < 4; ++j) { const int e = gI * 4 + j; const float pr = lg[e] * rden; const float s = pr + rb[e];
                        if (s > s0) { s1 = s0; i1 = i0; p1 = p0; s0 = s; i0 = e; p0 = pr; } else if (s > s1) { s1 = s; i1 = e; p1 = pr; } }
                    const float gs = s0 + s1;
                    if (gs > bestg) { bestg = gs; bi0 = i0; bi1 = i1; bp0 = p0; bp1 = p1; }
                }
                const float sum = bp0 + bp1;
                p.ridx[RR * 2] = bi0; p.ridx[RR * 2 + 1] = bi1; p.rgp[RR * 2] = bp0 / sum; p.rgp[RR * 2 + 1] = bp1 / sum;
                p.rrank[RR * 2] = __hip_atomic_fetch_add(hist + bi0, 1, __ATOMIC_RELAXED, __HIP_MEMORY_SCOPE_WORKGROUP);
                p.rrank[RR * 2 + 1] = __hip_atomic_fetch_add(hist + bi1, 1, __ATOMIC_RELAXED, __HIP_MEMORY_SCOPE_WORKGROUP);
            }
            base = Rn;
        }
        R = Rn;
    };
    while (R < Re) { trip(nA, nB); if (R >= Re) break; trip(mA, mB); }
#undef NM2_LOADP
#undef NM2_ADV
    TP_E(70, lds)
    __syncthreads(); if (t < 16) p.wgbase[blockIdx.x * 16 + t] = atomicAdd(p.cnt + t, hist[t]); __syncthreads();
}
__device__ __forceinline__ void f_place_gather(const PF& p, const FastWs& f, int r0) {
    const int t = tidx(), lane = t & 63, gw = blockIdx.x * (NTHREADS / 64) + (t >> 6), NGW = gdimx() * (NTHREADS / 64);
    const int rpw = (NVF::RALL - r0 + NGW - 1) / NGW, Rb = r0 + gw * rpw, Re = (Rb + rpw < NVF::RALL) ? Rb + rpw : NVF::RALL;
    for (int it = lane; it < (Re - Rb) * 2; it += 64) { const int ts = Rb * 2 + it, e = p.ridx[ts];
        const int pos = NVF::moe_off(p, e) + p.wgbase[blockIdx.x * 16 + e] + p.rrank[ts]; p.perm[pos] = ts; p.rpos[ts] = pos; }
}
__device__ __forceinline__ void f_mix(const PF& p, int layer, int r0) {
    const int t = tidx(), lane = t & 63, gw = blockIdx.x * (NTHREADS / 64) + (t >> 6), NGW = gdimx() * (NTHREADS / 64);
    for (int R = r0 + gw; R < NVF::RALL; R += NGW) {
        bf16s* m = p.hx + (size_t)R * DmF::D;
        { f32x4 v = unpack4(*(const u32x2*)(p.y2 + (size_t)R * 256 + lane * 4)); float ss = wave_sum(v[0] * v[0] + v[1] * v[1] + v[2] * v[2] + v[3] * v[3]);
          const float rstd = 1.0f / sqrtf(ss * (1.0f / 256.f) + 1e-6f); const f32x4 gv = *(const f32x4*)(p.hy_norm_g + layer * 256 + lane * 4);
          *(u32x2*)(m + lane * 4) = pack4(v * rstd * gv); }
        {
          const u32x4 w = *(const u32x4*)(p.o + (size_t)R * 512 + lane * 8); f32x4 a = unpack4((u32x2){w.x, w.y}), b = unpack4((u32x2){w.z, w.w});
          float ss = a[0] * a[0] + a[1] * a[1] + a[2] * a[2] + a[3] * a[3] + b[0] * b[0] + b[1] * b[1] + b[2] * b[2] + b[3] * b[3];
#pragma unroll
          for (int o = 8; o >= 1; o >>= 1) ss += __shfl_xor(ss, o);
          const float rstd = 1.0f / sqrtf(ss * (1.0f / 128.f) + 1e-6f);
          const u32x4 gw4 = *(const u32x4*)(p.z + (size_t)R * NVF::ZS + NVF::OFF_G + lane * 8); const f32x4 ga = unpack4((u32x2){gw4.x, gw4.y}), gb = unpack4((u32x2){gw4.z, gw4.w});
          const f32x4 na = *(const f32x4*)(p.hg_norm_g + layer * 512 + lane * 8), nb = *(const f32x4*)(p.hg_norm_g + layer * 512 + lane * 8 + 4);
          const u32x2 o0 = pack4(a * rstd * na * ga), o1 = pack4(b * rstd * nb * gb);
          *(u32x4*)(m + 256 + lane * 8) = (u32x4){o0.x, o0.y, o1.x, o1.y}; }
        { f32x4 v = unpack4(*(const u32x2*)(p.yfn + (size_t)R * 256 + lane * 4)); float ss = wave_sum(v[0] * v[0] + v[1] * v[1] + v[2] * v[2] + v[3] * v[3]);
          const float rstd = 1.0f / sqrtf(ss * (1.0f / 256.f) + 1e-6f); const f32x4 gv = *(const f32x4*)(p.fn_norm_g + layer * 256 + lane * 4);
          *(u32x2*)(m + 768 + lane * 4) = pack4(v * rstd * gv); }
    }
}
__device__ __forceinline__ void f_final(const PF& p, const bf16s* ymoe) {
    const int t = tidx(), lane = t & 63, gw = blockIdx.x * (NTHREADS / 64) + (t >> 6), NGW = gdimx() * (NTHREADS / 64);
    const int rpw = (NVF::RX + NGW - 1) / NGW, Rb = gw * rpw, Re = (Rb + rpw < NVF::RX) ? Rb + rpw : NVF::RX;
    f32x4 gfin[4];
#pragma unroll
    for (int i = 0; i < 4; ++i) gfin[i] = *(const f32x4*)(p.final_g + i * 256 + lane * 4);
    f32x4 nv[4]; MoePos npos; MoeRows nrows;
#define FN_LOAD(RR) do { _Pragma("unroll") for (int i_ = 0; i_ < 4; ++i_) nv[i_] = XS_LOAD4(p, NVF::RC + (RR), i_ * 256 + lane * 4); } while (0)
    if (Rb < Re) { FN_LOAD(Rb); npos = moe_pos_load(p, NVF::RC + Rb); nrows = moe_rows_load(ymoe, npos, lane); if (Rb + 1 < Re) npos = moe_pos_load(p, NVF::RC + Rb + 1); }
    for (int R = Rb; R < Re; ++R) {
        float* xr = p.out + (size_t)R * DmF::D;
        f32x4 v[4]; float ss = 0.f; const MoeRows crows = nrows;
#pragma unroll
        for (int i = 0; i < 4; ++i) v[i] = nv[i];
        if (R + 1 < Re) { FN_LOAD(R + 1); nrows = moe_rows_load(ymoe, npos, lane); if (R + 2 < Re) npos = moe_pos_load(p, NVF::RC + R + 2); }
        moe_combine_apply(p, crows, DmF::DEPTH - 1, NVF::RC + R, lane, v);
#pragma unroll
        for (int i = 0; i < 4; ++i) ss += v[i][0] * v[i][0] + v[i][1] * v[i][1] + v[i][2] * v[i][2] + v[i][3] * v[i][3];
        ss = wave_sum(ss);
        const float rstd = 1.0f / sqrtf(ss * (1.0f / DmF::D) + 1e-6f);
#pragma unroll
        for (int i = 0; i < 4; ++i) *(f32x4*)(xr + i * 256 + lane * 4) = v[i] * rstd * gfin[i];
    }
#undef FN_LOAD
#ifdef DIAG_OUT
    __syncthreads();
    if (blockIdx.x == 0 && t == 0) { asm volatile("s_waitcnt vmcnt(0)" ::: "memory"); p.out[0] = 1.0e4f * (1.0f + (float)__hip_atomic_load(p.cnt + DIAG_OUT, __ATOMIC_RELAXED, __HIP_MEMORY_SCOPE_AGENT)); }
#endif
#ifdef DIAG_SANITIZE
    __syncthreads();
    if (blockIdx.x == 0 && t == 0) { asm volatile("s_waitcnt vmcnt(0)" ::: "memory"); p.out[0] = 1.0e4f * (1.0f + (float)__hip_atomic_load(p.cnt + 40, __ATOMIC_RELAXED, __HIP_MEMORY_SCOPE_AGENT)); }
#endif
}
#ifndef HY_G
#define HY_G 8
#endif
#ifndef HY_EG
#define HY_EG 16
#endif
#ifndef REP_HYCONV
#define REP_HYCONV 1
#endif
template <int L> struct HyG {
    static_assert(8 * (2 * L * 2 + 32) + 16 * (L * 2 + 16) <= LDS_MISC_OFF, "Hyena LDS image does not fit");
    static constexpr int TB = L / 128;
    static constexpr int CS = 2 * L * 2 + 32;
    static constexpr int RSB = L * 2 + 16;
    static constexpr int U_OFF = 8 * CS;
    static constexpr int BYTES = U_OFF + 16 * RSB;
};

template <int L> __device__ __forceinline__ void hy_kr_load(const bf16s* kr, int t, u32x4& c0, u32x4& c1) {
    constexpr int NCH = 2 * L / 8; static_assert(NCH <= NTHREADS, "one chunk per thread");
    const int w = t < NCH ? t : NCH - 1;
    c0 = *(const u32x4*)(kr + w * 8); c1 = *(const u32x4*)(kr + (w + 1 < NCH ? w + 1 : w) * 8);
}
template <int L> __device__ __forceinline__ void hy_kr_write(LAS unsigned char* lds, int t, const u32x4& c0, u32x4 c1) {
    constexpr int NCH = 2 * L / 8;
    if (t < NCH) { const int w = t;
        if (w + 1 >= NCH) c1 = (u32x4){0u, 0u, 0u, 0u};
        unsigned S[8];
        S[0] = c0.x; S[1] = c0.y; S[2] = c0.z; S[3] = c0.w; S[4] = c1.x; S[5] = c1.y; S[6] = c1.z; S[7] = c1.w;
#pragma unroll
        for (int a = 0; a < 8; ++a) { u32x4 o;
            if ((a & 1) == 0) { o.x = S[a / 2]; o.y = S[a / 2 + 1]; o.z = S[a / 2 + 2]; o.w = S[a / 2 + 3]; }
            else { const int h = (a - 1) / 2; o.x = (S[h] >> 16) | (S[h + 1] << 16); o.y = (S[h + 1] >> 16) | (S[h + 2] << 16); o.z = (S[h + 2] >> 16) | (S[h + 3] << 16); o.w = (S[h + 3] >> 16) | (S[h + 4] << 16); }
            *(LAS u32x4*)(lds + a * HyG<L>::CS + w * 16) = o; }
    }
}
template <int L> struct HyRows {
    static constexpr int NCH = 16 * L / 8, PT = NCH / NTHREADS, CPR = L / 8; static_assert(NCH % NTHREADS == 0 && PT >= 1, "chunking");
    u32x4 v[PT]; unsigned e[PT];
};
template <int L> __device__ __forceinline__ void hy_rows_load(HyRows<L>& R, const bf16s* zrow, int t) {
    constexpr int PT = HyRows<L>::PT, CPR = HyRows<L>::CPR; const int lane = t & 63;
    const int s0 = (t % CPR) * 8;
    static_assert(NTHREADS % HyRows<L>::CPR == 0, "s0 must not depend on the chunk index");
    const int sel = (lane == 0 && s0 > 0) ? -2 : (lane == 63 && s0 + 8 < L) ? 8 : 0;
    const bf16s* src = zrow + (size_t)t * 8;
#pragma unroll
    for (int u = 0; u < PT; ++u) { R.v[u] = *(const u32x4*)(src + u * NTHREADS * 8); R.e[u] = *(const unsigned*)(src + u * NTHREADS * 8 + sel); }
}
template <int L> __device__ __forceinline__ void hy_rows_conv3(LAS unsigned char* dst, const HyRows<L>& R, float w0, float w1, float w2, float bias, int t) {
    constexpr int PT = HyRows<L>::PT, CPR = HyRows<L>::CPR; const int lane = t & 63;
#pragma unroll
    for (int u = 0; u < PT; ++u) { const int q = t + u * NTHREADS; const int b = q / CPR, s0 = (q % CPR) * 8;
        u32x4 o = R.v[u];
        const unsigned pw = (unsigned)__shfl_up((int)o.w, 1), nw = (unsigned)__shfl_down((int)o.x, 1);
        const float prev = s0 > 0 ? bfhi(lane == 0 ? R.e[u] : pw) : 0.f, nxt = s0 + 8 < L ? bflo(lane == 63 ? R.e[u] : nw) : 0.f;
        float z[10]; z[0] = prev; z[1] = bflo(o.x); z[2] = bfhi(o.x); z[3] = bflo(o.y); z[4] = bfhi(o.y); z[5] = bflo(o.z); z[6] = bfhi(o.z); z[7] = bflo(o.w); z[8] = bfhi(o.w); z[9] = nxt;
        float uu[8];
#pragma unroll
        for (int e = 0; e < 8; ++e) uu[e] = w0 * z[e] + w1 * z[e + 1] + w2 * z[e + 2] + bias;
        o.x = cvt_pk_bf16(uu[0], uu[1]); o.y = cvt_pk_bf16(uu[2], uu[3]); o.z = cvt_pk_bf16(uu[4], uu[5]); o.w = cvt_pk_bf16(uu[6], uu[7]);
        *(LAS u32x4*)(dst + b * HyG<L>::RSB + s0 * 2) = o; }
}
template <int L> __device__ __forceinline__ void hy_copy_out(LAS unsigned char* lds, bf16s* outp, int t) {
    constexpr int PT = HyRows<L>::PT, CPR = HyRows<L>::CPR;
#pragma unroll
    for (int u = 0; u < PT; ++u) { const int q = t + u * NTHREADS; const int b = q / CPR, s0 = (q % CPR) * 8;
        *(u32x4*)(outp + (size_t)b * L + s0) = *(const LAS u32x4*)(lds + HyG<L>::U_OFF + b * HyG<L>::RSB + s0 * 2); }
}
template <int L> __device__ __forceinline__ void hy_kloop(LAS unsigned char* lds, f32x4 (&acc)[HyG<L>::TB], int t) {
    constexpr int TB = HyG<L>::TB, CS = HyG<L>::CS, RSB = HyG<L>::RSB, U_OFF = HyG<L>::U_OFF, NJ = L / 32;
    const int lane = t & 63, w = __builtin_amdgcn_readfirstlane(t >> 6), r = lane & 15, q = lane >> 4;
    const int a = 7 - (r & 7);
    const int baseA = a * CS + 2 * (L - 8 - 8 * (r >> 3) + 8 * q) - 32 * TB * w;
    const int baseB = U_OFF + r * RSB + 16 * q;
    bf16x8 F[TB];
#pragma unroll
    for (int ii = 0; ii < TB; ++ii) acc[ii] = (f32x4){0.f, 0.f, 0.f, 0.f};
#pragma unroll
    for (int ii = 2; ii < TB; ++ii) F[ii] = *(const LAS bf16x8*)(lds + baseA - 32 * ii);
    constexpr int PER = TB / 2;
    TP_B(6)
    for (int j0 = 0; j0 < NJ; j0 += PER) {
        const int pA = baseA + 64 * j0, pB = baseB + 64 * j0;
#pragma unroll
        for (int jj = 0; jj < PER; ++jj) {
            F[(0 - 2 * jj) & (TB - 1)] = *(const LAS bf16x8*)(lds + pA + 64 * jj);
            F[(1 - 2 * jj) & (TB - 1)] = *(const LAS bf16x8*)(lds + pA + 64 * jj - 32);
            const bf16x8 Bf = *(const LAS bf16x8*)(lds + pB + 64 * jj);
#pragma unroll
            for (int ii = 0; ii < TB; ++ii) acc[ii] = __builtin_amdgcn_mfma_f32_16x16x32_bf16(F[(ii - 2 * jj) & (TB - 1)], Bf, acc[ii], 0, 0, 0);
        }
    }
    TP_E(6, lds)
}
template <int L> __device__ __forceinline__ void hy_gate_mul(LAS unsigned char* lds, const f32x4 (&acc)[HyG<L>::TB], int t) {
    constexpr int TB = HyG<L>::TB, RSB = HyG<L>::RSB, U_OFF = HyG<L>::U_OFF;
    const int lane = t & 63, w = __builtin_amdgcn_readfirstlane(t >> 6), r = lane & 15, q = lane >> 4;
#pragma unroll
    for (int ii = 0; ii < TB; ++ii) { const int t0 = 16 * (TB * w + ii) + 4 * q;
        const u32x2 g = *(const LAS u32x2*)(lds + r * RSB + t0 * 2);
        u32x2 wv; wv.x = cvt_pk_bf16(acc[ii][0] * bflo(g.x), acc[ii][1] * bfhi(g.x)); wv.y = cvt_pk_bf16(acc[ii][2] * bflo(g.y), acc[ii][3] * bfhi(g.y));
        *(LAS u32x2*)(lds + U_OFF + r * RSB + t0 * 2) = wv; }
}
template <int L> __device__ __forceinline__ void hy_unit(const PF& p, int layer, int c, LAS unsigned char* lds, const bf16s* zh, size_t zstride, const bf16s* krt, bf16s* y1t, bf16s* y2t) {
    static_assert(16 * HyG<L>::RSB <= 8 * HyG<L>::CS, "the gate block must fit the kernel copies' space");
    const int t = tidx();
    const float* cw = p.hy_conv_w + (size_t)layer * 9 * 256; const float* cb = p.hy_conv_b + (size_t)layer * 3 * 256;
    const bf16s* zv = zh + (size_t)c * zstride; const bf16s* z1 = zh + (size_t)(256 + c) * zstride; const bf16s* z2 = zh + (size_t)(512 + c) * zstride;
    u32x4 ka, kb; HyRows<L> R; f32x4 acc[HyG<L>::TB];
    TP_B(1) TP_B(3)
    hy_kr_load<L>(krt + (size_t)c * 2 * L, t, ka, kb);
    hy_rows_load<L>(R, zv, t);
    hy_kr_write<L>(lds, t, ka, kb);
    hy_rows_conv3<L>(lds + HyG<L>::U_OFF, R, cw[c], cw[768 + c], cw[1536 + c], cb[c], t);
    hy_kr_load<L>(krt + (size_t)(256 + c) * 2 * L, t, ka, kb);
    hy_rows_load<L>(R, z1, t);
    lds_barrier();
    TP_E(3, lds) TP_B(2)
    hy_kloop<L>(lds, acc, t);
    lds_barrier();
    hy_rows_conv3<L>(lds, R, cw[256 + c], cw[768 + 256 + c], cw[1536 + 256 + c], cb[256 + c], t);
    lds_barrier();
    hy_gate_mul<L>(lds, acc, t);
    lds_barrier();
    TP_E(2, lds) TP_B(4)
    hy_kr_write<L>(lds, t, ka, kb);
    hy_rows_load<L>(R, z2, t);
    lds_barrier();
    TP_E(4, lds) TP_B(5)
    hy_kloop<L>(lds, acc, t);
    lds_barrier();
    hy_rows_conv3<L>(lds, R, cw[512 + c], cw[768 + 512 + c], cw[1536 + 512 + c], cb[512 + c], t);
    lds_barrier();
    hy_gate_mul<L>(lds, acc, t);
    lds_barrier();
    hy_copy_out<L>(lds, y2t + (size_t)c * zstride, t);
    lds_barrier();
    TP_E(5, lds) TP_E(1, lds)
}
#ifndef HY_CTXN
#define HY_CTXN 64
#endif
#ifndef HY_NA
#define HY_NA 1
#endif
__device__ __forceinline__ void f_hyena(const PF& p, int layer, int with_ctx, LAS unsigned char* lds, int wg0, int nwg) {
    const int me = (int)blockIdx.x - wg0; if (me < 0 || me >= nwg) return;
    if (nwg == 128) {
        constexpr int NB = (256 - 64 * HY_NA) / 64; static_assert(64 * HY_NA + 64 * NB == 256, "HY_NA");
        const int c0 = me < 64 ? me * HY_NA : 64 * HY_NA + (me - 64) * NB, n = me < 64 ? HY_NA : NB;
        for (int c = c0; c < c0 + n; ++c)
            hy_unit<2048>(p, layer, c, lds, p.zh_x, NVF::RX, p.krt_x + (size_t)layer * 2 * 256 * 4096, p.y1t_x, p.y2t_x);
    } else {
        for (int c = me; c < 256; c += nwg)
            hy_unit<2048>(p, layer, c, lds, p.zh_x, NVF::RX, p.krt_x + (size_t)layer * 2 * 256 * 4096, p.y1t_x, p.y2t_x);
    }
    if (with_ctx) {
        const int cn = nwg == 128 ? HY_CTXN : nwg;
        if (me < cn)
            for (int c = me; c < 256; c += cn)
                hy_unit<256>(p, layer, c, lds, p.zh_c, NVF::RC, p.krt_c + (size_t)layer * 2 * 256 * 512, p.y1t_c, p.y2t_c);
    }
}
__device__ __forceinline__ void f_gen_krt(const PF& p) {
    const long tid = (long)blockIdx.x * NTHREADS + tidx(), nth = (long)gridDim.x * NTHREADS;
    constexpr int NC = DmF::NC, L = DmF::L, C = DmF::C, FH = DmF::FH;
    const float max_decay = logf(1e-2f) / 0.3f, min_decay = logf(1e-2f) / 1.5f;
    for (long i = tid; i < (long)DmF::DEPTH * (NC + L) * 4 * C; i += nth) {
        const int oc = (int)(i % (4 * C)), ll = (int)((i / (4 * C)) % (NC + L)), layer = (int)(i / ((long)4 * C * (NC + L)));
        const int isx = ll >= NC, Lw = isx ? L : NC, l = isx ? ll - NC : ll, c = oc % C, fdir = oc / C, order = fdir >> 1, bwd = fdir & 1;
        const float tt = (float)l / (float)(Lw - 1);
        const float* h2 = p.hf2 + (i / (4 * C)) * FH;
        const float* w3 = p.hy_w3 + (size_t)layer * FH * 4 * C + oc;
        float acc = 0.f;
        for (int k = 0; k < FH; ++k) acc += h2[k] * w3[(size_t)k * 4 * C];
        const float delta = min_decay + (max_decay - min_decay) * (float)c / (float)(C - 1);
        float v = acc * expf(-tt * fabsf(delta));
        bf16s* kr = (isx ? p.krt_x : p.krt_c) + ((size_t)(layer * 2 + order) * 256 + c) * 2 * Lw;
        if (!bwd) { if (l == 0) v += p.hy_bias[(layer * 2 + order) * C + c]; kr[(Lw - 1) - l] = f2bf(v); }
        else { if (l > 0) kr[(Lw - 1) + l] = f2bf(v); else kr[2 * Lw - 1] = 0; }
    }
}
__device__ __forceinline__ void f_mix2(const PF& p, int layer, int r0, LAS unsigned char* lds) {
    const int t = tidx(), lane = t & 63, wv = t >> 6;
    constexpr int TS = 132;
    LAS float* ssb = (LAS float*)(lds + 256 * TS);
    float gq[32];
#pragma unroll
    for (int k = 0; k < 32; ++k) gq[k] = p.hy_norm_g[layer * 256 + wv * 32 + k];
    for (int tile = r0 / 64 + blockIdx.x; tile < NVF::RALL / 64; tile += gridDim.x) {
        const int R0 = tile * 64; const bool isc = R0 < NVF::RC;
        const bf16s* src = isc ? p.y2t_c + R0 : p.y2t_x + (R0 - NVF::RC); const size_t stride = isc ? NVF::RC : NVF::RX;
        u32x4 hvv[4];
#pragma unroll
        for (int e = 0; e < 4; ++e) { const int q = t + e * NTHREADS, ch = q >> 3, k = q & 7; hvv[e] = *(const u32x4*)(src + (size_t)ch * stride + k * 8); }
        u32x4 wo[8], wb[8], wg[8]; u32x2 wf[8];
#pragma unroll
        for (int u = 0; u < 8; ++u) { const size_t R = (size_t)(R0 + wv * 8 + u);
            wo[u] = *(const u32x4*)(p.o + R * 512 + lane * 8); wb[u] = *(const u32x4*)(p.ob + R * 512 + lane * 8);
            wg[u] = *(const u32x4*)(p.z + R * NVF::ZS + NVF::OFF_G + lane * 8); wf[u] = *(const u32x2*)(p.yfn + R * 256 + lane * 4); }
#pragma unroll
        for (int e = 0; e < 4; ++e) { const int q = t + e * NTHREADS, ch = q >> 3, k = q & 7; const u32x4 v = hvv[e];
            LAS unsigned* d = (LAS unsigned*)(lds + ch * TS + k * 16); d[0] = v.x; d[1] = v.y; d[2] = v.z; d[3] = v.w; }
        lds_barrier();
        float hv[32]; float ss = 0.f;
#pragma unroll
        for (int k = 0; k < 32; ++k) { hv[k] = bf2f(*(const LAS bf16s*)(lds + (wv * 32 + k) * TS + lane * 2)); ss += hv[k] * hv[k]; }
        ssb[wv * 64 + lane] = ss;
        lds_barrier();
        float tot = 0.f;
#pragma unroll
        for (int k = 0; k < 8; ++k) tot += ssb[k * 64 + lane];
        { const float rstd = 1.0f / sqrtf(tot * (1.0f / 256.f) + 1e-6f); bf16s* m = p.hx + (size_t)(R0 + lane) * DmF::D + wv * 32;
#pragma unroll
          for (int k = 0; k < 32; k += 8) { u32x4 w; w.x = cvt_pk_bf16(hv[k] * rstd * gq[k], hv[k + 1] * rstd * gq[k + 1]); w.y = cvt_pk_bf16(hv[k + 2] * rstd * gq[k + 2], hv[k + 3] * rstd * gq[k + 3]);
              w.z = cvt_pk_bf16(hv[k + 4] * rstd * gq[k + 4], hv[k + 5] * rstd * gq[k + 5]); w.w = cvt_pk_bf16(hv[k + 6] * rstd * gq[k + 6], hv[k + 7] * rstd * gq[k + 7]); *(u32x4*)(m + k) = w; } }
        { const f32x4 na = *(const f32x4*)(p.hg_norm_g + layer * 512 + lane * 8), nb = *(const f32x4*)(p.hg_norm_g + layer * 512 + lane * 8 + 4), gf = *(const f32x4*)(p.fn_norm_g + layer * 256 + lane * 4);
          {
#pragma unroll
            for (int u = 0; u < 8; ++u) { const int R = R0 + wv * 8 + u; bf16s* m = p.hx + (size_t)R * DmF::D;
                f32x4 a = unpack4((u32x2){wo[u].x, wo[u].y}) + unpack4((u32x2){wb[u].x, wb[u].y}), b = unpack4((u32x2){wo[u].z, wo[u].w}) + unpack4((u32x2){wb[u].z, wb[u].w});
                float s2 = a[0] * a[0] + a[1] * a[1] + a[2] * a[2] + a[3] * a[3] + b[0] * b[0] + b[1] * b[1] + b[2] * b[2] + b[3] * b[3];
#pragma unroll
                for (int o = 8; o >= 1; o >>= 1) s2 += __shfl_xor(s2, o);
                const float rstd = 1.0f / sqrtf(s2 * (1.0f / 128.f) + 1e-6f);
                f32x4 ga = unpack4((u32x2){wg[u].x, wg[u].y}), gb = unpack4((u32x2){wg[u].z, wg[u].w});
#pragma unroll
                for (int e = 0; e < 4; ++e) { ga[e] = fast_silu(ga[e]); gb[e] = fast_silu(gb[e]); }
                const u32x2 o0 = pack4(a * rstd * na * ga), o1 = pack4(b * rstd * nb * gb);
                *(u32x4*)(m + 256 + lane * 8) = (u32x4){o0.x, o0.y, o1.x, o1.y};
                f32x4 v = unpack4(wf[u]); float s3 = wave_sum(v[0] * v[0] + v[1] * v[1] + v[2] * v[2] + v[3] * v[3]);
                const float rstd3 = 1.0f / sqrtf(s3 * (1.0f / 256.f) + 1e-6f);
                *(u32x2*)(m + 768 + lane * 4) = pack4(v * rstd3 * gf); }
          } }
        lds_barrier();
    }
}
#ifndef REP_HG3
#define REP_HG3 1
#endif
#ifndef HG_LOADPOS
#define HG_LOADPOS 0
#endif
#ifndef HG_FLIP
#define HG_FLIP 1
#endif
#ifndef HG_FLIP2
#define HG_FLIP2 0
#endif
#ifndef HG_ORDSH
#define HG_ORDSH 2
#endif
#ifndef HG_ORD
#define HG_ORD 0
#endif
#if HG_ORD
#define HG_SUBLOOP_PRAGMA _Pragma("nounroll")
#else
#define HG_SUBLOOP_PRAGMA _Pragma("unroll")
#endif
namespace hg {
constexpr int RS = 272, QE_SZ = 64 * RS, KET_SZ = 128 * 144, PT_SZ = 64 * 144;
constexpr int QE_OFF = 0, QM_OFF = QE_OFF + 2 * QE_SZ, KM_OFF = QM_OFF + 64 * RS  , KET_OFF = KM_OFF + 160 * RS, PT_OFF = KET_OFF + 2 * KET_SZ,
              TOT_OFF = PT_OFF + 2 * PT_SZ  , G_OFF = TOT_OFF + 4096  , END = G_OFF + 1024;
static_assert(END <= LDS_MISC_OFF, "HGRN LDS image does not fit");
typedef __bf16 bf16x2n __attribute__((ext_vector_type(2)));
__device__ __forceinline__ unsigned pk(float a, float b) { f32x2 v = {a, b}; bf16x2n r = __builtin_convertvector(v, bf16x2n); return __builtin_bit_cast(unsigned, r); }
__device__ __forceinline__ unsigned swp(unsigned x) { return (x >> 16) | (x << 16); }
__device__ __forceinline__ int chunk_rlo(int cc, int b, int dir) {
    const int seg = cc >= 4, ck = seg ? cc - 4 : cc, nck = seg ? 32 : 4, r0 = seg ? NVF::RC + b * 2048 : b * 256;
    return dir ? r0 + 64 * (nck - 1 - ck) : r0 + 64 * ck;
}
}
__device__ __forceinline__ void f_hgrn(const PF& p, LAS unsigned char* lds) {
    using namespace hg;
    const int t = tidx(), lane = t & 63, w = __builtin_amdgcn_readfirstlane(t >> 6), lr = lane & 15, qd = lane >> 4;
    const int sg = w >> 1, hh = w & 1, tau0 = 16 * sg + 8 * hh, d0 = 2 * lane;
    const int ord = ((w >> HG_ORDSH) & HG_ORD) ^ HG_FLIP, ord2 = ((w >> HG_ORDSH) & HG_ORD) ^ HG_FLIP2;
    const int dq = (d0 & ~31) + 8 * ((d0 >> 2) & 3) + 4 * ((d0 >> 4) & 1) + (d0 & 3);
    constexpr int ZS = NVF::ZS; constexpr size_t RALL = NVF::RALL;
    TP_B(11)
    for (int ci = (int)gridDim.x - 1 - (int)blockIdx.x; ci < 128; ci += gridDim.x) {
        const int dir = ci & 1, h = (ci >> 1) & 3, b = ci >> 3;
        const bf16s* zq = p.z + NVF::OFF_Q + h * 128 + d0; const bf16s* zl = p.z + (dir ? NVF::OFF_FB : NVF::OFF_FF) + h * 128 + d0;
        const bf16s* vrow = p.vit + (size_t)(h * 128 + 16 * w + lr) * RALL;
        bf16s* outp = (dir ? p.ob : p.o) + h * 128 + 16 * w + 4 * qd;
        f32x4 S[8];
#pragma unroll
        for (int i = 0; i < 8; ++i) S[i] = (f32x4){0.f, 0.f, 0.f, 0.f};
        for (int i = t; i < 2 * PT_SZ / 16; i += NTHREADS) *(LAS u32x4*)(lds + PT_OFF + i * 16) = (u32x4){0u, 0u, 0u, 0u};
#define HG_BAR() do { asm volatile("s_waitcnt lgkmcnt(0)" ::: "memory"); __builtin_amdgcn_s_barrier(); asm volatile("" ::: "memory"); } while (0)
        unsigned nq[8], nl[8]; u32x4 nv[2];
#define HG_LOADQL(cc) do { const int rlo_ = chunk_rlo((cc) < 36 ? (cc) : 35, b, dir); _Pragma("unroll") for (int i_ = 0; i_ < 8; ++i_) { const size_t R_ = dir ? rlo_ + 63 - (tau0 + i_) : rlo_ + tau0 + i_; \
            nq[i_] = *(const unsigned*)(zq + R_ * ZS); nl[i_] = *(const unsigned*)(zl + R_ * ZS); } } while (0)
#define HG_LOADV(cc) do { const int rlo_ = chunk_rlo((cc) < 36 ? (cc) : 35, b, dir); \
            _Pragma("unroll") for (int kb_ = 0; kb_ < 2; ++kb_) nv[kb_] = *(const u32x4*)(vrow + (dir ? rlo_ + 56 - 32 * kb_ - 8 * qd : rlo_ + 32 * kb_ + 8 * qd)); } while (0)
        unsigned cq[8], cl[8]; bf16x8 Vf[2];
#define HG_TAKEQL() do { _Pragma("unroll") for (int i_ = 0; i_ < 8; ++i_) { cq[i_] = nq[i_]; cl[i_] = nl[i_]; } } while (0)
#define HG_TAKEV() do { _Pragma("unroll") for (int kb_ = 0; kb_ < 2; ++kb_) { u32x4 x_ = nv[kb_]; if (dir) x_ = (u32x4){swp(x_.w), swp(x_.z), swp(x_.y), swp(x_.x)}; Vf[kb_] = __builtin_bit_cast(bf16x8, x_); } } while (0)
#define HG_TOTALS() do { float a0_ = 0.f, a1_ = 0.f; _Pragma("unroll") for (int i_ = 0; i_ < 8; ++i_) { a0_ += bflo(cl[i_]); a1_ += bfhi(cl[i_]); } \
            *(LAS f32x2*)(lds + TOT_OFF + (w * 128 + d0) * 4) = (f32x2){a0_, a1_}; } while (0)
        HG_LOADQL(0);
        HG_TAKEQL();
        HG_TOTALS();
        HG_BAR();
        for (int cc = -1; cc < 36; ++cc) {
            const int cur = cc & 1, nx = cur ^ 1;
            const int Rlo = chunk_rlo(cc < 0 ? 0 : cc, b, dir);
#if HG_LOADPOS == 0
            HG_LOADQL(cc + 2);
            HG_LOADV(cc + 1);
#endif
            TP_B(13)
HG_SUBLOOP_PRAGMA
            for (int sub = 0; sub < 2; ++sub) {
            if ((sub ^ ord) == 0) {
            TP_B(16)
            if (cc >= 0) {
                bf16x8 As[4];
#pragma unroll
                for (int kb = 0; kb < 4; ++kb) { u32x4 x; x.x = pk(S[2 * kb][0], S[2 * kb][1]); x.y = pk(S[2 * kb][2], S[2 * kb][3]); x.z = pk(S[2 * kb + 1][0], S[2 * kb + 1][1]); x.w = pk(S[2 * kb + 1][2], S[2 * kb + 1][3]); As[kb] = __builtin_bit_cast(bf16x8, x); }
#pragma unroll
                for (int ti = 0; ti < 4; ++ti) {
                    f32x4 acc = (f32x4){0.f, 0.f, 0.f, 0.f};
#pragma unroll
                    for (int kb = 0; kb < 4; ++kb) { const bf16x8 B = *(const LAS bf16x8*)(lds + QE_OFF + cur * QE_SZ + (16 * ti + lr) * RS + (32 * kb + 8 * qd) * 2);
                        acc = __builtin_amdgcn_mfma_f32_16x16x32_bf16(As[kb], B, acc, 0, 0, 0); }
#pragma unroll
                    for (int kb = 0; kb < 2; ++kb) if (kb == 0 || ti >= 2) { const bf16x8 B = *(const LAS bf16x8*)(lds + PT_OFF + cur * PT_SZ + (16 * ti + lr) * 144 + (32 * kb + 8 * qd) * 2); acc = __builtin_amdgcn_mfma_f32_16x16x32_bf16(Vf[kb], B, acc, 0, 0, 0); }
                    const int tt = 16 * ti + lr; const size_t R = dir ? Rlo + 63 - tt : Rlo + tt;
                    u32x2 wv; wv.x = pk(acc[0], acc[1]); wv.y = pk(acc[2], acc[3]);
                    *(u32x2*)(outp + R * 512) = wv;
                }
            }
            TP_E(16, lds)
            } else {
            TP_B(17)
            if (cc + 1 < 36) {
              f32x2 T[8];
#pragma unroll
              for (int j = 0; j < 8; ++j) T[j] = *(const LAS f32x2*)(lds + TOT_OFF + (j * 128 + d0) * 4);
              f32x2 pre[9]; pre[0] = (f32x2){0.f, 0.f};
#pragma unroll
              for (int j = 0; j < 8; ++j) pre[j + 1] = pre[j] + T[j];
              const f32x2 rt = sg == 0 ? pre[0] : sg == 1 ? pre[2] : sg == 2 ? pre[4] : pre[6];
              const f32x2 hoff = hh ? (sg == 0 ? T[0] : sg == 1 ? T[2] : sg == 2 ? T[4] : T[6]) : (f32x2){0.f, 0.f};
              const f32x2 bend = pre[8];
              const f32x2 Eoff = {__expf(rt[0]), __expf(rt[1])}, Fend = {__expf(bend[0] - rt[0]), __expf(bend[1] - rt[1])};
              const f32x2 F1 = {__expf(pre[2][0] - rt[0]), __expf(pre[2][1] - rt[1])}, F2 = {__expf(pre[4][0] - rt[0]), __expf(pre[4][1] - rt[1])}, F3 = {__expf(pre[6][0] - rt[0]), __expf(pre[6][1] - rt[1])};
              const int tl0 = sg == 0 ? 0 : sg == 1 ? 4 : sg == 2 ? 7 : 9;
              LAS unsigned char* qe = lds + QE_OFF + nx * QE_SZ; LAS unsigned char* ket = lds + KET_OFF + nx * KET_SZ;
              float ke0[8], ke1[8], kv0[8], kv1[8];
              float A0 = __expf(hoff[0]), A1 = __expf(hoff[1]);
#pragma unroll
              for (int i = 0; i < 8; ++i) { const int tau = tau0 + i, trow = 8 * hh + i;
                  const float q0 = bflo(cq[i]), q1 = bfhi(cq[i]);
                  const float f0 = __expf(bflo(cl[i])), f1 = __expf(bfhi(cl[i]));
                  const float k0 = 1.f - f0, k1 = 1.f - f1;
                  A0 *= f0; A1 *= f1;
                  const float ki0 = k0 * __builtin_amdgcn_rcpf(fmaxf(A0, 1.8e-35f)), ki1 = k1 * __builtin_amdgcn_rcpf(fmaxf(A1, 1.8e-35f));
                  const float qa0 = q0 * A0, qa1 = q1 * A1;
                  *(LAS unsigned*)(lds + QM_OFF + tau * RS + d0 * 2) = pk(qa0, qa1);
                  *(LAS unsigned*)(qe + tau * RS + dq * 2) = pk(qa0 * Eoff[0], qa1 * Eoff[1]);
                  *(LAS unsigned*)(lds + KM_OFF + (tl0 * 16 + trow) * RS + d0 * 2) = pk(ki0, ki1);
                  kv0[i] = ki0; kv1[i] = ki1; ke0[i] = ki0 * Fend[0]; ke1[i] = ki1 * Fend[1]; }
              if (sg < 1) {
#pragma unroll
                  for (int i = 0; i < 8; ++i) *(LAS unsigned*)(lds + KM_OFF + ((tl0 + 1 - sg) * 16 + 8 * hh + i) * RS + d0 * 2) = pk(kv0[i] * F1[0], kv1[i] * F1[1]); }
              if (sg < 2) {
#pragma unroll
                  for (int i = 0; i < 8; ++i) *(LAS unsigned*)(lds + KM_OFF + ((tl0 + 2 - sg) * 16 + 8 * hh + i) * RS + d0 * 2) = pk(kv0[i] * F2[0], kv1[i] * F2[1]); }
              if (sg < 3) {
#pragma unroll
                  for (int i = 0; i < 8; ++i) *(LAS unsigned*)(lds + KM_OFF + ((tl0 + 3 - sg) * 16 + 8 * hh + i) * RS + d0 * 2) = pk(kv0[i] * F3[0], kv1[i] * F3[1]); }
              u32x4 x0, x1; x0.x = pk(ke0[0], ke0[1]); x0.y = pk(ke0[2], ke0[3]); x0.z = pk(ke0[4], ke0[5]); x0.w = pk(ke0[6], ke0[7]); x1.x = pk(ke1[0], ke1[1]); x1.y = pk(ke1[2], ke1[3]); x1.z = pk(ke1[4], ke1[5]); x1.w = pk(ke1[6], ke1[7]);
              *(LAS u32x4*)(ket + d0 * 144 + tau0 * 2) = x0; *(LAS u32x4*)(ket + (d0 + 1) * 144 + tau0 * 2) = x1;
              if (w == 0) *(LAS f32x2*)(lds + G_OFF + nx * 512 + d0 * 4) = (f32x2){__expf(bend[0]), __expf(bend[1])};
            }
            TP_E(17, lds)
            }
#if HG_LOADPOS == 2
            if (sub == 0) { HG_LOADQL(cc + 2); HG_LOADV(cc + 1); }
#endif
            }
#if HG_LOADPOS == 1
            HG_LOADQL(cc + 2);
            HG_LOADV(cc + 1);
#endif
            HG_BAR();
            TP_E(13, lds) TP_B(15)
HG_SUBLOOP_PRAGMA
            for (int sub = 0; sub < 2; ++sub) {
            if ((sub ^ ord2) == 0) {
            if (cc + 1 < 36) {
                for (int tl = w; tl < 10; tl += 8) {
                    const int si = (int)((0x3221110000ull >> (4 * tl)) & 0xF), ti = (int)((0x3323213210ull >> (4 * tl)) & 0xF);
                    f32x4 acc = (f32x4){0.f, 0.f, 0.f, 0.f};
#pragma unroll
                    for (int kb = 0; kb < 4; ++kb) { const bf16x8 A = *(const LAS bf16x8*)(lds + KM_OFF + (16 * tl + lr) * RS + (32 * kb + 8 * qd) * 2); const bf16x8 B = *(const LAS bf16x8*)(lds + QM_OFF + (16 * ti + lr) * RS + (32 * kb + 8 * qd) * 2);
                        acc = __builtin_amdgcn_mfma_f32_16x16x32_bf16(A, B, acc, 0, 0, 0); }
                    if (si == ti) {
#pragma unroll
                        for (int e = 0; e < 4; ++e) if (4 * qd + e > lr) acc[e] = 0.f; }
                    u32x2 wv; wv.x = pk(acc[0], acc[1]); wv.y = pk(acc[2], acc[3]);
                    *(LAS u32x2*)(lds + PT_OFF + nx * PT_SZ + (16 * ti + lr) * 144 + (16 * si + 4 * qd) * 2) = wv;
                }
            }
            } else {
            if (cc >= 0) {
#pragma unroll
                for (int i = 0; i < 8; ++i) { const f32x4 g4 = *(const LAS f32x4*)(lds + G_OFF + cur * 512 + (16 * i + 4 * qd) * 4); f32x4 acc = S[i] * g4;
#pragma unroll
                    for (int kb = 0; kb < 2; ++kb) { const bf16x8 A = *(const LAS bf16x8*)(lds + KET_OFF + cur * KET_SZ + (16 * i + lr) * 144 + (32 * kb + 8 * qd) * 2); acc = __builtin_amdgcn_mfma_f32_16x16x32_bf16(A, Vf[kb], acc, 0, 0, 0); }
                    S[i] = acc; }
            }
            }
            }
            HG_TAKEQL();
            HG_TAKEV();
            HG_TOTALS();
            HG_BAR();
            TP_E(15, lds)
        }
#undef HG_TAKEQL
#undef HG_TAKEV
#undef HG_TOTALS
#undef HG_LOADQL
#undef HG_LOADV
#undef HG_BAR
        __syncthreads();
    }
    TP_E(11, lds)
}
__device__ __forceinline__ void f_ada(const PF& p, LAS unsigned char* lds) {
    const int t = tidx(), lane = t & 63, wv = t >> 6, kk = lane >> 4, c4 = lane & 15;
    constexpr int D = DmF::D, NR = DmF::B + 1, NITEM = DmF::DEPTH * 6 * D / 64, SP = 20;
    if ((int)blockIdx.x >= NITEM) return;
    LAS float* ST = (LAS float*)lds;
    LAS float* PR = ST + D * SP;
    { constexpr int NE = NR * D / NTHREADS; static_assert(NR * D % NTHREADS == 0 && D % NTHREADS == 0, "table fill");
      float cv[NE];
#pragma unroll
      for (int e = 0; e < NE; ++e) { const int i = t + e * NTHREADS, r = e / (D / NTHREADS), k = i % D; cv[e] = r < DmF::B ? p.c[r * D + k] : p.c_ctx[k]; }
#pragma unroll
      for (int e = 0; e < NE; ++e) { const int i = t + e * NTHREADS, r = e / (D / NTHREADS), k = i % D; const float c = cv[e]; ST[k * SP + r] = c / (1.f + __expf(-c)); } }
    __syncthreads();
    for (int q = blockIdx.x; q < NITEM; q += gridDim.x) {
        const int layer = q / (6 * D / 64), j0 = (q % (6 * D / 64)) * 64;
        const float* w = p.ada_w + (size_t)layer * D * 6 * D + j0 + c4 * 4;
        f32x4 acc[NR];
#pragma unroll
        for (int r = 0; r < NR; ++r) acc[r] = (f32x4){0.f, 0.f, 0.f, 0.f};
#pragma nounroll
        for (int kb = wv * 128; kb < wv * 128 + 128; kb += 32) {
            f32x4 wq[8];
#pragma unroll
            for (int u = 0; u < 8; ++u) wq[u] = *(const f32x4*)(w + (size_t)(kb + 4 * u + kk) * 6 * D);
#pragma unroll
            for (int u = 0; u < 8; ++u) { const LAS float* sp = ST + (kb + 4 * u + kk) * SP;
                const f32x4 s0 = *(const LAS f32x4*)sp, s1 = *(const LAS f32x4*)(sp + 4), s2 = *(const LAS f32x4*)(sp + 8), s3 = *(const LAS f32x4*)(sp + 12); const float s16 = sp[16];
#pragma unroll
                for (int e = 0; e < 4; ++e) { acc[e] += wq[u] * s0[e]; acc[4 + e] += wq[u] * s1[e]; acc[8 + e] += wq[u] * s2[e]; acc[12 + e] += wq[u] * s3[e]; }
                acc[16] += wq[u] * s16; }
        }
#pragma unroll
        for (int r = 0; r < NR; ++r)
#pragma unroll
            for (int e = 0; e < 4; ++e) { float x = acc[r][e]; x += __shfl_xor(x, 16); x += __shfl_xor(x, 32); acc[r][e] = x; }
        if (kk == 0) {
#pragma unroll
            for (int r = 0; r < NR; ++r) *(LAS f32x4*)(PR + (wv * NR + r) * 64 + c4 * 4) = acc[r]; }
        __syncthreads();
        for (int i = t; i < NR * 64; i += NTHREADS) { const int r = i >> 6, l2 = i & 63; float sum = 0.f;
#pragma unroll
            for (int w8 = 0; w8 < 8; ++w8) sum += PR[(w8 * NR + r) * 64 + l2];
            const int jj = j0 + l2; p.mod[((size_t)layer * NR + r) * 6 * D + jj] = sum + p.ada_b[layer * 6 * D + jj]; }
        __syncthreads();
    }
}
#ifndef PRO_DOUBLE
#define PRO_DOUBLE 1
#endif
constexpr int ADA_ITEMS = DmF::DEPTH * 6 * DmF::D / 64;
__device__ __forceinline__ int pro_nvw() { const int G = (int)gridDim.x; return (PRO_DOUBLE && G > ADA_ITEMS) ? ADA_ITEMS + 2 * (G - ADA_ITEMS) : G; }
__device__ __forceinline__ int pro_vw(int rep) { const int b = (int)blockIdx.x; if (!PRO_DOUBLE) return rep ? -1 : b; return b < ADA_ITEMS ? (rep ? -1 : b) : ADA_ITEMS + 2 * (b - ADA_ITEMS) + rep; }
__device__ __forceinline__ void f_gen_postab(const PF& p, float* postab) {
    constexpr int D = DmF::D, L = DmF::L, Q4 = D / 4;
    const long nth = (long)pro_nvw() * NTHREADS;
    const int k = (tidx() % (D / 4)) * 4, wq = k / Q4;
    float omega[4];
#pragma unroll
    for (int e = 0; e < 4; ++e) { const int ix = (k + e) % Q4; omega[e] = 1.0f / powf(10000.0f, (float)ix / (float)Q4); }
    for (int rep = 0; rep < 2; ++rep) { const int vw = pro_vw(rep); if (vw < 0) break;
        for (long i = (long)vw * NTHREADS + tidx(); i < (long)L * (D / 4); i += nth) {
            const int l = (int)(i / (D / 4));
            const float pos = (float)(wq < 2 ? l / DmF::GRID_W : l % DmF::GRID_W);
            f32x4 pe;
#pragma unroll
            for (int e = 0; e < 4; ++e) { const float a = pos * omega[e]; pe[e] = (wq & 1) ? cosf(a) : sinf(a); }
            *(f32x4*)(postab + (size_t)l * D + k) = pe;
        } }
}
__device__ __forceinline__ void f_gen_krt3(const PF& p, LAS unsigned char* lds, int rank, int nwork) {
    const int t = tidx(), cl = t & 63, lg = t >> 6;
    constexpr int NC = DmF::NC, L = DmF::L, C = DmF::C, FH = DmF::FH, NLB = (NC + L) / 64, NOB = 4 * C / 64;
    const float max_decay = logf(1e-2f) / 0.3f, min_decay = logf(1e-2f) / 1.5f;
    LAS float* T = (LAS float*)lds;
    LAS float* H2 = T + 64 * 65 + 28;
    static_assert(FH == 64 && (64 * 65 + 28) % 4 == 0, "krt3 tile layout");
    constexpr int NCOMBO = DmF::DEPTH * NOB;
    if (rank < 0) return;
    const int combo = rank % NCOMBO, grp = rank / NCOMBO, ngrp = (nwork - combo + NCOMBO - 1) / NCOMBO;
    const int layer = combo / NOB, ob = combo % NOB, oc = ob * 64 + cl, c = oc % C;
    float wr[FH];
    { const float* w3 = p.hy_w3 + (size_t)layer * FH * 4 * C + oc;
#pragma unroll
      for (int k = 0; k < FH; ++k) wr[k] = w3[(size_t)k * 4 * C]; }
    f32x4 x0, x1;
#define KRT_LOAD(lb_) do { const int lq_ = (lb_) < NLB ? (lb_) : NLB - 1; const f32x4* src_ = (const f32x4*)(p.hf2 + ((size_t)layer * (NC + L) + lq_ * 64) * FH); x0 = src_[t]; x1 = src_[t + NTHREADS]; } while (0)
    KRT_LOAD(grp);
    for (int lb = grp; lb < NLB; lb += ngrp) {
        const int isx = lb >= NC / 64, Lw = isx ? L : NC, l0 = (isx ? lb - NC / 64 : lb) * 64;
        const float delta = fabsf(min_decay + (max_decay - min_decay) * (float)c / (float)(C - 1));
        *(LAS f32x4*)(H2 + t * 4) = x0; *(LAS f32x4*)(H2 + (t + NTHREADS) * 4) = x1;
        KRT_LOAD(lb + ngrp);
        lds_barrier();
#pragma unroll
        for (int i = 0; i < 8; ++i) { const int l = l0 + lg * 8 + i; const LAS float* h2 = H2 + (lg * 8 + i) * FH;
            f32x2 a2 = {0.f, 0.f};
#pragma unroll
            for (int k = 0; k < FH; k += 4) { const f32x4 h = *(const LAS f32x4*)(h2 + k); a2 += (f32x2){h[0], h[1]} * (f32x2){wr[k], wr[k + 1]}; a2 += (f32x2){h[2], h[3]} * (f32x2){wr[k + 2], wr[k + 3]}; }
            T[cl * 65 + lg * 8 + i] = (a2[0] + a2[1]) * expf(-((float)l / (float)(Lw - 1)) * delta); }
        lds_barrier();
        { const int c2 = t >> 3, sg = t & 7, oc2 = ob * 64 + c2, cc = oc2 % C, fdir = oc2 / C, order = fdir >> 1, bwd = fdir & 1;
          bf16s* kr = (isx ? p.krt_x : p.krt_c) + ((size_t)(layer * 2 + order) * 256 + cc) * 2 * Lw;
          float v[8];
#pragma unroll
          for (int i = 0; i < 8; ++i) v[i] = T[c2 * 65 + sg * 8 + i];
          const int lb0 = l0 + sg * 8;
          if (!bwd) { if (lb0 == 0) v[0] += p.hy_bias[(layer * 2 + order) * C + cc];
              u32x4 w; w.x = cvt_pk_bf16(v[7], v[6]); w.y = cvt_pk_bf16(v[5], v[4]); w.z = cvt_pk_bf16(v[3], v[2]); w.w = cvt_pk_bf16(v[1], v[0]);
              *(u32x4*)(kr + (Lw - 8) - lb0) = w; }
          else { bf16s* q = kr + (Lw - 1) + lb0;
              if (lb0 > 0) q[0] = f2bf(v[0]); else kr[2 * Lw - 1] = 0;
              *(u32x2*)(q + 1) = (u32x2){cvt_pk_bf16(v[1], v[2]), cvt_pk_bf16(v[3], v[4])}; *(unsigned*)(q + 5) = cvt_pk_bf16(v[5], v[6]); q[7] = f2bf(v[7]); } }
        lds_barrier();
    }
}


__device__ __forceinline__ void f_fnet_nyq(const PF& p, int layer, int wg0) {
    const int me = (int)blockIdx.x - wg0; if (me < 0 || me >= 64) return;
    const int t = tidx(), lane = t & 63, w = t >> 6;
    const float sx = 1.0f / sqrtf(64.f * 2048.f);
#pragma unroll
    for (int h = 0; h < 2; ++h) {
        u32x4 v[4][4];
#pragma unroll
        for (int j = 0; j < 4; ++j) { const bf16s* src = p.pq_x + (size_t)(me * 64 + w * 8 + h * 4 + j) * 4096;
#pragma unroll
            for (int q = 0; q < 4; ++q) v[j][q] = *(const u32x4*)(src + q * 512 + lane * 8); }
#pragma unroll
        for (int j = 0; j < 4; ++j) { float a = 0.f;
#pragma unroll
            for (int q = 0; q < 4; ++q) { const u32x4 x = v[j][q]; a += (bflo(x.x) - bfhi(x.x)) + (bflo(x.y) - bfhi(x.y)) + (bflo(x.z) - bfhi(x.z)) + (bflo(x.w) - bfhi(x.w)); }
            a = wave_sum(a);
            const int rc = me * 64 + w * 8 + h * 4 + j, b = rc >> 8, c = rc & 255;
            if (lane == 0) p.yfn[(size_t)(NVF::RC + b * 2048 + 1024) * 256 + c] = f2bf(a * sx + p.fn_b[layer * 256 + c]); }
    }
}

__device__ __forceinline__ void f_pro_b(const PF& p, LAS unsigned char* lds) {
    constexpr int D = DmF::D, NC = DmF::NC, L = DmF::L, FH = DmF::FH, GD = DmF::GD, G = DmF::G, CFN = DmF::CFN, DP = DmF::DP, C = DmF::C, DHG = DmF::DHG;
    static_assert(FH == 64 && GD == 64 && G == 4 && NTHREADS == 512 && (NC + L) % 64 == 0, "f_pro_b tiling");
    const int t = tidx(); LAS float* A = (LAS float*)lds; LAS float* Bm = A + 64 * 64;
    constexpr int NWF = DmF::DEPTH * G * (D / 64), NHF = DmF::DEPTH * ((NC + L) / 64);
    for (int tile = blockIdx.x; tile < NWF + NHF; tile += gridDim.x) {
        if (tile < NWF) {
            const int layer = tile / (G * (D / 64)), g = (tile / (D / 64)) % G, k0 = (tile % (D / 64)) * 64;
            f32x4 av[2], bv[4];
#pragma unroll
            for (int h = 0; h < 2; ++h) av[h] = *(const f32x4*)(p.w_in + ((size_t)layer * D + k0 + (t >> 4) + 32 * h) * DP + 3 * C + 5 * DHG + g * GD + (t & 15) * 4);
#pragma unroll
            for (int h = 0; h < 4; ++h) bv[h] = *(const f32x4*)(p.wcs + ((size_t)(layer * G + g) * GD) * 2 * GD + (size_t)(t + h * NTHREADS) * 4);
#pragma unroll
            for (int h = 0; h < 2; ++h)
#pragma unroll
                for (int j = 0; j < 4; ++j) A[((t & 15) * 4 + j) * 64 + (t >> 4) + 32 * h] = av[h][j];
#pragma unroll
            for (int h = 0; h < 4; ++h) *(LAS f32x4*)(Bm + (t + h * NTHREADS) * 4) = bv[h];
            lds_barrier();
            const int n = t & 127, kq = t >> 7;
            float acc[16];
#pragma unroll
            for (int i = 0; i < 16; ++i) acc[i] = 0.f;
#pragma unroll 4
            for (int c = 0; c < 64; ++c) { const float b = Bm[c * 128 + n];
#pragma unroll
                for (int q = 0; q < 4; ++q) { const f32x4 a = *(const LAS f32x4*)(A + c * 64 + kq * 16 + q * 4);
#pragma unroll
                    for (int e = 0; e < 4; ++e) acc[q * 4 + e] += a[e] * b; } }
            const int sn = n >> 6, d = n & 63;
#pragma unroll
            for (int i = 0; i < 16; ++i) p.wfn[((size_t)layer * D + k0 + kq * 16 + i) * 2 * CFN + sn * CFN + g * GD + d] = acc[i];
        } else {
            const int q = tile - NWF, layer = q / ((NC + L) / 64), pos0 = (q % ((NC + L) / 64)) * 64;
            f32x4 av[2], bv[2];
#pragma unroll
            for (int h = 0; h < 2; ++h) { av[h] = *(const f32x4*)(p.hf1 + ((size_t)layer * (NC + L) + pos0) * FH + (size_t)(t + h * NTHREADS) * 4); bv[h] = *(const f32x4*)(p.hy_w2 + (size_t)layer * FH * FH + (size_t)(t + h * NTHREADS) * 4); }
#pragma unroll
            for (int h = 0; h < 2; ++h) { *(LAS f32x4*)(A + (t + h * NTHREADS) * 4) = av[h]; *(LAS f32x4*)(Bm + (t + h * NTHREADS) * 4) = bv[h]; }
            lds_barrier();
            const int j = t & 63, pg = t >> 6;
            float acc[8];
#pragma unroll
            for (int i = 0; i < 8; ++i) acc[i] = 0.f;
#pragma unroll 4
            for (int k = 0; k < 64; k += 4) { const float b0 = Bm[k * 64 + j], b1 = Bm[(k + 1) * 64 + j], b2 = Bm[(k + 2) * 64 + j], b3 = Bm[(k + 3) * 64 + j];
#pragma unroll
                for (int i = 0; i < 8; ++i) { const f32x4 a = *(const LAS f32x4*)(A + (pg * 8 + i) * 64 + k); acc[i] += a[0] * b0 + a[1] * b1 + a[2] * b2 + a[3] * b3; } }
            const float b2v = p.hy_b2[layer * FH + j], fr = p.hy_freq[layer * FH + j];
#pragma unroll
            for (int i = 0; i < 8; ++i) p.hf2[((size_t)layer * (NC + L) + pos0 + pg * 8 + i) * FH + j] = sinf(fr * (acc[i] + b2v));
        }
        lds_barrier();
    }
}

__device__ __forceinline__ void f_pro_a(const PF& p, LAS unsigned char* lds) {
    constexpr int D = DmF::D, NC = DmF::NC, L = DmF::L, FH = DmF::FH, GD = DmF::GD, G = DmF::G, NB = DmF::NB, EMB = DmF::EMB, DHG = DmF::DHG;
    static_assert(FH == 64 && GD == 64 && NB == 16 && EMB == 33 && NTHREADS == 512 && DmF::DEPTH == 2, "f_pro_a tiling");
    const int t = tidx(); LAS float* S0 = (LAS float*)lds;
    constexpr int NHF = (NC + L) / 64, NWC = DmF::DEPTH * G, NJOB = NHF + NWC + 1;
    for (int job = (int)gridDim.x - 1 - (int)blockIdx.x; job < NJOB; job += gridDim.x) {
        if (job < NHF) {
            LAS float* F = S0;
            LAS float* W1 = S0 + 64 * 36;
            const int ll0 = job * 64;
            for (int i = t; i < 2 * EMB * FH; i += NTHREADS) W1[i] = p.hy_w1[i];
            { const int pos = t & 63, bq = t >> 6, ll = ll0 + pos; const int Lw = ll < NC ? NC : L, l = ll < NC ? ll : ll - NC;
              const float wv = NVF::TWO_PI * (float)l / (float)Lw;
              if (bq == 0) F[pos * 36] = (float)l / (float)(Lw - 1);
#pragma nounroll
              for (int h = 0; h < 2; ++h) { const int bi = bq + 8 * h; const float band = 1e-4f + (float)bi * ((float)(NB - 1) - 1e-4f) / (float)(NB - 1);
                  F[pos * 36 + 1 + bi] = cosf(band * wv); F[pos * 36 + 1 + NB + bi] = -sinf(band * wv); } }
            lds_barrier();
            const int j = t & 63, pg = t >> 6;
            LAS float* OUT = W1 + 2 * EMB * FH;
#pragma nounroll
            for (int layer = 0; layer < 2; ++layer) {
                float acc[8];
#pragma unroll
                for (int i = 0; i < 8; ++i) acc[i] = 0.f;
                for (int e = 0; e < EMB; ++e) { const float w = W1[(layer * EMB + e) * FH + j];
#pragma unroll
                    for (int i = 0; i < 8; ++i) acc[i] += F[(pg * 8 + i) * 36 + e] * w; }
                const float b1 = p.hy_b1[layer * FH + j], fr = p.hy_freq[layer * FH + j];
#pragma unroll
                for (int i = 0; i < 8; ++i) OUT[(layer * 64 + pg * 8 + i) * 64 + j] = fr * (acc[i] + b1);
            }
            lds_barrier();
#pragma nounroll
            for (int i = t; i < 2 * 64 * 64; i += NTHREADS) { const int layer = i >> 12, r = i & 4095; p.hf1[((size_t)layer * (NC + L) + ll0) * FH + r] = sinf(OUT[i]); }
        } else if (job < NHF + NWC) {
            const int q = job - NHF, layer = q / G, g = q % G;
            LAS float* TC = S0; LAS float* TS = S0 + 64 * 64; LAS float* W = S0 + 2 * 64 * 64;
            for (int i = t; i < 64 * 64; i += NTHREADS) { const int c = i >> 6, m = i & 63; const float ang = NVF::TWO_PI * (float)((c * m) % GD) / (float)GD; TC[i] = __cosf(ang); TS[i] = __sinf(ang); }
            { f32x4 wv2[2];
#pragma unroll
              for (int h = 0; h < 2; ++h) wv2[h] = *(const f32x4*)(p.fn_w + ((size_t)(layer * G + g) * GD) * GD + (size_t)(t + h * NTHREADS) * 4);
#pragma unroll
              for (int h = 0; h < 2; ++h) *(LAS f32x4*)(W + (t + h * NTHREADS) * 4) = wv2[h]; }
            lds_barrier();
            const int n = t & 127, cq = t >> 7, sn = n >> 6, d = n & 63; const LAS float* T = sn ? TS : TC;
            float acc[16];
#pragma unroll
            for (int i = 0; i < 16; ++i) acc[i] = 0.f;
            for (int m = 0; m < 64; ++m) { const float w = W[m * 64 + d];
#pragma unroll
                for (int i = 0; i < 16; ++i) acc[i] += T[(cq * 16 + i) * 64 + m] * w; }
#pragma unroll
            for (int i = 0; i < 16; ++i) p.wcs[((size_t)(layer * G + g) * GD + cq * 16 + i) * 2 * GD + n] = acc[i];
        } else {
            for (int i = t; i < 2 * DHG; i += NTHREADS) {
                float mx = -1e30f;
                for (int l = 0; l < DmF::DEPTH; ++l) mx = fmaxf(mx, p.hg_lb[l * 2 * DHG + i]);
                float den = 0.f;
                for (int l = 0; l < DmF::DEPTH; ++l) den += expf(p.hg_lb[l * 2 * DHG + i] - mx);
                float cs = 0.f;
                for (int l = 0; l < DmF::DEPTH; ++l) { if (l > 0) cs += expf(p.hg_lb[l * 2 * DHG + i] - mx) / den; p.lbv[l * 2 * DHG + i] = cs; }
            }
        }
        lds_barrier();
    }
}

__device__ __forceinline__ void f_pro_ab(const PF& p, LAS unsigned char* lds) {
    constexpr int D = DmF::D, NC = DmF::NC, L = DmF::L, FH = DmF::FH, GD = DmF::GD, G = DmF::G, NB = DmF::NB, EMB = DmF::EMB, DHG = DmF::DHG, CFN = DmF::CFN, DP = DmF::DP, C = DmF::C;
    static_assert(FH == 64 && GD == 64 && G == 4 && NB == 16 && EMB == 33 && NTHREADS == 512 && DmF::DEPTH == 2, "f_pro_ab tiling");
    const int t = tidx(); LAS float* S0 = (LAS float*)lds;
    constexpr int NHF = (NC + L) / 64, NWF = DmF::DEPTH * G * (D / 64), NJOB = NHF + NWF + 1;
    for (int job = (int)gridDim.x - 1 - (int)blockIdx.x; job < NJOB; job += gridDim.x) {
        if (job < NHF) {
            LAS float* F = S0;
            LAS float* W1 = F + 64 * 36;
            LAS float* H1 = W1 + 2 * EMB * FH;
            LAS float* W2 = H1 + 2 * 64 * 64;
            LAS float* O2 = W2 + 2 * 64 * 64;
            const int ll0 = job * 64;
            for (int i = t; i < 2 * EMB * FH; i += NTHREADS) W1[i] = p.hy_w1[i];
            { f32x4 wv4[4];
#pragma unroll
              for (int h = 0; h < 4; ++h) wv4[h] = *(const f32x4*)(p.hy_w2 + (size_t)(t + h * NTHREADS) * 4);
#pragma unroll
              for (int h = 0; h < 4; ++h) *(LAS f32x4*)(W2 + (t + h * NTHREADS) * 4) = wv4[h]; }
            { const int pos = t & 63, bq = t >> 6, ll = ll0 + pos; const int Lw = ll < NC ? NC : L, l = ll < NC ? ll : ll - NC;
              const float wv = NVF::TWO_PI * (float)l / (float)Lw;
              if (bq == 0) F[pos * 36] = (float)l / (float)(Lw - 1);
#pragma nounroll
              for (int h = 0; h < 2; ++h) { const int bi = bq + 8 * h; const float band = 1e-4f + (float)bi * ((float)(NB - 1) - 1e-4f) / (float)(NB - 1);
                  F[pos * 36 + 1 + bi] = cosf(band * wv); F[pos * 36 + 1 + NB + bi] = -sinf(band * wv); } }
            lds_barrier();
            const int j = t & 63, pg = t >> 6;
#pragma nounroll
            for (int layer = 0; layer < 2; ++layer) {
                float acc[8];
#pragma unroll
                for (int i = 0; i < 8; ++i) acc[i] = 0.f;
                for (int e = 0; e < EMB; ++e) { const float w = W1[(layer * EMB + e) * FH + j];
#pragma unroll
                    for (int i = 0; i < 8; ++i) acc[i] += F[(pg * 8 + i) * 36 + e] * w; }
                const float b1 = p.hy_b1[layer * FH + j], fr = p.hy_freq[layer * FH + j];
#pragma unroll
                for (int i = 0; i < 8; ++i) H1[(layer * 64 + pg * 8 + i) * 64 + j] = fr * (acc[i] + b1);
            }
            lds_barrier();
#pragma nounroll
            for (int i = t; i < 2 * 64 * 64; i += NTHREADS) H1[i] = sinf(H1[i]);
            lds_barrier();
#pragma nounroll
            for (int layer = 0; layer < 2; ++layer) {
                float acc[8];
#pragma unroll
                for (int i = 0; i < 8; ++i) acc[i] = 0.f;
#pragma unroll 4
                for (int k = 0; k < 64; k += 4) { const LAS float* wp = W2 + (layer * 64 + k) * 64 + j; const float b0 = wp[0], b1 = wp[64], b2 = wp[128], b3 = wp[192];
#pragma unroll
                    for (int i = 0; i < 8; ++i) { const f32x4 a = *(const LAS f32x4*)(H1 + (layer * 64 + pg * 8 + i) * 64 + k); acc[i] += a[0] * b0 + a[1] * b1 + a[2] * b2 + a[3] * b3; } }
                const float b2v = p.hy_b2[layer * FH + j], fr = p.hy_freq[layer * FH + j];
#pragma unroll
                for (int i = 0; i < 8; ++i) O2[(layer * 64 + pg * 8 + i) * 64 + j] = fr * (acc[i] + b2v);
            }
            lds_barrier();
#pragma nounroll
            for (int i = t; i < 2 * 64 * 64; i += NTHREADS) { const int layer = i >> 12, r = i & 4095; p.hf2[((size_t)layer * (NC + L) + ll0) * FH + r] = sinf(O2[i]); }
        } else if (job < NHF + NWF) {
            const int q = job - NHF, layer = q / (G * (D / 64)), g = (q / (D / 64)) % G, k0 = (q % (D / 64)) * 64;
            LAS float* TC = S0; LAS float* TS = TC + 64 * 64; LAS float* W = TS + 64 * 64;
            LAS float* Bm = W + 64 * 64;
            LAS float* A = Bm + 64 * 128;
            f32x4 av[2], wv2[2];
#pragma unroll
            for (int h = 0; h < 2; ++h) { av[h] = *(const f32x4*)(p.w_in + ((size_t)layer * D + k0 + (t >> 4) + 32 * h) * DP + 3 * C + 5 * DHG + g * GD + (t & 15) * 4);
                wv2[h] = *(const f32x4*)(p.fn_w + ((size_t)(layer * G + g) * GD) * GD + (size_t)(t + h * NTHREADS) * 4); }
            for (int i = t; i < 64 * 64; i += NTHREADS) { const int c = i >> 6, m = i & 63; const float ang = NVF::TWO_PI * (float)((c * m) % GD) / (float)GD; TC[i] = __cosf(ang); TS[i] = __sinf(ang); }
#pragma unroll
            for (int h = 0; h < 2; ++h) { *(LAS f32x4*)(W + (t + h * NTHREADS) * 4) = wv2[h];
#pragma unroll
                for (int jj = 0; jj < 4; ++jj) A[((t & 15) * 4 + jj) * 64 + (t >> 4) + 32 * h] = av[h][jj]; }
            lds_barrier();
            const int n = t & 127, cq = t >> 7, sn = n >> 6, d = n & 63;
            { const LAS float* T = sn ? TS : TC;
              float acc[16];
#pragma unroll
              for (int i = 0; i < 16; ++i) acc[i] = 0.f;
              for (int m = 0; m < 64; ++m) { const float w = W[m * 64 + d];
#pragma unroll
                  for (int i = 0; i < 16; ++i) acc[i] += T[(cq * 16 + i) * 64 + m] * w; }
#pragma unroll
              for (int i = 0; i < 16; ++i) Bm[(cq * 16 + i) * 128 + n] = acc[i]; }
            lds_barrier();
            { float acc[16];
#pragma unroll
              for (int i = 0; i < 16; ++i) acc[i] = 0.f;
#pragma unroll 4
              for (int c = 0; c < 64; ++c) { const float b = Bm[c * 128 + n];
#pragma unroll
                  for (int qq = 0; qq < 4; ++qq) { const f32x4 a = *(const LAS f32x4*)(A + c * 64 + cq * 16 + qq * 4);
#pragma unroll
                      for (int e = 0; e < 4; ++e) acc[qq * 4 + e] += a[e] * b; } }
#pragma unroll
              for (int i = 0; i < 16; ++i) p.wfn[((size_t)layer * D + k0 + cq * 16 + i) * 2 * CFN + sn * CFN + g * GD + d] = acc[i]; }
        } else {
            for (int i = t; i < 2 * DHG; i += NTHREADS) {
                float mx = -1e30f;
                for (int l = 0; l < DmF::DEPTH; ++l) mx = fmaxf(mx, p.hg_lb[l * 2 * DHG + i]);
                float den = 0.f;
                for (int l = 0; l < DmF::DEPTH; ++l) den += expf(p.hg_lb[l * 2 * DHG + i] - mx);
                float cs = 0.f;
                for (int l = 0; l < DmF::DEPTH; ++l) { if (l > 0) cs += expf(p.hg_lb[l * 2 * DHG + i] - mx) / den; p.lbv[l * 2 * DHG + i] = cs; }
            }
        }
        lds_barrier();
    }
}
#define XB_TMO      128
#define XB_XCNT(j)  (256  + 64 * (j))
#define XB_XSUB(j)  (1280 + 64 * (j))
#define XB_XGEN(j)  (2304 + 64 * (j))
#define XB_TOP      3328
#define XB_TOPGEN   3392
#define XCD_BAR_WORDS 3456
#define XB_SPIN_CAP (1u << 21)

__device__ __forceinline__ unsigned xb_ld(unsigned* p)              { return __hip_atomic_load(p, __ATOMIC_RELAXED, __HIP_MEMORY_SCOPE_AGENT); }
__device__ __forceinline__ unsigned xb_add(unsigned* p, unsigned v) { return __hip_atomic_fetch_add(p, v, __ATOMIC_RELAXED, __HIP_MEMORY_SCOPE_AGENT); }
__device__ __forceinline__ unsigned xb_xcc_id() { return (unsigned)__builtin_amdgcn_s_getreg((3 << 11) | 20) & 0xFu; }
#define XB_SPIN(cond, bar) do { unsigned _sp = 0; while (cond) { __builtin_amdgcn_s_sleep(1); \
    if ((++_sp & 255u) == 0u) { if (xb_ld(&(bar)[XB_TMO])) break; if (_sp > XB_SPIN_CAP) { atomicAdd(&(bar)[XB_TMO], 1u); break; } } } } while (0)

struct XcdBarrier { unsigned* bar; unsigned x; volatile LAS unsigned* st; };

__device__ __forceinline__ XcdBarrier xcd_barrier_post(unsigned* bar, volatile LAS unsigned* st) {
    XcdBarrier b; b.bar = bar; b.x = xb_xcc_id(); b.st = st;
    if (threadIdx.x == 0) (void)xb_add(&bar[XB_XCNT(b.x)], 1u);
    return b;
}
__device__ __forceinline__ void xcd_barrier_complete(unsigned* bar, unsigned x, unsigned& nloc, unsigned& nx) {
    const unsigned G = gridDim.x * gridDim.y * gridDim.z;
    unsigned sum, cnt, mine, sp = 0u;
    for (;;) {
        sum = 0u; cnt = 0u; mine = 0u;
#pragma unroll
        for (unsigned j = 0; j < 16; ++j) { const unsigned c = xb_ld(&bar[XB_XCNT(j)]); sum += c; cnt += (c > 0u) ? 1u : 0u; mine = (j == x) ? c : mine; }
        if (sum == G) break;
        __builtin_amdgcn_s_sleep(1);
        if ((++sp & 255u) == 0u) { if (xb_ld(&bar[XB_TMO])) break; if (sp > XB_SPIN_CAP) { atomicAdd(&bar[XB_TMO], 1u); break; } }
    }
    nloc = mine > 0u ? mine : 1u; nx = cnt > 0u ? cnt : 1u;
}
__device__ __forceinline__ void xcd_barrier(const XcdBarrier& b) {
    asm volatile("s_waitcnt vmcnt(0)" ::: "memory");
    __syncthreads();
    if (threadIdx.x == 0) {
        unsigned* bar = b.bar;
        __builtin_amdgcn_s_waitcnt(0);
        unsigned nloc = b.st[0], nx = b.st[1];
        if (nloc == 0u) { xcd_barrier_complete(bar, b.x, nloc, nx); b.st[0] = nloc; b.st[1] = nx; }
        const unsigned old = xb_add(&bar[XB_XSUB(b.x)], 1u);
        const unsigned gen = old / nloc;
        if (old + 1u == (gen + 1u) * nloc) {
            __builtin_amdgcn_fence(__ATOMIC_RELEASE, "agent");
            asm volatile("s_waitcnt vmcnt(0)" ::: "memory");
            const unsigned og = xb_add(&bar[XB_TOP], 1u);
            const unsigned tg = og / nx;
            if (og + 1u == (tg + 1u) * nx) xb_add(&bar[XB_TOPGEN], 1u);
            else XB_SPIN(xb_ld(&bar[XB_TOPGEN]) == tg, bar);
            __builtin_amdgcn_fence(__ATOMIC_ACQUIRE, "agent");
            xb_add(&bar[XB_XGEN(b.x)], 1u);
            asm volatile("s_waitcnt vmcnt(0)" ::: "memory");
        } else {
            XB_SPIN(xb_ld(&bar[XB_XGEN(b.x)]) == gen, bar);
            __builtin_amdgcn_fence(__ATOMIC_ACQUIRE, "agent");
            asm volatile("s_waitcnt vmcnt(0)" ::: "memory");
        }
    }
    __syncthreads();
}


#if TPROBE >= 100
#define TPH_B(ph) if (((ph) == TPROBE - 100 || (ph) == TPROBE - 200) && (int)blockIdx.x == TPROBE_WG && tidx() == 0) *(LAS unsigned*)(lds + TP_OFF + 4) = (unsigned)wall_clock64();
#define TPH_SPIN_() { const unsigned d0_ = (unsigned)wall_clock64() - *(LAS unsigned*)(lds + TP_OFF + 4); const unsigned long long t0_ = wall_clock64(), d_ = (unsigned long long)TPROBE_MUL * d0_; while (wall_clock64() - t0_ < d_) __builtin_amdgcn_s_sleep(16); }
#define TPH_E(ph) if ((ph) == TPROBE - 100 && (int)blockIdx.x == TPROBE_WG && tidx() == 0) TPH_SPIN_()
#define TPH_W(ph) if ((ph) == TPROBE - 200 && (int)blockIdx.x == TPROBE_WG && tidx() == 0) TPH_SPIN_()
#else
#define TPH_B(ph)
#define TPH_E(ph)
#define TPH_W(ph)
#endif
constexpr int NPH = 1 + 9 * DmF::DEPTH + 1;
#ifndef ONE_LAUNCH
#define ONE_LAUNCH 1
#endif

#ifndef REP_ADA
#define REP_ADA 1
#endif
#ifndef REP_PA
#define REP_PA 1
#endif
#ifndef REP_INIT
#define REP_INIT 1
#endif
#ifndef REP_DFT
#define REP_DFT 1
#endif
#ifndef REP_PB
#define REP_PB 1
#endif
#ifndef REP_KRT
#define REP_KRT 1
#endif
#ifndef REP_DOWN
#define REP_DOWN 1
#endif
#ifndef REP_WOUT
#define REP_WOUT 1
#endif
#ifndef REP_NM2N
#define REP_NM2N 1
#endif
#ifndef REP_BAR
#define REP_BAR 0
#endif
#ifndef REP_PRO
#define REP_PRO 1
#endif
#ifndef REP_NM1
#define REP_NM1 1
#endif
#ifndef REP_INPROJ
#define REP_INPROJ 1
#endif
#ifndef CVT_A0
#define CVT_A0 1024
#endif
#ifndef CVT_A1
#define CVT_A1 1536
#endif
#ifndef DFT_IN_INPROJ
#define DFT_IN_INPROJ 1
#endif
#ifndef KRT_IN_INPROJ
#define KRT_IN_INPROJ 0
#endif
#ifndef REP_NYQ
#define REP_NYQ 1
#endif
#ifndef REP_FNET
#define REP_FNET 1
#endif
#ifndef REP_HGRN
#define REP_HGRN 1
#endif
#ifndef REP_HYENA
#define REP_HYENA 1
#endif
#ifndef REP_MIX
#define REP_MIX 1
#endif
#ifndef REP_CVTMOE
#define REP_CVTMOE 1
#endif
#ifndef REP_GATHER
#define REP_GATHER 1
#endif
#ifndef REP_GATEUP
#define REP_GATEUP 1
#endif
#ifndef FAST_HGRN
#define FAST_HGRN 1
#endif
#ifndef FAST_GEMM
#define FAST_GEMM 1
#endif
struct KArgs { PF p; FastWs f; unsigned* bar; int lo, hi; };
typedef const __attribute__((address_space(4))) KArgs* KP;

__global__ void __launch_bounds__(NTHREADS, 2) mega(KArgs a) {
    extern __shared__ __attribute__((aligned(16))) unsigned char lds_raw[];
    LAS unsigned char* lds = (LAS unsigned char*)lds_raw;
    volatile LAS unsigned* xbw = (volatile LAS unsigned*)(lds + LDS_MISC_OFF);
    if (threadIdx.x < 4) xbw[threadIdx.x] = 0u;
    __syncthreads();
    const int lo = a.lo, hi = a.hi;
    XcdBarrier bar; bar.bar = a.bar; bar.x = 0; bar.st = xbw;
    if (hi - lo > 1) bar = xcd_barrier_post(a.bar, xbw);
    int ph = 0;
    TP_ZERO(lds)
#define PHASE(...) do { int lo_ = lo, hi_ = hi; asm volatile("" : "+s"(lo_), "+s"(hi_)); if (ph >= lo_ && ph < hi_) { { KP kp_ = (KP)__builtin_amdgcn_kernarg_segment_ptr(); asm volatile("" : "+s"(kp_)); PF p; FastWs f; __builtin_memcpy(&p, &kp_->p, sizeof(PF)); __builtin_memcpy(&f, &kp_->f, sizeof(FastWs)); (void)f; \
        const long tid = (long)blockIdx.x * NTHREADS + tidx(), nth = (long)gridDim.x * NTHREADS; (void)tid; (void)nth; TPH_B(ph) __VA_ARGS__; TPH_E(ph) TP_SPIN(lds) } if (ph + 1 < hi_) xcd_barrier(bar); TPH_W(ph) } ++ph; } while (0)
    for (int rep_ = 0; rep_ < REP_PRO; ++rep_) { if (rep_) ph -= 1;
    PHASE({ TP_B(30) for (int q_ = 0; q_ < REP_ADA; ++q_) f_ada(p, lds); TP_E(30, lds) TP_B(31) for (int q_ = 0; q_ < REP_PA; ++q_) f_pro_ab(p, lds); TP_E(31, lds) TP_B(32) for (int q_ = 0; q_ < REP_INIT; ++q_) f_gen_postab(p, (float*)p.z); TP_E(32, lds) TP_B(33) if (!DFT_IN_INPROJ || gridDim.x != 256) { for (int q_ = 0; q_ < REP_DFT; ++q_) f_gen_dft(p, lds); } TP_E(33, lds) });
    }
    for (int q_ = 0; q_ < REP_BAR; ++q_) { PHASE({}); --ph; }
    for (int layer = 0; layer < DmF::DEPTH; ++layer) {
        const int last = layer == DmF::DEPTH - 1, r0 = last ? NVF::RC : 0;
        PHASE({ for (int rep_ = 0; rep_ < REP_NM1; ++rep_) { TP_B(36) if (layer == 0) f_normmod<false, false, true>(p, f.hxs, layer, 0, 0, lds, (const float*)p.z); else f_normmod<false, true>(p, f.hxs, layer, 0, 0, lds); TP_E(36, lds) TP_B(34) f_cvt_inout(p, f, layer, lds); TP_E(34, lds) }
                if (layer == 0 && KRT_IN_INPROJ == 0) { TP_B(35) for (int q_ = 0; q_ < REP_KRT; ++q_) f_gen_krt3(p, lds, (int)blockIdx.x, (int)gridDim.x); TP_E(35, lds) } });
        PHASE({ for (int rep_ = 0; rep_ < REP_INPROJ; ++rep_) f_inproj(p, f, layer, last, lds);
                if (layer == 0 && DFT_IN_INPROJ && gridDim.x == 256) { const int j_ = (int)blockIdx.x >> 3, x_ = (int)blockIdx.x & 7; const int rk_ = (j_ & 1) ? (j_ >> 1) * 8 + x_ : -1; f_gen_dft(p, lds, rk_, 128);
                    f_cvt_moe(p, f, layer, lds, rk_, 128, 0, CVT_A0); }
                if (layer == 0 && KRT_IN_INPROJ) { Deal d_; d_.init(); int rank_ = (int)blockIdx.x, nw_ = (int)gridDim.x; if (d_.W == 32) { rank_ = (d_.j & 7) == 7 ? d_.x * 4 + (d_.j >> 3) : -1; nw_ = 32; }
                    TP_B(35) f_gen_krt3(p, lds, rank_, nw_); TP_E(35, lds) } });
        PHASE({ const bool g256 = gridDim.x == 256; TP_B(20)
                for (int rep_ = 0; rep_ < REP_FNET; ++rep_) { f_fnet(p, layer, !last, lds); for (int q_ = 0; q_ < REP_NYQ; ++q_) f_fnet_nyq(p, layer, 64); }
                for (int rep_ = 0; rep_ < REP_HGRN; ++rep_) f_hgrn(p, lds);
                for (int rep_ = 0; rep_ < REP_HYENA; ++rep_) f_hyena(p, layer, !last, lds, 0, g256 ? 128 : (int)gridDim.x);
                if (last && g256 && CVT_A1 > 0) f_cvt_moe(p, f, layer, lds, (int)blockIdx.x < 128 ? (int)blockIdx.x : -1, 128, 0, CVT_A1);
                TP_E(20, lds) });
        PHASE({ for (int rep_ = 0; rep_ < REP_MIX; ++rep_) f_mix2(p, layer, r0, lds); });
        PHASE({ for (int q_ = 1; q_ < REP_WOUT; ++q_) f_wout(p, f, layer, r0, lds, 0.f); f_wout(p, f, layer, r0, lds);
                { const int G_ = (int)gridDim.x, j_ = (int)blockIdx.x >> 3, x_ = (int)blockIdx.x & 7; int rank_ = (int)blockIdx.x, nw_ = G_;
                  if (!last && G_ == 256) { rank_ = j_ < 8 ? -1 : (j_ - 8) * 8 + x_; nw_ = 192; }
                  for (int rep_ = 0; rep_ < REP_CVTMOE; ++rep_) { NVF::p_moe_reset(p, tid, nth); TP_B(37) f_cvt_moe(p, f, layer, lds, rank_, nw_, G_ == 256 ? (last ? CVT_A1 : (DFT_IN_INPROJ ? CVT_A0 : 0)) : 0, CVT_MOE_NT); TP_E(37, lds) } } });
        PHASE({ for (int q_ = 1; q_ < REP_NM2N; ++q_) f_normmod<false, false>(p, f.hxs, layer, 1, r0, lds); f_nm2_router(p, layer, r0, lds); });
        PHASE({ for (int rep_ = 0; rep_ < REP_GATHER; ++rep_) f_place_gather(p, f, r0); });
        PHASE({ for (int rep_ = 0; rep_ < REP_GATEUP; ++rep_) f_gateup(p, f, lds); });
        PHASE({ for (int q_ = 0; q_ < REP_DOWN; ++q_) f_down(p, f, layer, lds); });
    }
    PHASE(f_final(p, f.hxs));
#undef PHASE
}

static inline size_t al256(size_t x) { return (x + 255) & ~(size_t)255; }
extern "C" void kernel_launch(void* const* d_in, const int* in_sizes, int n_in, void* d_out, int out_size, void* d_ws, size_t ws_size, hipStream_t stream) {
    typedef DmF Dm; constexpr size_t RALL = NVF::RALL, D = Dm::D;
    KArgs a{};
    PF& p = a.p;
    const float** ip = (const float**)&p.x;
    for (int i = 0; i < 31; ++i) ip[i] = (const float*)d_in[i];
    p.out = (float*)d_out;
    size_t off = 0; char* ws = (char*)d_ws;
    auto carve = [&](size_t bytes) { char* r = ws + off; off += al256(bytes); return r; };
    unsigned* ctl = (unsigned*)carve(65536);
    a.bar = ctl; p.cnt = (int*)(ctl + 8192);
    p.mod = (float*)carve((size_t)Dm::DEPTH * (Dm::B + 1) * 6 * D * 4);
    p.lbv = (float*)carve((size_t)Dm::DEPTH * 2 * Dm::DHG * 4);
    p.wcs = (float*)carve((size_t)Dm::DEPTH * Dm::G * Dm::GD * 2 * Dm::GD * 4);
    p.wfn = (float*)carve((size_t)Dm::DEPTH * D * 2 * Dm::CFN * 4);
    p.hf1 = (float*)carve((size_t)Dm::DEPTH * (Dm::NC + Dm::L) * Dm::FH * 4);
    p.hf2 = (float*)carve((size_t)Dm::DEPTH * (Dm::NC + Dm::L) * Dm::FH * 4);
    p.hfil = nullptr;
    p.krt_x = (bf16s*)carve((size_t)Dm::DEPTH * 2 * Dm::C * 2 * Dm::L * 2); p.krt_c = (bf16s*)carve((size_t)Dm::DEPTH * 2 * Dm::C * 2 * Dm::NC * 2);
#if XBF16
    p.cw = nullptr;
#else
    p.cw = (float*)carve((size_t)NVF::RC * D * 4);
#endif
    p.rs = (float*)carve(RALL * 4);
#if XBF16
    p.xb = (bf16s*)carve(RALL * D * 2);
    p.hx = (bf16s*)d_out;
#else
    p.xb = nullptr; p.hx = (bf16s*)carve(RALL * D * 2);
#endif
    p.dft_x = (bf16s*)carve((size_t)2048 * 4096 * 2); p.dft_c = (bf16s*)carve((size_t)256 * 512 * 2);
    p.z = (bf16s*)carve(RALL * NVF::ZS * 2);
    p.zh_c = (bf16s*)carve((size_t)3 * Dm::C * NVF::RC * 2); p.zh_x = (bf16s*)carve((size_t)3 * Dm::C * NVF::RX * 2);
    p.pq_c = (bf16s*)carve((size_t)NVF::RC * Dm::CFN * 2 * 2); p.pq_x = (bf16s*)carve((size_t)NVF::RX * Dm::CFN * 2 * 2);
    p.uv = nullptr;
    p.y1 = nullptr; p.y2 = nullptr;
    p.y1t_c = p.hx; p.y1t_x = p.hx + (size_t)Dm::C * NVF::RC;
    p.y2t_c = (bf16s*)carve((size_t)Dm::C * NVF::RC * 2); p.y2t_x = (bf16s*)carve((size_t)Dm::C * NVF::RX * 2);
    p.o = (bf16s*)carve(RALL * Dm::DHG * 2); p.ob = (bf16s*)carve(RALL * Dm::DHG * 2); p.vit = (bf16s*)carve(RALL * Dm::DHG * 2);
    p.yfn = (bf16s*)carve(RALL * Dm::CFN * 2);
    p.ridx = (int*)carve(RALL * 2 * 4);
    p.rgp = (float*)carve(RALL * 2 * 4);
    p.perm = (int*)carve((2 * RALL + Dm::E * Dm::MPAD) * 4);
    p.rrank = (int*)carve(RALL * 2 * 4); p.rpos = (int*)carve(RALL * 2 * 4); p.wgbase = (int*)carve(4096 * 16 * 4);
    { char* big = (char*)p.z; const size_t npos = 2 * RALL + Dm::E * Dm::MPAD;
      a.f.hxs = (bf16s*)big; p.hmid = (bf16s*)(big + al256(npos * D * 2));
      a.f.wt_gu = (bf16s*)((char*)d_out + al256(RALL * D * 2)); a.f.wt_d = a.f.wt_gu + (size_t)Dm::E * 1024 * D;
      if ((char*)(a.f.wt_d + (size_t)Dm::E * D * Dm::DE) > (char*)d_out + (size_t)out_size * 4 || (char*)p.hmid + al256(npos * Dm::DE * 2) > (char*)(p.yfn + RALL * Dm::CFN)) { fprintf(stderr, "kernel_launch: MoE overlay does not fit\n"); return; } }
    a.f.wt_in = (bf16s*)carve((size_t)Dm::ZW * D * 2);
    a.f.wt_out = (bf16s*)carve((size_t)D * D * 2);
    if (off > ws_size || n_in != 31) { fprintf(stderr, "kernel_launch: workspace too small (%zu needed, %zu given) or n_in %d != 31; nothing launched\n", off, ws_size, n_in); return; }
    static int grid = 0;
    if (grid == 0) {
        int dev = 0, cus = 0, per_cu = 0;
        hipGetDevice(&dev); hipDeviceGetAttribute(&cus, hipDeviceAttributeMultiprocessorCount, dev);
        if (hipFuncSetAttribute((const void*)mega, hipFuncAttributeMaxDynamicSharedMemorySize, LDS_BYTES) != hipSuccess) { fprintf(stderr, "kernel_launch: hipFuncSetAttribute failed\n"); grid = -1; return; }
        hipOccupancyMaxActiveBlocksPerMultiprocessor(&per_cu, (const void*)mega, NTHREADS, LDS_BYTES);
        (void)hipGetLastError();
        if (per_cu < 1) fprintf(stderr, "kernel_launch: occupancy query says %d blocks per CU\n", per_cu);
        grid = cus > 0 ? cus : 256;
    }
    if (grid < 0) return;
    hipMemsetAsync(ctl, 0, 65536, stream);
#if ONE_LAUNCH
    a.lo = 0; a.hi = NPH;
    hipLaunchKernelGGL(mega, dim3(grid), dim3(NTHREADS), LDS_BYTES, stream, a);
#else
    for (int k = 0; k < NPH; ++k) { a.lo = k; a.hi = k + 1; hipLaunchKernelGGL(mega, dim3(grid), dim3(NTHREADS), LDS_BYTES, stream, a); }
#endif
}
```
